# Optimizing an MI355X kernel written in HIP

```python
import math
import jax, jax.numpy as jnp
from jax import lax
import numpy as np

D_MODEL = 1024
BATCH = 4
SEQ = 8192
DEPTH = 1

CHUNK = 64
Q_BLOCK = 128
EPS = 1e-6
D_FF = 2816
A_HEADS = 8
A_HEAD_DIM = 64
A_Q_W = A_HEADS * A_HEAD_DIM
IDX_HEADS = 8
IDX_DIM = 64
TOPK_MAX = 256
B_HEADS = 8
QK_NOPE = 64
QK_ROPE = 32
V_DIM = 64
Q_LORA = 384
KV_LORA = 256
B_V_W = B_HEADS * V_DIM
ROPE_THETA = 10000.0
NUM_BUCKETS = 32
MAX_DISTANCE = 128
IN_SIZES = (A_Q_W, A_HEAD_DIM, A_HEAD_DIM, IDX_HEADS * IDX_DIM, IDX_DIM, IDX_HEADS,
            Q_LORA, KV_LORA, QK_ROPE, 2 * D_MODEL)
IN_COLS = sum(IN_SIZES)
N_ADA = 9

kernel_name = "hybrid_dsa_mla_macaron_block"


def rmsnorm(x, g):
    xf = x.astype(jnp.float32)
    y = xf * lax.rsqrt(jnp.mean(xf * xf, axis=-1, keepdims=True) + EPS)
    return (y * g.astype(jnp.float32)).astype(x.dtype)


def modulate(h, shift, scale):
    return h * (1 + scale[:, None, :]) + shift[:, None, :]


def swiglu(h, w_in, w_down):
    g, u = jnp.split(h @ w_in, 2, axis=-1)
    return (jax.nn.silu(g) * u) @ w_down


def rope_angles(positions):
    half = QK_ROPE // 2
    freqs = ROPE_THETA ** (-2.0 * jnp.arange(half, dtype=jnp.float32) / QK_ROPE)
    ang = positions.astype(jnp.float32)[..., None] * freqs
    return jnp.cos(ang), jnp.sin(ang)


def apply_rope(x, cos, sin):
    cos = cos.astype(x.dtype)
    sin = sin.astype(x.dtype)
    x1, x2 = jnp.split(x, 2, axis=-1)
    return jnp.concatenate([x1 * cos - x2 * sin, x2 * cos + x1 * sin], axis=-1)


def t5_bucket(rel):
    half = NUM_BUCKETS // 2
    max_exact = half // 2
    ret = jnp.where(rel > 0, half, 0)
    n = jnp.abs(rel)
    nf = jnp.maximum(n, 1).astype(jnp.float32)
    large = max_exact + (jnp.log(nf / max_exact) / math.log(MAX_DISTANCE / max_exact)
                         * (half - max_exact)).astype(jnp.int32)
    large = jnp.minimum(large, half - 1)
    return ret + jnp.where(n < max_exact, n, large)


def to_blocks(a, nb):
    return jnp.swapaxes(a.reshape(a.shape[0], nb, Q_BLOCK, *a.shape[2:]), 0, 1)


def from_blocks(o):
    o = jnp.swapaxes(o, 0, 1)
    return o.reshape(o.shape[0], o.shape[1] * o.shape[2], -1)


def block_limit(t0):
    tq = t0 + jnp.arange(Q_BLOCK, dtype=jnp.int32)
    return (tq // CHUNK + 1) * CHUNK


def dsa_attention(q_a, k_a, v_a, q_idx, k_idx, w_idx, positions, rel_bias, topk):
    B, S = q_a.shape[0], q_a.shape[1]
    nb = S // Q_BLOCK
    key_ids = jnp.arange(S, dtype=jnp.int32)
    gather = jax.vmap(lambda a, i: a[i])
    idx_scale = IDX_DIM ** -0.5
    head_w_scale = IDX_HEADS ** -0.5
    attn_scale = A_HEAD_DIM ** -0.5
    k_idx_f = k_idx.astype(jnp.float32)

    def body(args):
        q_b, qi_b, wi_b, qpos_b, t0 = args
        limit = block_limit(t0)
        dots = jnp.einsum('bqhd,bsd->bqhs', qi_b.astype(jnp.float32), k_idx_f) * idx_scale
        score = jnp.einsum('bqh,bqhs->bqs', wi_b.astype(jnp.float32) * head_w_scale,
                           jax.nn.relu(dots))
        admissible = key_ids[None, :] < limit[:, None]
        score = jnp.where(admissible[None], score, -jnp.inf)
        _, sel = lax.top_k(score, topk)
        valid = sel < limit[None, :, None]
        k_sel = gather(k_a, sel)
        v_sel = gather(v_a, sel)
        pos_sel = gather(positions, sel)
        bias = rel_bias[t5_bucket(pos_sel - qpos_b[..., None])]
        s = jnp.einsum('bqhd,bqkd->bqhk', q_b, k_sel).astype(jnp.float32) * attn_scale
        s = s + jnp.moveaxis(bias, -1, 2).astype(jnp.float32)
        s = jnp.where(valid[:, :, None, :], s, -jnp.inf)
        p = jax.nn.softmax(s, axis=-1).astype(v_sel.dtype)
        return jnp.einsum('bqhk,bqkd->bqhd', p, v_sel)

    t0s = jnp.arange(nb, dtype=jnp.int32) * Q_BLOCK
    o = lax.map(body, (to_blocks(q_a, nb), to_blocks(q_idx, nb), to_blocks(w_idx, nb),
                       to_blocks(positions, nb), t0s))
    return from_blocks(o)


def mla_attention(q_nope, q_pe, k_nope, k_pe, v):
    S = q_nope.shape[1]
    nb = S // Q_BLOCK
    key_ids = jnp.arange(S, dtype=jnp.int32)
    scale = (QK_NOPE + QK_ROPE) ** -0.5

    def body(args):
        qn, qp, t0 = args
        limit = block_limit(t0)
        s = (jnp.einsum('bqhd,bshd->bhqs', qn, k_nope)
             + jnp.einsum('bqhr,bsr->bhqs', qp, k_pe)).astype(jnp.float32) * scale
        mask = key_ids[None, :] < limit[:, None]
        s = jnp.where(mask[None, None], s, -jnp.inf)
        p = jax.nn.softmax(s, axis=-1).astype(v.dtype)
        return jnp.einsum('bhqs,bshd->bqhd', p, v)

    t0s = jnp.arange(nb, dtype=jnp.int32) * Q_BLOCK
    o = lax.map(body, (to_blocks(q_nope, nb), to_blocks(q_pe, nb), t0s))
    return from_blocks(o)


def setup_inputs(seed: int = 0) -> dict:
    key = jax.random.key(seed)
    ks = jax.random.split(key, 32)
    f32 = jnp.float32

    def nrm(k, shape, fan_in, mult=1.0):
        return jax.random.normal(k, shape, f32) * (mult * fan_in ** -0.5)

    def gain(k, shape):
        return 1.0 + 0.05 * jax.random.normal(k, shape, f32)

    x = jax.random.normal(ks[0], (BATCH, SEQ, D_MODEL), f32)
    c = jax.random.normal(ks[1], (BATCH, D_MODEL), f32)
    start = jax.random.randint(ks[2], (BATCH, 1), 0, 4096, dtype=jnp.int32)
    positions = start + jnp.arange(SEQ, dtype=jnp.int32)[None, :]
    L = DEPTH
    return {
        "x": x,
        "c": c,
        "positions": positions,
        "w_ada": nrm(ks[3], (L, D_MODEL, N_ADA * D_MODEL), D_MODEL, 0.5),
        "b_ada": 0.02 * jax.random.normal(ks[4], (L, N_ADA * D_MODEL), f32),
        "g_ffn1": gain(ks[5], (L, D_MODEL)),
        "w_ffn1_in": nrm(ks[6], (L, D_MODEL, 2 * D_FF), D_MODEL),
        "w_ffn1_down": nrm(ks[7], (L, D_FF, D_MODEL), D_FF),
        "g_mix": gain(ks[8], (L, D_MODEL)),
        "w_in": nrm(ks[9], (L, D_MODEL, IN_COLS), D_MODEL),
        "g_cq": gain(ks[10], (L, Q_LORA)),
        "w_uq": nrm(ks[11], (L, Q_LORA, B_HEADS * (QK_NOPE + QK_ROPE)), Q_LORA),
        "g_ckv": gain(ks[12], (L, KV_LORA)),
        "w_uk": nrm(ks[13], (L, KV_LORA, B_HEADS * QK_NOPE), KV_LORA),
        "w_uv": nrm(ks[14], (L, KV_LORA, B_HEADS * V_DIM), KV_LORA),
        "rel_bias": 0.5 * jax.random.normal(ks[15], (NUM_BUCKETS, A_HEADS), f32),
        "w_o_a": nrm(ks[16], (L, A_Q_W, D_MODEL), A_Q_W),
        "w_o_b": nrm(ks[17], (L, B_V_W, D_MODEL), B_V_W),
        "w_out": nrm(ks[18], (L, D_MODEL, D_MODEL), D_MODEL),
        "g_ffn2": gain(ks[19], (L, D_MODEL)),
        "w_ffn2_in": nrm(ks[20], (L, D_MODEL, 2 * D_FF), D_MODEL),
        "w_ffn2_down": nrm(ks[21], (L, D_FF, D_MODEL), D_FF),
        "g_final": gain(ks[22], (D_MODEL,)),
    }


def reference(x, c, positions, w_ada, b_ada, g_ffn1, w_ffn1_in, w_ffn1_down, g_mix, w_in,
              g_cq, w_uq, g_ckv, w_uk, w_uv, rel_bias, w_o_a, w_o_b, w_out,
              g_ffn2, w_ffn2_in, w_ffn2_down, g_final):
    B, S, _ = x.shape
    topk = min(TOPK_MAX, S // 4)
    offsets = []
    acc = 0
    for n in IN_SIZES[:-1]:
        acc += n
        offsets.append(acc)
    cos, sin = rope_angles(positions)

    for l in range(DEPTH):
        mod = jax.nn.silu(c) @ w_ada[l] + b_ada[l]
        sh1, sc1, gt1, sh2, sc2, gt2, sh3, sc3, gt3 = jnp.split(mod, N_ADA, axis=-1)

        h = modulate(rmsnorm(x, g_ffn1[l]), sh1, sc1)
        x = x + 0.5 * gt1[:, None, :] * swiglu(h, w_ffn1_in[l], w_ffn1_down[l])

        h = modulate(rmsnorm(x, g_mix[l]), sh2, sc2)
        proj = h @ w_in[l]
        (q_a, k_a, v_a, q_idx, k_idx, w_idx, c_q, c_kv, k_rope,
         gate_logits) = jnp.split(proj, offsets, axis=-1)

        o_a = dsa_attention(q_a.reshape(B, S, A_HEADS, A_HEAD_DIM), k_a, v_a,
                            q_idx.reshape(B, S, IDX_HEADS, IDX_DIM), k_idx, w_idx,
                            positions, rel_bias, topk)

        q_b = (rmsnorm(c_q, g_cq[l]) @ w_uq[l]).reshape(B, S, B_HEADS, QK_NOPE + QK_ROPE)
        q_nope, q_pe = jnp.split(q_b, [QK_NOPE], axis=-1)
        c_kv_n = rmsnorm(c_kv, g_ckv[l])
        k_nope = (c_kv_n @ w_uk[l]).reshape(B, S, B_HEADS, QK_NOPE)
        v_b = (c_kv_n @ w_uv[l]).reshape(B, S, B_HEADS, V_DIM)
        q_pe = apply_rope(q_pe, cos[:, :, None, :], sin[:, :, None, :])
        k_pe = apply_rope(k_rope, cos, sin)
        o_b = mla_attention(q_nope, q_pe, k_nope, k_pe, v_b)

        g_a, g_b = jnp.split(jax.nn.sigmoid(gate_logits), 2, axis=-1)
        y = g_a * (o_a @ w_o_a[l]) + g_b * (o_b @ w_o_b[l])
        x = x + gt2[:, None, :] * (y @ w_out[l])

        h = modulate(rmsnorm(x, g_ffn2[l]), sh3, sc3)
        x = x + 0.5 * gt3[:, None, :] * swiglu(h, w_ffn2_in[l], w_ffn2_down[l])

    return rmsnorm(x, g_final)
```

```cpp
#include <hip/hip_runtime.h>
#include <cstdio>
#include <cstdint>
namespace pg8 {
#define PG8_LAS __attribute__((address_space(3)))
typedef unsigned short bf16_t;
typedef short bf16x8 __attribute__((ext_vector_type(8)));
typedef float f32x4 __attribute__((ext_vector_type(4)));
typedef unsigned u32x4 __attribute__((ext_vector_type(4)));
constexpr int BM = 256, BK = 64, HALF = 128, HTB = HALF * BK * 2  , STAGE_BYTES = 8 * HTB, NXCD = 8, WGM = 8;

__host__ __device__ __forceinline__ int lds_byte(int r, int c) { const int st = (r >> 4) * 2 + (c >> 5), rr = r & 15, cc = c & 31, ob = rr * 64 + cc * 2; return st * 1024 + (ob ^ (((ob >> 9) & 1) << 5)); }
__host__ __device__ __forceinline__ void stage_rc(int b, int& R, int& C) { const int st = b / 1024, sb = b % 1024, swz = sb ^ (((sb >> 9) & 1) << 5); R = (st >> 1) * 16 + swz / 64; C = (st & 1) * 32 + (swz % 64) / 2; }
__host__ __device__ __forceinline__ int perm32(int rho) { const int n = rho >> 4, i = rho & 15; return 8 * (i >> 2) + 4 * n + (i & 3); }

struct Unit { int pm, pn; };
struct Gemm { const bf16_t* A; const bf16_t* Bt; int M, N, K; };

struct StaticOrder {
    int nM, nN, nwg, G, c;
    __host__ __device__ void init(int M, int N, int G_, int c_) { nM = M / BM; nN = N / BM; nwg = nM * nN; G = G_; c = c_; }
    __host__ __device__ bool next(int i, Unit& u) const {
        const long L = (long)i * G + c; if (L >= nwg) return false;
        int wgid = (int)L; { const int q = nwg / NXCD, r = nwg % NXCD, xcd = wgid % NXCD, off = wgid / NXCD; wgid = (xcd < r ? xcd * (q + 1) : r * (q + 1) + (xcd - r) * q) + off; }
        const int nig = WGM * nN, gid = wgid / nig, fm = gid * WGM, gsz = (nM - fm) < WGM ? (nM - fm) : WGM;
        u.pm = fm + ((wgid % nig) % gsz); u.pn = (wgid % nig) / gsz; return true;
    }
    __device__ __forceinline__ void a_ready(const Unit&) const {}
    __device__ __forceinline__ void done(const Unit&) const {}
};

typedef float f32x2 __attribute__((ext_vector_type(2)));
typedef __bf16 bf16x2_cv __attribute__((ext_vector_type(2)));
__device__ __forceinline__ unsigned cvt_pk_bf16(float lo, float hi) { const f32x2 v = {lo, hi}; const bf16x2_cv b = __builtin_convertvector(v, bf16x2_cv); return __builtin_bit_cast(unsigned, b); }

__device__ __forceinline__ u32x4 pack8(const f32x4 a, const f32x4 b) { u32x4 w; w.x = cvt_pk_bf16(a[0], a[1]); w.y = cvt_pk_bf16(a[2], a[3]); w.z = cvt_pk_bf16(b[0], b[1]); w.w = cvt_pk_bf16(b[2], b[3]); return w; }
__device__ __forceinline__ float sigm(float v) { return __builtin_amdgcn_rcpf(1.f + __builtin_amdgcn_exp2f(-1.4426950408889634f * v)); }
__device__ __forceinline__ f32x4 sigm4(const f32x4 v) { return (f32x4){sigm(v[0]), sigm(v[1]), sigm(v[2]), sigm(v[3])}; }
__device__ __forceinline__ void unpack8(const u32x4 w, f32x4& a, f32x4& b) {
    a = (f32x4){__uint_as_float(w.x << 16), __uint_as_float(w.x & 0xffff0000u), __uint_as_float(w.y << 16), __uint_as_float(w.y & 0xffff0000u)};
    b = (f32x4){__uint_as_float(w.z << 16), __uint_as_float(w.z & 0xffff0000u), __uint_as_float(w.w << 16), __uint_as_float(w.w & 0xffff0000u)}; }
constexpr float EPS_RMS = 1e-6f;
constexpr float QSCALE = 0.10206207261596575f * 1.4426950408889634f;

struct EpiSwiglu {
    static constexpr bool PERM = true, AFTER_DRAIN = false;
    bf16_t* O; int ldc;
    __device__ __forceinline__ void operator()(const f32x4 (&acc)[2][2][4][2], const Unit& u, int wr, int wc, int fr, int fq) const {
        const int row0 = u.pm * BM + wr * 64 + fr, col0 = u.pn * HALF + wc * 32 + 8 * fq;
#pragma unroll
        for (int ai = 0; ai < 2; ++ai)
#pragma unroll
            for (int m = 0; m < 4; ++m) {
                const f32x4 g0 = acc[ai][0][m][0], g1 = acc[ai][0][m][1], u0 = acc[ai][1][m][0], u1 = acc[ai][1][m][1];
                const f32x4 v0 = g0 * sigm4(g0) * u0, v1 = g1 * sigm4(g1) * u1;
                *(u32x4*)(O + (size_t)(row0 + ai * HALF + m * 16) * ldc + col0) = pack8(v0, v1); }
    }
};
struct EpiResid {
    static constexpr bool PERM = false, AFTER_DRAIN = false;
    const float* base; float* out; const float* mod; int goff; float scale;
    __device__ __forceinline__ void operator()(const f32x4 (&acc)[2][2][4][2], const Unit& u, int wr, int wc, int fr, int fq) const {
        const float* gate = mod + (u.pm >> 5) * 9216 + goff;
        const int col0 = u.pn * BM + wc * 32 + 4 * fq;
        f32x4 gv[2][2];
#pragma unroll
        for (int bj = 0; bj < 2; ++bj)
#pragma unroll
            for (int n = 0; n < 2; ++n) gv[bj][n] = *(const f32x4*)(gate + col0 + bj * HALF + n * 16) * scale;
#pragma unroll
        for (int ai = 0; ai < 2; ++ai)
#pragma unroll
            for (int m = 0; m < 4; ++m) { const size_t off = (size_t)(u.pm * BM + ai * HALF + wr * 64 + m * 16 + fr) * 1024 + col0;
#pragma unroll
                for (int bj = 0; bj < 2; ++bj)
#pragma unroll
                    for (int n = 0; n < 2; ++n) { const f32x4 bs = *(const f32x4*)(base + off + bj * HALF + n * 16); *(f32x4*)(out + off + bj * HALF + n * 16) = bs + gv[bj][n] * acc[ai][bj][m][n]; } }
    }
};
struct EpiProj {
    static constexpr bool PERM = true, AFTER_DRAIN = false;
    bf16_t *QA, *QI, *CQ, *CKV, *KA, *VA, *KI, *KPE, *G; float *WI, *ssq_q, *ssq_kv; const float *rcos, *rsin;
    __device__ __forceinline__ void operator()(const f32x4 (&acc)[2][2][4][2], const Unit& u, int wr, int wc, int fr, int fq) const {
        const int row0 = u.pm * BM + wr * 64 + fr, pn = u.pn, c32 = wc * 32 + 8 * fq;
#pragma unroll
        for (int ai = 0; ai < 2; ++ai)
#pragma unroll
            for (int m = 0; m < 4; ++m) {
                const size_t r = (size_t)(row0 + ai * HALF + m * 16);
                const f32x4 a0 = acc[ai][0][m][0], a1 = acc[ai][0][m][1], b0 = acc[ai][1][m][0], b1 = acc[ai][1][m][1];
                const float sa = (a0[0] * a0[0] + a0[1] * a0[1]) + (a0[2] * a0[2] + a0[3] * a0[3]) + (a1[0] * a1[0] + a1[1] * a1[1]) + (a1[2] * a1[2] + a1[3] * a1[3]);
                const float sb = (b0[0] * b0[0] + b0[1] * b0[1]) + (b0[2] * b0[2] + b0[3] * b0[3]) + (b1[0] * b1[0] + b1[1] * b1[1]) + (b1[2] * b1[2] + b1[3] * b1[3]);
                if (pn < 2) { bf16_t* p = QA + r * 512 + pn * 256 + c32; *(u32x4*)p = pack8(a0, a1); *(u32x4*)(p + HALF) = pack8(b0, b1); }
                else if (pn < 4) { bf16_t* p = QI + r * 512 + (pn - 2) * 256 + c32; *(u32x4*)p = pack8(a0, a1); *(u32x4*)(p + HALF) = pack8(b0, b1); }
                else if (pn == 4) { bf16_t* p = CQ + r * 384 + c32; *(u32x4*)p = pack8(a0, a1); *(u32x4*)(p + HALF) = pack8(b0, b1);
                    float s = sa + sb; s += __shfl_xor(s, 16); s += __shfl_xor(s, 32); if (fq == 0) ssq_q[r * 8 + wc] = s; }
                else if (pn == 5) { *(u32x4*)(CQ + r * 384 + 256 + c32) = pack8(a0, a1); *(u32x4*)(CKV + r * 256 + c32) = pack8(b0, b1);
                    float s = sa; s += __shfl_xor(s, 16); s += __shfl_xor(s, 32); float t = sb; t += __shfl_xor(t, 16); t += __shfl_xor(t, 32);
                    if (fq == 0) { ssq_q[r * 8 + 4 + wc] = s; ssq_kv[r * 8 + wc] = t; } }
                else if (pn == 6) { *(u32x4*)(CKV + r * 256 + 128 + c32) = pack8(a0, a1);
                    float s = sa; s += __shfl_xor(s, 16); s += __shfl_xor(s, 32); if (fq == 0) ssq_kv[r * 8 + 4 + wc] = s;
                    if (wc < 2) *(u32x4*)(KA + r * 64 + c32) = pack8(b0, b1); else *(u32x4*)(VA + r * 64 + (c32 - 64)) = pack8(b0, b1); }
                else if (pn == 7) {
                    if (wc < 2) *(u32x4*)(KI + r * 64 + c32) = pack8(a0, a1);
                    else if (wc == 2) {
                        const f32x4 c4 = *(const f32x4*)(rcos + r * 16 + 4 * fq), s4 = *(const f32x4*)(rsin + r * 16 + 4 * fq);
                        const f32x4 o0 = (f32x4){a0[0] * c4[0] - a0[1] * s4[0], a0[1] * c4[0] + a0[0] * s4[0], a0[2] * c4[1] - a0[3] * s4[1], a0[3] * c4[1] + a0[2] * s4[1]};
                        const f32x4 o1 = (f32x4){a1[0] * c4[2] - a1[1] * s4[2], a1[1] * c4[2] + a1[0] * s4[2], a1[2] * c4[3] - a1[3] * s4[3], a1[3] * c4[3] + a1[2] * s4[3]};
                        *(u32x4*)(KPE + r * 32 + 8 * fq) = pack8(o0, o1); }
                    else if (fq == 0) { *(f32x4*)(WI + r * 8) = a0; *(f32x4*)(WI + r * 8 + 4) = a1; }
                }
                else { bf16_t* p = G + r * 2048 + (pn - 8) * 256 + c32; *(u32x4*)p = pack8(sigm4(a0), sigm4(a1)); *(u32x4*)(p + HALF) = pack8(sigm4(b0), sigm4(b1)); }
            }
    }
};
struct EpiUpQ {
    static constexpr bool PERM = true, AFTER_DRAIN = false;
    bf16_t* QB; const float* ssq; const float *rcos, *rsin;
    __device__ __forceinline__ void operator()(const f32x4 (&acc)[2][2][4][2], const Unit& u, int wr, int wc, int fr, int fq) const {
        const int row0 = u.pm * BM + wr * 64 + fr;
#pragma unroll
        for (int ai = 0; ai < 2; ++ai)
#pragma unroll
            for (int m = 0; m < 4; ++m) {
                const size_t r = (size_t)(row0 + ai * HALF + m * 16);
                const f32x4 pa = *(const f32x4*)(ssq + r * 8), pb = *(const f32x4*)(ssq + r * 8 + 4);
                const float rs = __builtin_amdgcn_rsqf((((pa[0] + pa[1]) + (pa[2] + pa[3])) + ((pb[0] + pb[1]) + (pb[2] + pb[3]))) * (1.f / 384.f) + EPS_RMS) * QSCALE;
#pragma unroll
                for (int bj = 0; bj < 2; ++bj) {
                    const int c = u.pn * BM + bj * HALF + wc * 32 + 8 * fq;
                    const bool pe = ((u.pn * 8 + bj * 4 + wc) % 3) == 2;
                    f32x4 v0 = acc[ai][bj][m][0] * rs, v1 = acc[ai][bj][m][1] * rs;
                    if (pe) { const int i0 = 4 * fq;
                        const f32x4 c4 = *(const f32x4*)(rcos + r * 16 + i0), s4 = *(const f32x4*)(rsin + r * 16 + i0);
                        const f32x4 o0 = (f32x4){v0[0] * c4[0] - v0[1] * s4[0], v0[1] * c4[0] + v0[0] * s4[0], v0[2] * c4[1] - v0[3] * s4[1], v0[3] * c4[1] + v0[2] * s4[1]};
                        const f32x4 o1 = (f32x4){v1[0] * c4[2] - v1[1] * s4[2], v1[1] * c4[2] + v1[0] * s4[2], v1[2] * c4[3] - v1[3] * s4[3], v1[3] * c4[3] + v1[2] * s4[3]};
                        v0 = o0; v1 = o1; }
                    *(u32x4*)(QB + r * 768 + c) = pack8(v0, v1); }
                asm volatile("" ::: "memory"); }
    }
};
struct EpiUpKV {
    static constexpr bool PERM = true, AFTER_DRAIN = false;
    bf16_t *KN, *VB; const float* ssq;
    __device__ __forceinline__ void operator()(const f32x4 (&acc)[2][2][4][2], const Unit& u, int wr, int wc, int fr, int fq) const {
        const int row0 = u.pm * BM + wr * 64 + fr; bf16_t* dst = (u.pn < 2) ? KN : VB; const int c0 = (u.pn & 1) * BM + wc * 32 + 8 * fq;
#pragma unroll
        for (int ai = 0; ai < 2; ++ai)
#pragma unroll
            for (int m = 0; m < 4; ++m) {
                const size_t r = (size_t)(row0 + ai * HALF + m * 16);
                const f32x4 pa = *(const f32x4*)(ssq + r * 8), pb = *(const f32x4*)(ssq + r * 8 + 4);
                const float rs = __builtin_amdgcn_rsqf((((pa[0] + pa[1]) + (pa[2] + pa[3])) + ((pb[0] + pb[1]) + (pb[2] + pb[3]))) * (1.f / 256.f) + EPS_RMS);
#pragma unroll
                for (int bj = 0; bj < 2; ++bj) *(u32x4*)(dst + r * 512 + c0 + bj * HALF) = pack8(acc[ai][bj][m][0] * rs, acc[ai][bj][m][1] * rs);
                asm volatile("" ::: "memory"); }
    }
};
template <bool ADD> struct EpiGate {
    static constexpr bool PERM = true, AFTER_DRAIN = false;
    const bf16_t* G; int goff; const bf16_t* Yin; bf16_t* Y;
    __device__ __forceinline__ void operator()(const f32x4 (&acc)[2][2][4][2], const Unit& u, int wr, int wc, int fr, int fq) const {
        const int row0 = u.pm * BM + wr * 64 + fr, c0 = u.pn * BM + wc * 32 + 8 * fq;
#pragma unroll
        for (int ai = 0; ai < 2; ++ai)
#pragma unroll
            for (int m = 0; m < 4; ++m) {
                const size_t r = (size_t)(row0 + ai * HALF + m * 16);
#pragma unroll
                for (int bj = 0; bj < 2; ++bj) { const int c = c0 + bj * HALF;
                    f32x4 g0, g1; unpack8(*(const u32x4*)(G + r * 2048 + goff + c), g0, g1);
                    f32x4 v0 = g0 * acc[ai][bj][m][0], v1 = g1 * acc[ai][bj][m][1];
                    if (ADD) { f32x4 y0, y1; unpack8(*(const u32x4*)(Yin + r * 1024 + c), y0, y1); v0 += y0; v1 += y1; }
                    *(u32x4*)(Y + r * 1024 + c) = pack8(v0, v1); } }
    }
};

template <class Epi, class Sched, bool ALIGN_EPI = false, bool SP2 = false>
__device__ __forceinline__ void gemm_phase(PG8_LAS unsigned char* lds, const Gemm g, const Sched& S, const Epi& E) {
    const int tid = threadIdx.x, wid = __builtin_amdgcn_readfirstlane(tid >> 6), lane = tid & 63, wr = wid >> 2, wc = wid & 3, fr = lane & 15, fq = lane >> 4;
    const int K = g.K, nt = K / BK;
    unsigned voffA[2], voffB[2];
#pragma unroll
    for (int i = 0; i < 2; ++i) { int R, C; stage_rc(tid * 16 + i * 8192, R, C); const int Rb = Epi::PERM ? ((R & ~31) + perm32(R & 31)) : R;
        voffA[i] = (unsigned)(R * K + C) * 2u; voffB[i] = (unsigned)(Rb * K + C) * 2u; }
    const size_t kstep = (size_t)(BK * 2);
    const size_t hstep = (size_t)HALF * K * 2;
    const size_t tstep = 2 * hstep;
    const unsigned ldsw = (unsigned)wid * 1024u;
    const int aoff = lds_byte(wr * 64 + fr, fq * 8), boff = lds_byte(wc * 32 + fr, fq * 8);
#define PG8_SA(b, h) (((b) * 2 + (h)) * HTB)
#define PG8_SB(b, h) ((4 + (b) * 2 + (h)) * HTB)
#define PG8_STAGE(bufoff, gbase, voff) do { _Pragma("unroll") for (int _i = 0; _i < 2; ++_i) \
        __builtin_amdgcn_global_load_lds((const unsigned*)((const char*)(gbase) + (voff)[_i]), (PG8_LAS unsigned*)(lds + (bufoff) + ldsw + _i * 8192), 16, 0, 0); } while (0)
#define PG8_LDA(dst, b, h) do { _Pragma("unroll") for (int m = 0; m < 4; ++m) _Pragma("unroll") for (int k = 0; k < 2; ++k) dst[m][k] = *(const PG8_LAS bf16x8*)(lds + PG8_SA(b, h) + aoff + m * 2048 + k * 1024); } while (0)
#define PG8_LDB(dst, b, h) do { _Pragma("unroll") for (int n = 0; n < 2; ++n) _Pragma("unroll") for (int k = 0; k < 2; ++k) dst[n][k] = *(const PG8_LAS bf16x8*)(lds + PG8_SB(b, h) + boff + n * 2048 + k * 1024); } while (0)
#define PG8_MMA(ai, bj, At, Bt) do { __builtin_amdgcn_s_setprio(1); _Pragma("unroll") for (int m = 0; m < 4; ++m) _Pragma("unroll") for (int n = 0; n < 2; ++n) _Pragma("unroll") for (int k = 0; k < 2; ++k) \
        acc[ai][bj][m][n] = __builtin_amdgcn_mfma_f32_16x16x32_bf16(Bt[n][k], At[m][k], acc[ai][bj][m][n], 0, 0, 0); __builtin_amdgcn_s_setprio(0); } while (0)
#define PG8_WAIT_V(n) asm volatile("s_waitcnt vmcnt(" #n ")" ::: "memory")
#define PG8_WAIT_L(n) asm volatile("s_waitcnt lgkmcnt(" #n ")" ::: "memory")
#define PG8_BAR __builtin_amdgcn_s_barrier()
#define PG8_SCHED __builtin_amdgcn_sched_barrier(0)
    Unit cur, nxt; int ui = 0;
    if (!S.next(0, cur)) return;
    f32x4 acc[2][2][4][2];
#pragma unroll
    for (int a = 0; a < 2; ++a)
#pragma unroll
        for (int b = 0; b < 2; ++b)
#pragma unroll
            for (int m = 0; m < 4; ++m)
#pragma unroll
                for (int n = 0; n < 2; ++n) acc[a][b][m][n] = (f32x4){0.f, 0.f, 0.f, 0.f};
    bf16x8 At[4][2], B0[2][2], B1[2][2];
    const char* cA = (const char*)g.A + (size_t)cur.pm * tstep; const char* cB = (const char*)g.Bt + (size_t)cur.pn * tstep;
    S.a_ready(cur);
    if constexpr (SP2) {
        PG8_STAGE(PG8_SB(0, 0), cB, voffB); PG8_STAGE(PG8_SB(0, 1), cB + hstep, voffB); PG8_STAGE(PG8_SA(0, 0), cA, voffA); PG8_STAGE(PG8_SA(0, 1), cA + hstep, voffA);
        if (wr == 1) PG8_BAR;
        PG8_WAIT_V(2); PG8_BAR;
        PG8_STAGE(PG8_SB(1, 0), cB + kstep, voffB); PG8_STAGE(PG8_SA(1, 0), cA + kstep, voffA); PG8_STAGE(PG8_SB(1, 1), cB + hstep + kstep, voffB);
        PG8_WAIT_V(6); PG8_BAR;
    } else {
        PG8_STAGE(PG8_SB(0, 0), cB, voffB); PG8_STAGE(PG8_SA(0, 0), cA, voffA); PG8_STAGE(PG8_SB(0, 1), cB + hstep, voffB); PG8_STAGE(PG8_SA(0, 1), cA + hstep, voffA);
        if (wr == 1) PG8_BAR;
        PG8_WAIT_V(4); PG8_BAR;
        PG8_STAGE(PG8_SB(1, 0), cB + kstep, voffB); PG8_STAGE(PG8_SA(1, 0), cA + kstep, voffA); PG8_STAGE(PG8_SB(1, 1), cB + hstep + kstep, voffB);
        PG8_WAIT_V(6); PG8_BAR;
    }
    for (;;) {
        const bool has_next = S.next(ui + 1, nxt);
        const char* nA = has_next ? (const char*)g.A + (size_t)nxt.pm * tstep : cA; const char* nB = has_next ? (const char*)g.Bt + (size_t)nxt.pn * tstep : cB;
#pragma nounroll
        for (int t = 0; t < nt; t += 2) {
            const bool last = (t == nt - 2);
            const char* a1 = cA + (size_t)(t + 1) * kstep;
            const char* a2 = last ? nA : cA + (size_t)(t + 2) * kstep; const char* b2 = last ? nB : cB + (size_t)(t + 2) * kstep;
            const char* a3 = a2 + kstep; const char* b3 = b2 + kstep;
            if (last && has_next) S.a_ready(nxt);
            if constexpr (SP2) {
            PG8_LDB(B0, 0, 0); PG8_LDB(B1, 0, 1); PG8_SCHED; PG8_LDA(At, 0, 0); PG8_STAGE(PG8_SA(1, 1), a1 + hstep, voffA);
            PG8_WAIT_V(8); PG8_WAIT_L(0); PG8_BAR; PG8_MMA(0, 0, At, B0); PG8_MMA(0, 1, At, B1); PG8_BAR; PG8_SCHED;
            PG8_LDA(At, 0, 1); PG8_STAGE(PG8_SB(0, 0), b2, voffB); PG8_STAGE(PG8_SB(0, 1), b2 + hstep, voffB); PG8_STAGE(PG8_SA(0, 0), a2, voffA);
            PG8_WAIT_V(8); PG8_WAIT_L(0); PG8_BAR; PG8_MMA(1, 0, At, B0); PG8_MMA(1, 1, At, B1); PG8_BAR; PG8_SCHED;
            PG8_LDB(B0, 1, 0); PG8_LDB(B1, 1, 1); PG8_SCHED; PG8_LDA(At, 1, 0); PG8_STAGE(PG8_SA(0, 1), a2 + hstep, voffA);
            PG8_WAIT_V(8); PG8_WAIT_L(0); PG8_BAR; PG8_MMA(0, 0, At, B0); PG8_MMA(0, 1, At, B1); PG8_BAR; PG8_SCHED;
            PG8_LDA(At, 1, 1); PG8_STAGE(PG8_SB(1, 0), b3, voffB); PG8_STAGE(PG8_SB(1, 1), b3 + hstep, voffB); PG8_STAGE(PG8_SA(1, 0), a3, voffA);
            PG8_WAIT_V(8); PG8_WAIT_L(0); PG8_BAR; PG8_MMA(1, 0, At, B0); PG8_MMA(1, 1, At, B1); PG8_BAR; PG8_SCHED;
            } else {
            PG8_LDB(B0, 0, 0); PG8_SCHED; PG8_LDA(At, 0, 0); PG8_STAGE(PG8_SA(1, 1), a1 + hstep, voffA);
            PG8_WAIT_L(8); PG8_BAR; PG8_WAIT_L(0); PG8_MMA(0, 0, At, B0); PG8_BAR; PG8_SCHED;
            PG8_LDB(B1, 0, 1); PG8_STAGE(PG8_SB(0, 0), b2, voffB);
            PG8_BAR; PG8_WAIT_L(0); PG8_MMA(0, 1, At, B1); PG8_BAR;
            PG8_LDA(At, 0, 1); PG8_STAGE(PG8_SA(0, 0), a2, voffA);
            PG8_BAR; PG8_WAIT_L(0); PG8_MMA(1, 0, At, B0); PG8_BAR; PG8_SCHED;
            PG8_STAGE(PG8_SB(0, 1), b2 + hstep, voffB);
            PG8_WAIT_V(6); PG8_BAR; PG8_MMA(1, 1, At, B1); PG8_BAR;
            PG8_LDB(B0, 1, 0); PG8_SCHED; PG8_LDA(At, 1, 0); PG8_STAGE(PG8_SA(0, 1), a2 + hstep, voffA);
            PG8_WAIT_L(8); PG8_BAR; PG8_WAIT_L(0); PG8_MMA(0, 0, At, B0); PG8_BAR; PG8_SCHED;
            PG8_LDB(B1, 1, 1); PG8_STAGE(PG8_SB(1, 0), b3, voffB);
            PG8_BAR; PG8_WAIT_L(0); PG8_MMA(0, 1, At, B1); PG8_BAR;
            PG8_LDA(At, 1, 1); PG8_STAGE(PG8_SA(1, 0), a3, voffA);
            PG8_BAR; PG8_WAIT_L(0); PG8_MMA(1, 0, At, B0); PG8_BAR; PG8_SCHED;
            PG8_STAGE(PG8_SB(1, 1), b3 + hstep, voffB);
            PG8_WAIT_V(6); PG8_BAR; PG8_MMA(1, 1, At, B1); PG8_BAR;
            }
        }
        if constexpr (ALIGN_EPI) { if (wr == 0) PG8_BAR; }
        if constexpr (!Epi::AFTER_DRAIN) { E(acc, cur, wr, wc, fr, fq); S.done(cur); }
        if (!has_next) break;
#pragma unroll
        for (int a = 0; a < 2; ++a)
#pragma unroll
            for (int b = 0; b < 2; ++b)
#pragma unroll
                for (int m = 0; m < 4; ++m)
#pragma unroll
                    for (int n = 0; n < 2; ++n) acc[a][b][m][n] = (f32x4){0.f, 0.f, 0.f, 0.f};
        cur = nxt; cA = nA; cB = nB; ++ui;
        if constexpr (ALIGN_EPI) { if (wr == 1) PG8_BAR; }
    }
    PG8_WAIT_V(0);
    if constexpr (!ALIGN_EPI) { if (wr == 0) PG8_BAR; }
    PG8_BAR;
    if constexpr (Epi::AFTER_DRAIN) { E.fused(acc, cur, wr, wc, fr, fq, lds, wid, lane); S.done(cur); }
#undef PG8_SA
#undef PG8_SB
#undef PG8_STAGE
#undef PG8_LDA
#undef PG8_LDB
#undef PG8_MMA
#undef PG8_WAIT_V
#undef PG8_WAIT_L
#undef PG8_BAR
#undef PG8_SCHED
}
}

constexpr int NWAVES = 8;
constexpr int BATCH = 4, T = 8192, D = 1024, DFF = 2816, M = BATCH * T;
constexpr int INC = 3944, NPROJ = 4096;
constexpr int O_QA = 0, O_KA = 512, O_VA = 576, O_QI = 640, O_KI = 1152, O_WI = 1216, O_CQ = 1224, O_CKV = 1608, O_KR = 1864, O_GATE = 1896;
constexpr float EPS = 1e-6f;
#ifndef MK_FUSED
#define MK_FUSED 0
#endif

constexpr size_t MiB = 1u << 20;
constexpr size_t WS_CTL = 0, CTL_ZERO_BYTES = 2 * MiB;
constexpr size_t WS_MOD = 256 * 1024;
constexpr size_t WS_SSQQ = 49 * MiB, WS_SSQKV = 50 * MiB;
constexpr size_t WS_W1A = 2 * MiB, SZ_WA = (size_t)2 * DFF * D * 2, SZ_WD = (size_t)D * DFF * 2;
constexpr size_t WS_W1D = WS_W1A + SZ_WA, WS_WIN = WS_W1D + SZ_WD, WS_WUQ = WS_WIN + (size_t)NPROJ * D * 2, WS_WUKV = WS_WUQ + (size_t)768 * 384 * 2;
constexpr size_t WS_WOA = WS_WUKV + (size_t)1024 * 256 * 2, WS_WOB = WS_WOA + (size_t)D * 512 * 2, WS_WOUT = WS_WOB + (size_t)D * 512 * 2;
constexpr size_t WS_W2A = WS_WOUT + (size_t)D * D * 2, WS_W2D = WS_W2A + SZ_WA, WS_WEND = WS_W2D + SZ_WD;
static_assert(WS_WEND <= 49 * MiB, "weights");
constexpr size_t WS_RCOS = 51 * MiB, WS_RSIN = 53 * MiB;
constexpr size_t WS_XN = 55 * MiB;
constexpr size_t WS_ACT = 119 * MiB;
constexpr size_t WS_QA = WS_ACT, WS_QI = WS_QA + 32 * MiB, WS_CQ = WS_QI + 32 * MiB, WS_CKV = WS_CQ + 24 * MiB, WS_KA = WS_CKV + 16 * MiB, WS_VA = WS_KA + 4 * MiB;
constexpr size_t WS_KI = WS_VA + 4 * MiB, WS_KPE = WS_KI + 4 * MiB, WS_WI = WS_KPE + 2 * MiB, WS_QB = WS_WI + 1 * MiB, WS_MIXEND = WS_QB + 48 * MiB;
static_assert(WS_MIXEND <= WS_ACT + 176 * MiB, "mixer overlay");
constexpr size_t WS_G = 295 * MiB;
constexpr size_t WS_KN = 423 * MiB, WS_VB = 455 * MiB;
constexpr size_t WS_SEL = 487 * MiB;
constexpr size_t WS_END = 503 * MiB;
static_assert(WS_XN + 64 * MiB <= WS_ACT && WS_ACT + 176 * MiB <= WS_G && WS_G + 128 * MiB <= WS_KN && WS_VB + 32 * MiB <= WS_SEL, "d_ws map");
constexpr size_t WS_OA = WS_QA, WS_OB = WS_QI, WS_Y1 = WS_KN, WS_Y = WS_XN;
constexpr int CW_TMO = 0, CW_CODE = 1, CW_BAR = 4096;

constexpr int RING_OFF = 0, RING_BYTES = 131072;
constexpr int LDSCTL_OFF = RING_BYTES, MISC_OFF = LDSCTL_OFF + 320;
constexpr int LDS_BYTES = 147456;
#define GAS __attribute__((address_space(1)))
#define LAS __attribute__((address_space(3)))
typedef unsigned short bf16;
typedef unsigned v4u __attribute__((ext_vector_type(4)));
typedef float f32x4 __attribute__((ext_vector_type(4)));
typedef short bf16x8 __attribute__((ext_vector_type(8)));
typedef GAS unsigned gu32;
typedef GAS unsigned long long gu64;
#define RLX_AGENT __ATOMIC_RELAXED, __HIP_MEMORY_SCOPE_AGENT
#define LDS_WAIT() asm volatile("s_waitcnt lgkmcnt(0)" ::: "memory")
#define VM_WAIT() asm volatile("s_waitcnt vmcnt(0)" ::: "memory")
__device__ __forceinline__ unsigned long long rt() { return __builtin_amdgcn_s_memrealtime(); }
__device__ __forceinline__ unsigned f2bf(float f) { unsigned u = __builtin_bit_cast(unsigned, f); return (u + 0x7fffu + ((u >> 16) & 1u)) >> 16; }
__device__ __forceinline__ unsigned pk2(float lo, float hi) { return f2bf(lo) | (f2bf(hi) << 16); }

#define XB_TMO      128
#define XB_XCNT(j)  (256  + 64 * (j))
#define XB_XSUB(j)  (1280 + 64 * (j))
#define XB_XGEN(j)  (2304 + 64 * (j))
#define XB_TOP      3328
#define XB_TOPGEN   3392
#define XCD_BAR_WORDS 3456
#define XB_SPIN_CAP (1u << 18)

__device__ __forceinline__ unsigned xb_ld(unsigned* p)              { return __hip_atomic_load(p, __ATOMIC_RELAXED, __HIP_MEMORY_SCOPE_AGENT); }
__device__ __forceinline__ unsigned xb_add(unsigned* p, unsigned v) { return __hip_atomic_fetch_add(p, v, __ATOMIC_RELAXED, __HIP_MEMORY_SCOPE_AGENT); }
__device__ __forceinline__ unsigned xb_xcc_id() { return (unsigned)__builtin_amdgcn_s_getreg((3 << 11) | 20) & 0xFu; }
#define XB_SPIN(cond, bar) do { unsigned _sp = 0; while (cond) { __builtin_amdgcn_s_sleep(1); \
    if ((++_sp & 255u) == 0u) { if (xb_ld(&(bar)[XB_TMO])) break; if (_sp > XB_SPIN_CAP) { atomicAdd(&(bar)[XB_TMO], 1u); break; } } } } while (0)

struct XcdBarrier {
    unsigned* bar; unsigned x;
    volatile LAS unsigned* st;
};

__device__ __forceinline__ XcdBarrier xcd_barrier_post(unsigned* bar, volatile LAS unsigned* st) {
    XcdBarrier b; b.bar = bar; b.x = xb_xcc_id(); b.st = st;
    if (threadIdx.x == 0) (void)xb_add(&bar[XB_XCNT(b.x)], 1u);
    return b;
}
__device__ __forceinline__ void xcd_barrier_complete(unsigned* bar, unsigned x, unsigned& nloc, unsigned& nx) {
    const unsigned G = gridDim.x * gridDim.y * gridDim.z;
    unsigned sum, cnt, mine, sp = 0u;
    for (;;) {
        sum = 0u; cnt = 0u; mine = 0u;
#pragma unroll
        for (unsigned j = 0; j < 16; ++j) { const unsigned c = xb_ld(&bar[XB_XCNT(j)]); sum += c; cnt += (c > 0u) ? 1u : 0u; mine = (j == x) ? c : mine; }
        if (sum == G) break;
        __builtin_amdgcn_s_sleep(1);
        if ((++sp & 255u) == 0u) { if (xb_ld(&bar[XB_TMO])) break; if (sp > XB_SPIN_CAP) { atomicAdd(&bar[XB_TMO], 1u); break; } }
    }
    nloc = mine > 0u ? mine : 1u; nx = cnt > 0u ? cnt : 1u;
}

__device__ __forceinline__ void xcd_barrier(const XcdBarrier& b) {
    asm volatile("s_waitcnt vmcnt(0)" ::: "memory");
    __syncthreads();
    if (threadIdx.x == 0) {
        unsigned* bar = b.bar;
        __builtin_amdgcn_s_waitcnt(0);
        unsigned nloc = b.st[0], nx = b.st[1];
        if (nloc == 0u) { xcd_barrier_complete(bar, b.x, nloc, nx); b.st[0] = nloc; b.st[1] = nx; }
        const unsigned old = xb_add(&bar[XB_XSUB(b.x)], 1u);
        const unsigned gen = old / nloc;
        if (old + 1u == (gen + 1u) * nloc) {
            __builtin_amdgcn_fence(__ATOMIC_RELEASE, "agent");
            asm volatile("s_waitcnt vmcnt(0)" ::: "memory");
            const unsigned og = xb_add(&bar[XB_TOP], 1u);
            const unsigned tg = og / nx;
            if (og + 1u == (tg + 1u) * nx) xb_add(&bar[XB_TOPGEN], 1u);
            else XB_SPIN(xb_ld(&bar[XB_TOPGEN]) == tg, bar);
            __builtin_amdgcn_fence(__ATOMIC_ACQUIRE, "agent");
            xb_add(&bar[XB_XGEN(b.x)], 1u);
            asm volatile("s_waitcnt vmcnt(0)" ::: "memory");
        } else {
            XB_SPIN(xb_ld(&bar[XB_XGEN(b.x)]) == gen, bar);
            __builtin_amdgcn_fence(__ATOMIC_ACQUIRE, "agent");
            asm volatile("s_waitcnt vmcnt(0)" ::: "memory");
        }
    }
    __syncthreads();
}

struct Frame {
    LAS unsigned char* lds;
    volatile LAS unsigned* MISC;
    gu32* ctl;
    int tid, lane, wave;
    int vcu, G;
};
__device__ __forceinline__ float wave_sum(float v) {
#pragma unroll
    for (int o = 1; o < 64; o <<= 1) v += __shfl_xor(v, o);
    return v;
}
struct MapIdent { int off; __device__ __forceinline__ int src(int n) const { return n + off; } };
struct MapFfnIn { __device__ __forceinline__ int src(int n) const { const int pn = n >> 8, j = n & 255; return (j >> 7) * DFF + pn * 128 + (j & 127); } };
struct MapProj { __device__ __forceinline__ int src(int n) const { const int pn = n >> 8, j = n & 255;
    if (pn < 2) return O_QA + n; if (pn < 4) return O_QI + (n - 512); if (pn == 4) return O_CQ + j;
    if (pn == 5) return j < 128 ? O_CQ + 256 + j : O_CKV + (j - 128);
    if (pn == 6) return j < 128 ? O_CKV + 128 + j : (j < 192 ? O_KA + (j - 128) : O_VA + (j - 192));
    if (pn == 7) { if (j < 64) return O_KI + j; if (j < 96) { const int jj = j - 64; return O_KR + (jj >> 1) + 16 * (jj & 1); } if (j < 104) return O_WI + (j - 96); return -1; }
    return O_GATE + (n - 2048); } };
struct MapUq { __device__ __forceinline__ int src(int n) const { const int h = n / 96, w = n % 96; if (w < 64) return n; const int jj = w - 64; return h * 96 + 64 + (jj >> 1) + 16 * (jj & 1); } };
template <class Map> __device__ __forceinline__ void p0_transpose_item(const float* W, int K, int Nsrc, int nblk, const float* kscale, bf16* WT, const Map mp, LAS float* scr, int item, int lane) {
    const int kb = item / nblk, nb = item % nblk, k0 = 64 * kb, n0 = 32 * nb;
    const int sc = mp.src(n0 + (lane & 31));
#pragma unroll 8
    for (int i = 0; i < 32; ++i) { const int kk = 2 * i + (lane >> 5); float v = sc >= 0 ? W[(size_t)(k0 + kk) * Nsrc + sc] : 0.f; if (kscale) v *= kscale[k0 + kk]; scr[kk * 33 + (lane & 31)] = v; }
    LDS_WAIT(); asm volatile("" ::: "memory");
    const int c = lane & 7;
#pragma unroll
    for (int j = 0; j < 4; ++j) { const int n = (lane >> 3) + 8 * j; const LAS float* s = scr + (8 * c) * 33 + n;
        v4u o; o.x = pk2(s[0 * 33], s[1 * 33]); o.y = pk2(s[2 * 33], s[3 * 33]); o.z = pk2(s[4 * 33], s[5 * 33]); o.w = pk2(s[6 * 33], s[7 * 33]);
        *(GAS v4u*)(WT + (size_t)(n0 + n) * K + k0 + 8 * c) = o; }
    LDS_WAIT(); asm volatile("" ::: "memory");
}
struct Args { const void* in[23]; float* out; unsigned char* ws; int ph_lo, ph_hi, li, pad; };

__device__ __forceinline__ void p0_prologue(Frame& F, const Args& A) {
    LAS float* scr = (LAS float*)(F.lds + RING_OFF + F.wave * 16384);
    const int gw = F.vcu * NWAVES + F.wave, NGW = F.G * NWAVES;
    unsigned char* ws = A.ws;
    {
        const float* c = (const float*)A.in[1]; const float* w = (const float*)A.in[3]; const float* bias = (const float*)A.in[4]; float* mod = (float*)(ws + WS_MOD);
        for (int cg = F.vcu; cg < 144; cg += F.G) {
            const int n = cg * 64 + F.lane, k0 = F.wave * 128;
#pragma unroll
            for (int b = 0; b < 4; ++b)
#pragma unroll
                for (int h = 0; h < 2; ++h) { const float v = c[b * D + k0 + h * 64 + F.lane]; scr[b * 128 + h * 64 + F.lane] = v / (1.f + __expf(-v)); }
            LDS_WAIT(); asm volatile("" ::: "memory");
            float a0 = 0.f, a1 = 0.f, a2 = 0.f, a3 = 0.f;
#pragma unroll 8
            for (int k = 0; k < 128; ++k) { const float wv = w[(size_t)(k0 + k) * 9216 + n]; a0 += scr[k] * wv; a1 += scr[128 + k] * wv; a2 += scr[256 + k] * wv; a3 += scr[384 + k] * wv; }
            scr[1024 + F.lane] = a0; scr[1088 + F.lane] = a1; scr[1152 + F.lane] = a2; scr[1216 + F.lane] = a3;
            __syncthreads();
            if (F.wave < 4) { float t = bias[n];
#pragma unroll
                for (int ww = 0; ww < 8; ++ww) t += ((LAS float*)(F.lds + RING_OFF + ww * 16384))[1024 + F.wave * 64 + F.lane];
                mod[F.wave * 9216 + n] = t; }
            __syncthreads();
        }
    }
    {
        const float* w1a = (const float*)A.in[6]; const float* w1d = (const float*)A.in[7]; const float* win = (const float*)A.in[9]; const float* gcq = (const float*)A.in[10];
        const float* wuq = (const float*)A.in[11]; const float* gckv = (const float*)A.in[12]; const float* wuk = (const float*)A.in[13]; const float* wuv = (const float*)A.in[14];
        const float* woa = (const float*)A.in[16]; const float* wob = (const float*)A.in[17]; const float* wout = (const float*)A.in[18]; const float* w2a = (const float*)A.in[20]; const float* w2d = (const float*)A.in[21];
        constexpr int I_A = 16 * 176, I_D = 44 * 32, I_IN = 16 * 128, I_UQ = 6 * 24, I_UK = 4 * 16, I_O = 8 * 32, I_OUT = 16 * 32;
        constexpr int NITEMS = 2 * I_A + 2 * I_D + I_IN + I_UQ + 2 * I_UK + 2 * I_O + I_OUT;
        for (int it = gw; it < NITEMS; it += NGW) {
            int r = it;
            if (r < I_A) { p0_transpose_item(w1a, D, 2 * DFF, 176, nullptr, (bf16*)(ws + WS_W1A), MapFfnIn{}, scr, r, F.lane); continue; } r -= I_A;
            if (r < I_A) { p0_transpose_item(w2a, D, 2 * DFF, 176, nullptr, (bf16*)(ws + WS_W2A), MapFfnIn{}, scr, r, F.lane); continue; } r -= I_A;
            if (r < I_D) { p0_transpose_item(w1d, DFF, D, 32, nullptr, (bf16*)(ws + WS_W1D), MapIdent{0}, scr, r, F.lane); continue; } r -= I_D;
            if (r < I_D) { p0_transpose_item(w2d, DFF, D, 32, nullptr, (bf16*)(ws + WS_W2D), MapIdent{0}, scr, r, F.lane); continue; } r -= I_D;
            if (r < I_IN) { p0_transpose_item(win, D, INC, 128, nullptr, (bf16*)(ws + WS_WIN), MapProj{}, scr, r, F.lane); continue; } r -= I_IN;
            if (r < I_UQ) { p0_transpose_item(wuq, 384, 768, 24, gcq, (bf16*)(ws + WS_WUQ), MapUq{}, scr, r, F.lane); continue; } r -= I_UQ;
            if (r < I_UK) { p0_transpose_item(wuk, 256, 512, 16, gckv, (bf16*)(ws + WS_WUKV), MapIdent{0}, scr, r, F.lane); continue; } r -= I_UK;
            if (r < I_UK) { p0_transpose_item(wuv, 256, 512, 16, gckv, (bf16*)(ws + WS_WUKV) + (size_t)512 * 256, MapIdent{0}, scr, r, F.lane); continue; } r -= I_UK;
            if (r < I_O) { p0_transpose_item(woa, 512, D, 32, nullptr, (bf16*)(ws + WS_WOA), MapIdent{0}, scr, r, F.lane); continue; } r -= I_O;
            if (r < I_O) { p0_transpose_item(wob, 512, D, 32, nullptr, (bf16*)(ws + WS_WOB), MapIdent{0}, scr, r, F.lane); continue; } r -= I_O;
            p0_transpose_item(wout, D, D, 32, nullptr, (bf16*)(ws + WS_WOUT), MapIdent{0}, scr, r, F.lane);
        }
    }
    {
        const int* pos = (const int*)A.in[2]; float* rc = (float*)(ws + WS_RCOS); float* rs = (float*)(ws + WS_RSIN);
        for (int idx = gw * 64 + F.lane; idx < M * 16; idx += NGW * 64) { const int t = idx >> 4, i = idx & 15;
            const float freq = powf(10000.0f, -2.0f * (float)i / 32.0f); const float ang = (float)pos[t] * freq;
            rc[idx] = cosf(ang); rs[idx] = sinf(ang); }
    }
}
__device__ __forceinline__ void norm_mod_phase(Frame& F, const float* xin, const float* g, const float* mod, int shoff, int scoff, bf16* out) {
    const int gw = F.vcu * NWAVES + F.wave, NGW = F.G * NWAVES;
    for (int m = gw; m < M; m += NGW) {
        const int b = m >> 13;
        const GAS f32x4* xr = (const GAS f32x4*)(xin + (size_t)m * D) + F.lane;
        const GAS f32x4* g4 = (const GAS f32x4*)g + F.lane; const GAS f32x4* sc4 = (const GAS f32x4*)(mod + b * 9216 + scoff) + F.lane; const GAS f32x4* sh4 = (const GAS f32x4*)(mod + b * 9216 + shoff) + F.lane;
        f32x4 v[4]; float s = 0.f;
#pragma unroll
        for (int j = 0; j < 4; ++j) { v[j] = xr[64 * j]; s += (v[j].x * v[j].x + v[j].y * v[j].y) + (v[j].z * v[j].z + v[j].w * v[j].w); }
        const float rs = __builtin_amdgcn_rsqf(wave_sum(s) * (1.f / D) + EPS);
        GAS unsigned long long* o8 = (GAS unsigned long long*)(out + (size_t)m * D) + F.lane;
#pragma unroll
        for (int j = 0; j < 4; ++j) { const f32x4 o = v[j] * rs * g4[64 * j] * (sc4[64 * j] + 1.f) + sh4[64 * j];
            o8[64 * j] = (unsigned long long)pk2(o.x, o.y) | ((unsigned long long)pk2(o.z, o.w) << 32); }
    }
}
__device__ __forceinline__ void final_norm_phase(Frame& F, const float* xin, const float* g, float* out) {
    const int gw = F.vcu * NWAVES + F.wave, NGW = F.G * NWAVES;
    for (int m = gw; m < M; m += NGW) {
        const GAS f32x4* xr = (const GAS f32x4*)(xin + (size_t)m * D) + F.lane; const GAS f32x4* g4 = (const GAS f32x4*)g + F.lane;
        f32x4 v[4]; float s = 0.f;
#pragma unroll
        for (int j = 0; j < 4; ++j) { v[j] = xr[64 * j]; s += (v[j].x * v[j].x + v[j].y * v[j].y) + (v[j].z * v[j].z + v[j].w * v[j].w); }
        const float rs = __builtin_amdgcn_rsqf(wave_sum(s) * (1.f / D) + EPS);
        GAS f32x4* o4 = (GAS f32x4*)(out + (size_t)m * D) + F.lane;
#pragma unroll
        for (int j = 0; j < 4; ++j) o4[64 * j] = v[j] * rs * g4[64 * j];
    }
}

constexpr int NPHASE = 16;
__global__ void __launch_bounds__(NWAVES * 64, 2) mk_fwd(Args args) {
    extern __shared__ __attribute__((aligned(16))) unsigned char lds[];
    Frame F;
    F.lds = (LAS unsigned char*)lds;
    F.MISC = (volatile LAS unsigned*)(F.lds + MISC_OFF);
    F.tid = threadIdx.x; F.lane = F.tid & 63; F.wave = __builtin_amdgcn_readfirstlane(F.tid >> 6);
    F.G = gridDim.x; { const int bx = blockIdx.x; F.vcu = (F.G % 8 == 0) ? (bx % 8) * (F.G / 8) + bx / 8 : bx; }
    unsigned char* ws = args.ws;
    F.ctl = (gu32*)(ws + WS_CTL);
    for (int u = F.tid; u < (LDS_BYTES - LDSCTL_OFF) / 4; u += NWAVES * 64) ((LAS unsigned*)(F.lds + LDSCTL_OFF))[u] = 0u;
    __syncthreads();
    XcdBarrier bar; bar.bar = (unsigned*)(F.ctl + CW_BAR); bar.x = 0; bar.st = nullptr;
    if (MK_FUSED) bar = xcd_barrier_post((unsigned*)(F.ctl + CW_BAR), F.MISC + 8);
#define GRID_BAR() do { if (MK_FUSED) xcd_barrier(bar); } while (0)
    const int lo = args.ph_lo, hi = args.ph_hi;
#ifdef ONLY_PH
#define IN(k) ((k) == ONLY_PH && lo <= (k) && (k) < hi)
#else
#define IN(k) (lo <= (k) && (k) < hi)
#endif
#define BOTH(k) (IN(k) && IN((k) + 1))
    const float* x = (const float*)args.in[0];
    const float* mod = (const float*)(ws + WS_MOD);
    bf16* XN = (bf16*)(ws + WS_XN); bf16* ACT = (bf16*)(ws + WS_ACT);
    float* X1 = args.out;
    const float* rcos = (const float*)(ws + WS_RCOS); const float* rsin = (const float*)(ws + WS_RSIN);
    float* ssq_q = (float*)(ws + WS_SSQQ); float* ssq_kv = (float*)(ws + WS_SSQKV);

    if (IN(0)) { p0_prologue(F, args); if (BOTH(0)) GRID_BAR(); }
    if (IN(1)) { norm_mod_phase(F, x, (const float*)args.in[5], mod, 0 * D, 1 * D, XN); if (BOTH(1)) GRID_BAR(); }
    if (IN(2)) {
        pg8::Gemm g{XN, (const bf16*)(ws + WS_W1A), M, 2 * DFF, D}; pg8::StaticOrder S; S.init(M, 2 * DFF, F.G, (int)blockIdx.x);
        pg8::EpiSwiglu E{ACT, DFF};
        pg8::gemm_phase<pg8::EpiSwiglu, pg8::StaticOrder, true, true>(F.lds + RING_OFF, g, S, E);
        if (BOTH(2)) GRID_BAR(); }
    if (IN(3)) {
        pg8::Gemm g{ACT, (const bf16*)(ws + WS_W1D), M, D, DFF}; pg8::StaticOrder S; S.init(M, D, F.G, (int)blockIdx.x);
        pg8::EpiResid E{x, X1, mod, 2 * D, 0.5f};
        pg8::gemm_phase<pg8::EpiResid, pg8::StaticOrder, true, true>(F.lds + RING_OFF, g, S, E);
        if (BOTH(3)) GRID_BAR(); }
    if (IN(4)) { norm_mod_phase(F, X1, (const float*)args.in[8], mod, 3 * D, 4 * D, XN); if (BOTH(4)) GRID_BAR(); }
    if (IN(5)) {
        pg8::Gemm g{XN, (const bf16*)(ws + WS_WIN), M, NPROJ, D}; pg8::StaticOrder S; S.init(M, NPROJ, F.G, (int)blockIdx.x);
        pg8::EpiProj E{(bf16*)(ws + WS_QA), (bf16*)(ws + WS_QI), (bf16*)(ws + WS_CQ), (bf16*)(ws + WS_CKV), (bf16*)(ws + WS_KA), (bf16*)(ws + WS_VA), (bf16*)(ws + WS_KI), (bf16*)(ws + WS_KPE), (bf16*)(ws + WS_G),
                       (float*)(ws + WS_WI), ssq_q, ssq_kv, rcos, rsin};
        pg8::gemm_phase<pg8::EpiProj, pg8::StaticOrder, true, true>(F.lds + RING_OFF, g, S, E);
        if (BOTH(5)) GRID_BAR(); }
    if (IN(6)) {
#ifndef P6_NO_Q
        { pg8::Gemm g{(const bf16*)(ws + WS_CQ), (const bf16*)(ws + WS_WUQ), M, 768, 384}; pg8::StaticOrder S; S.init(M, 768, F.G, (int)blockIdx.x);
          pg8::EpiUpQ E{(bf16*)(ws + WS_QB), ssq_q, rcos, rsin};
          pg8::gemm_phase<pg8::EpiUpQ, pg8::StaticOrder, true, true>(F.lds + RING_OFF, g, S, E); }
#endif
        __syncthreads();
#ifndef P6_NO_KV
        { pg8::Gemm g{(const bf16*)(ws + WS_CKV), (const bf16*)(ws + WS_WUKV), M, 1024, 256}; pg8::StaticOrder S; S.init(M, 1024, F.G, (int)blockIdx.x);
          pg8::EpiUpKV E{(bf16*)(ws + WS_KN), (bf16*)(ws + WS_VB), ssq_kv};
          pg8::gemm_phase<pg8::EpiUpKV, pg8::StaticOrder, true, true>(F.lds + RING_OFF, g, S, E); }
#endif
        if (BOTH(6)) GRID_BAR(); }
    if (IN(10)) {
        { pg8::Gemm g{(const bf16*)(ws + WS_OA), (const bf16*)(ws + WS_WOA), M, D, 512}; pg8::StaticOrder S; S.init(M, D, F.G, (int)blockIdx.x);
#ifdef EXP_ONE_GATE
          pg8::EpiGate<false> E{(const bf16*)(ws + WS_G), 0, nullptr, (bf16*)(ws + WS_Y)};
#else
          pg8::EpiGate<false> E{(const bf16*)(ws + WS_G), 0, nullptr, (bf16*)(ws + WS_Y1)};
#endif
          pg8::gemm_phase<pg8::EpiGate<false>, pg8::StaticOrder, true, true>(F.lds + RING_OFF, g, S, E); }
        VM_WAIT(); __syncthreads();
#ifndef EXP_ONE_GATE
        { pg8::Gemm g{(const bf16*)(ws + WS_OB), (const bf16*)(ws + WS_WOB), M, D, 512}; pg8::StaticOrder S; S.init(M, D, F.G, (int)blockIdx.x);
          pg8::EpiGate<true> E{(const bf16*)(ws + WS_G), 1024, (const bf16*)(ws + WS_Y1), (bf16*)(ws + WS_Y)};
          pg8::gemm_phase<pg8::EpiGate<true>, pg8::StaticOrder, true, true>(F.lds + RING_OFF, g, S, E); }
#endif
        if (BOTH(10)) GRID_BAR(); }
    if (IN(11)) {
        pg8::Gemm g{(const bf16*)(ws + WS_Y), (const bf16*)(ws + WS_WOUT), M, D, D}; pg8::StaticOrder S; S.init(M, D, F.G, (int)blockIdx.x);
        pg8::EpiResid E{X1, X1, mod, 5 * D, 1.0f};
        pg8::gemm_phase<pg8::EpiResid, pg8::StaticOrder, true, true>(F.lds + RING_OFF, g, S, E);
        if (BOTH(11)) GRID_BAR(); }
    if (IN(12)) { norm_mod_phase(F, X1, (const float*)args.in[19], mod, 6 * D, 7 * D, XN); if (BOTH(12)) GRID_BAR(); }
    if (IN(13)) {
        pg8::Gemm g{XN, (const bf16*)(ws + WS_W2A), M, 2 * DFF, D}; pg8::StaticOrder S; S.init(M, 2 * DFF, F.G, (int)blockIdx.x);
        pg8::EpiSwiglu E{ACT, DFF};
        pg8::gemm_phase<pg8::EpiSwiglu, pg8::StaticOrder, true, true>(F.lds + RING_OFF, g, S, E);
        if (BOTH(13)) GRID_BAR(); }
    if (IN(14)) {
        pg8::Gemm g{ACT, (const bf16*)(ws + WS_W2D), M, D, DFF}; pg8::StaticOrder S; S.init(M, D, F.G, (int)blockIdx.x);
        pg8::EpiResid E{X1, X1, mod, 8 * D, 0.5f};
        pg8::gemm_phase<pg8::EpiResid, pg8::StaticOrder, true, true>(F.lds + RING_OFF, g, S, E);
        if (BOTH(14)) GRID_BAR(); }
    if (IN(15)) { final_norm_phase(F, X1, (const float*)args.in[22], args.out); }
#undef IN
#undef BOTH
}

__device__ __forceinline__ float bf2f(bf16 v) { return __uint_as_float((unsigned)v << 16); }
__device__ __forceinline__ int t5_bucket(int rel) {
    const int n = rel < 0 ? -rel : rel; const int r = rel > 0 ? 16 : 0;
    if (n < 8) return r + n;
    int lg = (31 - __clz(n * n)) - 6; if (n >= 128 || lg > 7) lg = 7;
    return r + 8 + lg;
}
__device__ __forceinline__ unsigned okey(float f) { const unsigned u = __float_as_uint(f); return (u & 0x80000000u) ? ~u : (u | 0x80000000u); }

__global__ void __launch_bounds__(256) k_dsa(const bf16* QI, const bf16* KI, const float* WI, const bf16* QA, const bf16* KA, const bf16* VA, const int* positions, const float* rel_bias, bf16* OA) {
    __shared__ float sc[T];
    __shared__ float qi[512];
    __shared__ float qa[512];
    __shared__ float wi[8];
    __shared__ unsigned hist[256];
    __shared__ int sel[256];
    __shared__ float pr[8][256];
    __shared__ float red[8][4];
    __shared__ unsigned sh_prefix, sh_need, sh_cnt;
    __shared__ unsigned tcnt[256];
    const int gq = blockIdx.x, b = gq >> 13, t = gq & (T - 1), tid = threadIdx.x;
    const size_t rb = (size_t)b * T;
    const int limit = (t / 64 + 1) * 64;
    for (int j = tid; j < 512; j += 256) { qi[j] = bf2f(QI[(size_t)gq * 512 + j]); qa[j] = bf2f(QA[(size_t)gq * 512 + j]); }
    if (tid < 8) wi[tid] = WI[(size_t)gq * 8 + tid] * 0.35355339059327373f;
    __syncthreads();
    int nvalid;
    if (limit <= 256) { sel[tid] = tid; nvalid = limit; __syncthreads(); }
    else {
        for (int s = tid; s < limit; s += 256) {
            const bf16* kr = KI + (rb + s) * 64;
            float kk[64];
#pragma unroll
            for (int d = 0; d < 64; ++d) kk[d] = bf2f(kr[d]);
            float score = 0.f;
            for (int h = 0; h < 8; ++h) { float dsum = 0.f;
#pragma unroll
                for (int d = 0; d < 64; ++d) dsum += qi[h * 64 + d] * kk[d];
                score += wi[h] * fmaxf(dsum * 0.125f, 0.f); }
            sc[s] = score;
        }
        __syncthreads();
        unsigned prefix = 0, need = 256;
        for (int pass = 0; pass < 4; ++pass) {
            const int shift = 24 - 8 * pass;
            hist[tid] = 0; __syncthreads();
            for (int s = tid; s < limit; s += 256) { const unsigned k = okey(sc[s]);
                if (pass == 0 || (k >> (shift + 8)) == prefix) atomicAdd(&hist[(k >> shift) & 255u], 1u); }
            __syncthreads();
            if (tid == 0) { unsigned cum = 0; int dgt = 255;
                for (; dgt >= 0; --dgt) { if (cum + hist[dgt] >= need) break; cum += hist[dgt]; }
                if (dgt < 0) dgt = 0;
                sh_prefix = (prefix << 8) | (unsigned)dgt; sh_need = need - cum; }
            __syncthreads();
            prefix = sh_prefix; need = sh_need;
            __syncthreads();
        }
        const unsigned Tk = prefix;
        if (tid == 0) sh_cnt = 0;
        const int per = (limit + 255) / 256; const int s0 = tid * per, s1 = min(limit, s0 + per);
        unsigned ceq = 0; for (int s = s0; s < s1; ++s) ceq += (okey(sc[s]) == Tk);
        tcnt[tid] = ceq; __syncthreads();
        if (tid == 0) { unsigned run = 0; for (int i = 0; i < 256; ++i) { const unsigned c = tcnt[i]; tcnt[i] = run; run += c; } }
        __syncthreads();
        unsigned rank = tcnt[tid];
        for (int s = s0; s < s1; ++s) { const unsigned k = okey(sc[s]);
            if (k > Tk) { const unsigned p = atomicAdd(&sh_cnt, 1u); if (p < 256) sel[p] = s; }
            else if (k == Tk) { if (rank < need) { const unsigned p = atomicAdd(&sh_cnt, 1u); if (p < 256) sel[p] = s; } ++rank; } }
        __syncthreads();
        nvalid = 256;
    }
    const bool valid = tid < nvalid;
    const int key = valid ? sel[tid] : 0;
    float sv[8];
    {
        const bf16* kr = KA + (rb + key) * 64;
        float kk[64];
#pragma unroll
        for (int d = 0; d < 64; ++d) kk[d] = bf2f(kr[d]);
        const int bkt = t5_bucket(positions[rb + key] - positions[rb + t]);
        for (int h = 0; h < 8; ++h) { float dsum = 0.f;
#pragma unroll
            for (int d = 0; d < 64; ++d) dsum += qa[h * 64 + d] * kk[d];
            sv[h] = valid ? dsum * 0.125f + rel_bias[bkt * 8 + h] : -INFINITY; }
    }
    const int wv = tid >> 6, lane = tid & 63;
    float mx[8];
    for (int h = 0; h < 8; ++h) { float m = sv[h]; for (int o = 1; o < 64; o <<= 1) m = fmaxf(m, __shfl_xor(m, o)); if (lane == 0) red[h][wv] = m; }
    __syncthreads();
    for (int h = 0; h < 8; ++h) mx[h] = fmaxf(fmaxf(red[h][0], red[h][1]), fmaxf(red[h][2], red[h][3]));
    __syncthreads();
    float ev[8];
    for (int h = 0; h < 8; ++h) { ev[h] = valid ? expf(sv[h] - mx[h]) : 0.f; float s = ev[h]; for (int o = 1; o < 64; o <<= 1) s += __shfl_xor(s, o); if (lane == 0) red[h][wv] = s; }
    __syncthreads();
    for (int h = 0; h < 8; ++h) { const float sum = (red[h][0] + red[h][1]) + (red[h][2] + red[h][3]); pr[h][tid] = ev[h] / sum; }
    __syncthreads();
    {
        const int h = tid >> 5, d = (tid & 31) * 2; float a0 = 0.f, a1 = 0.f;
        for (int k = 0; k < nvalid; ++k) { const float p = pr[h][k]; const unsigned v = *(const unsigned*)(VA + (rb + sel[k]) * 64 + d); a0 += p * __uint_as_float(v << 16); a1 += p * __uint_as_float(v & 0xffff0000u); }
        *(unsigned*)(OA + (size_t)gq * 512 + h * 64 + d) = pk2(a0, a1);
    }
}

__global__ void __launch_bounds__(64) k_mla(const bf16* QB, const bf16* KN, const bf16* KPE, const bf16* VB, bf16* OB) {
    const int chunk = (int)gridDim.x - 1 - (int)blockIdx.x, h = blockIdx.y, b = blockIdx.z, t = chunk * 64 + threadIdx.x;
    const int limit = (chunk + 1) * 64; const size_t rb = (size_t)b * T;
    float q[96], acc[64];
#pragma unroll
    for (int d = 0; d < 96; ++d) q[d] = bf2f(QB[(rb + t) * 768 + h * 96 + d]);
#pragma unroll
    for (int d = 0; d < 64; ++d) acc[d] = 0.f;
    float m = -INFINITY, l = 0.f;
    for (int s = 0; s < limit; ++s) {
        const bf16* kr = KN + (rb + s) * 512 + h * 64; const bf16* kp = KPE + (rb + s) * 32; const bf16* vr = VB + (rb + s) * 512 + h * 64;
        float sc = 0.f;
#pragma unroll
        for (int d = 0; d < 64; ++d) sc += q[d] * bf2f(kr[d]);
#pragma unroll
        for (int d = 0; d < 32; ++d) sc += q[64 + d] * bf2f(kp[d]);
        if (sc > m) { const float f = exp2f(m - sc); l *= f;
#pragma unroll
            for (int d = 0; d < 64; ++d) acc[d] *= f;
            m = sc; }
        const float p = exp2f(sc - m); l += p;
#pragma unroll
        for (int d = 0; d < 64; ++d) acc[d] += p * bf2f(vr[d]);
    }
    const float il = 1.f / l;
#pragma unroll
    for (int d = 0; d < 64; d += 2) *(unsigned*)(OB + (rb + t) * 512 + h * 64 + d) = pk2(acc[d] * il, acc[d + 1] * il);
}

__global__ void k_dump(const bf16* src, float* out, size_t n) { for (size_t i = (size_t)blockIdx.x * 256 + threadIdx.x; i < n; i += (size_t)gridDim.x * 256) out[i] = bf2f(src[i]); }
extern "C" void kernel_launch(void* const* d_in, const int* in_sizes, int n_in, void* d_out, int out_size, void* d_ws, size_t ws_size, hipStream_t stream) {
    static int grid = 0;
    if (grid == 0) {
        if (n_in != 23 || out_size != M * D || ws_size < WS_END) { fprintf(stderr, "kernel_launch: unexpected problem shape (n_in %d, out %d, ws %zu)\n", n_in, out_size, ws_size); grid = -1; return; }
        int dev = 0, cus = 0, per_cu = 0;
        if (hipGetDevice(&dev) != hipSuccess || hipDeviceGetAttribute(&cus, hipDeviceAttributeMultiprocessorCount, dev) != hipSuccess) { grid = -1; return; }
        if (hipFuncSetAttribute((const void*)mk_fwd, hipFuncAttributeMaxDynamicSharedMemorySize, LDS_BYTES) != hipSuccess) { fprintf(stderr, "kernel_launch: hipFuncSetAttribute failed\n"); grid = -1; return; }
        if (hipOccupancyMaxActiveBlocksPerMultiprocessor(&per_cu, (const void*)mk_fwd, NWAVES * 64, LDS_BYTES) != hipSuccess || per_cu < 1) fprintf(stderr, "kernel_launch: occupancy query reports %d\n", per_cu);
        (void)hipGetLastError();
        grid = cus;
    }
    if (grid < 0) return;
    (void)in_sizes;
    if (hipMemsetAsync((char*)d_ws + WS_CTL, 0, CTL_ZERO_BYTES, stream) != hipSuccess) return;
    Args a{};
    for (int i = 0; i < 23; ++i) a.in[i] = d_in[i];
    a.out = (float*)d_out; a.ws = (unsigned char*)d_ws;
    unsigned char* ws = (unsigned char*)d_ws;
    auto launch = [&](int lo, int hi) { a.ph_lo = lo; a.ph_hi = hi; a.li = 0; hipLaunchKernelGGL(mk_fwd, dim3(grid), dim3(NWAVES * 64), LDS_BYTES, stream, a); };
#if MK_FUSED
    launch(0, NPHASE);
#else
#ifdef EXP_SKIP_MIXER
    for (int p = 0; p <= 3; ++p) launch(p, p + 1);
    for (int p = 12; p < NPHASE; ++p) launch(p, p + 1);
    return;
#endif
#ifdef EXP_DUMP_Y
    for (int p = 0; p <= 5; ++p) launch(p, p + 1);
#else
    for (int p = 0; p <= 6; ++p) launch(p, p + 1);
#endif
#ifndef EXP_SKIP_DSA
    k_dsa<<<M, 256, 0, stream>>>((const bf16*)(ws + WS_QI), (const bf16*)(ws + WS_KI), (const float*)(ws + WS_WI), (const bf16*)(ws + WS_QA), (const bf16*)(ws + WS_KA), (const bf16*)(ws + WS_VA),
                                 (const int*)d_in[2], (const float*)d_in[15], (bf16*)(ws + WS_OA));
#endif
#ifndef EXP_SKIP_DSA
    k_mla<<<dim3(T / 64, 8, BATCH), 64, 0, stream>>>((const bf16*)(ws + WS_QB), (const bf16*)(ws + WS_KN), (const bf16*)(ws + WS_KPE), (const bf16*)(ws + WS_VB), (bf16*)(ws + WS_OB));
#endif
#ifdef EXP_DUMP_Y
    k_dump<<<4096, 256, 0, stream>>>((const bf16*)(ws + WS_G), (float*)d_out, (size_t)M * D);
    return;
#endif
    for (int p = 10; p < NPHASE; ++p) launch(p, p + 1);
#endif
}
```

```cpp
#include <hip/hip_runtime.h>
#include <cstdio>
#include <cstdint>
namespace pg8 {
#define PG8_LAS __attribute__((address_space(3)))
typedef unsigned short bf16_t;
typedef short bf16x8 __attribute__((ext_vector_type(8)));
typedef float f32x4 __attribute__((ext_vector_type(4)));
typedef unsigned u32x4 __attribute__((ext_vector_type(4)));
constexpr int BM = 256, BK = 64, HALF = 128, HTB = HALF * BK * 2  , STAGE_BYTES = 8 * HTB, NXCD = 8, WGM = 8;

__host__ __device__ __forceinline__ int lds_byte(int r, int c) { const int st = (r >> 4) * 2 + (c >> 5), rr = r & 15, cc = c & 31, ob = rr * 64 + cc * 2; return st * 1024 + (ob ^ (((ob >> 9) & 1) << 5)); }
__host__ __device__ __forceinline__ void stage_rc(int b, int& R, int& C) { const int st = b / 1024, sb = b % 1024, swz = sb ^ (((sb >> 9) & 1) << 5); R = (st >> 1) * 16 + swz / 64; C = (st & 1) * 32 + (swz % 64) / 2; }
__host__ __device__ __forceinline__ int perm32(int rho) { const int n = rho >> 4, i = rho & 15; return 8 * (i >> 2) + 4 * n + (i & 3); }

struct Unit { int pm, pn; };
struct Gemm { const bf16_t* A; const bf16_t* Bt; int M, N, K; };

struct StaticOrder {
    int nM, nN, nwg, G, c;
    __host__ __device__ void init(int M, int N, int G_, int c_) { nM = M / BM; nN = N / BM; nwg = nM * nN; G = G_; c = c_; }
    __host__ __device__ bool next(int i, Unit& u) const {
        const long L = (long)i * G + c; if (L >= nwg) return false;
        int wgid = (int)L; { const int q = nwg / NXCD, r = nwg % NXCD, xcd = wgid % NXCD, off = wgid / NXCD; wgid = (xcd < r ? xcd * (q + 1) : r * (q + 1) + (xcd - r) * q) + off; }
        const int nig = WGM * nN, gid = wgid / nig, fm = gid * WGM, gsz = (nM - fm) < WGM ? (nM - fm) : WGM;
        u.pm = fm + ((wgid % nig) % gsz); u.pn = (wgid % nig) / gsz; return true;
    }
    __device__ __forceinline__ void a_ready(const Unit&) const {}
    __device__ __forceinline__ void done(const Unit&) const {}
};

typedef float f32x2 __attribute__((ext_vector_type(2)));
typedef __bf16 bf16x2_cv __attribute__((ext_vector_type(2)));
__device__ __forceinline__ unsigned cvt_pk_bf16(float lo, float hi) { const f32x2 v = {lo, hi}; const bf16x2_cv b = __builtin_convertvector(v, bf16x2_cv); return __builtin_bit_cast(unsigned, b); }

__device__ __forceinline__ u32x4 pack8(const f32x4 a, const f32x4 b) { u32x4 w; w.x = cvt_pk_bf16(a[0], a[1]); w.y = cvt_pk_bf16(a[2], a[3]); w.z = cvt_pk_bf16(b[0], b[1]); w.w = cvt_pk_bf16(b[2], b[3]); return w; }
__device__ __forceinline__ float sigm(float v) { return __builtin_amdgcn_rcpf(1.f + __builtin_amdgcn_exp2f(-1.4426950408889634f * v)); }
__device__ __forceinline__ f32x4 sigm4(const f32x4 v) { return (f32x4){sigm(v[0]), sigm(v[1]), sigm(v[2]), sigm(v[3])}; }
__device__ __forceinline__ void unpack8(const u32x4 w, f32x4& a, f32x4& b) {
    a = (f32x4){__uint_as_float(w.x << 16), __uint_as_float(w.x & 0xffff0000u), __uint_as_float(w.y << 16), __uint_as_float(w.y & 0xffff0000u)};
    b = (f32x4){__uint_as_float(w.z << 16), __uint_as_float(w.z & 0xffff0000u), __uint_as_float(w.w << 16), __uint_as_float(w.w & 0xffff0000u)}; }
constexpr float EPS_RMS = 1e-6f;
constexpr float QSCALE = 0.10206207261596575f * 1.4426950408889634f;

struct EpiSwiglu {
    static constexpr bool PERM = true, AFTER_DRAIN = false;
    bf16_t* O; int ldc;
    __device__ __forceinline__ void operator()(const f32x4 (&acc)[2][2][4][2], const Unit& u, int wr, int wc, int fr, int fq) const {
        const int row0 = u.pm * BM + wr * 64 + fr, col0 = u.pn * HALF + wc * 32 + 8 * fq;
#pragma unroll
        for (int ai = 0; ai < 2; ++ai)
#pragma unroll
            for (int m = 0; m < 4; ++m) {
                const f32x4 g0 = acc[ai][0][m][0], g1 = acc[ai][0][m][1], u0 = acc[ai][1][m][0], u1 = acc[ai][1][m][1];
                const f32x4 v0 = g0 * sigm4(g0) * u0, v1 = g1 * sigm4(g1) * u1;
                *(u32x4*)(O + (size_t)(row0 + ai * HALF + m * 16) * ldc + col0) = pack8(v0, v1); }
    }
};
struct EpiResid {
    static constexpr bool PERM = false, AFTER_DRAIN = false;
    const float* base; float* out; const float* mod; int goff; float scale;
    __device__ __forceinline__ void operator()(const f32x4 (&acc)[2][2][4][2], const Unit& u, int wr, int wc, int fr, int fq) const {
        const float* gate = mod + (u.pm >> 5) * 9216 + goff;
        const int col0 = u.pn * BM + wc * 32 + 4 * fq;
        f32x4 gv[2][2];
#pragma unroll
        for (int bj = 0; bj < 2; ++bj)
#pragma unroll
            for (int n = 0; n < 2; ++n) gv[bj][n] = *(const f32x4*)(gate + col0 + bj * HALF + n * 16) * scale;
#pragma unroll
        for (int ai = 0; ai < 2; ++ai)
#pragma unroll
            for (int m = 0; m < 4; ++m) { const size_t off = (size_t)(u.pm * BM + ai * HALF + wr * 64 + m * 16 + fr) * 1024 + col0;
#pragma unroll
                for (int bj = 0; bj < 2; ++bj)
#pragma unroll
                    for (int n = 0; n < 2; ++n) { const f32x4 bs = *(const f32x4*)(base + off + bj * HALF + n * 16); *(f32x4*)(out + off + bj * HALF + n * 16) = bs + gv[bj][n] * acc[ai][bj][m][n]; } }
    }
};
struct EpiProj {
    static constexpr bool PERM = true, AFTER_DRAIN = false;
    bf16_t *QA, *QI, *CQ, *CKV, *KA, *VA, *KI, *KPE, *G; float *WI, *ssq_q, *ssq_kv; const float *rcos, *rsin;
    __device__ __forceinline__ void operator()(const f32x4 (&acc)[2][2][4][2], const Unit& u, int wr, int wc, int fr, int fq) const {
        const int row0 = u.pm * BM + wr * 64 + fr, pn = u.pn, c32 = wc * 32 + 8 * fq;
#pragma unroll
        for (int ai = 0; ai < 2; ++ai)
#pragma unroll
            for (int m = 0; m < 4; ++m) {
                const size_t r = (size_t)(row0 + ai * HALF + m * 16);
                const f32x4 a0 = acc[ai][0][m][0], a1 = acc[ai][0][m][1], b0 = acc[ai][1][m][0], b1 = acc[ai][1][m][1];
                const float sa = (a0[0] * a0[0] + a0[1] * a0[1]) + (a0[2] * a0[2] + a0[3] * a0[3]) + (a1[0] * a1[0] + a1[1] * a1[1]) + (a1[2] * a1[2] + a1[3] * a1[3]);
                const float sb = (b0[0] * b0[0] + b0[1] * b0[1]) + (b0[2] * b0[2] + b0[3] * b0[3]) + (b1[0] * b1[0] + b1[1] * b1[1]) + (b1[2] * b1[2] + b1[3] * b1[3]);
                if (pn < 2) { bf16_t* p = QA + r * 512 + pn * 256 + c32; *(u32x4*)p = pack8(a0, a1); *(u32x4*)(p + HALF) = pack8(b0, b1); }
                else if (pn < 4) { bf16_t* p = QI + r * 512 + (pn - 2) * 256 + c32; *(u32x4*)p = pack8(a0, a1); *(u32x4*)(p + HALF) = pack8(b0, b1); }
                else if (pn == 4) { bf16_t* p = CQ + r * 384 + c32; *(u32x4*)p = pack8(a0, a1); *(u32x4*)(p + HALF) = pack8(b0, b1);
                    float s = sa + sb; s += __shfl_xor(s, 16); s += __shfl_xor(s, 32); if (fq == 0) ssq_q[r * 8 + wc] = s; }
                else if (pn == 5) { *(u32x4*)(CQ + r * 384 + 256 + c32) = pack8(a0, a1); *(u32x4*)(CKV + r * 256 + c32) = pack8(b0, b1);
                    float s = sa; s += __shfl_xor(s, 16); s += __shfl_xor(s, 32); float t = sb; t += __shfl_xor(t, 16); t += __shfl_xor(t, 32);
                    if (fq == 0) { ssq_q[r * 8 + 4 + wc] = s; ssq_kv[r * 8 + wc] = t; } }
                else if (pn == 6) { *(u32x4*)(CKV + r * 256 + 128 + c32) = pack8(a0, a1);
                    float s = sa; s += __shfl_xor(s, 16); s += __shfl_xor(s, 32); if (fq == 0) ssq_kv[r * 8 + 4 + wc] = s;
                    if (wc < 2) *(u32x4*)(KA + r * 64 + c32) = pack8(b0, b1); else *(u32x4*)(VA + r * 64 + (c32 - 64)) = pack8(b0, b1); }
                else if (pn == 7) {
                    if (wc < 2) *(u32x4*)(KI + r * 64 + c32) = pack8(a0, a1);
                    else if (wc == 2) {
                        const f32x4 c4 = *(const f32x4*)(rcos + r * 16 + 4 * fq), s4 = *(const f32x4*)(rsin + r * 16 + 4 * fq);
                        const f32x4 o0 = (f32x4){a0[0] * c4[0] - a0[1] * s4[0], a0[1] * c4[0] + a0[0] * s4[0], a0[2] * c4[1] - a0[3] * s4[1], a0[3] * c4[1] + a0[2] * s4[1]};
                        const f32x4 o1 = (f32x4){a1[0] * c4[2] - a1[1] * s4[2], a1[1] * c4[2] + a1[0] * s4[2], a1[2] * c4[3] - a1[3] * s4[3], a1[3] * c4[3] + a1[2] * s4[3]};
                        *(u32x4*)(KPE + r * 32 + 8 * fq) = pack8(o0, o1); }
                    else if (fq == 0) { *(f32x4*)(WI + r * 8) = a0; *(f32x4*)(WI + r * 8 + 4) = a1; }
                }
                else { bf16_t* p = G + r * 2048 + (pn - 8) * 256 + c32; *(u32x4*)p = pack8(sigm4(a0), sigm4(a1)); *(u32x4*)(p + HALF) = pack8(sigm4(b0), sigm4(b1)); }
            }
    }
};
struct EpiUpQ {
    static constexpr bool PERM = true, AFTER_DRAIN = false;
    bf16_t* QB; const float* ssq; const float *rcos, *rsin;
    __device__ __forceinline__ void operator()(const f32x4 (&acc)[2][2][4][2], const Unit& u, int wr, int wc, int fr, int fq) const {
        const int row0 = u.pm * BM + wr * 64 + fr;
#pragma unroll
        for (int ai = 0; ai < 2; ++ai)
#pragma unroll
            for (int m = 0; m < 4; ++m) {
                const size_t r = (size_t)(row0 + ai * HALF + m * 16);
                const f32x4 pa = *(const f32x4*)(ssq + r * 8), pb = *(const f32x4*)(ssq + r * 8 + 4);
                const float rs = __builtin_amdgcn_rsqf((((pa[0] + pa[1]) + (pa[2] + pa[3])) + ((pb[0] + pb[1]) + (pb[2] + pb[3]))) * (1.f / 384.f) + EPS_RMS) * QSCALE;
#pragma unroll
                for (int bj = 0; bj < 2; ++bj) {
                    const int c = u.pn * BM + bj * HALF + wc * 32 + 8 * fq;
                    const bool pe = ((u.pn * 8 + bj * 4 + wc) % 3) == 2;
                    f32x4 v0 = acc[ai][bj][m][0] * rs, v1 = acc[ai][bj][m][1] * rs;
                    if (pe) { const int i0 = 4 * fq;
                        const f32x4 c4 = *(const f32x4*)(rcos + r * 16 + i0), s4 = *(const f32x4*)(rsin + r * 16 + i0);
                        const f32x4 o0 = (f32x4){v0[0] * c4[0] - v0[1] * s4[0], v0[1] * c4[0] + v0[0] * s4[0], v0[2] * c4[1] - v0[3] * s4[1], v0[3] * c4[1] + v0[2] * s4[1]};
                        const f32x4 o1 = (f32x4){v1[0] * c4[2] - v1[1] * s4[2], v1[1] * c4[2] + v1[0] * s4[2], v1[2] * c4[3] - v1[3] * s4[3], v1[3] * c4[3] + v1[2] * s4[3]};
                        v0 = o0; v1 = o1; }
                    *(u32x4*)(QB + r * 768 + c) = pack8(v0, v1); }
                asm volatile("" ::: "memory"); }
    }
};
struct EpiUpKV {
    static constexpr bool PERM = true, AFTER_DRAIN = false;
    bf16_t *KN, *VB; const float* ssq;
    __device__ __forceinline__ void operator()(const f32x4 (&acc)[2][2][4][2], const Unit& u, int wr, int wc, int fr, int fq) const {
        const int row0 = u.pm * BM + wr * 64 + fr; bf16_t* dst = (u.pn < 2) ? KN : VB; const int c0 = (u.pn & 1) * BM + wc * 32 + 8 * fq;
#pragma unroll
        for (int ai = 0; ai < 2; ++ai)
#pragma unroll
            for (int m = 0; m < 4; ++m) {
                const size_t r = (size_t)(row0 + ai * HALF + m * 16);
                const f32x4 pa = *(const f32x4*)(ssq + r * 8), pb = *(const f32x4*)(ssq + r * 8 + 4);
                const float rs = __builtin_amdgcn_rsqf((((pa[0] + pa[1]) + (pa[2] + pa[3])) + ((pb[0] + pb[1]) + (pb[2] + pb[3]))) * (1.f / 256.f) + EPS_RMS);
#pragma unroll
                for (int bj = 0; bj < 2; ++bj) *(u32x4*)(dst + r * 512 + c0 + bj * HALF) = pack8(acc[ai][bj][m][0] * rs, acc[ai][bj][m][1] * rs);
                asm volatile("" ::: "memory"); }
    }
};
template <bool ADD> struct EpiGate {
    static constexpr bool PERM = true, AFTER_DRAIN = false;
    const bf16_t* G; int goff; const bf16_t* Yin; bf16_t* Y;
    __device__ __forceinline__ void operator()(const f32x4 (&acc)[2][2][4][2], const Unit& u, int wr, int wc, int fr, int fq) const {
        const int row0 = u.pm * BM + wr * 64 + fr, c0 = u.pn * BM + wc * 32 + 8 * fq;
#pragma unroll
        for (int ai = 0; ai < 2; ++ai)
#pragma unroll
            for (int m = 0; m < 4; ++m) {
                const size_t r = (size_t)(row0 + ai * HALF + m * 16);
#pragma unroll
                for (int bj = 0; bj < 2; ++bj) { const int c = c0 + bj * HALF;
                    f32x4 g0, g1; unpack8(*(const u32x4*)(G + r * 2048 + goff + c), g0, g1);
                    f32x4 v0 = g0 * acc[ai][bj][m][0], v1 = g1 * acc[ai][bj][m][1];
                    if (ADD) { f32x4 y0, y1; unpack8(*(const u32x4*)(Yin + r * 1024 + c), y0, y1); v0 += y0; v1 += y1; }
                    *(u32x4*)(Y + r * 1024 + c) = pack8(v0, v1); } }
    }
};

template <class Epi, class Sched, bool ALIGN_EPI = false, bool SP2 = false>
__device__ __forceinline__ void gemm_phase(PG8_LAS unsigned char* lds, const Gemm g, const Sched& S, const Epi& E) {
    const int tid = threadIdx.x, wid = __builtin_amdgcn_readfirstlane(tid >> 6), lane = tid & 63, wr = wid >> 2, wc = wid & 3, fr = lane & 15, fq = lane >> 4;
    const int K = g.K, nt = K / BK;
    unsigned voffA[2], voffB[2];
#pragma unroll
    for (int i = 0; i < 2; ++i) { int R, C; stage_rc(tid * 16 + i * 8192, R, C); const int Rb = Epi::PERM ? ((R & ~31) + perm32(R & 31)) : R;
        voffA[i] = (unsigned)(R * K + C) * 2u; voffB[i] = (unsigned)(Rb * K + C) * 2u; }
    const size_t kstep = (size_t)(BK * 2);
    const size_t hstep = (size_t)HALF * K * 2;
    const size_t tstep = 2 * hstep;
    const unsigned ldsw = (unsigned)wid * 1024u;
    const int aoff = lds_byte(wr * 64 + fr, fq * 8), boff = lds_byte(wc * 32 + fr, fq * 8);
#define PG8_SA(b, h) (((b) * 2 + (h)) * HTB)
#define PG8_SB(b, h) ((4 + (b) * 2 + (h)) * HTB)
#define PG8_STAGE(bufoff, gbase, voff) do { _Pragma("unroll") for (int _i = 0; _i < 2; ++_i) \
        __builtin_amdgcn_global_load_lds((const unsigned*)((const char*)(gbase) + (voff)[_i]), (PG8_LAS unsigned*)(lds + (bufoff) + ldsw + _i * 8192), 16, 0, 0); } while (0)
#define PG8_LDA(dst, b, h) do { _Pragma("unroll") for (int m = 0; m < 4; ++m) _Pragma("unroll") for (int k = 0; k < 2; ++k) dst[m][k] = *(const PG8_LAS bf16x8*)(lds + PG8_SA(b, h) + aoff + m * 2048 + k * 1024); } while (0)
#define PG8_LDB(dst, b, h) do { _Pragma("unroll") for (int n = 0; n < 2; ++n) _Pragma("unroll") for (int k = 0; k < 2; ++k) dst[n][k] = *(const PG8_LAS bf16x8*)(lds + PG8_SB(b, h) + boff + n * 2048 + k * 1024); } while (0)
#define PG8_MMA(ai, bj, At, Bt) do { __builtin_amdgcn_s_setprio(1); _Pragma("unroll") for (int m = 0; m < 4; ++m) _Pragma("unroll") for (int n = 0; n < 2; ++n) _Pragma("unroll") for (int k = 0; k < 2; ++k) \
        acc[ai][bj][m][n] = __builtin_amdgcn_mfma_f32_16x16x32_bf16(Bt[n][k], At[m][k], acc[ai][bj][m][n], 0, 0, 0); __builtin_amdgcn_s_setprio(0); } while (0)
#define PG8_WAIT_V(n) asm volatile("s_waitcnt vmcnt(" #n ")" ::: "memory")
#define PG8_WAIT_L(n) asm volatile("s_waitcnt lgkmcnt(" #n ")" ::: "memory")
#define PG8_BAR __builtin_amdgcn_s_barrier()
#define PG8_SCHED __builtin_amdgcn_sched_barrier(0)
    Unit cur, nxt; int ui = 0;
    if (!S.next(0, cur)) return;
    f32x4 acc[2][2][4][2];
#pragma unroll
    for (int a = 0; a < 2; ++a)
#pragma unroll
        for (int b = 0; b < 2; ++b)
#pragma unroll
            for (int m = 0; m < 4; ++m)
#pragma unroll
                for (int n = 0; n < 2; ++n) acc[a][b][m][n] = (f32x4){0.f, 0.f, 0.f, 0.f};
    bf16x8 At[4][2], B0[2][2], B1[2][2];
    const char* cA = (const char*)g.A + (size_t)cur.pm * tstep; const char* cB = (const char*)g.Bt + (size_t)cur.pn * tstep;
    S.a_ready(cur);
    if constexpr (SP2) {
        PG8_STAGE(PG8_SB(0, 0), cB, voffB); PG8_STAGE(PG8_SB(0, 1), cB + hstep, voffB); PG8_STAGE(PG8_SA(0, 0), cA, voffA); PG8_STAGE(PG8_SA(0, 1), cA + hstep, voffA);
        if (wr == 1) PG8_BAR;
        PG8_WAIT_V(2); PG8_BAR;
        PG8_STAGE(PG8_SB(1, 0), cB + kstep, voffB); PG8_STAGE(PG8_SA(1, 0), cA + kstep, voffA); PG8_STAGE(PG8_SB(1, 1), cB + hstep + kstep, voffB);
        PG8_WAIT_V(6); PG8_BAR;
    } else {
        PG8_STAGE(PG8_SB(0, 0), cB, voffB); PG8_STAGE(PG8_SA(0, 0), cA, voffA); PG8_STAGE(PG8_SB(0, 1), cB + hstep, voffB); PG8_STAGE(PG8_SA(0, 1), cA + hstep, voffA);
        if (wr == 1) PG8_BAR;
        PG8_WAIT_V(4); PG8_BAR;
        PG8_STAGE(PG8_SB(1, 0), cB + kstep, voffB); PG8_STAGE(PG8_SA(1, 0), cA + kstep, voffA); PG8_STAGE(PG8_SB(1, 1), cB + hstep + kstep, voffB);
        PG8_WAIT_V(6); PG8_BAR;
    }
    for (;;) {
        const bool has_next = S.next(ui + 1, nxt);
        const char* nA = has_next ? (const char*)g.A + (size_t)nxt.pm * tstep : cA; const char* nB = has_next ? (const char*)g.Bt + (size_t)nxt.pn * tstep : cB;
#pragma nounroll
        for (int t = 0; t < nt; t += 2) {
            const bool last = (t == nt - 2);
            const char* a1 = cA + (size_t)(t + 1) * kstep;
            const char* a2 = last ? nA : cA + (size_t)(t + 2) * kstep; const char* b2 = last ? nB : cB + (size_t)(t + 2) * kstep;
            const char* a3 = a2 + kstep; const char* b3 = b2 + kstep;
            if (last && has_next) S.a_ready(nxt);
            if constexpr (SP2) {
            PG8_LDB(B0, 0, 0); PG8_LDB(B1, 0, 1); PG8_SCHED; PG8_LDA(At, 0, 0); PG8_STAGE(PG8_SA(1, 1), a1 + hstep, voffA);
            PG8_WAIT_V(8); PG8_WAIT_L(0); PG8_BAR; PG8_MMA(0, 0, At, B0); PG8_MMA(0, 1, At, B1); PG8_BAR; PG8_SCHED;
            PG8_LDA(At, 0, 1); PG8_STAGE(PG8_SB(0, 0), b2, voffB); PG8_STAGE(PG8_SB(0, 1), b2 + hstep, voffB); PG8_STAGE(PG8_SA(0, 0), a2, voffA);
            PG8_WAIT_V(8); PG8_WAIT_L(0); PG8_BAR; PG8_MMA(1, 0, At, B0); PG8_MMA(1, 1, At, B1); PG8_BAR; PG8_SCHED;
            PG8_LDB(B0, 1, 0); PG8_LDB(B1, 1, 1); PG8_SCHED; PG8_LDA(At, 1, 0); PG8_STAGE(PG8_SA(0, 1), a2 + hstep, voffA);
            PG8_WAIT_V(8); PG8_WAIT_L(0); PG8_BAR; PG8_MMA(0, 0, At, B0); PG8_MMA(0, 1, At, B1); PG8_BAR; PG8_SCHED;
            PG8_LDA(At, 1, 1); PG8_STAGE(PG8_SB(1, 0), b3, voffB); PG8_STAGE(PG8_SB(1, 1), b3 + hstep, voffB); PG8_STAGE(PG8_SA(1, 0), a3, voffA);
            PG8_WAIT_V(8); PG8_WAIT_L(0); PG8_BAR; PG8_MMA(1, 0, At, B0); PG8_MMA(1, 1, At, B1); PG8_BAR; PG8_SCHED;
            } else {
            PG8_LDB(B0, 0, 0); PG8_SCHED; PG8_LDA(At, 0, 0); PG8_STAGE(PG8_SA(1, 1), a1 + hstep, voffA);
            PG8_WAIT_L(8); PG8_BAR; PG8_WAIT_L(0); PG8_MMA(0, 0, At, B0); PG8_BAR; PG8_SCHED;
            PG8_LDB(B1, 0, 1); PG8_STAGE(PG8_SB(0, 0), b2, voffB);
            PG8_BAR; PG8_WAIT_L(0); PG8_MMA(0, 1, At, B1); PG8_BAR;
            PG8_LDA(At, 0, 1); PG8_STAGE(PG8_SA(0, 0), a2, voffA);
            PG8_BAR; PG8_WAIT_L(0); PG8_MMA(1, 0, At, B0); PG8_BAR; PG8_SCHED;
            PG8_STAGE(PG8_SB(0, 1), b2 + hstep, voffB);
            PG8_WAIT_V(6); PG8_BAR; PG8_MMA(1, 1, At, B1); PG8_BAR;
            PG8_LDB(B0, 1, 0); PG8_SCHED; PG8_LDA(At, 1, 0); PG8_STAGE(PG8_SA(0, 1), a2 + hstep, voffA);
            PG8_WAIT_L(8); PG8_BAR; PG8_WAIT_L(0); PG8_MMA(0, 0, At, B0); PG8_BAR; PG8_SCHED;
            PG8_LDB(B1, 1, 1); PG8_STAGE(PG8_SB(1, 0), b3, voffB);
            PG8_BAR; PG8_WAIT_L(0); PG8_MMA(0, 1, At, B1); PG8_BAR;
            PG8_LDA(At, 1, 1); PG8_STAGE(PG8_SA(1, 0), a3, voffA);
            PG8_BAR; PG8_WAIT_L(0); PG8_MMA(1, 0, At, B0); PG8_BAR; PG8_SCHED;
            PG8_STAGE(PG8_SB(1, 1), b3 + hstep, voffB);
            PG8_WAIT_V(6); PG8_BAR; PG8_MMA(1, 1, At, B1); PG8_BAR;
            }
        }
        if constexpr (ALIGN_EPI) { if (wr == 0) PG8_BAR; }
        if constexpr (!Epi::AFTER_DRAIN) { E(acc, cur, wr, wc, fr, fq); S.done(cur); }
        if (!has_next) break;
#pragma unroll
        for (int a = 0; a < 2; ++a)
#pragma unroll
            for (int b = 0; b < 2; ++b)
#pragma unroll
                for (int m = 0; m < 4; ++m)
#pragma unroll
                    for (int n = 0; n < 2; ++n) acc[a][b][m][n] = (f32x4){0.f, 0.f, 0.f, 0.f};
        cur = nxt; cA = nA; cB = nB; ++ui;
        if constexpr (ALIGN_EPI) { if (wr == 1) PG8_BAR; }
    }
    PG8_WAIT_V(0);
    if constexpr (!ALIGN_EPI) { if (wr == 0) PG8_BAR; }
    PG8_BAR;
    if constexpr (Epi::AFTER_DRAIN) { E.fused(acc, cur, wr, wc, fr, fq, lds, wid, lane); S.done(cur); }
#undef PG8_SA
#undef PG8_SB
#undef PG8_STAGE
#undef PG8_LDA
#undef PG8_LDB
#undef PG8_MMA
#undef PG8_WAIT_V
#undef PG8_WAIT_L
#undef PG8_BAR
#undef PG8_SCHED
}
}

constexpr int NWAVES = 8;
constexpr int BATCH = 4, T = 8192, D = 1024, DFF = 2816, M = BATCH * T;
constexpr int INC = 3944, NPROJ = 4096;
constexpr int O_QA = 0, O_KA = 512, O_VA = 576, O_QI = 640, O_KI = 1152, O_WI = 1216, O_CQ = 1224, O_CKV = 1608, O_KR = 1864, O_GATE = 1896;
constexpr float EPS = 1e-6f;
#ifndef MK_FUSED
#define MK_FUSED 1
#endif

constexpr size_t MiB = 1u << 20;
constexpr size_t WS_CTL = 0, CTL_ZERO_BYTES = 2 * MiB;
constexpr size_t WS_MOD = 256 * 1024;
constexpr size_t WS_SSQQ = 49 * MiB, WS_SSQKV = 50 * MiB;
constexpr size_t WS_W1A = 2 * MiB, SZ_WA = (size_t)2 * DFF * D * 2, SZ_WD = (size_t)D * DFF * 2;
constexpr size_t WS_W1D = WS_W1A + SZ_WA, WS_WIN = WS_W1D + SZ_WD, WS_WUQ = WS_WIN + (size_t)NPROJ * D * 2, WS_WUKV = WS_WUQ + (size_t)768 * 384 * 2;
constexpr size_t WS_WOA = WS_WUKV + (size_t)1024 * 256 * 2, WS_WOB = WS_WOA + (size_t)D * 512 * 2, WS_WOUT = WS_WOB + (size_t)D * 512 * 2;
constexpr size_t WS_W2A = WS_WOUT + (size_t)D * D * 2, WS_W2D = WS_W2A + SZ_WA, WS_WEND = WS_W2D + SZ_WD;
static_assert(WS_WEND <= 49 * MiB, "weights");
constexpr size_t WS_RCOS = 51 * MiB, WS_RSIN = 53 * MiB;
constexpr size_t WS_XN = 55 * MiB;
constexpr size_t WS_ACT = 119 * MiB;
constexpr size_t WS_QA = WS_ACT, WS_QI = WS_QA + 32 * MiB, WS_CQ = WS_QI + 32 * MiB, WS_CKV = WS_CQ + 24 * MiB, WS_KA = WS_CKV + 16 * MiB, WS_VA = WS_KA + 4 * MiB;
constexpr size_t WS_KI = WS_VA + 4 * MiB, WS_KPE = WS_KI + 4 * MiB, WS_WI = WS_KPE + 2 * MiB, WS_QB = WS_WI + 1 * MiB, WS_MIXEND = WS_QB + 48 * MiB;
static_assert(WS_MIXEND <= WS_ACT + 176 * MiB, "mixer overlay");
constexpr size_t WS_G = 295 * MiB;
constexpr size_t WS_KN = 423 * MiB, WS_VB = 455 * MiB;
constexpr size_t WS_SEL = 487 * MiB;
constexpr size_t WS_END = 503 * MiB;
static_assert(WS_XN + 64 * MiB <= WS_ACT && WS_ACT + 176 * MiB <= WS_G && WS_G + 128 * MiB <= WS_KN && WS_VB + 32 * MiB <= WS_SEL, "d_ws map");
constexpr size_t WS_OA = WS_QA, WS_OB = WS_QI, WS_Y1 = WS_KN, WS_Y = WS_XN;
constexpr int CW_TMO = 0, CW_CODE = 1, CW_BAR = 4096;

constexpr int RING_OFF = 0, RING_BYTES = 147456;
constexpr int LDSCTL_OFF = RING_BYTES, MISC_OFF = LDSCTL_OFF + 320;
constexpr int LDS_BYTES = RING_BYTES + 1024;
#define GAS __attribute__((address_space(1)))
#define LAS __attribute__((address_space(3)))
typedef unsigned short bf16;
typedef unsigned v4u __attribute__((ext_vector_type(4)));
typedef float f32x4 __attribute__((ext_vector_type(4)));
typedef short bf16x8 __attribute__((ext_vector_type(8)));
typedef GAS unsigned gu32;
typedef GAS unsigned long long gu64;
#define RLX_AGENT __ATOMIC_RELAXED, __HIP_MEMORY_SCOPE_AGENT
#define LDS_WAIT() asm volatile("s_waitcnt lgkmcnt(0)" ::: "memory")
#define VM_WAIT() asm volatile("s_waitcnt vmcnt(0)" ::: "memory")
__device__ __forceinline__ unsigned long long rt() { return __builtin_amdgcn_s_memrealtime(); }
__device__ __forceinline__ unsigned f2bf(float f) { unsigned u = __builtin_bit_cast(unsigned, f); return (u + 0x7fffu + ((u >> 16) & 1u)) >> 16; }
__device__ __forceinline__ unsigned pk2(float lo, float hi) { return f2bf(lo) | (f2bf(hi) << 16); }

#define XB_TMO      128
#define XB_XCNT(j)  (256  + 64 * (j))
#define XB_XSUB(j)  (1280 + 64 * (j))
#define XB_XGEN(j)  (2304 + 64 * (j))
#define XB_TOP      3328
#define XB_TOPGEN   3392
#define XCD_BAR_WORDS 3456
#define XB_SPIN_CAP (1u << 18)

__device__ __forceinline__ unsigned xb_ld(unsigned* p)              { return __hip_atomic_load(p, __ATOMIC_RELAXED, __HIP_MEMORY_SCOPE_AGENT); }
__device__ __forceinline__ unsigned xb_add(unsigned* p, unsigned v) { return __hip_atomic_fetch_add(p, v, __ATOMIC_RELAXED, __HIP_MEMORY_SCOPE_AGENT); }
__device__ __forceinline__ unsigned xb_xcc_id() { return (unsigned)__builtin_amdgcn_s_getreg((3 << 11) | 20) & 0xFu; }
#define XB_SPIN(cond, bar) do { unsigned _sp = 0; while (cond) { __builtin_amdgcn_s_sleep(1); \
    if ((++_sp & 255u) == 0u) { if (xb_ld(&(bar)[XB_TMO])) break; if (_sp > XB_SPIN_CAP) { atomicAdd(&(bar)[XB_TMO], 1u); break; } } } } while (0)

struct XcdBarrier {
    unsigned* bar; unsigned x;
    volatile LAS unsigned* st;
};

__device__ __forceinline__ XcdBarrier xcd_barrier_post(unsigned* bar, volatile LAS unsigned* st) {
    XcdBarrier b; b.bar = bar; b.x = xb_xcc_id(); b.st = st;
    if (threadIdx.x == 0) (void)xb_add(&bar[XB_XCNT(b.x)], 1u);
    return b;
}
__device__ __forceinline__ void xcd_barrier_complete(unsigned* bar, unsigned x, unsigned& nloc, unsigned& nx) {
    const unsigned G = gridDim.x * gridDim.y * gridDim.z;
    unsigned sum, cnt, mine, sp = 0u;
    for (;;) {
        sum = 0u; cnt = 0u; mine = 0u;
#pragma unroll
        for (unsigned j = 0; j < 16; ++j) { const unsigned c = xb_ld(&bar[XB_XCNT(j)]); sum += c; cnt += (c > 0u) ? 1u : 0u; mine = (j == x) ? c : mine; }
        if (sum == G) break;
        __builtin_amdgcn_s_sleep(1);
        if ((++sp & 255u) == 0u) { if (xb_ld(&bar[XB_TMO])) break; if (sp > XB_SPIN_CAP) { atomicAdd(&bar[XB_TMO], 1u); break; } }
    }
    nloc = mine > 0u ? mine : 1u; nx = cnt > 0u ? cnt : 1u;
}

__device__ __forceinline__ void xcd_barrier(const XcdBarrier& b) {
    asm volatile("s_waitcnt vmcnt(0)" ::: "memory");
    __syncthreads();
    if (threadIdx.x == 0) {
        unsigned* bar = b.bar;
        __builtin_amdgcn_s_waitcnt(0);
        unsigned nloc = b.st[0], nx = b.st[1];
        if (nloc == 0u) { xcd_barrier_complete(bar, b.x, nloc, nx); b.st[0] = nloc; b.st[1] = nx; }
        const unsigned old = xb_add(&bar[XB_XSUB(b.x)], 1u);
        const unsigned gen = old / nloc;
        if (old + 1u == (gen + 1u) * nloc) {
            __builtin_amdgcn_fence(__ATOMIC_RELEASE, "agent");
            asm volatile("s_waitcnt vmcnt(0)" ::: "memory");
            const unsigned og = xb_add(&bar[XB_TOP], 1u);
            const unsigned tg = og / nx;
            if (og + 1u == (tg + 1u) * nx) xb_add(&bar[XB_TOPGEN], 1u);
            else XB_SPIN(xb_ld(&bar[XB_TOPGEN]) == tg, bar);
            __builtin_amdgcn_fence(__ATOMIC_ACQUIRE, "agent");
            xb_add(&bar[XB_XGEN(b.x)], 1u);
            asm volatile("s_waitcnt vmcnt(0)" ::: "memory");
        } else {
            XB_SPIN(xb_ld(&bar[XB_XGEN(b.x)]) == gen, bar);
            __builtin_amdgcn_fence(__ATOMIC_ACQUIRE, "agent");
            asm volatile("s_waitcnt vmcnt(0)" ::: "memory");
        }
    }
    __syncthreads();
}

struct Frame {
    LAS unsigned char* lds;
    volatile LAS unsigned* MISC;
    gu32* ctl;
    int tid, lane, wave;
    int vcu, G;
};
__device__ __forceinline__ float wave_sum(float v) {
#pragma unroll
    for (int o = 1; o < 64; o <<= 1) v += __shfl_xor(v, o);
    return v;
}
struct MapIdent { int off; __device__ __forceinline__ int src(int n) const { return n + off; } };
struct MapFfnIn { __device__ __forceinline__ int src(int n) const { const int pn = n >> 8, j = n & 255; return (j >> 7) * DFF + pn * 128 + (j & 127); } };
struct MapProj { __device__ __forceinline__ int src(int n) const { const int pn = n >> 8, j = n & 255;
    if (pn < 2) return O_QA + n; if (pn < 4) return O_QI + (n - 512); if (pn == 4) return O_CQ + j;
    if (pn == 5) return j < 128 ? O_CQ + 256 + j : O_CKV + (j - 128);
    if (pn == 6) return j < 128 ? O_CKV + 128 + j : (j < 192 ? O_KA + (j - 128) : O_VA + (j - 192));
    if (pn == 7) { if (j < 64) return O_KI + j; if (j < 96) { const int jj = j - 64; return O_KR + (jj >> 1) + 16 * (jj & 1); } if (j < 104) return O_WI + (j - 96); return -1; }
    return O_GATE + (n - 2048); } };
struct MapUq { __device__ __forceinline__ int src(int n) const { const int h = n / 96, w = n % 96; if (w < 64) return n; const int jj = w - 64; return h * 96 + 64 + (jj >> 1) + 16 * (jj & 1); } };
template <class Map> __device__ __forceinline__ void p0_transpose_item(const float* W, int K, int Nsrc, int nblk, const float* kscale, bf16* WT, const Map mp, LAS float* scr, int item, int lane) {
    const int kb = item / nblk, nb = item % nblk, k0 = 64 * kb, n0 = 32 * nb;
    const int sc = mp.src(n0 + (lane & 31));
#pragma unroll 8
    for (int i = 0; i < 32; ++i) { const int kk = 2 * i + (lane >> 5); float v = sc >= 0 ? W[(size_t)(k0 + kk) * Nsrc + sc] : 0.f; if (kscale) v *= kscale[k0 + kk]; scr[kk * 33 + (lane & 31)] = v; }
    LDS_WAIT(); asm volatile("" ::: "memory");
    const int c = lane & 7;
#pragma unroll
    for (int j = 0; j < 4; ++j) { const int n = (lane >> 3) + 8 * j; const LAS float* s = scr + (8 * c) * 33 + n;
        v4u o; o.x = pk2(s[0 * 33], s[1 * 33]); o.y = pk2(s[2 * 33], s[3 * 33]); o.z = pk2(s[4 * 33], s[5 * 33]); o.w = pk2(s[6 * 33], s[7 * 33]);
        *(GAS v4u*)(WT + (size_t)(n0 + n) * K + k0 + 8 * c) = o; }
    LDS_WAIT(); asm volatile("" ::: "memory");
}
struct Args { const void* in[23]; float* out; unsigned char* ws; int ph_lo, ph_hi, li, pad; };

__device__ __forceinline__ void p0_prologue(Frame& F, const Args& A) {
    LAS float* scr = (LAS float*)(F.lds + RING_OFF + F.wave * 16384);
    const int gw = F.vcu * NWAVES + F.wave, NGW = F.G * NWAVES;
    unsigned char* ws = A.ws;
    {
        const float* c = (const float*)A.in[1]; const float* w = (const float*)A.in[3]; const float* bias = (const float*)A.in[4]; float* mod = (float*)(ws + WS_MOD);
        for (int cg = F.vcu; cg < 144; cg += F.G) {
            const int n = cg * 64 + F.lane, k0 = F.wave * 128;
#pragma unroll
            for (int b = 0; b < 4; ++b)
#pragma unroll
                for (int h = 0; h < 2; ++h) { const float v = c[b * D + k0 + h * 64 + F.lane]; scr[b * 128 + h * 64 + F.lane] = v / (1.f + __expf(-v)); }
            LDS_WAIT(); asm volatile("" ::: "memory");
            float a0 = 0.f, a1 = 0.f, a2 = 0.f, a3 = 0.f;
#pragma unroll 8
            for (int k = 0; k < 128; ++k) { const float wv = w[(size_t)(k0 + k) * 9216 + n]; a0 += scr[k] * wv; a1 += scr[128 + k] * wv; a2 += scr[256 + k] * wv; a3 += scr[384 + k] * wv; }
            scr[1024 + F.lane] = a0; scr[1088 + F.lane] = a1; scr[1152 + F.lane] = a2; scr[1216 + F.lane] = a3;
            __syncthreads();
            if (F.wave < 4) { float t = bias[n];
#pragma unroll
                for (int ww = 0; ww < 8; ++ww) t += ((LAS float*)(F.lds + RING_OFF + ww * 16384))[1024 + F.wave * 64 + F.lane];
                mod[F.wave * 9216 + n] = t; }
            __syncthreads();
        }
    }
    {
        const float* w1a = (const float*)A.in[6]; const float* w1d = (const float*)A.in[7]; const float* win = (const float*)A.in[9]; const float* gcq = (const float*)A.in[10];
        const float* wuq = (const float*)A.in[11]; const float* gckv = (const float*)A.in[12]; const float* wuk = (const float*)A.in[13]; const float* wuv = (const float*)A.in[14];
        const float* woa = (const float*)A.in[16]; const float* wob = (const float*)A.in[17]; const float* wout = (const float*)A.in[18]; const float* w2a = (const float*)A.in[20]; const float* w2d = (const float*)A.in[21];
        constexpr int I_A = 16 * 176, I_D = 44 * 32, I_IN = 16 * 128, I_UQ = 6 * 24, I_UK = 4 * 16, I_O = 8 * 32, I_OUT = 16 * 32;
        constexpr int NITEMS = 2 * I_A + 2 * I_D + I_IN + I_UQ + 2 * I_UK + 2 * I_O + I_OUT;
        for (int it = gw; it < NITEMS; it += NGW) {
            int r = it;
            if (r < I_A) { p0_transpose_item(w1a, D, 2 * DFF, 176, nullptr, (bf16*)(ws + WS_W1A), MapFfnIn{}, scr, r, F.lane); continue; } r -= I_A;
            if (r < I_A) { p0_transpose_item(w2a, D, 2 * DFF, 176, nullptr, (bf16*)(ws + WS_W2A), MapFfnIn{}, scr, r, F.lane); continue; } r -= I_A;
            if (r < I_D) { p0_transpose_item(w1d, DFF, D, 32, nullptr, (bf16*)(ws + WS_W1D), MapIdent{0}, scr, r, F.lane); continue; } r -= I_D;
            if (r < I_D) { p0_transpose_item(w2d, DFF, D, 32, nullptr, (bf16*)(ws + WS_W2D), MapIdent{0}, scr, r, F.lane); continue; } r -= I_D;
            if (r < I_IN) { p0_transpose_item(win, D, INC, 128, nullptr, (bf16*)(ws + WS_WIN), MapProj{}, scr, r, F.lane); continue; } r -= I_IN;
            if (r < I_UQ) { p0_transpose_item(wuq, 384, 768, 24, gcq, (bf16*)(ws + WS_WUQ), MapUq{}, scr, r, F.lane); continue; } r -= I_UQ;
            if (r < I_UK) { p0_transpose_item(wuk, 256, 512, 16, gckv, (bf16*)(ws + WS_WUKV), MapIdent{0}, scr, r, F.lane); continue; } r -= I_UK;
            if (r < I_UK) { p0_transpose_item(wuv, 256, 512, 16, gckv, (bf16*)(ws + WS_WUKV) + (size_t)512 * 256, MapIdent{0}, scr, r, F.lane); continue; } r -= I_UK;
            if (r < I_O) { p0_transpose_item(woa, 512, D, 32, nullptr, (bf16*)(ws + WS_WOA), MapIdent{0}, scr, r, F.lane); continue; } r -= I_O;
            if (r < I_O) { p0_transpose_item(wob, 512, D, 32, nullptr, (bf16*)(ws + WS_WOB), MapIdent{0}, scr, r, F.lane); continue; } r -= I_O;
            p0_transpose_item(wout, D, D, 32, nullptr, (bf16*)(ws + WS_WOUT), MapIdent{0}, scr, r, F.lane);
        }
    }
    {
        const int* pos = (const int*)A.in[2]; float* rc = (float*)(ws + WS_RCOS); float* rs = (float*)(ws + WS_RSIN);
        for (int idx = gw * 64 + F.lane; idx < M * 16; idx += NGW * 64) { const int t = idx >> 4, i = idx & 15;
            const float freq = powf(10000.0f, -2.0f * (float)i / 32.0f); const float ang = (float)pos[t] * freq;
            rc[idx] = cosf(ang); rs[idx] = sinf(ang); }
    }
}
__device__ __forceinline__ void norm_mod_phase(Frame& F, const float* xin, const float* g, const float* mod, int shoff, int scoff, bf16* out) {
    const int gw = F.vcu * NWAVES + F.wave, NGW = F.G * NWAVES;
    for (int m = gw; m < M; m += NGW) {
        const int b = m >> 13;
        const GAS f32x4* xr = (const GAS f32x4*)(xin + (size_t)m * D) + F.lane;
        const GAS f32x4* g4 = (const GAS f32x4*)g + F.lane; const GAS f32x4* sc4 = (const GAS f32x4*)(mod + b * 9216 + scoff) + F.lane; const GAS f32x4* sh4 = (const GAS f32x4*)(mod + b * 9216 + shoff) + F.lane;
        f32x4 v[4]; float s = 0.f;
#pragma unroll
        for (int j = 0; j < 4; ++j) { v[j] = xr[64 * j]; s += (v[j].x * v[j].x + v[j].y * v[j].y) + (v[j].z * v[j].z + v[j].w * v[j].w); }
        const float rs = __builtin_amdgcn_rsqf(wave_sum(s) * (1.f / D) + EPS);
        GAS unsigned long long* o8 = (GAS unsigned long long*)(out + (size_t)m * D) + F.lane;
#pragma unroll
        for (int j = 0; j < 4; ++j) { const f32x4 o = v[j] * rs * g4[64 * j] * (sc4[64 * j] + 1.f) + sh4[64 * j];
            o8[64 * j] = (unsigned long long)pk2(o.x, o.y) | ((unsigned long long)pk2(o.z, o.w) << 32); }
    }
}
__device__ __forceinline__ void final_norm_phase(Frame& F, const float* xin, const float* g, float* out) {
    const int gw = F.vcu * NWAVES + F.wave, NGW = F.G * NWAVES;
    for (int m = gw; m < M; m += NGW) {
        const GAS f32x4* xr = (const GAS f32x4*)(xin + (size_t)m * D) + F.lane; const GAS f32x4* g4 = (const GAS f32x4*)g + F.lane;
        f32x4 v[4]; float s = 0.f;
#pragma unroll
        for (int j = 0; j < 4; ++j) { v[j] = xr[64 * j]; s += (v[j].x * v[j].x + v[j].y * v[j].y) + (v[j].z * v[j].z + v[j].w * v[j].w); }
        const float rs = __builtin_amdgcn_rsqf(wave_sum(s) * (1.f / D) + EPS);
        GAS f32x4* o4 = (GAS f32x4*)(out + (size_t)m * D) + F.lane;
#pragma unroll
        for (int j = 0; j < 4; ++j) o4[64 * j] = v[j] * rs * g4[64 * j];
    }
}

namespace mla {
typedef unsigned u32x4 __attribute__((ext_vector_type(4)));
typedef short bf16x8 __attribute__((ext_vector_type(8)));
typedef short s16x4 __attribute__((ext_vector_type(4)));
typedef float f32x16 __attribute__((ext_vector_type(16)));
constexpr int KSLOT = 12288, VSLOT = 8192;
constexpr int L_K = 0, L_V = 2 * KSLOT, L_WS = L_V + 2 * VSLOT, L_OST = L_WS + 2048, L_END = L_OST + 8 * 4096;
static_assert(L_END <= RING_BYTES, "attention LDS");
__device__ __forceinline__ int crow(int r, int hi) { return (r & 3) + 8 * (r >> 2) + 4 * hi; }
__device__ __forceinline__ float xhalf(float v) { return __shfl_xor(v, 32); }
__device__ __forceinline__ void pv(f32x16* o, int vb, bf16x8 pa0, bf16x8 pa1, bf16x8 pa2, bf16x8 pa3) {
#pragma unroll
    for (int d0 = 0; d0 < 2; ++d0) { s16x4 lo[4], hi[4];
#pragma unroll
        for (int ks = 0; ks < 4; ++ks) {
            asm volatile("ds_read_b64_tr_b16 %0,%1 offset:%c2" : "=&v"(lo[ks]) : "v"(vb), "i"(d0 * 4096 + ks * 1024) : "memory");
            asm volatile("ds_read_b64_tr_b16 %0,%1 offset:%c2" : "=&v"(hi[ks]) : "v"(vb), "i"(d0 * 4096 + ks * 1024 + 512) : "memory"); }
        asm volatile("s_waitcnt lgkmcnt(0)" ::: "memory"); __builtin_amdgcn_sched_barrier(0);
#define MLA_PK(k) (bf16x8){lo[k][0], lo[k][1], lo[k][2], lo[k][3], hi[k][0], hi[k][1], hi[k][2], hi[k][3]}
        o[d0] = __builtin_amdgcn_mfma_f32_32x32x16_bf16(pa0, MLA_PK(0), o[d0], 0, 0, 0);
        o[d0] = __builtin_amdgcn_mfma_f32_32x32x16_bf16(pa1, MLA_PK(1), o[d0], 0, 0, 0);
        o[d0] = __builtin_amdgcn_mfma_f32_32x32x16_bf16(pa2, MLA_PK(2), o[d0], 0, 0, 0);
        o[d0] = __builtin_amdgcn_mfma_f32_32x32x16_bf16(pa3, MLA_PK(3), o[d0], 0, 0, 0);
#undef MLA_PK
    }
}
__device__ __forceinline__ void attn_unit(int b, int h, int qb, const bf16* QB, const bf16* KN, const bf16* KPE, const bf16* VB, bf16* OB, LAS unsigned char* lds) {
    const int tid = threadIdx.x, lane = tid & 63, r32 = lane & 31, hi = lane >> 5; const int wid = __builtin_amdgcn_readfirstlane(tid >> 6);
    const size_t rowbase = (size_t)b * T; const int q0 = qb * 256;
    const int NT = 4 * (qb + 1), my_last = 4 * qb + (wid >> 1);
    LAS float* wsf = (LAS float*)(lds + L_WS) + wid * 64;
#define MLA_DMA(t, slot) do { const size_t krow_ = rowbase + (size_t)(t) * 64 + lane; \
        __builtin_amdgcn_global_load_lds((const unsigned*)(KN + krow_ * 512 + h * 64 + wid * 8), (LAS unsigned*)(lds + L_K + (slot) * KSLOT + wid * 1024), 16, 0, 0); \
        if (wid < 4) __builtin_amdgcn_global_load_lds((const unsigned*)(KPE + krow_ * 32 + wid * 8), (LAS unsigned*)(lds + L_K + (slot) * KSLOT + (8 + wid) * 1024), 16, 0, 0); \
        const size_t vrow_ = rowbase + (size_t)(t) * 64 + 16 * (wid & 3) + (lane >> 2); \
        __builtin_amdgcn_global_load_lds((const unsigned*)(VB + vrow_ * 512 + h * 64 + (wid >> 2) * 32 + (lane & 3) * 8), (LAS unsigned*)(lds + L_V + (slot) * VSLOT + wid * 1024), 16, 0, 0); } while (0)
    MLA_DMA(0, 0);
    bf16x8 qr[6];
    { const bf16* Qw = QB + (rowbase + q0 + wid * 32 + r32) * 768 + h * 96 + hi * 8;
#pragma unroll
      for (int d0 = 0; d0 < 6; ++d0) qr[d0] = *(const bf16x8*)(Qw + d0 * 16); }
    float m = -INFINITY, l = 0.f; f32x16 o[2];
#pragma unroll
    for (int r = 0; r < 16; ++r) { o[0][r] = 0.f; o[1][r] = 0.f; }
    const int kofs = hi * 1024 + r32 * 16;
    const int vb0 = (int)(unsigned)(uintptr_t)(lds + L_V) + ((lane >> 4) & 1) * 32 + (lane & 3) * 8 + (4 * hi + ((lane & 15) >> 2)) * 64;
    for (int t = 0; t < NT; ++t) {
        asm volatile("s_waitcnt vmcnt(0) lgkmcnt(0)\n\ts_barrier" ::: "memory");
        if (t + 1 < NT) MLA_DMA(t + 1, (t + 1) & 1);
        if (t <= my_last) {
            const int slot = t & 1;
            const LAS unsigned char* kb = lds + L_K + slot * KSLOT + kofs;
            f32x16 p0, p1;
#pragma unroll
            for (int r = 0; r < 16; ++r) { p0[r] = 0.f; p1[r] = 0.f; }
#pragma unroll
            for (int d0 = 0; d0 < 6; ++d0) {
                const bf16x8 b0 = *(const LAS bf16x8*)(kb + d0 * 2048), b1 = *(const LAS bf16x8*)(kb + d0 * 2048 + 512);
                p0 = __builtin_amdgcn_mfma_f32_32x32x16_bf16(b0, qr[d0], p0, 0, 0, 0);
                p1 = __builtin_amdgcn_mfma_f32_32x32x16_bf16(b1, qr[d0], p1, 0, 0, 0); }
            float rm = fmaxf(p0[0], p1[0]);
#pragma unroll
            for (int r = 1; r < 16; ++r) rm = fmaxf(rm, fmaxf(p0[r], p1[r]));
            rm = fmaxf(rm, xhalf(rm));
            if (__any(rm > m)) {
                const float mn = fmaxf(m, rm), f = __builtin_amdgcn_exp2f(m - mn);
                l *= f; m = mn;
                if (hi == 0) wsf[r32] = f;
                asm volatile("s_waitcnt lgkmcnt(0)" ::: "memory");
#pragma unroll
                for (int r = 0; r < 16; ++r) { const float fr_ = wsf[crow(r, hi)]; o[0][r] *= fr_; o[1][r] *= fr_; }
            }
            float sacc = 0.f;
#pragma unroll
            for (int r = 0; r < 16; ++r) { p0[r] = __builtin_amdgcn_exp2f(p0[r] - m); p1[r] = __builtin_amdgcn_exp2f(p1[r] - m); sacc += p0[r] + p1[r]; }
            l += sacc;
            u32x4 pw0, pw1, pw2, pw3;
            pw0 = (u32x4){pg8::cvt_pk_bf16(p0[0], p0[1]), pg8::cvt_pk_bf16(p0[2], p0[3]), pg8::cvt_pk_bf16(p0[4], p0[5]), pg8::cvt_pk_bf16(p0[6], p0[7])};
            pw1 = (u32x4){pg8::cvt_pk_bf16(p0[8], p0[9]), pg8::cvt_pk_bf16(p0[10], p0[11]), pg8::cvt_pk_bf16(p0[12], p0[13]), pg8::cvt_pk_bf16(p0[14], p0[15])};
            pw2 = (u32x4){pg8::cvt_pk_bf16(p1[0], p1[1]), pg8::cvt_pk_bf16(p1[2], p1[3]), pg8::cvt_pk_bf16(p1[4], p1[5]), pg8::cvt_pk_bf16(p1[6], p1[7])};
            pw3 = (u32x4){pg8::cvt_pk_bf16(p1[8], p1[9]), pg8::cvt_pk_bf16(p1[10], p1[11]), pg8::cvt_pk_bf16(p1[12], p1[13]), pg8::cvt_pk_bf16(p1[14], p1[15])};
            pv(o, vb0 + slot * VSLOT, __builtin_bit_cast(bf16x8, pw0), __builtin_bit_cast(bf16x8, pw1), __builtin_bit_cast(bf16x8, pw2), __builtin_bit_cast(bf16x8, pw3));
        }
    }
#undef MLA_DMA
    l += xhalf(l);
    if (hi == 0) wsf[32 + r32] = l;
    asm volatile("s_waitcnt lgkmcnt(0)" ::: "memory");
    LAS bf16* stg = (LAS bf16*)(lds + L_OST) + wid * 2048;
#pragma unroll
    for (int r = 0; r < 16; ++r) { const int orow = crow(r, hi); const float rl = __builtin_amdgcn_rcpf(wsf[32 + orow]);
        stg[orow * 64 + r32] = (bf16)(pg8::cvt_pk_bf16(o[0][r] * rl, 0.f) & 0xffffu); stg[orow * 64 + 32 + r32] = (bf16)(pg8::cvt_pk_bf16(o[1][r] * rl, 0.f) & 0xffffu); }
    asm volatile("s_waitcnt lgkmcnt(0)" ::: "memory");
    bf16* Ow = OB + (rowbase + q0 + wid * 32) * 512 + h * 64;
#pragma unroll
    for (int i = 0; i < 4; ++i) { const int row = i * 8 + (lane >> 3), ch = lane & 7; const u32x4 v = *(const LAS u32x4*)(stg + row * 64 + ch * 8); *(u32x4*)(Ow + (size_t)row * 512 + ch * 8) = v; }
    asm volatile("s_waitcnt lgkmcnt(0)\n\ts_barrier" ::: "memory");
}
__device__ __forceinline__ void phase(int vcu, int G, const bf16* QB, const bf16* KN, const bf16* KPE, const bf16* VB, bf16* OB, LAS unsigned char* lds) {
    for (int u = vcu; u < 1024; u += G) { const int i = u >> 8, v = u & 255, bh = v >> 3, s = v & 7;
        const int qb = (i == 0) ? s : (i == 1) ? 15 - s : (i == 2) ? 16 + s : 31 - s;
        attn_unit(bh >> 3, bh & 7, qb, QB, KN, KPE, VB, OB, lds); }
}
}

namespace idx {
typedef short bf16x8 __attribute__((ext_vector_type(8)));
typedef float f32x16 __attribute__((ext_vector_type(16)));
typedef unsigned u32x2 __attribute__((ext_vector_type(2)));
constexpr int CAP = 512, TRIG = 448;
constexpr int L_CAND = 0, L_KT = 32 * CAP * 8, KTB = 8192, L_END = L_KT + 2 * KTB;
static_assert(L_END <= RING_BYTES, "indexer LDS");
__device__ __forceinline__ unsigned okey(float f) { const unsigned u = __float_as_uint(f); return (u & 0x80000000u) ? ~u : (u | 0x80000000u); }
__device__ __forceinline__ float ikey(unsigned k) { return __uint_as_float((k & 0x80000000u) ? (k ^ 0x80000000u) : ~k); }
__device__ __forceinline__ int prefix64(unsigned long long m) { return (int)__builtin_amdgcn_mbcnt_hi((unsigned)(m >> 32), __builtin_amdgcn_mbcnt_lo((unsigned)m, 0u)); }
__device__ __forceinline__ int count_ge(const unsigned (&k)[8], unsigned thr) { int c = 0;
#pragma unroll
    for (int j = 0; j < 8; ++j) c += __popcll(__ballot(k[j] >= thr));
    return c; }
template <bool FINAL> __device__ __forceinline__ int select(LAS u32x2* cand, int n, int lane, unsigned& thr_key, unsigned short* sel_out) {
    unsigned k[8], ix[8]; float sc[8];
#pragma unroll
    for (int j = 0; j < 8; ++j) { const int e = lane + 64 * j; const bool v = e < n; const u32x2 en = cand[v ? e : 0]; sc[j] = __uint_as_float(en.x); ix[j] = en.y; k[j] = v ? okey(sc[j]) : 0u; }
    unsigned kmin = 0xffffffffu, kmax = 0u;
#pragma unroll
    for (int j = 0; j < 8; ++j) { if (k[j] != 0u) { kmin = min(kmin, k[j]); kmax = max(kmax, k[j]); } }
#pragma unroll
    for (int o = 1; o < 64; o <<= 1) { kmin = min(kmin, (unsigned)__shfl_xor((int)kmin, o)); kmax = max(kmax, (unsigned)__shfl_xor((int)kmax, o)); }
    unsigned lo = kmin, hx = kmax + 1u; int c_lo = n;
    const int accept = FINAL ? 256 : 384;
    for (int it = 0; it < 40 && c_lo > accept && hx - lo > 1u; ++it) {
        const unsigned mid = lo + ((hx - lo) >> 1); const int c = count_ge(k, mid);
        if (c >= 256) { lo = mid; c_lo = c; } else hx = mid; }
    const unsigned Tk = lo;
    int r_eq = 1 << 30;
    if (FINAL || c_lo > accept) r_eq = 256 - count_ge(k, Tk + 1u);
    int running = 0, eqrun = 0;
#pragma unroll
    for (int j = 0; j < 8; ++j) {
        const bool gt = k[j] > Tk, eq = (k[j] == Tk);
        const unsigned long long meq = __ballot(eq);
        const bool take = gt || (eq && (eqrun + prefix64(meq)) < r_eq);
        const unsigned long long mt = __ballot(take);
        const int pos = running + prefix64(mt);
        if (take) { if (FINAL) { if (pos < 256) sel_out[pos] = (unsigned short)ix[j]; } else cand[pos] = (u32x2){__float_as_uint(sc[j]), ix[j]}; }
        running += __popcll(mt); eqrun += __popcll(meq);
    }
    thr_key = Tk;
    return running;
}
__device__ __forceinline__ void unit(int b, int g, const bf16* QI, const bf16* KI, const float* WI, unsigned short* SEL, LAS unsigned char* lds) {
    const int q0 = g * 32, L = 64 * (q0 / 64 + 1);
    if (L <= 256) return;
    const int tid = threadIdx.x, lane = tid & 63, c = lane & 31, hi = lane >> 5; const int wid = __builtin_amdgcn_readfirstlane(tid >> 6);
    const size_t rowbase = (size_t)b * T; const int ntile = L / 64;
    bf16x8 Af[4];
    { const int r = c, jq = ((r >> 2) & 1) + 2 * (r >> 4), hd = (r & 3) + 4 * ((r >> 3) & 1);
      const bf16* qp = QI + (rowbase + q0 + 4 * wid + jq) * 512 + hd * 64 + 8 * hi;
#pragma unroll
      for (int s = 0; s < 4; ++s) Af[s] = *(const bf16x8*)(qp + 16 * s); }
    float wv[2][8];
#pragma unroll
    for (int u = 0; u < 2; ++u) { const float* wp = WI + (rowbase + q0 + 4 * wid + hi + 2 * u) * 8; const f32x4 a = *(const f32x4*)wp, bq = *(const f32x4*)(wp + 4);
#pragma unroll
        for (int i = 0; i < 4; ++i) { wv[u][i] = a[i] * (0.125f * 0.35355339059327373f); wv[u][4 + i] = bq[i] * (0.125f * 0.35355339059327373f); } }
    float tau[2] = {-INFINITY, -INFINITY}; int cnt[2] = {0, 0};
    LAS u32x2* cbase = (LAS u32x2*)(lds + L_CAND) + (size_t)(wid * 4) * CAP;
#define IDX_DMA(t, slot) __builtin_amdgcn_global_load_lds((const unsigned*)(KI + (rowbase + (size_t)(t) * 64 + lane) * 64 + wid * 8), (LAS unsigned*)(lds + L_KT + (slot) * KTB + wid * 1024), 16, 0, 0)
    IDX_DMA(0, 0);
    for (int t = 0; t < ntile; ++t) {
        asm volatile("s_waitcnt vmcnt(0) lgkmcnt(0)\n\ts_barrier" ::: "memory");
        if (t + 1 < ntile) IDX_DMA(t + 1, (t + 1) & 1);
        const LAS unsigned char* kb = lds + L_KT + (t & 1) * KTB + hi * 1024 + c * 16;
#pragma unroll
        for (int kh = 0; kh < 2; ++kh) {
            f32x16 acc;
#pragma unroll
            for (int r = 0; r < 16; ++r) acc[r] = 0.f;
#pragma unroll
            for (int s = 0; s < 4; ++s) { const bf16x8 Bf = *(const LAS bf16x8*)(kb + s * 2048 + kh * 512); acc = __builtin_amdgcn_mfma_f32_32x32x16_bf16(Af[s], Bf, acc, 0, 0, 0); }
            const unsigned key = (unsigned)(t * 64 + kh * 32 + c);
#pragma unroll
            for (int u = 0; u < 2; ++u) {
                float s = 0.f;
#pragma unroll
                for (int i = 0; i < 8; ++i) s = fmaf(fmaxf(acc[8 * u + i], 0.f), wv[u][i], s);
                const bool pass = s > tau[u];
                const unsigned long long m = __ballot(pass);
                if (m) {
                    const unsigned mlo = (unsigned)m, mhi = (unsigned)(m >> 32);
                    const int pre = hi ? (int)__builtin_amdgcn_mbcnt_hi(mhi, 0u) : (int)__builtin_amdgcn_mbcnt_lo(mlo, 0u);
                    if (pass) cbase[(size_t)(hi + 2 * u) * CAP + cnt[u] + pre] = (u32x2){__float_as_uint(s), key};
                    cnt[u] += hi ? __popc(mhi) : __popc(mlo);
                }
            }
        }
#pragma unroll
        for (int u = 0; u < 2; ++u)
#pragma unroll
            for (int hh = 0; hh < 2; ++hh) {
                const int n = __builtin_amdgcn_readlane(cnt[u], hh * 32);
                if (n > TRIG) { unsigned tk; asm volatile("s_waitcnt lgkmcnt(0)" ::: "memory");
                    const int nn = select<false>(cbase + (size_t)(hh + 2 * u) * CAP, n, lane, tk, nullptr);
                    if (hi == hh) { cnt[u] = nn; tau[u] = ikey(tk); } }
            }
    }
#undef IDX_DMA
    asm volatile("s_waitcnt lgkmcnt(0)" ::: "memory");
#pragma unroll
    for (int u = 0; u < 2; ++u)
#pragma unroll
        for (int hh = 0; hh < 2; ++hh) {
            const int n = __builtin_amdgcn_readlane(cnt[u], hh * 32); unsigned tk;
            (void)select<true>(cbase + (size_t)(hh + 2 * u) * CAP, n, lane, tk, SEL + (rowbase + q0 + 4 * wid + hh + 2 * u) * 256);
        }
    asm volatile("s_waitcnt lgkmcnt(0)\n\ts_barrier" ::: "memory");
}
__device__ __forceinline__ void phase(int vcu, int G, const bf16* QI, const bf16* KI, const float* WI, unsigned short* SEL, LAS unsigned char* lds) {
    for (int u = vcu; u < 1024; u += G) { const int i = u >> 8, v = u & 255, b = v >> 6, s = v & 63;
        const int g = (i == 0) ? s : (i == 1) ? 127 - s : (i == 2) ? 128 + s : 255 - s;
        unit(b, g, QI, KI, WI, SEL, lds); }
}
}

namespace dsa {
typedef unsigned u32x4m __attribute__((ext_vector_type(4)));
typedef unsigned u32x2m __attribute__((ext_vector_type(2)));
typedef short bf16x8 __attribute__((ext_vector_type(8)));
typedef short v4i16 __attribute__((ext_vector_type(4)));
constexpr int WREG = 17408, L_BIAS = 8 * WREG, L_END = L_BIAS + 33 * 8 * 4;
static_assert(L_END <= RING_BYTES, "dsa LDS");
constexpr float LOG2E = 1.4426950408889634f;
__device__ __forceinline__ int t5_bucket(int rel) {
    const int n = rel < 0 ? -rel : rel; const int r = rel > 0 ? 16 : 0;
    if (n < 8) return r + n;
    int lg = (31 - __clz(n * n)) - 6; if (n >= 128 || lg > 7) lg = 7;
    return r + 8 + lg;
}
__device__ __forceinline__ void phase(int vcu, int G, const bf16* QA, const bf16* KA, const bf16* VA, const unsigned short* SEL, const int* positions, const float* rel_bias, bf16* OA, LAS unsigned char* lds) {
    const int tid = threadIdx.x, lane = tid & 63, l15 = lane & 15, kq = lane >> 4; const int wid = __builtin_amdgcn_readfirstlane(tid >> 6);
    LAS float* bt = (LAS float*)(lds + L_BIAS);
    for (int i = tid; i < 33 * 8; i += NWAVES * 64) bt[i] = (i < 256) ? rel_bias[i] * LOG2E : -INFINITY;
    __syncthreads();
    LAS unsigned char* wl = lds + wid * WREG;
    LAS unsigned short* selL = (LAS unsigned short*)(wl + 16384); LAS unsigned char* bktL = wl + 16384 + 512;
    const int gw = vcu * NWAVES + wid, NGW = G * NWAVES;
    const int trofs = ((l15 >> 2) + 4 * kq) * 128 + (l15 & 3) * 8;
    for (int q = gw; q < M; q += NGW) {
        const int b = q >> 13, t = q & (T - 1); const size_t rowbase = (size_t)b * T;
        const int limit = 64 * (t / 64 + 1), nvalid = limit < 256 ? limit : 256; const int posq = positions[q];
#pragma unroll
        for (int j = 0; j < 4; ++j) { const int k = lane + 64 * j; const int sv = (limit <= 256) ? (k < limit ? k : limit - 1) : (int)SEL[(size_t)q * 256 + k];
            const int bk = (k < nvalid) ? t5_bucket(positions[rowbase + sv] - posq) : 32; selL[k] = (unsigned short)sv; bktL[k] = (unsigned char)bk; }
        asm volatile("s_waitcnt lgkmcnt(0)" ::: "memory");
#define DSA_VDMA(cch, buf) do { _Pragma("unroll") for (int i_ = 0; i_ < 8; ++i_) { const int row_ = selL[64 * (cch) + 8 * i_ + (lane >> 3)]; \
            __builtin_amdgcn_global_load_lds((const unsigned*)(VA + (rowbase + row_) * 64 + (lane & 7) * 8), (LAS unsigned*)(wl + (buf) * 8192 + i_ * 1024), 16, 0, 0); } } while (0)
        DSA_VDMA(0, 0); DSA_VDMA(1, 1);
        bf16x8 Qf[2];
#pragma unroll
        for (int s = 0; s < 2; ++s) { Qf[s] = (bf16x8){0, 0, 0, 0, 0, 0, 0, 0}; if (l15 < 8) Qf[s] = *(const bf16x8*)(QA + (size_t)q * 512 + l15 * 64 + 32 * s + 8 * kq); }
        f32x4 St[16];
#pragma unroll
        for (int half = 0; half < 2; ++half) {
            bf16x8 Ka[8][2];
#pragma unroll
            for (int i = 0; i < 8; ++i) { const int row = selL[16 * (8 * half + i) + l15]; const bf16* kp = KA + (rowbase + row) * 64 + 8 * kq;
                Ka[i][0] = *(const bf16x8*)kp; Ka[i][1] = *(const bf16x8*)(kp + 32); }
#pragma unroll
            for (int i = 0; i < 8; ++i) { f32x4 a = {0.f, 0.f, 0.f, 0.f};
                a = __builtin_amdgcn_mfma_f32_16x16x32_bf16(Ka[i][0], Qf[0], a, 0, 0, 0); a = __builtin_amdgcn_mfma_f32_16x16x32_bf16(Ka[i][1], Qf[1], a, 0, 0, 0); St[8 * half + i] = a; }
        }
        float mx = -INFINITY;
#pragma unroll
        for (int kt = 0; kt < 16; ++kt) { const unsigned bk4 = *(const LAS unsigned*)(bktL + 16 * kt + 4 * kq);
#pragma unroll
            for (int i = 0; i < 4; ++i) { const float s = St[kt][i] * (0.125f * LOG2E) + bt[((bk4 >> (8 * i)) & 255u) * 8 + (l15 & 7)]; St[kt][i] = s; mx = fmaxf(mx, s); } }
        mx = fmaxf(mx, __shfl_xor(mx, 16)); mx = fmaxf(mx, __shfl_xor(mx, 32));
        float lsum = 0.f;
#pragma unroll
        for (int kt = 0; kt < 16; ++kt)
#pragma unroll
            for (int i = 0; i < 4; ++i) { const float p = __builtin_amdgcn_exp2f(St[kt][i] - mx); St[kt][i] = p; lsum += p; }
        lsum += __shfl_xor(lsum, 16); lsum += __shfl_xor(lsum, 32);
        f32x4 O[4];
#pragma unroll
        for (int dt = 0; dt < 4; ++dt) O[dt] = (f32x4){0.f, 0.f, 0.f, 0.f};
#pragma unroll
        for (int cch = 0; cch < 4; ++cch) {
            if (cch < 2) { if (cch == 0) asm volatile("s_waitcnt vmcnt(8)" ::: "memory"); else asm volatile("s_waitcnt vmcnt(0)" ::: "memory"); }
            else asm volatile("s_waitcnt vmcnt(0)" ::: "memory");
            const LAS unsigned char* vb = wl + (cch & 1) * 8192 + trofs;
#pragma unroll
            for (int k2 = 0; k2 < 2; ++k2) {
                const int kk = 2 * cch + k2;
                const f32x4 pa = St[2 * kk], pb = St[2 * kk + 1];
                u32x4m pw; pw.x = pg8::cvt_pk_bf16(pa[0], pa[1]); pw.y = pg8::cvt_pk_bf16(pa[2], pa[3]); pw.z = pg8::cvt_pk_bf16(pb[0], pb[1]); pw.w = pg8::cvt_pk_bf16(pb[2], pb[3]);
                const bf16x8 Pf = __builtin_bit_cast(bf16x8, pw);
#pragma unroll
                for (int dt = 0; dt < 4; ++dt) {
                    const v4i16 v0 = __builtin_amdgcn_ds_read_tr16_b64_v4i16((LAS v4i16*)(vb + k2 * 4096 + dt * 32));
                    const v4i16 v1 = __builtin_amdgcn_ds_read_tr16_b64_v4i16((LAS v4i16*)(vb + k2 * 4096 + 2048 + dt * 32));
                    const bf16x8 Vf = (bf16x8){v0[0], v0[1], v0[2], v0[3], v1[0], v1[1], v1[2], v1[3]};
                    O[dt] = __builtin_amdgcn_mfma_f32_16x16x32_bf16(Vf, Pf, O[dt], 0, 0, 0); }
            }
            if (cch < 2) { asm volatile("s_waitcnt lgkmcnt(0)" ::: "memory"); DSA_VDMA(cch + 2, cch & 1); }
        }
#undef DSA_VDMA
        if (l15 < 8) { const float rl = __builtin_amdgcn_rcpf(lsum);
#pragma unroll
            for (int dt = 0; dt < 4; ++dt) { u32x2m w; w.x = pg8::cvt_pk_bf16(O[dt][0] * rl, O[dt][1] * rl); w.y = pg8::cvt_pk_bf16(O[dt][2] * rl, O[dt][3] * rl);
                *(u32x2m*)(OA + (size_t)q * 512 + l15 * 64 + 16 * dt + 4 * kq) = w; } }
        asm volatile("s_waitcnt lgkmcnt(0)" ::: "memory");
    }
}
}

constexpr int NPHASE = 16;
__global__ void __launch_bounds__(NWAVES * 64, 2) mk_fwd(Args args) {
    extern __shared__ __attribute__((aligned(16))) unsigned char lds[];
    Frame F;
    F.lds = (LAS unsigned char*)lds;
    F.MISC = (volatile LAS unsigned*)(F.lds + MISC_OFF);
    F.tid = threadIdx.x; F.lane = F.tid & 63; F.wave = __builtin_amdgcn_readfirstlane(F.tid >> 6);
    F.G = gridDim.x; { const int bx = blockIdx.x; F.vcu = (F.G % 8 == 0) ? (bx % 8) * (F.G / 8) + bx / 8 : bx; }
    unsigned char* ws = args.ws;
    F.ctl = (gu32*)(ws + WS_CTL);
    for (int u = F.tid; u < (LDS_BYTES - LDSCTL_OFF) / 4; u += NWAVES * 64) ((LAS unsigned*)(F.lds + LDSCTL_OFF))[u] = 0u;
    __syncthreads();
    XcdBarrier bar; bar.bar = (unsigned*)(F.ctl + CW_BAR); bar.x = 0; bar.st = nullptr;
    if (MK_FUSED) bar = xcd_barrier_post((unsigned*)(F.ctl + CW_BAR), F.MISC + 8);
#define GRID_BAR() do { if (MK_FUSED) xcd_barrier(bar); } while (0)
    const int lo = args.ph_lo, hi = args.ph_hi;
#ifdef ONLY_PH
#define IN(k) ((k) == ONLY_PH && lo <= (k) && (k) < hi)
#else
#define IN(k) (lo <= (k) && (k) < hi)
#endif
#define BOTH(k) (IN(k) && IN((k) + 1))
    const float* x = (const float*)args.in[0];
    const float* mod = (const float*)(ws + WS_MOD);
    bf16* XN = (bf16*)(ws + WS_XN); bf16* ACT = (bf16*)(ws + WS_ACT);
    float* X1 = args.out;
    const float* rcos = (const float*)(ws + WS_RCOS); const float* rsin = (const float*)(ws + WS_RSIN);
    float* ssq_q = (float*)(ws + WS_SSQQ); float* ssq_kv = (float*)(ws + WS_SSQKV);

    if (IN(0)) { p0_prologue(F, args); if (BOTH(0)) GRID_BAR(); }
    if (IN(1)) { norm_mod_phase(F, x, (const float*)args.in[5], mod, 0 * D, 1 * D, XN); if (BOTH(1)) GRID_BAR(); }
    if (IN(2)) {
        pg8::Gemm g{XN, (const bf16*)(ws + WS_W1A), M, 2 * DFF, D}; pg8::StaticOrder S; S.init(M, 2 * DFF, F.G, (int)blockIdx.x);
        pg8::EpiSwiglu E{ACT, DFF};
        pg8::gemm_phase<pg8::EpiSwiglu, pg8::StaticOrder, true, true>(F.lds + RING_OFF, g, S, E);
        if (BOTH(2)) GRID_BAR(); }
    if (IN(3)) {
        pg8::Gemm g{ACT, (const bf16*)(ws + WS_W1D), M, D, DFF}; pg8::StaticOrder S; S.init(M, D, F.G, (int)blockIdx.x);
        pg8::EpiResid E{x, X1, mod, 2 * D, 0.5f};
        pg8::gemm_phase<pg8::EpiResid, pg8::StaticOrder, true, true>(F.lds + RING_OFF, g, S, E);
        if (BOTH(3)) GRID_BAR(); }
    if (IN(4)) { norm_mod_phase(F, X1, (const float*)args.in[8], mod, 3 * D, 4 * D, XN); if (BOTH(4)) GRID_BAR(); }
    if (IN(5)) {
        pg8::Gemm g{XN, (const bf16*)(ws + WS_WIN), M, NPROJ, D}; pg8::StaticOrder S; S.init(M, NPROJ, F.G, (int)blockIdx.x);
        pg8::EpiProj E{(bf16*)(ws + WS_QA), (bf16*)(ws + WS_QI), (bf16*)(ws + WS_CQ), (bf16*)(ws + WS_CKV), (bf16*)(ws + WS_KA), (bf16*)(ws + WS_VA), (bf16*)(ws + WS_KI), (bf16*)(ws + WS_KPE), (bf16*)(ws + WS_G),
                       (float*)(ws + WS_WI), ssq_q, ssq_kv, rcos, rsin};
        pg8::gemm_phase<pg8::EpiProj, pg8::StaticOrder, true, true>(F.lds + RING_OFF, g, S, E);
        if (BOTH(5)) GRID_BAR(); }
    if (IN(6)) {
#ifndef P6_NO_Q
        { pg8::Gemm g{(const bf16*)(ws + WS_CQ), (const bf16*)(ws + WS_WUQ), M, 768, 384}; pg8::StaticOrder S; S.init(M, 768, F.G, (int)blockIdx.x);
          pg8::EpiUpQ E{(bf16*)(ws + WS_QB), ssq_q, rcos, rsin};
          pg8::gemm_phase<pg8::EpiUpQ, pg8::StaticOrder, true, true>(F.lds + RING_OFF, g, S, E); }
#endif
        __syncthreads();
#ifndef P6_NO_KV
        { pg8::Gemm g{(const bf16*)(ws + WS_CKV), (const bf16*)(ws + WS_WUKV), M, 1024, 256}; pg8::StaticOrder S; S.init(M, 1024, F.G, (int)blockIdx.x);
          pg8::EpiUpKV E{(bf16*)(ws + WS_KN), (bf16*)(ws + WS_VB), ssq_kv};
          pg8::gemm_phase<pg8::EpiUpKV, pg8::StaticOrder, true, true>(F.lds + RING_OFF, g, S, E); }
#endif
        __syncthreads(); }
    if (IN(7)) { idx::phase(F.vcu, F.G, (const bf16*)(ws + WS_QI), (const bf16*)(ws + WS_KI), (const float*)(ws + WS_WI), (unsigned short*)(ws + WS_SEL), F.lds + RING_OFF); if (BOTH(7)) GRID_BAR(); }
    if (IN(8)) { dsa::phase(F.vcu, F.G, (const bf16*)(ws + WS_QA), (const bf16*)(ws + WS_KA), (const bf16*)(ws + WS_VA), (const unsigned short*)(ws + WS_SEL), (const int*)args.in[2], (const float*)args.in[15], (bf16*)(ws + WS_OA), F.lds + RING_OFF); __syncthreads(); }
    if (IN(9)) { mla::phase(F.vcu, F.G, (const bf16*)(ws + WS_QB), (const bf16*)(ws + WS_KN), (const bf16*)(ws + WS_KPE), (const bf16*)(ws + WS_VB), (bf16*)(ws + WS_OB), F.lds + RING_OFF); if (BOTH(9)) GRID_BAR(); }
    if (IN(10)) {
        { pg8::Gemm g{(const bf16*)(ws + WS_OA), (const bf16*)(ws + WS_WOA), M, D, 512}; pg8::StaticOrder S; S.init(M, D, F.G, (int)blockIdx.x);
#ifdef EXP_ONE_GATE
          pg8::EpiGate<false> E{(const bf16*)(ws + WS_G), 0, nullptr, (bf16*)(ws + WS_Y)};
#else
          pg8::EpiGate<false> E{(const bf16*)(ws + WS_G), 0, nullptr, (bf16*)(ws + WS_Y1)};
#endif
          pg8::gemm_phase<pg8::EpiGate<false>, pg8::StaticOrder, true, true>(F.lds + RING_OFF, g, S, E); }
        VM_WAIT(); __syncthreads();
#ifndef EXP_ONE_GATE
        { pg8::Gemm g{(const bf16*)(ws + WS_OB), (const bf16*)(ws + WS_WOB), M, D, 512}; pg8::StaticOrder S; S.init(M, D, F.G, (int)blockIdx.x);
          pg8::EpiGate<true> E{(const bf16*)(ws + WS_G), 1024, (const bf16*)(ws + WS_Y1), (bf16*)(ws + WS_Y)};
          pg8::gemm_phase<pg8::EpiGate<true>, pg8::StaticOrder, true, true>(F.lds + RING_OFF, g, S, E); }
#endif
        if (BOTH(10)) GRID_BAR(); }
    if (IN(11)) {
        pg8::Gemm g{(const bf16*)(ws + WS_Y), (const bf16*)(ws + WS_WOUT), M, D, D}; pg8::StaticOrder S; S.init(M, D, F.G, (int)blockIdx.x);
        pg8::EpiResid E{X1, X1, mod, 5 * D, 1.0f};
        pg8::gemm_phase<pg8::EpiResid, pg8::StaticOrder, true, true>(F.lds + RING_OFF, g, S, E);
        if (BOTH(11)) GRID_BAR(); }
    if (IN(12)) { norm_mod_phase(F, X1, (const float*)args.in[19], mod, 6 * D, 7 * D, XN); if (BOTH(12)) GRID_BAR(); }
    if (IN(13)) {
        pg8::Gemm g{XN, (const bf16*)(ws + WS_W2A), M, 2 * DFF, D}; pg8::StaticOrder S; S.init(M, 2 * DFF, F.G, (int)blockIdx.x);
        pg8::EpiSwiglu E{ACT, DFF};
        pg8::gemm_phase<pg8::EpiSwiglu, pg8::StaticOrder, true, true>(F.lds + RING_OFF, g, S, E);
        if (BOTH(13)) GRID_BAR(); }
    if (IN(14)) {
        pg8::Gemm g{ACT, (const bf16*)(ws + WS_W2D), M, D, DFF}; pg8::StaticOrder S; S.init(M, D, F.G, (int)blockIdx.x);
        pg8::EpiResid E{X1, X1, mod, 8 * D, 0.5f};
        pg8::gemm_phase<pg8::EpiResid, pg8::StaticOrder, true, true>(F.lds + RING_OFF, g, S, E);
        if (BOTH(14)) GRID_BAR(); }
    if (IN(15)) { final_norm_phase(F, X1, (const float*)args.in[22], args.out); }
#undef IN
#undef BOTH
}

__device__ __forceinline__ float bf2f(bf16 v) { return __uint_as_float((unsigned)v << 16); }
__device__ __forceinline__ int t5_bucket(int rel) {
    const int n = rel < 0 ? -rel : rel; const int r = rel > 0 ? 16 : 0;
    if (n < 8) return r + n;
    int lg = (31 - __clz(n * n)) - 6; if (n >= 128 || lg > 7) lg = 7;
    return r + 8 + lg;
}
__device__ __forceinline__ unsigned okey(float f) { const unsigned u = __float_as_uint(f); return (u & 0x80000000u) ? ~u : (u | 0x80000000u); }

__global__ void __launch_bounds__(256) k_dsa(const bf16* QI, const bf16* KI, const float* WI, const bf16* QA, const bf16* KA, const bf16* VA, const int* positions, const float* rel_bias, bf16* OA, const unsigned short* SEL) {
    __shared__ float sc[T];
    __shared__ float qi[512];
    __shared__ float qa[512];
    __shared__ float wi[8];
    __shared__ unsigned hist[256];
    __shared__ int sel[256];
    __shared__ float pr[8][256];
    __shared__ float red[8][4];
    __shared__ unsigned sh_prefix, sh_need, sh_cnt;
    __shared__ unsigned tcnt[256];
    const int gq = blockIdx.x, b = gq >> 13, t = gq & (T - 1), tid = threadIdx.x;
    const size_t rb = (size_t)b * T;
    const int limit = (t / 64 + 1) * 64;
    for (int j = tid; j < 512; j += 256) { qi[j] = bf2f(QI[(size_t)gq * 512 + j]); qa[j] = bf2f(QA[(size_t)gq * 512 + j]); }
    if (tid < 8) wi[tid] = WI[(size_t)gq * 8 + tid] * 0.35355339059327373f;
    __syncthreads();
    int nvalid;
    if (limit <= 256) { sel[tid] = tid; nvalid = limit; __syncthreads(); }
    else if (SEL) { sel[tid] = SEL[(size_t)gq * 256 + tid]; nvalid = 256; __syncthreads(); }
    else {
        for (int s = tid; s < limit; s += 256) {
            const bf16* kr = KI + (rb + s) * 64;
            float kk[64];
#pragma unroll
            for (int d = 0; d < 64; ++d) kk[d] = bf2f(kr[d]);
            float score = 0.f;
            for (int h = 0; h < 8; ++h) { float dsum = 0.f;
#pragma unroll
                for (int d = 0; d < 64; ++d) dsum += qi[h * 64 + d] * kk[d];
                score += wi[h] * fmaxf(dsum * 0.125f, 0.f); }
            sc[s] = score;
        }
        __syncthreads();
        unsigned prefix = 0, need = 256;
        for (int pass = 0; pass < 4; ++pass) {
            const int shift = 24 - 8 * pass;
            hist[tid] = 0; __syncthreads();
            for (int s = tid; s < limit; s += 256) { const unsigned k = okey(sc[s]);
                if (pass == 0 || (k >> (shift + 8)) == prefix) atomicAdd(&hist[(k >> shift) & 255u], 1u); }
            __syncthreads();
            if (tid == 0) { unsigned cum = 0; int dgt = 255;
                for (; dgt >= 0; --dgt) { if (cum + hist[dgt] >= need) break; cum += hist[dgt]; }
                if (dgt < 0) dgt = 0;
                sh_prefix = (prefix << 8) | (unsigned)dgt; sh_need = need - cum; }
            __syncthreads();
            prefix = sh_prefix; need = sh_need;
            __syncthreads();
        }
        const unsigned Tk = prefix;
        if (tid == 0) sh_cnt = 0;
        const int per = (limit + 255) / 256; const int s0 = tid * per, s1 = min(limit, s0 + per);
        unsigned ceq = 0; for (int s = s0; s < s1; ++s) ceq += (okey(sc[s]) == Tk);
        tcnt[tid] = ceq; __syncthreads();
        if (tid == 0) { unsigned run = 0; for (int i = 0; i < 256; ++i) { const unsigned c = tcnt[i]; tcnt[i] = run; run += c; } }
        __syncthreads();
        unsigned rank = tcnt[tid];
        for (int s = s0; s < s1; ++s) { const unsigned k = okey(sc[s]);
            if (k > Tk) { const unsigned p = atomicAdd(&sh_cnt, 1u); if (p < 256) sel[p] = s; }
            else if (k == Tk) { if (rank < need) { const unsigned p = atomicAdd(&sh_cnt, 1u); if (p < 256) sel[p] = s; } ++rank; } }
        __syncthreads();
        nvalid = 256;
    }
    const bool valid = tid < nvalid;
    const int key = valid ? sel[tid] : 0;
    float sv[8];
    {
        const bf16* kr = KA + (rb + key) * 64;
        float kk[64];
#pragma unroll
        for (int d = 0; d < 64; ++d) kk[d] = bf2f(kr[d]);
        const int bkt = t5_bucket(positions[rb + key] - positions[rb + t]);
        for (int h = 0; h < 8; ++h) { float dsum = 0.f;
#pragma unroll
            for (int d = 0; d < 64; ++d) dsum += qa[h * 64 + d] * kk[d];
            sv[h] = valid ? dsum * 0.125f + rel_bias[bkt * 8 + h] : -INFINITY; }
    }
    const int wv = tid >> 6, lane = tid & 63;
    float mx[8];
    for (int h = 0; h < 8; ++h) { float m = sv[h]; for (int o = 1; o < 64; o <<= 1) m = fmaxf(m, __shfl_xor(m, o)); if (lane == 0) red[h][wv] = m; }
    __syncthreads();
    for (int h = 0; h < 8; ++h) mx[h] = fmaxf(fmaxf(red[h][0], red[h][1]), fmaxf(red[h][2], red[h][3]));
    __syncthreads();
    float ev[8];
    for (int h = 0; h < 8; ++h) { ev[h] = valid ? expf(sv[h] - mx[h]) : 0.f; float s = ev[h]; for (int o = 1; o < 64; o <<= 1) s += __shfl_xor(s, o); if (lane == 0) red[h][wv] = s; }
    __syncthreads();
    for (int h = 0; h < 8; ++h) { const float sum = (red[h][0] + red[h][1]) + (red[h][2] + red[h][3]); pr[h][tid] = ev[h] / sum; }
    __syncthreads();
    {
        const int h = tid >> 5, d = (tid & 31) * 2; float a0 = 0.f, a1 = 0.f;
        for (int k = 0; k < nvalid; ++k) { const float p = pr[h][k]; const unsigned v = *(const unsigned*)(VA + (rb + sel[k]) * 64 + d); a0 += p * __uint_as_float(v << 16); a1 += p * __uint_as_float(v & 0xffff0000u); }
        *(unsigned*)(OA + (size_t)gq * 512 + h * 64 + d) = pk2(a0, a1);
    }
}

__global__ void __launch_bounds__(64) k_mla(const bf16* QB, const bf16* KN, const bf16* KPE, const bf16* VB, bf16* OB) {
    const int chunk = (int)gridDim.x - 1 - (int)blockIdx.x, h = blockIdx.y, b = blockIdx.z, t = chunk * 64 + threadIdx.x;
    const int limit = (chunk + 1) * 64; const size_t rb = (size_t)b * T;
    float q[96], acc[64];
#pragma unroll
    for (int d = 0; d < 96; ++d) q[d] = bf2f(QB[(rb + t) * 768 + h * 96 + d]);
#pragma unroll
    for (int d = 0; d < 64; ++d) acc[d] = 0.f;
    float m = -INFINITY, l = 0.f;
    for (int s = 0; s < limit; ++s) {
        const bf16* kr = KN + (rb + s) * 512 + h * 64; const bf16* kp = KPE + (rb + s) * 32; const bf16* vr = VB + (rb + s) * 512 + h * 64;
        float sc = 0.f;
#pragma unroll
        for (int d = 0; d < 64; ++d) sc += q[d] * bf2f(kr[d]);
#pragma unroll
        for (int d = 0; d < 32; ++d) sc += q[64 + d] * bf2f(kp[d]);
        if (sc > m) { const float f = exp2f(m - sc); l *= f;
#pragma unroll
            for (int d = 0; d < 64; ++d) acc[d] *= f;
            m = sc; }
        const float p = exp2f(sc - m); l += p;
#pragma unroll
        for (int d = 0; d < 64; ++d) acc[d] += p * bf2f(vr[d]);
    }
    const float il = 1.f / l;
#pragma unroll
    for (int d = 0; d < 64; d += 2) *(unsigned*)(OB + (rb + t) * 512 + h * 64 + d) = pk2(acc[d] * il, acc[d + 1] * il);
}

__global__ void k_dump(const bf16* src, float* out, size_t n) { for (size_t i = (size_t)blockIdx.x * 256 + threadIdx.x; i < n; i += (size_t)gridDim.x * 256) out[i] = bf2f(src[i]); }
extern "C" void kernel_launch(void* const* d_in, const int* in_sizes, int n_in, void* d_out, int out_size, void* d_ws, size_t ws_size, hipStream_t stream) {
    static int grid = 0;
    if (grid == 0) {
        if (n_in != 23 || out_size != M * D || ws_size < WS_END) { fprintf(stderr, "kernel_launch: unexpected problem shape (n_in %d, out %d, ws %zu)\n", n_in, out_size, ws_size); grid = -1; return; }
        int dev = 0, cus = 0, per_cu = 0;
        if (hipGetDevice(&dev) != hipSuccess || hipDeviceGetAttribute(&cus, hipDeviceAttributeMultiprocessorCount, dev) != hipSuccess) { grid = -1; return; }
        if (hipFuncSetAttribute((const void*)mk_fwd, hipFuncAttributeMaxDynamicSharedMemorySize, LDS_BYTES) != hipSuccess) { fprintf(stderr, "kernel_launch: hipFuncSetAttribute failed\n"); grid = -1; return; }
        if (hipOccupancyMaxActiveBlocksPerMultiprocessor(&per_cu, (const void*)mk_fwd, NWAVES * 64, LDS_BYTES) != hipSuccess || per_cu < 1) fprintf(stderr, "kernel_launch: occupancy query reports %d\n", per_cu);
        (void)hipGetLastError();
        grid = cus;
    }
    if (grid < 0) return;
    (void)in_sizes;
    if (hipMemsetAsync((char*)d_ws + WS_CTL, 0, CTL_ZERO_BYTES, stream) != hipSuccess) return;
    Args a{};
    for (int i = 0; i < 23; ++i) a.in[i] = d_in[i];
    a.out = (float*)d_out; a.ws = (unsigned char*)d_ws;
    unsigned char* ws = (unsigned char*)d_ws;
    auto launch = [&](int lo, int hi) { a.ph_lo = lo; a.ph_hi = hi; a.li = 0; hipLaunchKernelGGL(mk_fwd, dim3(grid), dim3(NWAVES * 64), LDS_BYTES, stream, a); };
#if MK_FUSED
    launch(0, NPHASE);
#else
#ifdef EXP_SKIP_MIXER
    for (int p = 0; p <= 3; ++p) launch(p, p + 1);
    for (int p = 12; p < NPHASE; ++p) launch(p, p + 1);
    return;
#endif
#ifdef EXP_DUMP_Y
    for (int p = 0; p <= 5; ++p) launch(p, p + 1);
#else
    for (int p = 0; p <= 6; ++p) launch(p, p + 1);
#endif
    launch(7, 8);
    launch(8, 9);
    launch(9, 10);
#ifdef EXP_DUMP_Y
    k_dump<<<4096, 256, 0, stream>>>((const bf16*)(ws + WS_G), (float*)d_out, (size_t)M * D);
    return;
#endif
    for (int p = 10; p < NPHASE; ++p) launch(p, p + 1);
#endif
}
```

```cpp
#include <hip/hip_runtime.h>
#include <cstdio>
#include <cstdint>
namespace pg8 {
#define PG8_LAS __attribute__((address_space(3)))
typedef unsigned short bf16_t;
typedef short bf16x8 __attribute__((ext_vector_type(8)));
typedef float f32x4 __attribute__((ext_vector_type(4)));
typedef unsigned u32x4 __attribute__((ext_vector_type(4)));
constexpr int BM = 256, BK = 64, HALF = 128, HTB = HALF * BK * 2  , STAGE_BYTES = 8 * HTB, NXCD = 8, WGM = 8;

__host__ __device__ __forceinline__ int lds_byte(int r, int c) { const int st = (r >> 4) * 2 + (c >> 5), rr = r & 15, cc = c & 31, ob = rr * 64 + cc * 2; return st * 1024 + (ob ^ (((ob >> 9) & 1) << 5)); }
__host__ __device__ __forceinline__ void stage_rc(int b, int& R, int& C) { const int st = b / 1024, sb = b % 1024, swz = sb ^ (((sb >> 9) & 1) << 5); R = (st >> 1) * 16 + swz / 64; C = (st & 1) * 32 + (swz % 64) / 2; }
__host__ __device__ __forceinline__ int perm32(int rho) { const int n = rho >> 4, i = rho & 15; return 8 * (i >> 2) + 4 * n + (i & 3); }

struct Unit { int pm, pn; };
struct Gemm { const bf16_t* A; const bf16_t* Bt; int M, N, K; };

struct StaticOrder {
    int nM, nN, nwg, G, c;
    __host__ __device__ void init(int M, int N, int G_, int c_) { nM = M / BM; nN = N / BM; nwg = nM * nN; G = G_; c = c_; }
    __host__ __device__ bool next(int i, Unit& u) const {
        const long L = (long)i * G + c; if (L >= nwg) return false;
        int wgid = (int)L; { const int q = nwg / NXCD, r = nwg % NXCD, xcd = wgid % NXCD, off = wgid / NXCD; wgid = (xcd < r ? xcd * (q + 1) : r * (q + 1) + (xcd - r) * q) + off; }
        const int nig = WGM * nN, gid = wgid / nig, fm = gid * WGM, gsz = (nM - fm) < WGM ? (nM - fm) : WGM;
        u.pm = fm + ((wgid % nig) % gsz); u.pn = (wgid % nig) / gsz; return true;
    }
    __device__ __forceinline__ void a_ready(const Unit&) const {}
    __device__ __forceinline__ void done(const Unit&) const {}
};

typedef float f32x2 __attribute__((ext_vector_type(2)));
typedef __bf16 bf16x2_cv __attribute__((ext_vector_type(2)));
__device__ __forceinline__ unsigned cvt_pk_bf16(float lo, float hi) { const f32x2 v = {lo, hi}; const bf16x2_cv b = __builtin_convertvector(v, bf16x2_cv); return __builtin_bit_cast(unsigned, b); }

__device__ __forceinline__ u32x4 pack8(const f32x4 a, const f32x4 b) { u32x4 w; w.x = cvt_pk_bf16(a[0], a[1]); w.y = cvt_pk_bf16(a[2], a[3]); w.z = cvt_pk_bf16(b[0], b[1]); w.w = cvt_pk_bf16(b[2], b[3]); return w; }
__device__ __forceinline__ float sigm(float v) { return __builtin_amdgcn_rcpf(1.f + __builtin_amdgcn_exp2f(-1.4426950408889634f * v)); }
__device__ __forceinline__ f32x4 sigm4(const f32x4 v) { return (f32x4){sigm(v[0]), sigm(v[1]), sigm(v[2]), sigm(v[3])}; }
__device__ __forceinline__ void unpack8(const u32x4 w, f32x4& a, f32x4& b) {
    a = (f32x4){__uint_as_float(w.x << 16), __uint_as_float(w.x & 0xffff0000u), __uint_as_float(w.y << 16), __uint_as_float(w.y & 0xffff0000u)};
    b = (f32x4){__uint_as_float(w.z << 16), __uint_as_float(w.z & 0xffff0000u), __uint_as_float(w.w << 16), __uint_as_float(w.w & 0xffff0000u)}; }
constexpr float EPS_RMS = 1e-6f;
constexpr float QSCALE = 0.10206207261596575f * 1.4426950408889634f;

struct EpiSwiglu {
    static constexpr bool PERM = true, AFTER_DRAIN = false;
    bf16_t* O; int ldc;
    __device__ __forceinline__ void operator()(const f32x4 (&acc)[2][2][4][2], const Unit& u, int wr, int wc, int fr, int fq) const {
        const int row0 = u.pm * BM + wr * 64 + fr, col0 = u.pn * HALF + wc * 32 + 8 * fq;
#pragma unroll
        for (int ai = 0; ai < 2; ++ai)
#pragma unroll
            for (int m = 0; m < 4; ++m) {
                const f32x4 g0 = acc[ai][0][m][0], g1 = acc[ai][0][m][1], u0 = acc[ai][1][m][0], u1 = acc[ai][1][m][1];
                const f32x4 v0 = g0 * sigm4(g0) * u0, v1 = g1 * sigm4(g1) * u1;
                *(u32x4*)(O + (size_t)(row0 + ai * HALF + m * 16) * ldc + col0) = pack8(v0, v1); }
    }
};
struct EpiResid {
    static constexpr bool PERM = false, AFTER_DRAIN = false;
    const float* base; float* out; const float* mod; int goff; float scale;
    __device__ __forceinline__ void operator()(const f32x4 (&acc)[2][2][4][2], const Unit& u, int wr, int wc, int fr, int fq) const {
        const float* gate = mod + (u.pm >> 5) * 9216 + goff;
        const int col0 = u.pn * BM + wc * 32 + 4 * fq;
        f32x4 gv[2][2];
#pragma unroll
        for (int bj = 0; bj < 2; ++bj)
#pragma unroll
            for (int n = 0; n < 2; ++n) gv[bj][n] = *(const f32x4*)(gate + col0 + bj * HALF + n * 16) * scale;
#pragma unroll
        for (int ai = 0; ai < 2; ++ai)
#pragma unroll
            for (int m = 0; m < 4; ++m) { const size_t off = (size_t)(u.pm * BM + ai * HALF + wr * 64 + m * 16 + fr) * 1024 + col0;
#pragma unroll
                for (int bj = 0; bj < 2; ++bj)
#pragma unroll
                    for (int n = 0; n < 2; ++n) { const f32x4 bs = *(const f32x4*)(base + off + bj * HALF + n * 16); *(f32x4*)(out + off + bj * HALF + n * 16) = bs + gv[bj][n] * acc[ai][bj][m][n]; } }
    }
};
struct EpiProj {
    static constexpr bool PERM = true, AFTER_DRAIN = false;
    bf16_t *QA, *QI, *CQ, *CKV, *KA, *VA, *KI, *KPE, *G; float *WI, *ssq_q, *ssq_kv; const float *rcos, *rsin;
    __device__ __forceinline__ void operator()(const f32x4 (&acc)[2][2][4][2], const Unit& u, int wr, int wc, int fr, int fq) const {
        const int row0 = u.pm * BM + wr * 64 + fr, pn = u.pn, c32 = wc * 32 + 8 * fq;
#pragma unroll
        for (int ai = 0; ai < 2; ++ai)
#pragma unroll
            for (int m = 0; m < 4; ++m) {
                const size_t r = (size_t)(row0 + ai * HALF + m * 16);
                const f32x4 a0 = acc[ai][0][m][0], a1 = acc[ai][0][m][1], b0 = acc[ai][1][m][0], b1 = acc[ai][1][m][1];
                const float sa = (a0[0] * a0[0] + a0[1] * a0[1]) + (a0[2] * a0[2] + a0[3] * a0[3]) + (a1[0] * a1[0] + a1[1] * a1[1]) + (a1[2] * a1[2] + a1[3] * a1[3]);
                const float sb = (b0[0] * b0[0] + b0[1] * b0[1]) + (b0[2] * b0[2] + b0[3] * b0[3]) + (b1[0] * b1[0] + b1[1] * b1[1]) + (b1[2] * b1[2] + b1[3] * b1[3]);
                if (pn < 2) { bf16_t* p = QA + r * 512 + pn * 256 + c32; *(u32x4*)p = pack8(a0, a1); *(u32x4*)(p + HALF) = pack8(b0, b1); }
                else if (pn < 4) { bf16_t* p = QI + r * 512 + (pn - 2) * 256 + c32; *(u32x4*)p = pack8(a0, a1); *(u32x4*)(p + HALF) = pack8(b0, b1); }
                else if (pn == 4) { bf16_t* p = CQ + r * 384 + c32; *(u32x4*)p = pack8(a0, a1); *(u32x4*)(p + HALF) = pack8(b0, b1);
                    float s = sa + sb; s += __shfl_xor(s, 16); s += __shfl_xor(s, 32); if (fq == 0) ssq_q[r * 8 + wc] = s; }
                else if (pn == 5) { *(u32x4*)(CQ + r * 384 + 256 + c32) = pack8(a0, a1); *(u32x4*)(CKV + r * 256 + c32) = pack8(b0, b1);
                    float s = sa; s += __shfl_xor(s, 16); s += __shfl_xor(s, 32); float t = sb; t += __shfl_xor(t, 16); t += __shfl_xor(t, 32);
                    if (fq == 0) { ssq_q[r * 8 + 4 + wc] = s; ssq_kv[r * 8 + wc] = t; } }
                else if (pn == 6) { *(u32x4*)(CKV + r * 256 + 128 + c32) = pack8(a0, a1);
                    float s = sa; s += __shfl_xor(s, 16); s += __shfl_xor(s, 32); if (fq == 0) ssq_kv[r * 8 + 4 + wc] = s;
                    if (wc < 2) *(u32x4*)(KA + r * 64 + c32) = pack8(b0, b1); else *(u32x4*)(VA + r * 64 + (c32 - 64)) = pack8(b0, b1); }
                else if (pn == 7) {
                    if (wc < 2) *(u32x4*)(KI + r * 64 + c32) = pack8(a0, a1);
                    else if (wc == 2) {
                        const f32x4 c4 = *(const f32x4*)(rcos + r * 16 + 4 * fq), s4 = *(const f32x4*)(rsin + r * 16 + 4 * fq);
                        const f32x4 o0 = (f32x4){a0[0] * c4[0] - a0[1] * s4[0], a0[1] * c4[0] + a0[0] * s4[0], a0[2] * c4[1] - a0[3] * s4[1], a0[3] * c4[1] + a0[2] * s4[1]};
                        const f32x4 o1 = (f32x4){a1[0] * c4[2] - a1[1] * s4[2], a1[1] * c4[2] + a1[0] * s4[2], a1[2] * c4[3] - a1[3] * s4[3], a1[3] * c4[3] + a1[2] * s4[3]};
                        *(u32x4*)(KPE + r * 32 + 8 * fq) = pack8(o0, o1); }
                    else if (fq == 0) { *(f32x4*)(WI + r * 8) = a0; *(f32x4*)(WI + r * 8 + 4) = a1; }
                }
                else { bf16_t* p = G + r * 2048 + (pn - 8) * 256 + c32; *(u32x4*)p = pack8(sigm4(a0), sigm4(a1)); *(u32x4*)(p + HALF) = pack8(sigm4(b0), sigm4(b1)); }
            }
    }
};
struct EpiUpQ {
    static constexpr bool PERM = true, AFTER_DRAIN = false;
    bf16_t* QB; const float* ssq; const float *rcos, *rsin;
    __device__ __forceinline__ void operator()(const f32x4 (&acc)[2][2][4][2], const Unit& u, int wr, int wc, int fr, int fq) const {
        const int row0 = u.pm * BM + wr * 64 + fr;
#pragma unroll
        for (int ai = 0; ai < 2; ++ai)
#pragma unroll
            for (int m = 0; m < 4; ++m) {
                const size_t r = (size_t)(row0 + ai * HALF + m * 16);
                const f32x4 pa = *(const f32x4*)(ssq + r * 8), pb = *(const f32x4*)(ssq + r * 8 + 4);
                const float rs = __builtin_amdgcn_rsqf((((pa[0] + pa[1]) + (pa[2] + pa[3])) + ((pb[0] + pb[1]) + (pb[2] + pb[3]))) * (1.f / 384.f) + EPS_RMS) * QSCALE;
#pragma unroll
                for (int bj = 0; bj < 2; ++bj) {
                    const int c = u.pn * BM + bj * HALF + wc * 32 + 8 * fq;
                    const bool pe = ((u.pn * 8 + bj * 4 + wc) % 3) == 2;
                    f32x4 v0 = acc[ai][bj][m][0] * rs, v1 = acc[ai][bj][m][1] * rs;
                    if (pe) { const int i0 = 4 * fq;
                        const f32x4 c4 = *(const f32x4*)(rcos + r * 16 + i0), s4 = *(const f32x4*)(rsin + r * 16 + i0);
                        const f32x4 o0 = (f32x4){v0[0] * c4[0] - v0[1] * s4[0], v0[1] * c4[0] + v0[0] * s4[0], v0[2] * c4[1] - v0[3] * s4[1], v0[3] * c4[1] + v0[2] * s4[1]};
                        const f32x4 o1 = (f32x4){v1[0] * c4[2] - v1[1] * s4[2], v1[1] * c4[2] + v1[0] * s4[2], v1[2] * c4[3] - v1[3] * s4[3], v1[3] * c4[3] + v1[2] * s4[3]};
                        v0 = o0; v1 = o1; }
                    *(u32x4*)(QB + r * 768 + c) = pack8(v0, v1); }
                asm volatile("" ::: "memory"); }
    }
};
struct EpiUpKV {
    static constexpr bool PERM = true, AFTER_DRAIN = false;
    bf16_t *KN, *VB; const float* ssq;
    __device__ __forceinline__ void operator()(const f32x4 (&acc)[2][2][4][2], const Unit& u, int wr, int wc, int fr, int fq) const {
        const int row0 = u.pm * BM + wr * 64 + fr; bf16_t* dst = (u.pn < 2) ? KN : VB; const int c0 = (u.pn & 1) * BM + wc * 32 + 8 * fq;
#pragma unroll
        for (int ai = 0; ai < 2; ++ai)
#pragma unroll
            for (int m = 0; m < 4; ++m) {
                const size_t r = (size_t)(row0 + ai * HALF + m * 16);
                const f32x4 pa = *(const f32x4*)(ssq + r * 8), pb = *(const f32x4*)(ssq + r * 8 + 4);
                const float rs = __builtin_amdgcn_rsqf((((pa[0] + pa[1]) + (pa[2] + pa[3])) + ((pb[0] + pb[1]) + (pb[2] + pb[3]))) * (1.f / 256.f) + EPS_RMS);
#pragma unroll
                for (int bj = 0; bj < 2; ++bj) *(u32x4*)(dst + r * 512 + c0 + bj * HALF) = pack8(acc[ai][bj][m][0] * rs, acc[ai][bj][m][1] * rs);
                asm volatile("" ::: "memory"); }
    }
};
template <bool ADD> struct EpiGate {
    static constexpr bool PERM = true, AFTER_DRAIN = false;
    const bf16_t* G; int goff; const bf16_t* Yin; bf16_t* Y;
    __device__ __forceinline__ void operator()(const f32x4 (&acc)[2][2][4][2], const Unit& u, int wr, int wc, int fr, int fq) const {
        const int row0 = u.pm * BM + wr * 64 + fr, c0 = u.pn * BM + wc * 32 + 8 * fq;
#pragma unroll
        for (int ai = 0; ai < 2; ++ai)
#pragma unroll
            for (int m = 0; m < 4; ++m) {
                const size_t r = (size_t)(row0 + ai * HALF + m * 16);
#pragma unroll
                for (int bj = 0; bj < 2; ++bj) { const int c = c0 + bj * HALF;
                    f32x4 g0, g1; unpack8(*(const u32x4*)(G + r * 2048 + goff + c), g0, g1);
                    f32x4 v0 = g0 * acc[ai][bj][m][0], v1 = g1 * acc[ai][bj][m][1];
                    if (ADD) { f32x4 y0, y1; unpack8(*(const u32x4*)(Yin + r * 1024 + c), y0, y1); v0 += y0; v1 += y1; }
                    *(u32x4*)(Y + r * 1024 + c) = pack8(v0, v1); } }
    }
};

template <class Epi, class Sched, bool ALIGN_EPI = false, bool SP2 = false>
__device__ __forceinline__ void gemm_phase(PG8_LAS unsigned char* lds, const Gemm g, const Sched& S, const Epi& E) {
    const int tid = threadIdx.x, wid = __builtin_amdgcn_readfirstlane(tid >> 6), lane = tid & 63, wr = wid >> 2, wc = wid & 3, fr = lane & 15, fq = lane >> 4;
    const int K = g.K, nt = K / BK;
    unsigned voffA[2], voffB[2];
#pragma unroll
    for (int i = 0; i < 2; ++i) { int R, C; stage_rc(tid * 16 + i * 8192, R, C); const int Rb = Epi::PERM ? ((R & ~31) + perm32(R & 31)) : R;
        voffA[i] = (unsigned)(R * K + C) * 2u; voffB[i] = (unsigned)(Rb * K + C) * 2u; }
    const size_t kstep = (size_t)(BK * 2);
    const size_t hstep = (size_t)HALF * K * 2;
    const size_t tstep = 2 * hstep;
    const unsigned ldsw = (unsigned)wid * 1024u;
    const int aoff = lds_byte(wr * 64 + fr, fq * 8), boff = lds_byte(wc * 32 + fr, fq * 8);
#define PG8_SA(b, h) (((b) * 2 + (h)) * HTB)
#define PG8_SB(b, h) ((4 + (b) * 2 + (h)) * HTB)
#define PG8_STAGE(bufoff, gbase, voff) do { _Pragma("unroll") for (int _i = 0; _i < 2; ++_i) \
        __builtin_amdgcn_global_load_lds((const unsigned*)((const char*)(gbase) + (voff)[_i]), (PG8_LAS unsigned*)(lds + (bufoff) + ldsw + _i * 8192), 16, 0, 0); } while (0)
#define PG8_LDA(dst, b, h) do { _Pragma("unroll") for (int m = 0; m < 4; ++m) _Pragma("unroll") for (int k = 0; k < 2; ++k) dst[m][k] = *(const PG8_LAS bf16x8*)(lds + PG8_SA(b, h) + aoff + m * 2048 + k * 1024); } while (0)
#define PG8_LDB(dst, b, h) do { _Pragma("unroll") for (int n = 0; n < 2; ++n) _Pragma("unroll") for (int k = 0; k < 2; ++k) dst[n][k] = *(const PG8_LAS bf16x8*)(lds + PG8_SB(b, h) + boff + n * 2048 + k * 1024); } while (0)
#define PG8_MMA(ai, bj, At, Bt) do { __builtin_amdgcn_s_setprio(1); _Pragma("unroll") for (int m = 0; m < 4; ++m) _Pragma("unroll") for (int n = 0; n < 2; ++n) _Pragma("unroll") for (int k = 0; k < 2; ++k) \
        acc[ai][bj][m][n] = __builtin_amdgcn_mfma_f32_16x16x32_bf16(Bt[n][k], At[m][k], acc[ai][bj][m][n], 0, 0, 0); __builtin_amdgcn_s_setprio(0); } while (0)
#define PG8_WAIT_V(n) asm volatile("s_waitcnt vmcnt(" #n ")" ::: "memory")
#define PG8_WAIT_L(n) asm volatile("s_waitcnt lgkmcnt(" #n ")" ::: "memory")
#define PG8_BAR __builtin_amdgcn_s_barrier()
#define PG8_SCHED __builtin_amdgcn_sched_barrier(0)
    Unit cur, nxt; int ui = 0;
    if (!S.next(0, cur)) return;
    f32x4 acc[2][2][4][2];
#pragma unroll
    for (int a = 0; a < 2; ++a)
#pragma unroll
        for (int b = 0; b < 2; ++b)
#pragma unroll
            for (int m = 0; m < 4; ++m)
#pragma unroll
                for (int n = 0; n < 2; ++n) acc[a][b][m][n] = (f32x4){0.f, 0.f, 0.f, 0.f};
    bf16x8 At[4][2], B0[2][2], B1[2][2];
    const char* cA = (const char*)g.A + (size_t)cur.pm * tstep; const char* cB = (const char*)g.Bt + (size_t)cur.pn * tstep;
    S.a_ready(cur);
    if constexpr (SP2) {
        PG8_STAGE(PG8_SB(0, 0), cB, voffB); PG8_STAGE(PG8_SB(0, 1), cB + hstep, voffB); PG8_STAGE(PG8_SA(0, 0), cA, voffA); PG8_STAGE(PG8_SA(0, 1), cA + hstep, voffA);
        if (wr == 1) PG8_BAR;
        PG8_WAIT_V(2); PG8_BAR;
        PG8_STAGE(PG8_SB(1, 0), cB + kstep, voffB); PG8_STAGE(PG8_SA(1, 0), cA + kstep, voffA); PG8_STAGE(PG8_SB(1, 1), cB + hstep + kstep, voffB);
        PG8_WAIT_V(6); PG8_BAR;
    } else {
        PG8_STAGE(PG8_SB(0, 0), cB, voffB); PG8_STAGE(PG8_SA(0, 0), cA, voffA); PG8_STAGE(PG8_SB(0, 1), cB + hstep, voffB); PG8_STAGE(PG8_SA(0, 1), cA + hstep, voffA);
        if (wr == 1) PG8_BAR;
        PG8_WAIT_V(4); PG8_BAR;
        PG8_STAGE(PG8_SB(1, 0), cB + kstep, voffB); PG8_STAGE(PG8_SA(1, 0), cA + kstep, voffA); PG8_STAGE(PG8_SB(1, 1), cB + hstep + kstep, voffB);
        PG8_WAIT_V(6); PG8_BAR;
    }
    for (;;) {
        const bool has_next = S.next(ui + 1, nxt);
        const char* nA = has_next ? (const char*)g.A + (size_t)nxt.pm * tstep : cA; const char* nB = has_next ? (const char*)g.Bt + (size_t)nxt.pn * tstep : cB;
#pragma nounroll
        for (int t = 0; t < nt; t += 2) {
            const bool last = (t == nt - 2);
            const char* a1 = cA + (size_t)(t + 1) * kstep;
            const char* a2 = last ? nA : cA + (size_t)(t + 2) * kstep; const char* b2 = last ? nB : cB + (size_t)(t + 2) * kstep;
            const char* a3 = a2 + kstep; const char* b3 = b2 + kstep;
            if (last && has_next) S.a_ready(nxt);
            if constexpr (SP2) {
            PG8_LDB(B0, 0, 0); PG8_LDB(B1, 0, 1); PG8_SCHED; PG8_LDA(At, 0, 0); PG8_STAGE(PG8_SA(1, 1), a1 + hstep, voffA);
            PG8_WAIT_V(8); PG8_WAIT_L(0); PG8_BAR; PG8_MMA(0, 0, At, B0); PG8_MMA(0, 1, At, B1); PG8_BAR; PG8_SCHED;
            PG8_LDA(At, 0, 1); PG8_STAGE(PG8_SB(0, 0), b2, voffB); PG8_STAGE(PG8_SB(0, 1), b2 + hstep, voffB); PG8_STAGE(PG8_SA(0, 0), a2, voffA);
            PG8_WAIT_V(8); PG8_WAIT_L(0); PG8_BAR; PG8_MMA(1, 0, At, B0); PG8_MMA(1, 1, At, B1); PG8_BAR; PG8_SCHED;
            PG8_LDB(B0, 1, 0); PG8_LDB(B1, 1, 1); PG8_SCHED; PG8_LDA(At, 1, 0); PG8_STAGE(PG8_SA(0, 1), a2 + hstep, voffA);
            PG8_WAIT_V(8); PG8_WAIT_L(0); PG8_BAR; PG8_MMA(0, 0, At, B0); PG8_MMA(0, 1, At, B1); PG8_BAR; PG8_SCHED;
            PG8_LDA(At, 1, 1); PG8_STAGE(PG8_SB(1, 0), b3, voffB); PG8_STAGE(PG8_SB(1, 1), b3 + hstep, voffB); PG8_STAGE(PG8_SA(1, 0), a3, voffA);
            PG8_WAIT_V(8); PG8_WAIT_L(0); PG8_BAR; PG8_MMA(1, 0, At, B0); PG8_MMA(1, 1, At, B1); PG8_BAR; PG8_SCHED;
            } else {
            PG8_LDB(B0, 0, 0); PG8_SCHED; PG8_LDA(At, 0, 0); PG8_STAGE(PG8_SA(1, 1), a1 + hstep, voffA);
            PG8_WAIT_L(8); PG8_BAR; PG8_WAIT_L(0); PG8_MMA(0, 0, At, B0); PG8_BAR; PG8_SCHED;
            PG8_LDB(B1, 0, 1); PG8_STAGE(PG8_SB(0, 0), b2, voffB);
            PG8_BAR; PG8_WAIT_L(0); PG8_MMA(0, 1, At, B1); PG8_BAR;
            PG8_LDA(At, 0, 1); PG8_STAGE(PG8_SA(0, 0), a2, voffA);
            PG8_BAR; PG8_WAIT_L(0); PG8_MMA(1, 0, At, B0); PG8_BAR; PG8_SCHED;
            PG8_STAGE(PG8_SB(0, 1), b2 + hstep, voffB);
            PG8_WAIT_V(6); PG8_BAR; PG8_MMA(1, 1, At, B1); PG8_BAR;
            PG8_LDB(B0, 1, 0); PG8_SCHED; PG8_LDA(At, 1, 0); PG8_STAGE(PG8_SA(0, 1), a2 + hstep, voffA);
            PG8_WAIT_L(8); PG8_BAR; PG8_WAIT_L(0); PG8_MMA(0, 0, At, B0); PG8_BAR; PG8_SCHED;
            PG8_LDB(B1, 1, 1); PG8_STAGE(PG8_SB(1, 0), b3, voffB);
            PG8_BAR; PG8_WAIT_L(0); PG8_MMA(0, 1, At, B1); PG8_BAR;
            PG8_LDA(At, 1, 1); PG8_STAGE(PG8_SA(1, 0), a3, voffA);
            PG8_BAR; PG8_WAIT_L(0); PG8_MMA(1, 0, At, B0); PG8_BAR; PG8_SCHED;
            PG8_STAGE(PG8_SB(1, 1), b3 + hstep, voffB);
            PG8_WAIT_V(6); PG8_BAR; PG8_MMA(1, 1, At, B1); PG8_BAR;
            }
        }
        if constexpr (ALIGN_EPI) { if (wr == 0) PG8_BAR; }
        if constexpr (!Epi::AFTER_DRAIN) { E(acc, cur, wr, wc, fr, fq); S.done(cur); }
        if (!has_next) break;
#pragma unroll
        for (int a = 0; a < 2; ++a)
#pragma unroll
            for (int b = 0; b < 2; ++b)
#pragma unroll
                for (int m = 0; m < 4; ++m)
#pragma unroll
                    for (int n = 0; n < 2; ++n) acc[a][b][m][n] = (f32x4){0.f, 0.f, 0.f, 0.f};
        cur = nxt; cA = nA; cB = nB; ++ui;
        if constexpr (ALIGN_EPI) { if (wr == 1) PG8_BAR; }
    }
    PG8_WAIT_V(0);
    if constexpr (!ALIGN_EPI) { if (wr == 0) PG8_BAR; }
    PG8_BAR;
    if constexpr (Epi::AFTER_DRAIN) { E.fused(acc, cur, wr, wc, fr, fq, lds, wid, lane); S.done(cur); }
#undef PG8_SA
#undef PG8_SB
#undef PG8_STAGE
#undef PG8_LDA
#undef PG8_LDB
#undef PG8_MMA
#undef PG8_WAIT_V
#undef PG8_WAIT_L
#undef PG8_BAR
#undef PG8_SCHED
}
}

constexpr int NWAVES = 8;
constexpr int BATCH = 4, T = 8192, D = 1024, DFF = 2816, M = BATCH * T;
constexpr int INC = 3944, NPROJ = 4096;
constexpr int O_QA = 0, O_KA = 512, O_VA = 576, O_QI = 640, O_KI = 1152, O_WI = 1216, O_CQ = 1224, O_CKV = 1608, O_KR = 1864, O_GATE = 1896;
constexpr float EPS = 1e-6f;
#ifndef MK_FUSED
#define MK_FUSED 1
#endif

constexpr size_t MiB = 1u << 20;
constexpr size_t WS_CTL = 0, CTL_ZERO_BYTES = 2 * MiB;
constexpr size_t WS_MOD = 256 * 1024;
constexpr size_t WS_SSQQ = 49 * MiB, WS_SSQKV = 50 * MiB;
constexpr size_t WS_W1A = 2 * MiB, SZ_WA = (size_t)2 * DFF * D * 2, SZ_WD = (size_t)D * DFF * 2;
constexpr size_t WS_W1D = WS_W1A + SZ_WA, WS_WIN = WS_W1D + SZ_WD, WS_WUQ = WS_WIN + (size_t)NPROJ * D * 2, WS_WUKV = WS_WUQ + (size_t)768 * 384 * 2;
constexpr size_t WS_WOA = WS_WUKV + (size_t)1024 * 256 * 2, WS_WOB = WS_WOA + (size_t)D * 512 * 2, WS_WOUT = WS_WOB + (size_t)D * 512 * 2;
constexpr size_t WS_W2A = WS_WOUT + (size_t)D * D * 2, WS_W2D = WS_W2A + SZ_WA, WS_WEND = WS_W2D + SZ_WD;
static_assert(WS_WEND <= 49 * MiB, "weights");
constexpr size_t WS_RCOS = 51 * MiB, WS_RSIN = 53 * MiB;
constexpr size_t WS_XN = 55 * MiB;
constexpr size_t WS_ACT = 119 * MiB;
constexpr size_t WS_QA = WS_ACT, WS_QI = WS_QA + 32 * MiB, WS_CQ = WS_QI + 32 * MiB, WS_CKV = WS_CQ + 24 * MiB, WS_KA = WS_CKV + 16 * MiB, WS_VA = WS_KA + 4 * MiB;
constexpr size_t WS_KI = WS_VA + 4 * MiB, WS_KPE = WS_KI + 4 * MiB, WS_WI = WS_KPE + 2 * MiB, WS_QB = WS_WI + 1 * MiB, WS_MIXEND = WS_QB + 48 * MiB;
static_assert(WS_MIXEND <= WS_ACT + 176 * MiB, "mixer overlay");
constexpr size_t WS_G = 295 * MiB;
constexpr size_t WS_KN = 423 * MiB, WS_VB = 455 * MiB;
constexpr size_t WS_SEL = 487 * MiB;
constexpr size_t WS_END = 503 * MiB;
static_assert(WS_XN + 64 * MiB <= WS_ACT && WS_ACT + 176 * MiB <= WS_G && WS_G + 128 * MiB <= WS_KN && WS_VB + 32 * MiB <= WS_SEL, "d_ws map");
constexpr size_t WS_OA = WS_CQ, WS_OB = WS_QI, WS_Y1 = WS_KN, WS_Y = WS_XN;
constexpr int CW_TMO = 0, CW_CODE = 1, CW_BAR = 4096;

constexpr int RING_OFF = 0, RING_BYTES = 151552;
constexpr int LDSCTL_OFF = RING_BYTES, MISC_OFF = LDSCTL_OFF + 320;
constexpr int LDS_BYTES = RING_BYTES + 1024;
#ifndef PROF_SEL
#define PROF_SEL 0
#endif
#ifndef PROF_MULT
#define PROF_MULT 4
#endif
#define PROF_WORD(ldsring, wid_) ((LAS unsigned*)((ldsring) + (MISC_OFF - RING_OFF) + 64) + (wid_))
#define PROF_T0(id) unsigned long long pt_##id = 0ull; if (PROF_SEL == (id)) pt_##id = __builtin_amdgcn_s_memrealtime()
#define PROF_T1(id, ldsring, wid_, lane_) do { if (PROF_SEL == (id)) { const unsigned d_ = (unsigned)(__builtin_amdgcn_s_memrealtime() - pt_##id); if ((lane_) == 0) *PROF_WORD(ldsring, wid_) += d_; } } while (0)
#define GAS __attribute__((address_space(1)))
#define LAS __attribute__((address_space(3)))
typedef unsigned short bf16;
typedef unsigned v4u __attribute__((ext_vector_type(4)));
typedef float f32x4 __attribute__((ext_vector_type(4)));
typedef short bf16x8 __attribute__((ext_vector_type(8)));
typedef GAS unsigned gu32;
typedef GAS unsigned long long gu64;
#define RLX_AGENT __ATOMIC_RELAXED, __HIP_MEMORY_SCOPE_AGENT
#define LDS_WAIT() asm volatile("s_waitcnt lgkmcnt(0)" ::: "memory")
#define VM_WAIT() asm volatile("s_waitcnt vmcnt(0)" ::: "memory")
__device__ __forceinline__ unsigned long long rt() { return __builtin_amdgcn_s_memrealtime(); }
__device__ __forceinline__ unsigned f2bf(float f) { unsigned u = __builtin_bit_cast(unsigned, f); return (u + 0x7fffu + ((u >> 16) & 1u)) >> 16; }
__device__ __forceinline__ unsigned pk2(float lo, float hi) { return f2bf(lo) | (f2bf(hi) << 16); }

#define XB_TMO      128
#define XB_XCNT(j)  (256  + 64 * (j))
#define XB_XSUB(j)  (1280 + 64 * (j))
#define XB_XGEN(j)  (2304 + 64 * (j))
#define XB_TOP      3328
#define XB_TOPGEN   3392
#define XCD_BAR_WORDS 3456
#define XB_SPIN_CAP (1u << 18)

__device__ __forceinline__ unsigned xb_ld(unsigned* p)              { return __hip_atomic_load(p, __ATOMIC_RELAXED, __HIP_MEMORY_SCOPE_AGENT); }
__device__ __forceinline__ unsigned xb_add(unsigned* p, unsigned v) { return __hip_atomic_fetch_add(p, v, __ATOMIC_RELAXED, __HIP_MEMORY_SCOPE_AGENT); }
__device__ __forceinline__ unsigned xb_xcc_id() { return (unsigned)__builtin_amdgcn_s_getreg((3 << 11) | 20) & 0xFu; }
#define XB_SPIN(cond, bar) do { unsigned _sp = 0; while (cond) { __builtin_amdgcn_s_sleep(1); \
    if ((++_sp & 255u) == 0u) { if (xb_ld(&(bar)[XB_TMO])) break; if (_sp > XB_SPIN_CAP) { atomicAdd(&(bar)[XB_TMO], 1u); break; } } } } while (0)

struct XcdBarrier {
    unsigned* bar; unsigned x;
    volatile LAS unsigned* st;
};

__device__ __forceinline__ XcdBarrier xcd_barrier_post(unsigned* bar, volatile LAS unsigned* st) {
    XcdBarrier b; b.bar = bar; b.x = xb_xcc_id(); b.st = st;
    if (threadIdx.x == 0) (void)xb_add(&bar[XB_XCNT(b.x)], 1u);
    return b;
}
__device__ __forceinline__ void xcd_barrier_complete(unsigned* bar, unsigned x, unsigned& nloc, unsigned& nx) {
    const unsigned G = gridDim.x * gridDim.y * gridDim.z;
    unsigned sum, cnt, mine, sp = 0u;
    for (;;) {
        sum = 0u; cnt = 0u; mine = 0u;
#pragma unroll
        for (unsigned j = 0; j < 16; ++j) { const unsigned c = xb_ld(&bar[XB_XCNT(j)]); sum += c; cnt += (c > 0u) ? 1u : 0u; mine = (j == x) ? c : mine; }
        if (sum == G) break;
        __builtin_amdgcn_s_sleep(1);
        if ((++sp & 255u) == 0u) { if (xb_ld(&bar[XB_TMO])) break; if (sp > XB_SPIN_CAP) { atomicAdd(&bar[XB_TMO], 1u); break; } }
    }
    nloc = mine > 0u ? mine : 1u; nx = cnt > 0u ? cnt : 1u;
}

__device__ __forceinline__ void xcd_barrier(const XcdBarrier& b) {
    asm volatile("s_waitcnt vmcnt(0)" ::: "memory");
    __syncthreads();
    if (threadIdx.x == 0) {
        unsigned* bar = b.bar;
        __builtin_amdgcn_s_waitcnt(0);
        unsigned nloc = b.st[0], nx = b.st[1];
        if (nloc == 0u) { xcd_barrier_complete(bar, b.x, nloc, nx); b.st[0] = nloc; b.st[1] = nx; }
        const unsigned old = xb_add(&bar[XB_XSUB(b.x)], 1u);
        const unsigned gen = old / nloc;
        if (old + 1u == (gen + 1u) * nloc) {
            __builtin_amdgcn_fence(__ATOMIC_RELEASE, "agent");
            asm volatile("s_waitcnt vmcnt(0)" ::: "memory");
            const unsigned og = xb_add(&bar[XB_TOP], 1u);
            const unsigned tg = og / nx;
            if (og + 1u == (tg + 1u) * nx) xb_add(&bar[XB_TOPGEN], 1u);
            else XB_SPIN(xb_ld(&bar[XB_TOPGEN]) == tg, bar);
            __builtin_amdgcn_fence(__ATOMIC_ACQUIRE, "agent");
            xb_add(&bar[XB_XGEN(b.x)], 1u);
            asm volatile("s_waitcnt vmcnt(0)" ::: "memory");
        } else {
            XB_SPIN(xb_ld(&bar[XB_XGEN(b.x)]) == gen, bar);
            __builtin_amdgcn_fence(__ATOMIC_ACQUIRE, "agent");
            asm volatile("s_waitcnt vmcnt(0)" ::: "memory");
        }
    }
    __syncthreads();
}

struct Frame {
    LAS unsigned char* lds;
    volatile LAS unsigned* MISC;
    gu32* ctl;
    int tid, lane, wave;
    int vcu, G;
};
__device__ __forceinline__ float wave_sum(float v) {
#pragma unroll
    for (int o = 1; o < 64; o <<= 1) v += __shfl_xor(v, o);
    return v;
}
struct MapIdent { int off; __device__ __forceinline__ int src(int n) const { return n + off; } };
struct MapFfnIn { __device__ __forceinline__ int src(int n) const { const int pn = n >> 8, j = n & 255; return (j >> 7) * DFF + pn * 128 + (j & 127); } };
struct MapProj { __device__ __forceinline__ int src(int n) const { const int pn = n >> 8, j = n & 255;
    if (pn < 2) return O_QA + n; if (pn < 4) return O_QI + (n - 512); if (pn == 4) return O_CQ + j;
    if (pn == 5) return j < 128 ? O_CQ + 256 + j : O_CKV + (j - 128);
    if (pn == 6) return j < 128 ? O_CKV + 128 + j : (j < 192 ? O_KA + (j - 128) : O_VA + (j - 192));
    if (pn == 7) { if (j < 64) return O_KI + j; if (j < 96) { const int jj = j - 64; return O_KR + (jj >> 1) + 16 * (jj & 1); } if (j < 104) return O_WI + (j - 96); return -1; }
    return O_GATE + (n - 2048); } };
struct MapUq { __device__ __forceinline__ int src(int n) const { const int h = n / 96, w = n % 96; if (w < 64) return n; const int jj = w - 64; return h * 96 + 64 + (jj >> 1) + 16 * (jj & 1); } };
template <class Map> __device__ __forceinline__ void p0_transpose_item(const float* W, int K, int Nsrc, int nblk, const float* kscale, bf16* WT, const Map mp, LAS float* scr, int item, int lane) {
    const int kb = item / nblk, nb = item % nblk, k0 = 64 * kb, n0 = 32 * nb;
    const int sc = mp.src(n0 + (lane & 31));
#pragma unroll 8
    for (int i = 0; i < 32; ++i) { const int kk = 2 * i + (lane >> 5); float v = sc >= 0 ? W[(size_t)(k0 + kk) * Nsrc + sc] : 0.f; if (kscale) v *= kscale[k0 + kk]; scr[kk * 33 + (lane & 31)] = v; }
    LDS_WAIT(); asm volatile("" ::: "memory");
    const int c = lane & 7;
#pragma unroll
    for (int j = 0; j < 4; ++j) { const int n = (lane >> 3) + 8 * j; const LAS float* s = scr + (8 * c) * 33 + n;
        v4u o; o.x = pk2(s[0 * 33], s[1 * 33]); o.y = pk2(s[2 * 33], s[3 * 33]); o.z = pk2(s[4 * 33], s[5 * 33]); o.w = pk2(s[6 * 33], s[7 * 33]);
        *(GAS v4u*)(WT + (size_t)(n0 + n) * K + k0 + 8 * c) = o; }
    LDS_WAIT(); asm volatile("" ::: "memory");
}
struct Args { const void* in[23]; float* out; unsigned char* ws; int ph_lo, ph_hi, li, pad; };

__device__ __forceinline__ void p0_prologue(Frame& F, const Args& A) {
    LAS float* scr = (LAS float*)(F.lds + RING_OFF + F.wave * 16384);
    const int gw = F.vcu * NWAVES + F.wave, NGW = F.G * NWAVES;
    unsigned char* ws = A.ws;
    {
        const float* c = (const float*)A.in[1]; const float* w = (const float*)A.in[3]; const float* bias = (const float*)A.in[4]; float* mod = (float*)(ws + WS_MOD);
        for (int cg = F.vcu; cg < 144; cg += F.G) {
            const int n = cg * 64 + F.lane, k0 = F.wave * 128;
#pragma unroll
            for (int b = 0; b < 4; ++b)
#pragma unroll
                for (int h = 0; h < 2; ++h) { const float v = c[b * D + k0 + h * 64 + F.lane]; scr[b * 128 + h * 64 + F.lane] = v / (1.f + __expf(-v)); }
            LDS_WAIT(); asm volatile("" ::: "memory");
            float a0 = 0.f, a1 = 0.f, a2 = 0.f, a3 = 0.f;
#pragma unroll 8
            for (int k = 0; k < 128; ++k) { const float wv = w[(size_t)(k0 + k) * 9216 + n]; a0 += scr[k] * wv; a1 += scr[128 + k] * wv; a2 += scr[256 + k] * wv; a3 += scr[384 + k] * wv; }
            scr[1024 + F.lane] = a0; scr[1088 + F.lane] = a1; scr[1152 + F.lane] = a2; scr[1216 + F.lane] = a3;
            __syncthreads();
            if (F.wave < 4) { float t = bias[n];
#pragma unroll
                for (int ww = 0; ww < 8; ++ww) t += ((LAS float*)(F.lds + RING_OFF + ww * 16384))[1024 + F.wave * 64 + F.lane];
                mod[F.wave * 9216 + n] = t; }
            __syncthreads();
        }
    }
    {
        const float* w1a = (const float*)A.in[6]; const float* w1d = (const float*)A.in[7]; const float* win = (const float*)A.in[9]; const float* gcq = (const float*)A.in[10];
        const float* wuq = (const float*)A.in[11]; const float* gckv = (const float*)A.in[12]; const float* wuk = (const float*)A.in[13]; const float* wuv = (const float*)A.in[14];
        const float* woa = (const float*)A.in[16]; const float* wob = (const float*)A.in[17]; const float* wout = (const float*)A.in[18]; const float* w2a = (const float*)A.in[20]; const float* w2d = (const float*)A.in[21];
        constexpr int I_A = 16 * 176, I_D = 44 * 32, I_IN = 16 * 128, I_UQ = 6 * 24, I_UK = 4 * 16, I_O = 8 * 32, I_OUT = 16 * 32;
        constexpr int NITEMS = 2 * I_A + 2 * I_D + I_IN + I_UQ + 2 * I_UK + 2 * I_O + I_OUT;
        for (int it = gw; it < NITEMS; it += NGW) {
            int r = it;
            if (r < I_A) { p0_transpose_item(w1a, D, 2 * DFF, 176, nullptr, (bf16*)(ws + WS_W1A), MapFfnIn{}, scr, r, F.lane); continue; } r -= I_A;
            if (r < I_A) { p0_transpose_item(w2a, D, 2 * DFF, 176, nullptr, (bf16*)(ws + WS_W2A), MapFfnIn{}, scr, r, F.lane); continue; } r -= I_A;
            if (r < I_D) { p0_transpose_item(w1d, DFF, D, 32, nullptr, (bf16*)(ws + WS_W1D), MapIdent{0}, scr, r, F.lane); continue; } r -= I_D;
            if (r < I_D) { p0_transpose_item(w2d, DFF, D, 32, nullptr, (bf16*)(ws + WS_W2D), MapIdent{0}, scr, r, F.lane); continue; } r -= I_D;
            if (r < I_IN) { p0_transpose_item(win, D, INC, 128, nullptr, (bf16*)(ws + WS_WIN), MapProj{}, scr, r, F.lane); continue; } r -= I_IN;
            if (r < I_UQ) { p0_transpose_item(wuq, 384, 768, 24, gcq, (bf16*)(ws + WS_WUQ), MapUq{}, scr, r, F.lane); continue; } r -= I_UQ;
            if (r < I_UK) { p0_transpose_item(wuk, 256, 512, 16, gckv, (bf16*)(ws + WS_WUKV), MapIdent{0}, scr, r, F.lane); continue; } r -= I_UK;
            if (r < I_UK) { p0_transpose_item(wuv, 256, 512, 16, gckv, (bf16*)(ws + WS_WUKV) + (size_t)512 * 256, MapIdent{0}, scr, r, F.lane); continue; } r -= I_UK;
            if (r < I_O) { p0_transpose_item(woa, 512, D, 32, nullptr, (bf16*)(ws + WS_WOA), MapIdent{0}, scr, r, F.lane); continue; } r -= I_O;
            if (r < I_O) { p0_transpose_item(wob, 512, D, 32, nullptr, (bf16*)(ws + WS_WOB), MapIdent{0}, scr, r, F.lane); continue; } r -= I_O;
            p0_transpose_item(wout, D, D, 32, nullptr, (bf16*)(ws + WS_WOUT), MapIdent{0}, scr, r, F.lane);
        }
    }
    {
        const int* pos = (const int*)A.in[2]; float* rc = (float*)(ws + WS_RCOS); float* rs = (float*)(ws + WS_RSIN);
        for (int idx = gw * 64 + F.lane; idx < M * 16; idx += NGW * 64) { const int t = idx >> 4, i = idx & 15;
            const float freq = powf(10000.0f, -2.0f * (float)i / 32.0f); const float ang = (float)pos[t] * freq;
            rc[idx] = cosf(ang); rs[idx] = sinf(ang); }
    }
}
__device__ __forceinline__ void norm_mod_phase(Frame& F, const float* xin, const float* g, const float* mod, int shoff, int scoff, bf16* out) {
    const int gw = F.vcu * NWAVES + F.wave, NGW = F.G * NWAVES;
    for (int m = gw; m < M; m += NGW) {
        const int b = m >> 13;
        const GAS f32x4* xr = (const GAS f32x4*)(xin + (size_t)m * D) + F.lane;
        const GAS f32x4* g4 = (const GAS f32x4*)g + F.lane; const GAS f32x4* sc4 = (const GAS f32x4*)(mod + b * 9216 + scoff) + F.lane; const GAS f32x4* sh4 = (const GAS f32x4*)(mod + b * 9216 + shoff) + F.lane;
        f32x4 v[4]; float s = 0.f;
#pragma unroll
        for (int j = 0; j < 4; ++j) { v[j] = xr[64 * j]; s += (v[j].x * v[j].x + v[j].y * v[j].y) + (v[j].z * v[j].z + v[j].w * v[j].w); }
        const float rs = __builtin_amdgcn_rsqf(wave_sum(s) * (1.f / D) + EPS);
        GAS unsigned long long* o8 = (GAS unsigned long long*)(out + (size_t)m * D) + F.lane;
#pragma unroll
        for (int j = 0; j < 4; ++j) { const f32x4 o = v[j] * rs * g4[64 * j] * (sc4[64 * j] + 1.f) + sh4[64 * j];
            o8[64 * j] = (unsigned long long)pk2(o.x, o.y) | ((unsigned long long)pk2(o.z, o.w) << 32); }
    }
}
__device__ __forceinline__ void final_norm_phase(Frame& F, const float* xin, const float* g, float* out) {
    const int gw = F.vcu * NWAVES + F.wave, NGW = F.G * NWAVES;
    for (int m = gw; m < M; m += NGW) {
        const GAS f32x4* xr = (const GAS f32x4*)(xin + (size_t)m * D) + F.lane; const GAS f32x4* g4 = (const GAS f32x4*)g + F.lane;
        f32x4 v[4]; float s = 0.f;
#pragma unroll
        for (int j = 0; j < 4; ++j) { v[j] = xr[64 * j]; s += (v[j].x * v[j].x + v[j].y * v[j].y) + (v[j].z * v[j].z + v[j].w * v[j].w); }
        const float rs = __builtin_amdgcn_rsqf(wave_sum(s) * (1.f / D) + EPS);
        GAS f32x4* o4 = (GAS f32x4*)(out + (size_t)m * D) + F.lane;
#pragma unroll
        for (int j = 0; j < 4; ++j) o4[64 * j] = v[j] * rs * g4[64 * j];
    }
}

namespace mla {
typedef unsigned u32x4 __attribute__((ext_vector_type(4)));
typedef short bf16x8 __attribute__((ext_vector_type(8)));
typedef short s16x4 __attribute__((ext_vector_type(4)));
typedef float f32x16 __attribute__((ext_vector_type(16)));
constexpr int KSLOT = 12288, VSLOT = 8192;
constexpr int L_K = 0, L_V = 3 * KSLOT, L_WS = L_V + 3 * VSLOT, L_OST = L_WS + 2048, L_END = L_OST + 8 * 4096;
static_assert(L_END <= RING_BYTES, "attention LDS");
__device__ __forceinline__ int crow(int r, int hi) { return (r & 3) + 8 * (r >> 2) + 4 * hi; }
__device__ __forceinline__ float xhalf(float v) { return __shfl_xor(v, 32); }
__device__ __forceinline__ void pv(f32x16* o, int vb, bf16x8 pa0, bf16x8 pa1, bf16x8 pa2, bf16x8 pa3) {
#pragma unroll
    for (int d0 = 0; d0 < 2; ++d0) { s16x4 lo[4], hi[4];
#pragma unroll
        for (int ks = 0; ks < 4; ++ks) {
            asm volatile("ds_read_b64_tr_b16 %0,%1 offset:%c2" : "=&v"(lo[ks]) : "v"(vb), "i"(d0 * 4096 + ks * 1024) : "memory");
            asm volatile("ds_read_b64_tr_b16 %0,%1 offset:%c2" : "=&v"(hi[ks]) : "v"(vb), "i"(d0 * 4096 + ks * 1024 + 512) : "memory"); }
        asm volatile("s_waitcnt lgkmcnt(0)" ::: "memory"); __builtin_amdgcn_sched_barrier(0);
#define MLA_PK(k) (bf16x8){lo[k][0], lo[k][1], lo[k][2], lo[k][3], hi[k][0], hi[k][1], hi[k][2], hi[k][3]}
        o[d0] = __builtin_amdgcn_mfma_f32_32x32x16_bf16(pa0, MLA_PK(0), o[d0], 0, 0, 0);
        o[d0] = __builtin_amdgcn_mfma_f32_32x32x16_bf16(pa1, MLA_PK(1), o[d0], 0, 0, 0);
        o[d0] = __builtin_amdgcn_mfma_f32_32x32x16_bf16(pa2, MLA_PK(2), o[d0], 0, 0, 0);
        o[d0] = __builtin_amdgcn_mfma_f32_32x32x16_bf16(pa3, MLA_PK(3), o[d0], 0, 0, 0);
#undef MLA_PK
    }
}
__device__ __forceinline__ void attn_unit(int b, int h, int qb, const bf16* QB, const bf16* KN, const bf16* KPE, const bf16* VB, bf16* OB, LAS unsigned char* lds) {
    const int tid = threadIdx.x, lane = tid & 63, r32 = lane & 31, hi = lane >> 5; const int wid = __builtin_amdgcn_readfirstlane(tid >> 6);
    const size_t rowbase = (size_t)b * T; const int q0 = qb * 256;
    const int NT = 4 * (qb + 1), my_last = 4 * qb + (wid >> 1);
    LAS float* wsf = (LAS float*)(lds + L_WS) + wid * 64;
#define MLA_DMA(t, slot) do { const size_t krow_ = rowbase + (size_t)(t) * 64 + lane; \
        __builtin_amdgcn_global_load_lds((const unsigned*)(KN + krow_ * 512 + h * 64 + wid * 8), (LAS unsigned*)(lds + L_K + (slot) * KSLOT + wid * 1024), 16, 0, 0); \
        if (wid < 4) __builtin_amdgcn_global_load_lds((const unsigned*)(KPE + krow_ * 32 + wid * 8), (LAS unsigned*)(lds + L_K + (slot) * KSLOT + (8 + wid) * 1024), 16, 0, 0); \
        const size_t vrow_ = rowbase + (size_t)(t) * 64 + 16 * (wid & 3) + (lane >> 2); \
        __builtin_amdgcn_global_load_lds((const unsigned*)(VB + vrow_ * 512 + h * 64 + (wid >> 2) * 32 + (lane & 3) * 8), (LAS unsigned*)(lds + L_V + (slot) * VSLOT + wid * 1024), 16, 0, 0); } while (0)
    bf16x8 qr[6];
    { const bf16* Qw = QB + (rowbase + q0 + wid * 32 + r32) * 768 + h * 96 + hi * 8;
#pragma unroll
      for (int d0 = 0; d0 < 6; ++d0) qr[d0] = *(const bf16x8*)(Qw + d0 * 16); }
    MLA_DMA(0, 0); MLA_DMA(1, 1);
    int slot = 0, slot2 = 2;
    float m = -INFINITY, l = 0.f; f32x16 o[2];
#pragma unroll
    for (int r = 0; r < 16; ++r) { o[0][r] = 0.f; o[1][r] = 0.f; }
    const int kofs = hi * 1024 + r32 * 16;
    const int vb0 = (int)(unsigned)(uintptr_t)(lds + L_V) + ((lane >> 4) & 1) * 32 + (lane & 3) * 8 + (4 * hi + ((lane & 15) >> 2)) * 64;
    for (int t = 0; t < NT; ++t) {
        if (t + 1 < NT) { if (wid < 4) asm volatile("s_waitcnt vmcnt(3) lgkmcnt(0)\n\ts_barrier" ::: "memory"); else asm volatile("s_waitcnt vmcnt(2) lgkmcnt(0)\n\ts_barrier" ::: "memory"); }
        else asm volatile("s_waitcnt vmcnt(0) lgkmcnt(0)\n\ts_barrier" ::: "memory");
        if (t + 2 < NT) MLA_DMA(t + 2, slot2);
        const int cslot = slot; slot = (slot == 2) ? 0 : slot + 1; slot2 = (slot2 == 2) ? 0 : slot2 + 1;
        if (t <= my_last) {
            const int slot = cslot;
            const LAS unsigned char* kb = lds + L_K + slot * KSLOT + kofs;
            f32x16 p0, p1;
#pragma unroll
            for (int r = 0; r < 16; ++r) { p0[r] = 0.f; p1[r] = 0.f; }
#pragma unroll
            for (int d0 = 0; d0 < 6; ++d0) {
                const bf16x8 b0 = *(const LAS bf16x8*)(kb + d0 * 2048), b1 = *(const LAS bf16x8*)(kb + d0 * 2048 + 512);
                p0 = __builtin_amdgcn_mfma_f32_32x32x16_bf16(b0, qr[d0], p0, 0, 0, 0);
                p1 = __builtin_amdgcn_mfma_f32_32x32x16_bf16(b1, qr[d0], p1, 0, 0, 0); }
            float rm = fmaxf(p0[0], p1[0]);
#pragma unroll
            for (int r = 1; r < 16; ++r) rm = fmaxf(rm, fmaxf(p0[r], p1[r]));
            rm = fmaxf(rm, xhalf(rm));
            if (__any(rm > m)) {
                const float mn = fmaxf(m, rm), f = __builtin_amdgcn_exp2f(m - mn);
                l *= f; m = mn;
                if (hi == 0) wsf[r32] = f;
                asm volatile("s_waitcnt lgkmcnt(0)" ::: "memory");
#pragma unroll
                for (int r = 0; r < 16; ++r) { const float fr_ = wsf[crow(r, hi)]; o[0][r] *= fr_; o[1][r] *= fr_; }
            }
            float sacc = 0.f;
#pragma unroll
            for (int r = 0; r < 16; ++r) { p0[r] = __builtin_amdgcn_exp2f(p0[r] - m); p1[r] = __builtin_amdgcn_exp2f(p1[r] - m); sacc += p0[r] + p1[r]; }
            l += sacc;
            u32x4 pw0, pw1, pw2, pw3;
            pw0 = (u32x4){pg8::cvt_pk_bf16(p0[0], p0[1]), pg8::cvt_pk_bf16(p0[2], p0[3]), pg8::cvt_pk_bf16(p0[4], p0[5]), pg8::cvt_pk_bf16(p0[6], p0[7])};
            pw1 = (u32x4){pg8::cvt_pk_bf16(p0[8], p0[9]), pg8::cvt_pk_bf16(p0[10], p0[11]), pg8::cvt_pk_bf16(p0[12], p0[13]), pg8::cvt_pk_bf16(p0[14], p0[15])};
            pw2 = (u32x4){pg8::cvt_pk_bf16(p1[0], p1[1]), pg8::cvt_pk_bf16(p1[2], p1[3]), pg8::cvt_pk_bf16(p1[4], p1[5]), pg8::cvt_pk_bf16(p1[6], p1[7])};
            pw3 = (u32x4){pg8::cvt_pk_bf16(p1[8], p1[9]), pg8::cvt_pk_bf16(p1[10], p1[11]), pg8::cvt_pk_bf16(p1[12], p1[13]), pg8::cvt_pk_bf16(p1[14], p1[15])};
            pv(o, vb0 + slot * VSLOT, __builtin_bit_cast(bf16x8, pw0), __builtin_bit_cast(bf16x8, pw1), __builtin_bit_cast(bf16x8, pw2), __builtin_bit_cast(bf16x8, pw3));
        }
    }
#undef MLA_DMA
    l += xhalf(l);
    if (hi == 0) wsf[32 + r32] = l;
    asm volatile("s_waitcnt lgkmcnt(0)" ::: "memory");
    LAS bf16* stg = (LAS bf16*)(lds + L_OST) + wid * 2048;
#pragma unroll
    for (int r = 0; r < 16; ++r) { const int orow = crow(r, hi); const float rl = __builtin_amdgcn_rcpf(wsf[32 + orow]);
        stg[orow * 64 + r32] = (bf16)(pg8::cvt_pk_bf16(o[0][r] * rl, 0.f) & 0xffffu); stg[orow * 64 + 32 + r32] = (bf16)(pg8::cvt_pk_bf16(o[1][r] * rl, 0.f) & 0xffffu); }
    asm volatile("s_waitcnt lgkmcnt(0)" ::: "memory");
    bf16* Ow = OB + (rowbase + q0 + wid * 32) * 512 + h * 64;
#pragma unroll
    for (int i = 0; i < 4; ++i) { const int row = i * 8 + (lane >> 3), ch = lane & 7; const u32x4 v = *(const LAS u32x4*)(stg + row * 64 + ch * 8); *(u32x4*)(Ow + (size_t)row * 512 + ch * 8) = v; }
    asm volatile("s_waitcnt lgkmcnt(0)\n\ts_barrier" ::: "memory");
}
__device__ __forceinline__ void phase(int vcu, int G, const bf16* QB, const bf16* KN, const bf16* KPE, const bf16* VB, bf16* OB, LAS unsigned char* lds) {
    for (int u = vcu; u < 1024; u += G) { const int i = u >> 8, v = u & 255, bh = v >> 3, s = v & 7;
        const int qb = (i == 0) ? s : (i == 1) ? 15 - s : (i == 2) ? 16 + s : 31 - s;
        attn_unit(bh >> 3, bh & 7, qb, QB, KN, KPE, VB, OB, lds); }
}
}

namespace idx {
typedef short bf16x8 __attribute__((ext_vector_type(8)));
typedef float f32x16 __attribute__((ext_vector_type(16)));
typedef unsigned u32x2 __attribute__((ext_vector_type(2)));
constexpr int CAP = 576, TRIG = CAP - 64, NE = (CAP + 63) / 64;
constexpr int L_CAND = 0, L_TRASH = 32 * CAP * 8, L_END = L_TRASH + 8 * 512;
constexpr int KEEP_MAX = 272, SCHED_MIN = 304;
static_assert(L_END <= RING_BYTES, "indexer LDS");
__device__ __forceinline__ unsigned okey(float f) { const unsigned u = __float_as_uint(f); return (u & 0x80000000u) ? ~u : (u | 0x80000000u); }
__device__ __forceinline__ float ikey(unsigned k) { return __uint_as_float((k & 0x80000000u) ? (k ^ 0x80000000u) : ~k); }
__device__ __forceinline__ int prefix64(unsigned long long m) { return (int)__builtin_amdgcn_mbcnt_hi((unsigned)(m >> 32), __builtin_amdgcn_mbcnt_lo((unsigned)m, 0u)); }
__device__ __forceinline__ int count_ge(const unsigned (&k)[8], unsigned thr) { int c = 0;
#pragma unroll
    for (int j = 0; j < 8; ++j) c += __popcll(__ballot(k[j] >= thr));
    return c; }
template <bool FINAL> __device__ __forceinline__ int select(LAS u32x2* cand, int n, int lane, unsigned& thr_key, unsigned short* sel_out) {
    unsigned k[8], ix[8]; float sc[8];
#pragma unroll
    for (int j = 0; j < 8; ++j) { const int e = lane + 64 * j; const bool v = e < n; const u32x2 en = cand[v ? e : 0]; sc[j] = __uint_as_float(en.x); ix[j] = en.y; k[j] = v ? okey(sc[j]) : 0u; }
    unsigned kmin = 0xffffffffu, kmax = 0u;
#pragma unroll
    for (int j = 0; j < 8; ++j) { if (k[j] != 0u) { kmin = min(kmin, k[j]); kmax = max(kmax, k[j]); } }
#pragma unroll
    for (int o = 1; o < 64; o <<= 1) { kmin = min(kmin, (unsigned)__shfl_xor((int)kmin, o)); kmax = max(kmax, (unsigned)__shfl_xor((int)kmax, o)); }
    unsigned lo = kmin, hx = kmax + 1u; int c_lo = n;
    const int accept = FINAL ? 256 : KEEP_MAX;
    for (int it = 0; it < 40 && c_lo > accept && hx - lo > 1u; ++it) {
        const unsigned mid = lo + ((hx - lo) >> 1); const int c = count_ge(k, mid);
        if (c >= 256) { lo = mid; c_lo = c; } else hx = mid; }
    const unsigned Tk = lo;
    int r_eq = 1 << 30;
    if (FINAL || c_lo > accept) r_eq = 256 - count_ge(k, Tk + 1u);
    int running = 0, eqrun = 0;
#pragma unroll
    for (int j = 0; j < 8; ++j) {
        const bool gt = k[j] > Tk, eq = (k[j] == Tk);
        const unsigned long long meq = __ballot(eq);
        const bool take = gt || (eq && (eqrun + prefix64(meq)) < r_eq);
        const unsigned long long mt = __ballot(take);
        const int pos = running + prefix64(mt);
        if (take) { if (FINAL) { if (pos < 256) sel_out[pos] = (unsigned short)ix[j]; } else cand[pos] = (u32x2){__float_as_uint(sc[j]), ix[j]}; }
        running += __popcll(mt); eqrun += __popcll(meq);
    }
    thr_key = Tk;
    return running;
}

__device__ __forceinline__ unsigned wave_umax(unsigned v) {
    v = max(v, (unsigned)__builtin_amdgcn_update_dpp(0, (int)v, 0xB1, 0xf, 0xf, false)); v = max(v, (unsigned)__builtin_amdgcn_update_dpp(0, (int)v, 0x4E, 0xf, 0xf, false));
    v = max(v, (unsigned)__builtin_amdgcn_update_dpp(0, (int)v, 0x141, 0xf, 0xf, false)); v = max(v, (unsigned)__builtin_amdgcn_update_dpp(0, (int)v, 0x140, 0xf, 0xf, false));
    return max(max((unsigned)__builtin_amdgcn_readlane((int)v, 0), (unsigned)__builtin_amdgcn_readlane((int)v, 16)), max((unsigned)__builtin_amdgcn_readlane((int)v, 32), (unsigned)__builtin_amdgcn_readlane((int)v, 48)));
}
__device__ __forceinline__ unsigned wave_umin(unsigned v) { return ~wave_umax(~v); }
__device__ __forceinline__ unsigned wave_usum(unsigned v) {
    v += (unsigned)__builtin_amdgcn_update_dpp(0, (int)v, 0xB1, 0xf, 0xf, false); v += (unsigned)__builtin_amdgcn_update_dpp(0, (int)v, 0x4E, 0xf, 0xf, false);
    v += (unsigned)__builtin_amdgcn_update_dpp(0, (int)v, 0x141, 0xf, 0xf, false); v += (unsigned)__builtin_amdgcn_update_dpp(0, (int)v, 0x140, 0xf, 0xf, false);
    return ((unsigned)__builtin_amdgcn_readlane((int)v, 0) + (unsigned)__builtin_amdgcn_readlane((int)v, 16)) + ((unsigned)__builtin_amdgcn_readlane((int)v, 32) + (unsigned)__builtin_amdgcn_readlane((int)v, 48));
}
__device__ __forceinline__ int count_ge_v(const unsigned (&k)[8], unsigned thr) { unsigned c = 0;
#pragma unroll
    for (int j = 0; j < 8; ++j) c += (k[j] >= thr) ? 1u : 0u;
    return (int)wave_usum(c); }
template <bool FINAL> __device__ __forceinline__ void select4(LAS u32x2* cb, int (&n)[4], unsigned (&tk)[4], int lane, unsigned short* sel_out, LAS u32x2* trash, unsigned short* gtrash) {
    unsigned k[4][NE], ix[4][NE];
#pragma unroll
    for (int q = 0; q < 4; ++q)
#pragma unroll
        for (int j = 0; j < NE; ++j) { const int e = lane + 64 * j; const bool v = e < n[q]; const u32x2 en = cb[(size_t)q * CAP + (v ? e : 0)]; ix[q][j] = en.y; k[q][j] = v ? okey(__uint_as_float(en.x)) : 0u; }
    unsigned lo[4], hx[4]; int clo[4];
#pragma unroll
    for (int q = 0; q < 4; ++q) { unsigned mn = 0xffffffffu, mxv = 0u;
#pragma unroll
        for (int j = 0; j < NE; ++j) { mxv = max(mxv, k[q][j]); mn = min(mn, k[q][j] ? k[q][j] : 0xffffffffu); }
        lo[q] = wave_umin(mn); hx[q] = wave_umax(mxv) + 1u; clo[q] = n[q]; }
    const int accept = FINAL ? 256 : KEEP_MAX;
    for (int it = 0; it < 40; ++it) {
        unsigned mid[4]; int c[4]; bool any = false;
#pragma unroll
        for (int q = 0; q < 4; ++q) mid[q] = lo[q] + ((hx[q] - lo[q]) >> 1);
#pragma unroll
        for (int q = 0; q < 4; ++q) { unsigned cl = 0;
#pragma unroll
            for (int j = 0; j < NE; ++j) cl += (k[q][j] >= mid[q]) ? 1u : 0u;
            c[q] = (int)wave_usum(cl); }
#pragma unroll
        for (int q = 0; q < 4; ++q) { const bool upd = (clo[q] > accept) && (hx[q] - lo[q] > 1u), ge = c[q] >= 256;
            lo[q] = (upd && ge) ? mid[q] : lo[q]; clo[q] = (upd && ge) ? c[q] : clo[q]; hx[q] = (upd && !ge) ? mid[q] : hx[q]; any = any || upd; }
        if (!any) break;
    }
#pragma unroll
    for (int q = 0; q < 4; ++q) {
        const unsigned Tk = lo[q];
        const bool ties = FINAL ? (clo[q] != 256) : (clo[q] > accept);
        int running = 0;
        if (!ties) {
#pragma unroll
            for (int j = 0; j < NE; ++j) {
                const bool take = k[q][j] >= Tk;
                const unsigned long long mt = __ballot(take);
                const int pos = running + prefix64(mt);
                if (FINAL) { unsigned short* dst = take ? sel_out + (size_t)q * 256 + pos : gtrash + lane; *dst = (unsigned short)ix[q][j]; }
                else { LAS u32x2* dst = take ? cb + (size_t)q * CAP + pos : trash + lane; *dst = (u32x2){__float_as_uint(ikey(k[q][j])), ix[q][j]}; }
                running += __popcll(mt);
            }
        } else {
            unsigned cg = 0;
#pragma unroll
            for (int j = 0; j < NE; ++j) cg += (k[q][j] > Tk) ? 1u : 0u;
            const int r_eq = 256 - (int)wave_usum(cg); int eqrun = 0;
#pragma unroll
            for (int j = 0; j < NE; ++j) {
                const bool gt = k[q][j] > Tk, eq = (k[q][j] == Tk);
                const unsigned long long meq = __ballot(eq);
                const bool take = gt || (eq && (eqrun + prefix64(meq)) < r_eq);
                const unsigned long long mt = __ballot(take);
                const int pos = running + prefix64(mt);
                if (FINAL) { unsigned short* dst = (take && pos < 256) ? sel_out + (size_t)q * 256 + pos : gtrash + lane; *dst = (unsigned short)ix[q][j]; }
                else { LAS u32x2* dst = take ? cb + (size_t)q * CAP + pos : trash + lane; *dst = (u32x2){__float_as_uint(ikey(k[q][j])), ix[q][j]}; }
                running += __popcll(mt); eqrun += __popcll(meq);
            }
        }
        tk[q] = Tk; n[q] = running;
    }
}
__device__ __forceinline__ void unit(int b, int g, const bf16* QI, const bf16* KI, const float* WI, unsigned short* SEL, unsigned short* gtrash, LAS unsigned char* lds, int variant) {
    const int q0 = g * 32, L = 64 * (q0 / 64 + 1);
    if (L <= 256) return;
    const int tid = threadIdx.x, lane = tid & 63, c = lane & 31, hi = lane >> 5; const int wid = __builtin_amdgcn_readfirstlane(tid >> 6);
    const size_t rowbase = (size_t)b * T; const int ntile = L / 64;
    bf16x8 Af[4];
    { const int r = c, jq = ((r >> 2) & 1) + 2 * (r >> 4), hd = (r & 3) + 4 * ((r >> 3) & 1);
      const bf16* qp = QI + (rowbase + q0 + 4 * wid + jq) * 512 + hd * 64 + 8 * hi;
#pragma unroll
      for (int s = 0; s < 4; ++s) Af[s] = *(const bf16x8*)(qp + 16 * s); }
    float wv[2][8];
#pragma unroll
    for (int u = 0; u < 2; ++u) { const float* wp = WI + (rowbase + q0 + 4 * wid + hi + 2 * u) * 8; const f32x4 a = *(const f32x4*)wp, bq = *(const f32x4*)(wp + 4);
#pragma unroll
        for (int i = 0; i < 4; ++i) { wv[u][i] = a[i] * (0.125f * 0.35355339059327373f); wv[u][4 + i] = bq[i] * (0.125f * 0.35355339059327373f); } }
    float tau[2] = {-INFINITY, -INFINITY}; int cnt[2] = {0, 0};
    LAS u32x2* cbase = (LAS u32x2*)(lds + L_CAND) + (size_t)(wid * 4) * CAP;
    LAS u32x2* trash = (LAS u32x2*)(lds + L_TRASH) + wid * 64;
    const bf16* kp = KI + (rowbase + c) * 64 + 8 * hi;
    bf16x8 Ba[8], Bb[8];
#define IDX_LOAD(dst, tt) do { _Pragma("unroll") for (int i_ = 0; i_ < 8; ++i_) dst[i_] = *(const bf16x8*)(kp + (size_t)((tt) * 64 + (i_ >> 2) * 32) * 64 + 16 * (i_ & 3)); } while (0)
#define IDX_TILE(Bf, tt) do { \
        f32x16 acc0, acc1; \
        _Pragma("unroll") for (int r_ = 0; r_ < 16; ++r_) { acc0[r_] = 0.f; acc1[r_] = 0.f; } \
        _Pragma("unroll") for (int s4 = 0; s4 < 4; ++s4) { acc0 = __builtin_amdgcn_mfma_f32_32x32x16_bf16(Af[s4], Bf[s4], acc0, 0, 0, 0); acc1 = __builtin_amdgcn_mfma_f32_32x32x16_bf16(Af[s4], Bf[4 + s4], acc1, 0, 0, 0); } \
        float sv[2][2]; \
        _Pragma("unroll") for (int u = 0; u < 2; ++u) { float a_ = 0.f, b_ = 0.f; \
            _Pragma("unroll") for (int i = 0; i < 8; ++i) { a_ = fmaf(__builtin_amdgcn_fmed3f(acc0[8 * u + i], 0.f, 3.0e38f), wv[u][i], a_); b_ = fmaf(__builtin_amdgcn_fmed3f(acc1[8 * u + i], 0.f, 3.0e38f), wv[u][i], b_); } \
            sv[u][0] = a_; sv[u][1] = b_; } \
        bool ps[2][2]; unsigned long long mk[2][2]; \
        _Pragma("unroll") for (int u = 0; u < 2; ++u) _Pragma("unroll") for (int kh = 0; kh < 2; ++kh) { ps[u][kh] = (sv[u][kh] > tau[u]) && !(variant & 2); mk[u][kh] = __ballot(ps[u][kh]); } \
        if ((mk[0][0] | mk[0][1] | mk[1][0] | mk[1][1]) != 0ull) { \
            _Pragma("unroll") for (int u = 0; u < 2; ++u) _Pragma("unroll") for (int kh = 0; kh < 2; ++kh) { \
                const unsigned mlo = (unsigned)mk[u][kh], mhi = (unsigned)(mk[u][kh] >> 32); \
                const int pre = (int)__builtin_amdgcn_mbcnt_hi(mhi, __builtin_amdgcn_mbcnt_lo(mlo, 0u)) - (hi ? __popc(mlo) : 0);     \
                LAS u32x2* dst = ps[u][kh] ? cbase + (size_t)(hi + 2 * u) * CAP + cnt[u] + pre : trash + lane; \
                *dst = (u32x2){__float_as_uint(sv[u][kh]), (unsigned)((tt) * 64 + kh * 32 + c)}; \
                cnt[u] += hi ? __popc(mhi) : __popc(mlo); } } \
    } while (0)
    IDX_LOAD(Ba, 0); IDX_LOAD(Bb, 1);
    for (int t = 0; t < ntile; t += 2) {
#define IDX_CHECK() do { const int n0 = __builtin_amdgcn_readlane(cnt[0], 0), n1 = __builtin_amdgcn_readlane(cnt[0], 32), n2 = __builtin_amdgcn_readlane(cnt[1], 0), n3 = __builtin_amdgcn_readlane(cnt[1], 32); \
          if (max(max(n0, n1), max(n2, n3)) > TRIG && !(variant & 1)) { int n4[4] = {n0, n1, n2, n3}; unsigned tk4[4]; \
            PROF_T0(1); select4<false>(cbase, n4, tk4, lane, nullptr, trash, gtrash); PROF_T1(1, lds, wid, lane); \
            cnt[0] = hi ? n4[1] : n4[0]; cnt[1] = hi ? n4[3] : n4[2]; tau[0] = ikey(hi ? tk4[1] : tk4[0]); tau[1] = ikey(hi ? tk4[3] : tk4[2]); } } while (0)
        IDX_CHECK();
        IDX_TILE(Ba, t);
        if (t + 2 < ntile) IDX_LOAD(Ba, t + 2);
        if (t + 1 < ntile) { IDX_CHECK(); IDX_TILE(Bb, t + 1); if (t + 3 < ntile) IDX_LOAD(Bb, t + 3); }
    }
#undef IDX_LOAD
#undef IDX_TILE
#undef IDX_CHECK
    asm volatile("s_waitcnt lgkmcnt(0)" ::: "memory");
    if (!(variant & 9)) { int n4[4] = {__builtin_amdgcn_readlane(cnt[0], 0), __builtin_amdgcn_readlane(cnt[0], 32), __builtin_amdgcn_readlane(cnt[1], 0), __builtin_amdgcn_readlane(cnt[1], 32)}; unsigned tk4[4];
      PROF_T0(2); select4<true>(cbase, n4, tk4, lane, SEL + (rowbase + q0 + 4 * wid) * 256, trash, gtrash); PROF_T1(2, lds, wid, lane); }
    asm volatile("s_waitcnt lgkmcnt(0)" ::: "memory");
}
__device__ __forceinline__ void phase(int vcu, int G, const bf16* QI, const bf16* KI, const float* WI, unsigned short* SEL, unsigned short* gtrash, LAS unsigned char* lds, int variant) {
    PROF_T0(7);
    for (int u = vcu; u < 1024; u += G) { const int i = u >> 8, v = u & 255, b = v >> 6, s = v & 63;
        const int g = (i == 0) ? s : (i == 1) ? 127 - s : (i == 2) ? 128 + s : 255 - s;
        unit(b, g, QI, KI, WI, SEL, gtrash, lds, variant); }
    PROF_T1(7, lds, (int)__builtin_amdgcn_readfirstlane(threadIdx.x >> 6), (int)(threadIdx.x & 63));
    __syncthreads();
}
}

namespace dsa {
typedef unsigned u32x4m __attribute__((ext_vector_type(4)));
typedef unsigned u32x2m __attribute__((ext_vector_type(2)));
typedef short bf16x8 __attribute__((ext_vector_type(8)));
typedef short v4i16 __attribute__((ext_vector_type(4)));
constexpr int WREG = 17408, L_BIAS = 8 * WREG, L_END = L_BIAS + 33 * 8 * 4;
static_assert(L_END <= RING_BYTES, "dsa LDS");
constexpr float LOG2E = 1.4426950408889634f;
__device__ __forceinline__ int t5_bucket(int rel) {
    const int n = rel < 0 ? -rel : rel; const int r = rel > 0 ? 16 : 0;
    if (n < 8) return r + n;
    int lg = (31 - __clz(n * n)) - 6; if (n >= 128 || lg > 7) lg = 7;
    return r + 8 + lg;
}
__device__ __forceinline__ void phase(int vcu, int G, const bf16* QA, const bf16* KA, const bf16* VA, const unsigned short* SEL, const int* positions, const float* rel_bias, bf16* OA, LAS unsigned char* lds) {
    const int tid = threadIdx.x, lane = tid & 63, l15 = lane & 15, kq = lane >> 4; const int wid = __builtin_amdgcn_readfirstlane(tid >> 6);
    LAS float* bt = (LAS float*)(lds + L_BIAS);
    for (int i = tid; i < 33 * 8; i += NWAVES * 64) bt[i] = (i < 256) ? rel_bias[i] * LOG2E : -INFINITY;
    __syncthreads();
    LAS unsigned char* wl = lds + wid * WREG;
    LAS unsigned short* selL = (LAS unsigned short*)(wl + 16384); LAS unsigned char* bktL = wl + 16384 + 512;
    const int gw = vcu * NWAVES + wid, NGW = G * NWAVES;
    const int trofs = ((l15 >> 2) + 4 * kq) * 128 + (l15 & 3) * 8;
    for (int q = gw; q < M; q += NGW) {
        const int b = q >> 13, t = q & (T - 1); const size_t rowbase = (size_t)b * T;
        const int limit = 64 * (t / 64 + 1), nvalid = limit < 256 ? limit : 256; const int posq = positions[q];
#pragma unroll
        for (int j = 0; j < 4; ++j) { const int k = lane + 64 * j; const int sv = (limit <= 256) ? (k < limit ? k : limit - 1) : (int)SEL[(size_t)q * 256 + k];
            const int bk = (k < nvalid) ? t5_bucket(positions[rowbase + sv] - posq) : 32; selL[k] = (unsigned short)sv; bktL[k] = (unsigned char)bk; }
        asm volatile("s_waitcnt lgkmcnt(0)" ::: "memory");
#define DSA_VDMA(cch, buf) do { _Pragma("unroll") for (int i_ = 0; i_ < 8; ++i_) { const int row_ = selL[64 * (cch) + 8 * i_ + (lane >> 3)]; \
            __builtin_amdgcn_global_load_lds((const unsigned*)(VA + (rowbase + row_) * 64 + (lane & 7) * 8), (LAS unsigned*)(wl + (buf) * 8192 + i_ * 1024), 16, 0, 0); } } while (0)
        DSA_VDMA(0, 0); DSA_VDMA(1, 1);
        bf16x8 Qf[2];
#pragma unroll
        for (int s = 0; s < 2; ++s) { Qf[s] = (bf16x8){0, 0, 0, 0, 0, 0, 0, 0}; if (l15 < 8) Qf[s] = *(const bf16x8*)(QA + (size_t)q * 512 + l15 * 64 + 32 * s + 8 * kq); }
        f32x4 St[16];
#pragma unroll
        for (int half = 0; half < 2; ++half) {
            bf16x8 Ka[8][2];
#pragma unroll
            for (int i = 0; i < 8; ++i) { const int row = selL[16 * (8 * half + i) + l15]; const bf16* kp = KA + (rowbase + row) * 64 + 8 * kq;
                Ka[i][0] = *(const bf16x8*)kp; Ka[i][1] = *(const bf16x8*)(kp + 32); }
#pragma unroll
            for (int i = 0; i < 8; ++i) { f32x4 a = {0.f, 0.f, 0.f, 0.f};
                a = __builtin_amdgcn_mfma_f32_16x16x32_bf16(Ka[i][0], Qf[0], a, 0, 0, 0); a = __builtin_amdgcn_mfma_f32_16x16x32_bf16(Ka[i][1], Qf[1], a, 0, 0, 0); St[8 * half + i] = a; }
        }
        float mx = -INFINITY;
#pragma unroll
        for (int kt = 0; kt < 16; ++kt) { const unsigned bk4 = *(const LAS unsigned*)(bktL + 16 * kt + 4 * kq);
#pragma unroll
            for (int i = 0; i < 4; ++i) { const float s = St[kt][i] * (0.125f * LOG2E) + bt[((bk4 >> (8 * i)) & 255u) * 8 + (l15 & 7)]; St[kt][i] = s; mx = fmaxf(mx, s); } }
        mx = fmaxf(mx, __shfl_xor(mx, 16)); mx = fmaxf(mx, __shfl_xor(mx, 32));
        float lsum = 0.f;
#pragma unroll
        for (int kt = 0; kt < 16; ++kt)
#pragma unroll
            for (int i = 0; i < 4; ++i) { const float p = __builtin_amdgcn_exp2f(St[kt][i] - mx); St[kt][i] = p; lsum += p; }
        lsum += __shfl_xor(lsum, 16); lsum += __shfl_xor(lsum, 32);
        f32x4 O[4];
#pragma unroll
        for (int dt = 0; dt < 4; ++dt) O[dt] = (f32x4){0.f, 0.f, 0.f, 0.f};
#pragma unroll
        for (int cch = 0; cch < 4; ++cch) {
            if (cch < 2) { if (cch == 0) asm volatile("s_waitcnt vmcnt(8)" ::: "memory"); else asm volatile("s_waitcnt vmcnt(0)" ::: "memory"); }
            else asm volatile("s_waitcnt vmcnt(0)" ::: "memory");
            const LAS unsigned char* vb = wl + (cch & 1) * 8192 + trofs;
#pragma unroll
            for (int k2 = 0; k2 < 2; ++k2) {
                const int kk = 2 * cch + k2;
                const f32x4 pa = St[2 * kk], pb = St[2 * kk + 1];
                u32x4m pw; pw.x = pg8::cvt_pk_bf16(pa[0], pa[1]); pw.y = pg8::cvt_pk_bf16(pa[2], pa[3]); pw.z = pg8::cvt_pk_bf16(pb[0], pb[1]); pw.w = pg8::cvt_pk_bf16(pb[2], pb[3]);
                const bf16x8 Pf = __builtin_bit_cast(bf16x8, pw);
#pragma unroll
                for (int dt = 0; dt < 4; ++dt) {
                    const v4i16 v0 = __builtin_amdgcn_ds_read_tr16_b64_v4i16((LAS v4i16*)(vb + k2 * 4096 + dt * 32));
                    const v4i16 v1 = __builtin_amdgcn_ds_read_tr16_b64_v4i16((LAS v4i16*)(vb + k2 * 4096 + 2048 + dt * 32));
                    const bf16x8 Vf = (bf16x8){v0[0], v0[1], v0[2], v0[3], v1[0], v1[1], v1[2], v1[3]};
                    O[dt] = __builtin_amdgcn_mfma_f32_16x16x32_bf16(Vf, Pf, O[dt], 0, 0, 0); }
            }
            if (cch < 2) { asm volatile("s_waitcnt lgkmcnt(0)" ::: "memory"); DSA_VDMA(cch + 2, cch & 1); }
        }
#undef DSA_VDMA
        if (l15 < 8) { const float rl = __builtin_amdgcn_rcpf(lsum);
#pragma unroll
            for (int dt = 0; dt < 4; ++dt) { u32x2m w; w.x = pg8::cvt_pk_bf16(O[dt][0] * rl, O[dt][1] * rl); w.y = pg8::cvt_pk_bf16(O[dt][2] * rl, O[dt][3] * rl);
                *(u32x2m*)(OA + (size_t)q * 512 + l15 * 64 + 16 * dt + 4 * kq) = w; } }
        asm volatile("s_waitcnt lgkmcnt(0)" ::: "memory");
    }
}
}

constexpr int NPHASE = 16;
__global__ void __launch_bounds__(NWAVES * 64, 2) mk_fwd(Args args) {
    extern __shared__ __attribute__((aligned(16))) unsigned char lds[];
    Frame F;
    F.lds = (LAS unsigned char*)lds;
    F.MISC = (volatile LAS unsigned*)(F.lds + MISC_OFF);
    F.tid = threadIdx.x; F.lane = F.tid & 63; F.wave = __builtin_amdgcn_readfirstlane(F.tid >> 6);
    F.G = gridDim.x; { const int bx = blockIdx.x; F.vcu = (F.G % 8 == 0) ? (bx % 8) * (F.G / 8) + bx / 8 : bx; }
    unsigned char* ws = args.ws;
    F.ctl = (gu32*)(ws + WS_CTL);
    for (int u = F.tid; u < (LDS_BYTES - LDSCTL_OFF) / 4; u += NWAVES * 64) ((LAS unsigned*)(F.lds + LDSCTL_OFF))[u] = 0u;
    __syncthreads();
    XcdBarrier bar; bar.bar = (unsigned*)(F.ctl + CW_BAR); bar.x = 0; bar.st = nullptr;
    if (MK_FUSED) bar = xcd_barrier_post((unsigned*)(F.ctl + CW_BAR), F.MISC + 8);
#define GRID_BAR() do { if (MK_FUSED) xcd_barrier(bar); } while (0)
    const int lo = args.ph_lo, hi = args.ph_hi;
#ifdef ONLY_PH
#define IN(k) ((k) == ONLY_PH && lo <= (k) && (k) < hi)
#else
#define IN(k) (lo <= (k) && (k) < hi)
#endif
#define BOTH(k) (IN(k) && IN((k) + 1))
#ifndef DUP_PH
#define DUP_PH -1
#endif
#ifndef P7_VARIANT
#define P7_VARIANT 0
#endif
#define REP(k) for (int rep_ = 0; rep_ < ((k) == DUP_PH ? 2 : 1); ++rep_)
    const float* x = (const float*)args.in[0];
    const float* mod = (const float*)(ws + WS_MOD);
    bf16* XN = (bf16*)(ws + WS_XN); bf16* ACT = (bf16*)(ws + WS_ACT);
    float* X1 = args.out;
    const float* rcos = (const float*)(ws + WS_RCOS); const float* rsin = (const float*)(ws + WS_RSIN);
    float* ssq_q = (float*)(ws + WS_SSQQ); float* ssq_kv = (float*)(ws + WS_SSQKV);

    if (IN(0)) REP(0) { p0_prologue(F, args); if (BOTH(0)) GRID_BAR(); }
    if (IN(1)) REP(1) { norm_mod_phase(F, x, (const float*)args.in[5], mod, 0 * D, 1 * D, XN); if (BOTH(1)) GRID_BAR(); }
    if (IN(2)) REP(2) {
        pg8::Gemm g{XN, (const bf16*)(ws + WS_W1A), M, 2 * DFF, D}; pg8::StaticOrder S; S.init(M, 2 * DFF, F.G, (int)blockIdx.x);
        pg8::EpiSwiglu E{ACT, DFF};
        pg8::gemm_phase<pg8::EpiSwiglu, pg8::StaticOrder, true, true>(F.lds + RING_OFF, g, S, E);
        if (BOTH(2)) GRID_BAR(); }
    if (IN(3)) REP(3) {
        pg8::Gemm g{ACT, (const bf16*)(ws + WS_W1D), M, D, DFF}; pg8::StaticOrder S; S.init(M, D, F.G, (int)blockIdx.x);
        pg8::EpiResid E{x, X1, mod, 2 * D, 0.5f};
        pg8::gemm_phase<pg8::EpiResid, pg8::StaticOrder, true, true>(F.lds + RING_OFF, g, S, E);
        if (BOTH(3)) GRID_BAR(); }
    if (IN(4)) REP(4) { norm_mod_phase(F, X1, (const float*)args.in[8], mod, 3 * D, 4 * D, XN); if (BOTH(4)) GRID_BAR(); }
    if (IN(5)) REP(5) {
        pg8::Gemm g{XN, (const bf16*)(ws + WS_WIN), M, NPROJ, D}; pg8::StaticOrder S; S.init(M, NPROJ, F.G, (int)blockIdx.x);
        pg8::EpiProj E{(bf16*)(ws + WS_QA), (bf16*)(ws + WS_QI), (bf16*)(ws + WS_CQ), (bf16*)(ws + WS_CKV), (bf16*)(ws + WS_KA), (bf16*)(ws + WS_VA), (bf16*)(ws + WS_KI), (bf16*)(ws + WS_KPE), (bf16*)(ws + WS_G),
                       (float*)(ws + WS_WI), ssq_q, ssq_kv, rcos, rsin};
        pg8::gemm_phase<pg8::EpiProj, pg8::StaticOrder, true, true>(F.lds + RING_OFF, g, S, E);
        if (BOTH(5)) GRID_BAR(); }
    if (IN(6)) REP(6) {
        { pg8::Gemm g{(const bf16*)(ws + WS_CQ), (const bf16*)(ws + WS_WUQ), M, 768, 384}; pg8::StaticOrder S; S.init(M, 768, F.G, (int)blockIdx.x);
          pg8::EpiUpQ E{(bf16*)(ws + WS_QB), ssq_q, rcos, rsin};
          pg8::gemm_phase<pg8::EpiUpQ, pg8::StaticOrder, true, true>(F.lds + RING_OFF, g, S, E); }
        __syncthreads();
        { pg8::Gemm g{(const bf16*)(ws + WS_CKV), (const bf16*)(ws + WS_WUKV), M, 1024, 256}; pg8::StaticOrder S; S.init(M, 1024, F.G, (int)blockIdx.x);
          pg8::EpiUpKV E{(bf16*)(ws + WS_KN), (bf16*)(ws + WS_VB), ssq_kv};
          pg8::gemm_phase<pg8::EpiUpKV, pg8::StaticOrder, true, true>(F.lds + RING_OFF, g, S, E); }
        __syncthreads(); }
    if (IN(7)) REP(7) { idx::phase(F.vcu, F.G, (const bf16*)(ws + WS_QI), (const bf16*)(ws + WS_KI), (const float*)(ws + WS_WI), (unsigned short*)(ws + WS_SEL), (unsigned short*)(ws + WS_END), F.lds + RING_OFF, (DUP_PH == 7 && rep_ == 0) ? P7_VARIANT : 0); if (BOTH(7)) GRID_BAR(); }
    if (IN(8)) REP(8) { dsa::phase(F.vcu, F.G, (const bf16*)(ws + WS_QA), (const bf16*)(ws + WS_KA), (const bf16*)(ws + WS_VA), (const unsigned short*)(ws + WS_SEL), (const int*)args.in[2], (const float*)args.in[15], (bf16*)(ws + WS_OA), F.lds + RING_OFF); __syncthreads(); }
    if (IN(9)) REP(9) { mla::phase(F.vcu, F.G, (const bf16*)(ws + WS_QB), (const bf16*)(ws + WS_KN), (const bf16*)(ws + WS_KPE), (const bf16*)(ws + WS_VB), (bf16*)(ws + WS_OB), F.lds + RING_OFF); if (BOTH(9)) GRID_BAR(); }
    if (IN(10)) REP(10) {
        { pg8::Gemm g{(const bf16*)(ws + WS_OA), (const bf16*)(ws + WS_WOA), M, D, 512}; pg8::StaticOrder S; S.init(M, D, F.G, (int)blockIdx.x);
          pg8::EpiGate<false> E{(const bf16*)(ws + WS_G), 0, nullptr, (bf16*)(ws + WS_Y1)};
          pg8::gemm_phase<pg8::EpiGate<false>, pg8::StaticOrder, true, true>(F.lds + RING_OFF, g, S, E); }
        VM_WAIT(); __syncthreads();
        { pg8::Gemm g{(const bf16*)(ws + WS_OB), (const bf16*)(ws + WS_WOB), M, D, 512}; pg8::StaticOrder S; S.init(M, D, F.G, (int)blockIdx.x);
          pg8::EpiGate<true> E{(const bf16*)(ws + WS_G), 1024, (const bf16*)(ws + WS_Y1), (bf16*)(ws + WS_Y)};
          pg8::gemm_phase<pg8::EpiGate<true>, pg8::StaticOrder, true, true>(F.lds + RING_OFF, g, S, E); }
        if (BOTH(10)) GRID_BAR(); }
    if (IN(11)) {
        pg8::Gemm g{(const bf16*)(ws + WS_Y), (const bf16*)(ws + WS_WOUT), M, D, D}; pg8::StaticOrder S; S.init(M, D, F.G, (int)blockIdx.x);
        pg8::EpiResid E{X1, X1, mod, 5 * D, 1.0f};
        pg8::gemm_phase<pg8::EpiResid, pg8::StaticOrder, true, true>(F.lds + RING_OFF, g, S, E);
        if (BOTH(11)) GRID_BAR(); }
    if (IN(12)) REP(12) { norm_mod_phase(F, X1, (const float*)args.in[19], mod, 6 * D, 7 * D, XN); if (BOTH(12)) GRID_BAR(); }
    if (IN(13)) REP(13) {
        pg8::Gemm g{XN, (const bf16*)(ws + WS_W2A), M, 2 * DFF, D}; pg8::StaticOrder S; S.init(M, 2 * DFF, F.G, (int)blockIdx.x);
        pg8::EpiSwiglu E{ACT, DFF};
        pg8::gemm_phase<pg8::EpiSwiglu, pg8::StaticOrder, true, true>(F.lds + RING_OFF, g, S, E);
        if (BOTH(13)) GRID_BAR(); }
    if (IN(14)) {
        pg8::Gemm g{ACT, (const bf16*)(ws + WS_W2D), M, D, DFF}; pg8::StaticOrder S; S.init(M, D, F.G, (int)blockIdx.x);
        pg8::EpiResid E{X1, X1, mod, 8 * D, 0.5f};
        pg8::gemm_phase<pg8::EpiResid, pg8::StaticOrder, true, true>(F.lds + RING_OFF, g, S, E);
        if (BOTH(14)) GRID_BAR(); }
    if (IN(15)) { final_norm_phase(F, X1, (const float*)args.in[22], args.out); }
    if (PROF_SEL != 0) { asm volatile("s_waitcnt lgkmcnt(0)" ::: "memory"); const unsigned a_ = *PROF_WORD(F.lds + RING_OFF, F.wave); const unsigned long long t0_ = __builtin_amdgcn_s_memrealtime();
        while (__builtin_amdgcn_s_memrealtime() - t0_ < (unsigned long long)a_ * PROF_MULT) __builtin_amdgcn_s_sleep(32); }
#undef IN
#undef BOTH
}

extern "C" void kernel_launch(void* const* d_in, const int* in_sizes, int n_in, void* d_out, int out_size, void* d_ws, size_t ws_size, hipStream_t stream) {
    static int grid = 0;
    if (grid == 0) {
        if (n_in != 23 || out_size != M * D || ws_size < WS_END) { fprintf(stderr, "kernel_launch: unexpected problem shape (n_in %d, out %d, ws %zu)\n", n_in, out_size, ws_size); grid = -1; return; }
        int dev = 0, cus = 0, per_cu = 0;
        if (hipGetDevice(&dev) != hipSuccess || hipDeviceGetAttribute(&cus, hipDeviceAttributeMultiprocessorCount, dev) != hipSuccess) { grid = -1; return; }
        if (hipFuncSetAttribute((const void*)mk_fwd, hipFuncAttributeMaxDynamicSharedMemorySize, LDS_BYTES) != hipSuccess) { fprintf(stderr, "kernel_launch: hipFuncSetAttribute failed\n"); grid = -1; return; }
        if (hipOccupancyMaxActiveBlocksPerMultiprocessor(&per_cu, (const void*)mk_fwd, NWAVES * 64, LDS_BYTES) != hipSuccess || per_cu < 1) fprintf(stderr, "kernel_launch: occupancy query reports %d\n", per_cu);
        (void)hipGetLastError();
        grid = cus;
    }
    if (grid < 0) return;
    (void)in_sizes;
    if (hipMemsetAsync((char*)d_ws + WS_CTL, 0, CTL_ZERO_BYTES, stream) != hipSuccess) return;
    Args a{};
    for (int i = 0; i < 23; ++i) a.in[i] = d_in[i];
    a.out = (float*)d_out; a.ws = (unsigned char*)d_ws;
    auto launch = [&](int lo, int hi) { a.ph_lo = lo; a.ph_hi = hi; a.li = 0; hipLaunchKernelGGL(mk_fwd, dim3(grid), dim3(NWAVES * 64), LDS_BYTES, stream, a); };
#if MK_FUSED
    launch(0, NPHASE);
#else
    for (int p = 0; p < NPHASE; ++p) launch(p, p + 1);
#endif
}
```

```cpp
#include <hip/hip_runtime.h>
#include <cstdio>
#include <cstdint>
namespace pg8 {
#define PG8_LAS __attribute__((address_space(3)))
typedef unsigned short bf16_t;
typedef short bf16x8 __attribute__((ext_vector_type(8)));
typedef float f32x4 __attribute__((ext_vector_type(4)));
typedef unsigned u32x4 __attribute__((ext_vector_type(4)));
constexpr int BM = 256, BK = 64, HALF = 128, HTB = HALF * BK * 2  , STAGE_BYTES = 8 * HTB, NXCD = 8, WGM = 8;

__host__ __device__ __forceinline__ int lds_byte(int r, int c) { const int st = (r >> 4) * 2 + (c >> 5), rr = r & 15, cc = c & 31, ob = rr * 64 + cc * 2; return st * 1024 + (ob ^ (((ob >> 9) & 1) << 5)); }
__host__ __device__ __forceinline__ void stage_rc(int b, int& R, int& C) { const int st = b / 1024, sb = b % 1024, swz = sb ^ (((sb >> 9) & 1) << 5); R = (st >> 1) * 16 + swz / 64; C = (st & 1) * 32 + (swz % 64) / 2; }
__host__ __device__ __forceinline__ int perm32(int rho) { const int n = rho >> 4, i = rho & 15; return 8 * (i >> 2) + 4 * n + (i & 3); }

struct Unit { int pm, pn; };
struct Gemm { const bf16_t* A; const bf16_t* Bt; int M, N, K; };

struct StaticOrder {
    int nM, nN, nwg, G, c;
    __host__ __device__ void init(int M, int N, int G_, int c_) { nM = M / BM; nN = N / BM; nwg = nM * nN; G = G_; c = c_; }
    __host__ __device__ bool next(int i, Unit& u) const {
        const long L = (long)i * G + c; if (L >= nwg) return false;
        int wgid = (int)L; { const int q = nwg / NXCD, r = nwg % NXCD, xcd = wgid % NXCD, off = wgid / NXCD; wgid = (xcd < r ? xcd * (q + 1) : r * (q + 1) + (xcd - r) * q) + off; }
        const int nig = WGM * nN, gid = wgid / nig, fm = gid * WGM, gsz = (nM - fm) < WGM ? (nM - fm) : WGM;
        u.pm = fm + ((wgid % nig) % gsz); u.pn = (wgid % nig) / gsz; return true;
    }
    __device__ __forceinline__ void a_ready(const Unit&) const {}
    __device__ __forceinline__ void done(const Unit&) const {}
};

typedef float f32x2 __attribute__((ext_vector_type(2)));
typedef __bf16 bf16x2_cv __attribute__((ext_vector_type(2)));
__device__ __forceinline__ unsigned cvt_pk_bf16(float lo, float hi) { const f32x2 v = {lo, hi}; const bf16x2_cv b = __builtin_convertvector(v, bf16x2_cv); return __builtin_bit_cast(unsigned, b); }

__device__ __forceinline__ u32x4 pack8(const f32x4 a, const f32x4 b) { u32x4 w; w.x = cvt_pk_bf16(a[0], a[1]); w.y = cvt_pk_bf16(a[2], a[3]); w.z = cvt_pk_bf16(b[0], b[1]); w.w = cvt_pk_bf16(b[2], b[3]); return w; }
__device__ __forceinline__ float sigm(float v) { return __builtin_amdgcn_rcpf(1.f + __builtin_amdgcn_exp2f(-1.4426950408889634f * v)); }
__device__ __forceinline__ f32x4 sigm4(const f32x4 v) { return (f32x4){sigm(v[0]), sigm(v[1]), sigm(v[2]), sigm(v[3])}; }
__device__ __forceinline__ void unpack8(const u32x4 w, f32x4& a, f32x4& b) {
    a = (f32x4){__uint_as_float(w.x << 16), __uint_as_float(w.x & 0xffff0000u), __uint_as_float(w.y << 16), __uint_as_float(w.y & 0xffff0000u)};
    b = (f32x4){__uint_as_float(w.z << 16), __uint_as_float(w.z & 0xffff0000u), __uint_as_float(w.w << 16), __uint_as_float(w.w & 0xffff0000u)}; }
constexpr float EPS_RMS = 1e-6f;
constexpr float QSCALE = 0.10206207261596575f * 1.4426950408889634f;

struct EpiSwiglu {
    static constexpr bool PERM = true, AFTER_DRAIN = false;
    bf16_t* O; int ldc;
    __device__ __forceinline__ void operator()(const f32x4 (&acc)[2][2][4][2], const Unit& u, int wr, int wc, int fr, int fq) const {
        const int row0 = u.pm * BM + wr * 64 + fr, col0 = u.pn * HALF + wc * 32 + 8 * fq;
#pragma unroll
        for (int ai = 0; ai < 2; ++ai)
#pragma unroll
            for (int m = 0; m < 4; ++m) {
                const f32x4 g0 = acc[ai][0][m][0], g1 = acc[ai][0][m][1], u0 = acc[ai][1][m][0], u1 = acc[ai][1][m][1];
                const f32x4 v0 = g0 * sigm4(g0) * u0, v1 = g1 * sigm4(g1) * u1;
                *(u32x4*)(O + (size_t)(row0 + ai * HALF + m * 16) * ldc + col0) = pack8(v0, v1); }
    }
};
struct EpiResid {
    static constexpr bool PERM = false, AFTER_DRAIN = false;
    const float* base; float* out; const float* mod; int goff; float scale;
    __device__ __forceinline__ void operator()(const f32x4 (&acc)[2][2][4][2], const Unit& u, int wr, int wc, int fr, int fq) const {
        const float* gate = mod + (u.pm >> 5) * 9216 + goff;
        const int col0 = u.pn * BM + wc * 32 + 4 * fq;
        f32x4 gv[2][2];
#pragma unroll
        for (int bj = 0; bj < 2; ++bj)
#pragma unroll
            for (int n = 0; n < 2; ++n) gv[bj][n] = *(const f32x4*)(gate + col0 + bj * HALF + n * 16) * scale;
#pragma unroll
        for (int ai = 0; ai < 2; ++ai)
#pragma unroll
            for (int m = 0; m < 4; ++m) { const size_t off = (size_t)(u.pm * BM + ai * HALF + wr * 64 + m * 16 + fr) * 1024 + col0;
#pragma unroll
                for (int bj = 0; bj < 2; ++bj)
#pragma unroll
                    for (int n = 0; n < 2; ++n) { const f32x4 bs = *(const f32x4*)(base + off + bj * HALF + n * 16); *(f32x4*)(out + off + bj * HALF + n * 16) = bs + gv[bj][n] * acc[ai][bj][m][n]; } }
    }
};
struct EpiProj {
    static constexpr bool PERM = true, AFTER_DRAIN = false;
    bf16_t *QA, *QI, *CQ, *CKV, *KA, *VA, *KI, *KPE, *G; float *WI, *ssq_q, *ssq_kv; const float *rcos, *rsin;
    __device__ __forceinline__ void operator()(const f32x4 (&acc)[2][2][4][2], const Unit& u, int wr, int wc, int fr, int fq) const {
        const int row0 = u.pm * BM + wr * 64 + fr, pn = u.pn, c32 = wc * 32 + 8 * fq;
#pragma unroll
        for (int ai = 0; ai < 2; ++ai)
#pragma unroll
            for (int m = 0; m < 4; ++m) {
                const size_t r = (size_t)(row0 + ai * HALF + m * 16);
                const f32x4 a0 = acc[ai][0][m][0], a1 = acc[ai][0][m][1], b0 = acc[ai][1][m][0], b1 = acc[ai][1][m][1];
                const float sa = (a0[0] * a0[0] + a0[1] * a0[1]) + (a0[2] * a0[2] + a0[3] * a0[3]) + (a1[0] * a1[0] + a1[1] * a1[1]) + (a1[2] * a1[2] + a1[3] * a1[3]);
                const float sb = (b0[0] * b0[0] + b0[1] * b0[1]) + (b0[2] * b0[2] + b0[3] * b0[3]) + (b1[0] * b1[0] + b1[1] * b1[1]) + (b1[2] * b1[2] + b1[3] * b1[3]);
                if (pn < 2) { bf16_t* p = QA + r * 512 + pn * 256 + c32; *(u32x4*)p = pack8(a0, a1); *(u32x4*)(p + HALF) = pack8(b0, b1); }
                else if (pn < 4) { bf16_t* p = QI + r * 512 + (pn - 2) * 256 + c32; *(u32x4*)p = pack8(a0, a1); *(u32x4*)(p + HALF) = pack8(b0, b1); }
                else if (pn == 4) { bf16_t* p = CQ + r * 384 + c32; *(u32x4*)p = pack8(a0, a1); *(u32x4*)(p + HALF) = pack8(b0, b1);
                    float s = sa + sb; s += __shfl_xor(s, 16); s += __shfl_xor(s, 32); if (fq == 0) ssq_q[r * 8 + wc] = s; }
                else if (pn == 5) { *(u32x4*)(CQ + r * 384 + 256 + c32) = pack8(a0, a1); *(u32x4*)(CKV + r * 256 + c32) = pack8(b0, b1);
                    float s = sa; s += __shfl_xor(s, 16); s += __shfl_xor(s, 32); float t = sb; t += __shfl_xor(t, 16); t += __shfl_xor(t, 32);
                    if (fq == 0) { ssq_q[r * 8 + 4 + wc] = s; ssq_kv[r * 8 + wc] = t; } }
                else if (pn == 6) { *(u32x4*)(CKV + r * 256 + 128 + c32) = pack8(a0, a1);
                    float s = sa; s += __shfl_xor(s, 16); s += __shfl_xor(s, 32); if (fq == 0) ssq_kv[r * 8 + 4 + wc] = s;
                    if (wc < 2) *(u32x4*)(KA + r * 64 + c32) = pack8(b0, b1); else *(u32x4*)(VA + r * 64 + (c32 - 64)) = pack8(b0, b1); }
                else if (pn == 7) {
                    if (wc < 2) *(u32x4*)(KI + r * 64 + c32) = pack8(a0, a1);
                    else if (wc == 2) {
                        const f32x4 c4 = *(const f32x4*)(rcos + r * 16 + 4 * fq), s4 = *(const f32x4*)(rsin + r * 16 + 4 * fq);
                        const f32x4 o0 = (f32x4){a0[0] * c4[0] - a0[1] * s4[0], a0[1] * c4[0] + a0[0] * s4[0], a0[2] * c4[1] - a0[3] * s4[1], a0[3] * c4[1] + a0[2] * s4[1]};
                        const f32x4 o1 = (f32x4){a1[0] * c4[2] - a1[1] * s4[2], a1[1] * c4[2] + a1[0] * s4[2], a1[2] * c4[3] - a1[3] * s4[3], a1[3] * c4[3] + a1[2] * s4[3]};
                        *(u32x4*)(KPE + r * 32 + 8 * fq) = pack8(o0, o1); }
                    else if (fq == 0) { *(f32x4*)(WI + r * 8) = a0; *(f32x4*)(WI + r * 8 + 4) = a1; }
                }
                else { bf16_t* p = G + r * 2048 + (pn - 8) * 256 + c32; *(u32x4*)p = pack8(sigm4(a0), sigm4(a1)); *(u32x4*)(p + HALF) = pack8(sigm4(b0), sigm4(b1)); }
            }
    }
};
struct EpiUpQ {
    static constexpr bool PERM = true, AFTER_DRAIN = false;
    bf16_t* QB; const float* ssq; const float *rcos, *rsin;
    __device__ __forceinline__ void operator()(const f32x4 (&acc)[2][2][4][2], const Unit& u, int wr, int wc, int fr, int fq) const {
        const int row0 = u.pm * BM + wr * 64 + fr;
#pragma unroll
        for (int ai = 0; ai < 2; ++ai)
#pragma unroll
            for (int m = 0; m < 4; ++m) {
                const size_t r = (size_t)(row0 + ai * HALF + m * 16);
                const f32x4 pa = *(const f32x4*)(ssq + r * 8), pb = *(const f32x4*)(ssq + r * 8 + 4);
                const float rs = __builtin_amdgcn_rsqf((((pa[0] + pa[1]) + (pa[2] + pa[3])) + ((pb[0] + pb[1]) + (pb[2] + pb[3]))) * (1.f / 384.f) + EPS_RMS) * QSCALE;
#pragma unroll
                for (int bj = 0; bj < 2; ++bj) {
                    const int c = u.pn * BM + bj * HALF + wc * 32 + 8 * fq;
                    const bool pe = ((u.pn * 8 + bj * 4 + wc) % 3) == 2;
                    f32x4 v0 = acc[ai][bj][m][0] * rs, v1 = acc[ai][bj][m][1] * rs;
                    if (pe) { const int i0 = 4 * fq;
                        const f32x4 c4 = *(const f32x4*)(rcos + r * 16 + i0), s4 = *(const f32x4*)(rsin + r * 16 + i0);
                        const f32x4 o0 = (f32x4){v0[0] * c4[0] - v0[1] * s4[0], v0[1] * c4[0] + v0[0] * s4[0], v0[2] * c4[1] - v0[3] * s4[1], v0[3] * c4[1] + v0[2] * s4[1]};
                        const f32x4 o1 = (f32x4){v1[0] * c4[2] - v1[1] * s4[2], v1[1] * c4[2] + v1[0] * s4[2], v1[2] * c4[3] - v1[3] * s4[3], v1[3] * c4[3] + v1[2] * s4[3]};
                        v0 = o0; v1 = o1; }
                    *(u32x4*)(QB + r * 768 + c) = pack8(v0, v1); }
                asm volatile("" ::: "memory"); }
    }
};
struct EpiUpKV {
    static constexpr bool PERM = true, AFTER_DRAIN = false;
    bf16_t *KN, *VB; const float* ssq;
    __device__ __forceinline__ void operator()(const f32x4 (&acc)[2][2][4][2], const Unit& u, int wr, int wc, int fr, int fq) const {
        const int row0 = u.pm * BM + wr * 64 + fr; bf16_t* dst = (u.pn < 2) ? KN : VB; const int c0 = (u.pn & 1) * BM + wc * 32 + 8 * fq;
#pragma unroll
        for (int ai = 0; ai < 2; ++ai)
#pragma unroll
            for (int m = 0; m < 4; ++m) {
                const size_t r = (size_t)(row0 + ai * HALF + m * 16);
                const f32x4 pa = *(const f32x4*)(ssq + r * 8), pb = *(const f32x4*)(ssq + r * 8 + 4);
                const float rs = __builtin_amdgcn_rsqf((((pa[0] + pa[1]) + (pa[2] + pa[3])) + ((pb[0] + pb[1]) + (pb[2] + pb[3]))) * (1.f / 256.f) + EPS_RMS);
#pragma unroll
                for (int bj = 0; bj < 2; ++bj) *(u32x4*)(dst + r * 512 + c0 + bj * HALF) = pack8(acc[ai][bj][m][0] * rs, acc[ai][bj][m][1] * rs);
                asm volatile("" ::: "memory"); }
    }
};
template <bool ADD> struct EpiGate {
    static constexpr bool PERM = true, AFTER_DRAIN = false;
    const bf16_t* G; int goff; const bf16_t* Yin; bf16_t* Y;
    __device__ __forceinline__ void operator()(const f32x4 (&acc)[2][2][4][2], const Unit& u, int wr, int wc, int fr, int fq) const {
        const int row0 = u.pm * BM + wr * 64 + fr, c0 = u.pn * BM + wc * 32 + 8 * fq;
#pragma unroll
        for (int ai = 0; ai < 2; ++ai)
#pragma unroll
            for (int m = 0; m < 4; ++m) {
                const size_t r = (size_t)(row0 + ai * HALF + m * 16);
#pragma unroll
                for (int bj = 0; bj < 2; ++bj) { const int c = c0 + bj * HALF;
                    f32x4 g0, g1; unpack8(*(const u32x4*)(G + r * 2048 + goff + c), g0, g1);
                    f32x4 v0 = g0 * acc[ai][bj][m][0], v1 = g1 * acc[ai][bj][m][1];
                    if (ADD) { f32x4 y0, y1; unpack8(*(const u32x4*)(Yin + r * 1024 + c), y0, y1); v0 += y0; v1 += y1; }
                    *(u32x4*)(Y + r * 1024 + c) = pack8(v0, v1); } }
    }
};

template <class Epi, class Sched, bool ALIGN_EPI = false, bool SP2 = false>
__device__ __forceinline__ void gemm_phase(PG8_LAS unsigned char* lds, const Gemm g, const Sched& S, const Epi& E) {
    const int tid = threadIdx.x, wid = __builtin_amdgcn_readfirstlane(tid >> 6), lane = tid & 63, wr = wid >> 2, wc = wid & 3, fr = lane & 15, fq = lane >> 4;
    const int K = g.K, nt = K / BK;
    unsigned voffA[2], voffB[2];
#pragma unroll
    for (int i = 0; i < 2; ++i) { int R, C; stage_rc(tid * 16 + i * 8192, R, C); const int Rb = Epi::PERM ? ((R & ~31) + perm32(R & 31)) : R;
        voffA[i] = (unsigned)(R * K + C) * 2u; voffB[i] = (unsigned)(Rb * K + C) * 2u; }
    const size_t kstep = (size_t)(BK * 2);
    const size_t hstep = (size_t)HALF * K * 2;
    const size_t tstep = 2 * hstep;
    const unsigned ldsw = (unsigned)wid * 1024u;
    const int aoff = lds_byte(wr * 64 + fr, fq * 8), boff = lds_byte(wc * 32 + fr, fq * 8);
#define PG8_SA(b, h) (((b) * 2 + (h)) * HTB)
#define PG8_SB(b, h) ((4 + (b) * 2 + (h)) * HTB)
#define PG8_STAGE(bufoff, gbase, voff) do { _Pragma("unroll") for (int _i = 0; _i < 2; ++_i) \
        __builtin_amdgcn_global_load_lds((const unsigned*)((const char*)(gbase) + (voff)[_i]), (PG8_LAS unsigned*)(lds + (bufoff) + ldsw + _i * 8192), 16, 0, 0); } while (0)
#define PG8_LDA(dst, b, h) do { _Pragma("unroll") for (int m = 0; m < 4; ++m) _Pragma("unroll") for (int k = 0; k < 2; ++k) dst[m][k] = *(const PG8_LAS bf16x8*)(lds + PG8_SA(b, h) + aoff + m * 2048 + k * 1024); } while (0)
#define PG8_LDB(dst, b, h) do { _Pragma("unroll") for (int n = 0; n < 2; ++n) _Pragma("unroll") for (int k = 0; k < 2; ++k) dst[n][k] = *(const PG8_LAS bf16x8*)(lds + PG8_SB(b, h) + boff + n * 2048 + k * 1024); } while (0)
#define PG8_MMA(ai, bj, At, Bt) do { __builtin_amdgcn_s_setprio(1); _Pragma("unroll") for (int m = 0; m < 4; ++m) _Pragma("unroll") for (int n = 0; n < 2; ++n) _Pragma("unroll") for (int k = 0; k < 2; ++k) \
        acc[ai][bj][m][n] = __builtin_amdgcn_mfma_f32_16x16x32_bf16(Bt[n][k], At[m][k], acc[ai][bj][m][n], 0, 0, 0); __builtin_amdgcn_s_setprio(0); } while (0)
#define PG8_WAIT_V(n) asm volatile("s_waitcnt vmcnt(" #n ")" ::: "memory")
#define PG8_WAIT_L(n) asm volatile("s_waitcnt lgkmcnt(" #n ")" ::: "memory")
#define PG8_BAR __builtin_amdgcn_s_barrier()
#define PG8_SCHED __builtin_amdgcn_sched_barrier(0)
    Unit cur, nxt; int ui = 0;
    if (!S.next(0, cur)) return;
    f32x4 acc[2][2][4][2];
#pragma unroll
    for (int a = 0; a < 2; ++a)
#pragma unroll
        for (int b = 0; b < 2; ++b)
#pragma unroll
            for (int m = 0; m < 4; ++m)
#pragma unroll
                for (int n = 0; n < 2; ++n) acc[a][b][m][n] = (f32x4){0.f, 0.f, 0.f, 0.f};
    bf16x8 At[4][2], B0[2][2], B1[2][2];
    const char* cA = (const char*)g.A + (size_t)cur.pm * tstep; const char* cB = (const char*)g.Bt + (size_t)cur.pn * tstep;
    S.a_ready(cur);
    if constexpr (SP2) {
        PG8_STAGE(PG8_SB(0, 0), cB, voffB); PG8_STAGE(PG8_SB(0, 1), cB + hstep, voffB); PG8_STAGE(PG8_SA(0, 0), cA, voffA); PG8_STAGE(PG8_SA(0, 1), cA + hstep, voffA);
        if (wr == 1) PG8_BAR;
        PG8_WAIT_V(2); PG8_BAR;
        PG8_STAGE(PG8_SB(1, 0), cB + kstep, voffB); PG8_STAGE(PG8_SA(1, 0), cA + kstep, voffA); PG8_STAGE(PG8_SB(1, 1), cB + hstep + kstep, voffB);
        PG8_WAIT_V(6); PG8_BAR;
    } else {
        PG8_STAGE(PG8_SB(0, 0), cB, voffB); PG8_STAGE(PG8_SA(0, 0), cA, voffA); PG8_STAGE(PG8_SB(0, 1), cB + hstep, voffB); PG8_STAGE(PG8_SA(0, 1), cA + hstep, voffA);
        if (wr == 1) PG8_BAR;
        PG8_WAIT_V(4); PG8_BAR;
        PG8_STAGE(PG8_SB(1, 0), cB + kstep, voffB); PG8_STAGE(PG8_SA(1, 0), cA + kstep, voffA); PG8_STAGE(PG8_SB(1, 1), cB + hstep + kstep, voffB);
        PG8_WAIT_V(6); PG8_BAR;
    }
    for (;;) {
        const bool has_next = S.next(ui + 1, nxt);
        const char* nA = has_next ? (const char*)g.A + (size_t)nxt.pm * tstep : cA; const char* nB = has_next ? (const char*)g.Bt + (size_t)nxt.pn * tstep : cB;
#pragma nounroll
        for (int t = 0; t < nt; t += 2) {
            const bool last = (t == nt - 2);
            const char* a1 = cA + (size_t)(t + 1) * kstep;
            const char* a2 = last ? nA : cA + (size_t)(t + 2) * kstep; const char* b2 = last ? nB : cB + (size_t)(t + 2) * kstep;
            const char* a3 = a2 + kstep; const char* b3 = b2 + kstep;
            if (last && has_next) S.a_ready(nxt);
            if constexpr (SP2) {
            PG8_LDB(B0, 0, 0); PG8_LDB(B1, 0, 1); PG8_SCHED; PG8_LDA(At, 0, 0); PG8_STAGE(PG8_SA(1, 1), a1 + hstep, voffA);
            PG8_WAIT_V(8); PG8_WAIT_L(0); PG8_BAR; PG8_MMA(0, 0, At, B0); PG8_MMA(0, 1, At, B1); PG8_BAR; PG8_SCHED;
            PG8_LDA(At, 0, 1); PG8_STAGE(PG8_SB(0, 0), b2, voffB); PG8_STAGE(PG8_SB(0, 1), b2 + hstep, voffB); PG8_STAGE(PG8_SA(0, 0), a2, voffA);
            PG8_WAIT_V(8); PG8_WAIT_L(0); PG8_BAR; PG8_MMA(1, 0, At, B0); PG8_MMA(1, 1, At, B1); PG8_BAR; PG8_SCHED;
            PG8_LDB(B0, 1, 0); PG8_LDB(B1, 1, 1); PG8_SCHED; PG8_LDA(At, 1, 0); PG8_STAGE(PG8_SA(0, 1), a2 + hstep, voffA);
            PG8_WAIT_V(8); PG8_WAIT_L(0); PG8_BAR; PG8_MMA(0, 0, At, B0); PG8_MMA(0, 1, At, B1); PG8_BAR; PG8_SCHED;
            PG8_LDA(At, 1, 1); PG8_STAGE(PG8_SB(1, 0), b3, voffB); PG8_STAGE(PG8_SB(1, 1), b3 + hstep, voffB); PG8_STAGE(PG8_SA(1, 0), a3, voffA);
            PG8_WAIT_V(8); PG8_WAIT_L(0); PG8_BAR; PG8_MMA(1, 0, At, B0); PG8_MMA(1, 1, At, B1); PG8_BAR; PG8_SCHED;
            } else {
            PG8_LDB(B0, 0, 0); PG8_SCHED; PG8_LDA(At, 0, 0); PG8_STAGE(PG8_SA(1, 1), a1 + hstep, voffA);
            PG8_WAIT_L(8); PG8_BAR; PG8_WAIT_L(0); PG8_MMA(0, 0, At, B0); PG8_BAR; PG8_SCHED;
            PG8_LDB(B1, 0, 1); PG8_STAGE(PG8_SB(0, 0), b2, voffB);
            PG8_BAR; PG8_WAIT_L(0); PG8_MMA(0, 1, At, B1); PG8_BAR;
            PG8_LDA(At, 0, 1); PG8_STAGE(PG8_SA(0, 0), a2, voffA);
            PG8_BAR; PG8_WAIT_L(0); PG8_MMA(1, 0, At, B0); PG8_BAR; PG8_SCHED;
            PG8_STAGE(PG8_SB(0, 1), b2 + hstep, voffB);
            PG8_WAIT_V(6); PG8_BAR; PG8_MMA(1, 1, At, B1); PG8_BAR;
            PG8_LDB(B0, 1, 0); PG8_SCHED; PG8_LDA(At, 1, 0); PG8_STAGE(PG8_SA(0, 1), a2 + hstep, voffA);
            PG8_WAIT_L(8); PG8_BAR; PG8_WAIT_L(0); PG8_MMA(0, 0, At, B0); PG8_BAR; PG8_SCHED;
            PG8_LDB(B1, 1, 1); PG8_STAGE(PG8_SB(1, 0), b3, voffB);
            PG8_BAR; PG8_WAIT_L(0); PG8_MMA(0, 1, At, B1); PG8_BAR;
            PG8_LDA(At, 1, 1); PG8_STAGE(PG8_SA(1, 0), a3, voffA);
            PG8_BAR; PG8_WAIT_L(0); PG8_MMA(1, 0, At, B0); PG8_BAR; PG8_SCHED;
            PG8_STAGE(PG8_SB(1, 1), b3 + hstep, voffB);
            PG8_WAIT_V(6); PG8_BAR; PG8_MMA(1, 1, At, B1); PG8_BAR;
            }
        }
        if constexpr (ALIGN_EPI) { if (wr == 0) PG8_BAR; }
        if constexpr (!Epi::AFTER_DRAIN) { E(acc, cur, wr, wc, fr, fq); S.done(cur); }
        if (!has_next) break;
#pragma unroll
        for (int a = 0; a < 2; ++a)
#pragma unroll
            for (int b = 0; b < 2; ++b)
#pragma unroll
                for (int m = 0; m < 4; ++m)
#pragma unroll
                    for (int n = 0; n < 2; ++n) acc[a][b][m][n] = (f32x4){0.f, 0.f, 0.f, 0.f};
        cur = nxt; cA = nA; cB = nB; ++ui;
        if constexpr (ALIGN_EPI) { if (wr == 1) PG8_BAR; }
    }
    PG8_WAIT_V(0);
    if constexpr (!ALIGN_EPI) { if (wr == 0) PG8_BAR; }
    PG8_BAR;
    if constexpr (Epi::AFTER_DRAIN) { E.fused(acc, cur, wr, wc, fr, fq, lds, wid, lane); S.done(cur); }
#undef PG8_SA
#undef PG8_SB
#undef PG8_STAGE
#undef PG8_LDA
#undef PG8_LDB
#undef PG8_MMA
#undef PG8_WAIT_V
#undef PG8_WAIT_L
#undef PG8_BAR
#undef PG8_SCHED
}
}

constexpr int NWAVES = 8;
constexpr int BATCH = 4, T = 8192, D = 1024, DFF = 2816, M = BATCH * T;
constexpr int INC = 3944, NPROJ = 4096;
constexpr int O_QA = 0, O_KA = 512, O_VA = 576, O_QI = 640, O_KI = 1152, O_WI = 1216, O_CQ = 1224, O_CKV = 1608, O_KR = 1864, O_GATE = 1896;
constexpr float EPS = 1e-6f;
#ifndef MK_FUSED
#define MK_FUSED 1
#endif

constexpr size_t MiB = 1u << 20;
constexpr size_t WS_CTL = 0, CTL_ZERO_BYTES = 2 * MiB;
constexpr size_t WS_MOD = 256 * 1024;
constexpr size_t WS_SSQQ = 49 * MiB, WS_SSQKV = 50 * MiB;
constexpr size_t WS_W1A = 2 * MiB, SZ_WA = (size_t)2 * DFF * D * 2, SZ_WD = (size_t)D * DFF * 2;
constexpr size_t WS_W1D = WS_W1A + SZ_WA, WS_WIN = WS_W1D + SZ_WD, WS_WUQ = WS_WIN + (size_t)NPROJ * D * 2, WS_WUKV = WS_WUQ + (size_t)768 * 384 * 2;
constexpr size_t WS_WOA = WS_WUKV + (size_t)1024 * 256 * 2, WS_WOB = WS_WOA + (size_t)D * 512 * 2, WS_WOUT = WS_WOB + (size_t)D * 512 * 2;
constexpr size_t WS_W2A = WS_WOUT + (size_t)D * D * 2, WS_W2D = WS_W2A + SZ_WA, WS_WEND = WS_W2D + SZ_WD;
static_assert(WS_WEND <= 49 * MiB, "weights");
constexpr size_t WS_RCOS = 51 * MiB, WS_RSIN = 53 * MiB;
constexpr size_t WS_XN = 55 * MiB;
constexpr size_t WS_ACT = 119 * MiB;
constexpr size_t WS_QA = WS_ACT, WS_QI = WS_QA + 32 * MiB, WS_CQ = WS_QI + 32 * MiB, WS_CKV = WS_CQ + 24 * MiB, WS_KA = WS_CKV + 16 * MiB, WS_VA = WS_KA + 4 * MiB;
constexpr size_t WS_KI = WS_VA + 4 * MiB, WS_KPE = WS_KI + 4 * MiB, WS_WI = WS_KPE + 2 * MiB, WS_QB = WS_WI + 1 * MiB, WS_MIXEND = WS_QB + 48 * MiB;
static_assert(WS_MIXEND <= WS_ACT + 176 * MiB, "mixer overlay");
constexpr size_t WS_G = 295 * MiB;
constexpr size_t WS_KN = 423 * MiB, WS_VB = 455 * MiB;
constexpr size_t WS_SEL = 487 * MiB;
constexpr size_t WS_END = 503 * MiB;
static_assert(WS_XN + 64 * MiB <= WS_ACT && WS_ACT + 176 * MiB <= WS_G && WS_G + 128 * MiB <= WS_KN && WS_VB + 32 * MiB <= WS_SEL, "d_ws map");
constexpr size_t WS_OA = WS_CQ, WS_OB = WS_QI, WS_Y1 = WS_KN, WS_Y = WS_XN;
constexpr int CW_TMO = 0, CW_CODE = 1, CW_BAR = 4096;

constexpr int RING_OFF = 0, RING_BYTES = 151552;
constexpr int LDSCTL_OFF = RING_BYTES, MISC_OFF = LDSCTL_OFF + 320;
constexpr int LDS_BYTES = RING_BYTES + 1024;
#ifndef PROF_SEL
#define PROF_SEL 0
#endif
#ifndef PROF_MULT
#define PROF_MULT 4
#endif
#define PROF_WORD(ldsring, wid_) ((LAS unsigned*)((ldsring) + (MISC_OFF - RING_OFF) + 64) + (wid_))
#define PROF_T0(id) unsigned long long pt_##id = 0ull; if (PROF_SEL == (id)) pt_##id = __builtin_amdgcn_s_memrealtime()
#define PROF_T1(id, ldsring, wid_, lane_) do { if (PROF_SEL == (id)) { const unsigned d_ = (unsigned)(__builtin_amdgcn_s_memrealtime() - pt_##id); if ((lane_) == 0) *PROF_WORD(ldsring, wid_) += d_; } } while (0)
#define GAS __attribute__((address_space(1)))
#define LAS __attribute__((address_space(3)))
typedef unsigned short bf16;
typedef unsigned v4u __attribute__((ext_vector_type(4)));
typedef float f32x4 __attribute__((ext_vector_type(4)));
typedef short bf16x8 __attribute__((ext_vector_type(8)));
typedef GAS unsigned gu32;
typedef GAS unsigned long long gu64;
#define RLX_AGENT __ATOMIC_RELAXED, __HIP_MEMORY_SCOPE_AGENT
#define LDS_WAIT() asm volatile("s_waitcnt lgkmcnt(0)" ::: "memory")
#define VM_WAIT() asm volatile("s_waitcnt vmcnt(0)" ::: "memory")
__device__ __forceinline__ unsigned long long rt() { return __builtin_amdgcn_s_memrealtime(); }
__device__ __forceinline__ unsigned f2bf(float f) { unsigned u = __builtin_bit_cast(unsigned, f); return (u + 0x7fffu + ((u >> 16) & 1u)) >> 16; }
__device__ __forceinline__ unsigned pk2(float lo, float hi) { return f2bf(lo) | (f2bf(hi) << 16); }

#define XB_TMO      128
#define XB_XCNT(j)  (256  + 64 * (j))
#define XB_XSUB(j)  (1280 + 64 * (j))
#define XB_XGEN(j)  (2304 + 64 * (j))
#define XB_TOP      3328
#define XB_TOPGEN   3392
#define XCD_BAR_WORDS 3456
#define XB_SPIN_CAP (1u << 18)

__device__ __forceinline__ unsigned xb_ld(unsigned* p)              { return __hip_atomic_load(p, __ATOMIC_RELAXED, __HIP_MEMORY_SCOPE_AGENT); }
__device__ __forceinline__ unsigned xb_add(unsigned* p, unsigned v) { return __hip_atomic_fetch_add(p, v, __ATOMIC_RELAXED, __HIP_MEMORY_SCOPE_AGENT); }
__device__ __forceinline__ unsigned xb_xcc_id() { return (unsigned)__builtin_amdgcn_s_getreg((3 << 11) | 20) & 0xFu; }
#define XB_SPIN(cond, bar) do { unsigned _sp = 0; while (cond) { __builtin_amdgcn_s_sleep(1); \
    if ((++_sp & 255u) == 0u) { if (xb_ld(&(bar)[XB_TMO])) break; if (_sp > XB_SPIN_CAP) { atomicAdd(&(bar)[XB_TMO], 1u); break; } } } } while (0)

struct XcdBarrier {
    unsigned* bar; unsigned x;
    volatile LAS unsigned* st;
};

__device__ __forceinline__ XcdBarrier xcd_barrier_post(unsigned* bar, volatile LAS unsigned* st) {
    XcdBarrier b; b.bar = bar; b.x = xb_xcc_id(); b.st = st;
    if (threadIdx.x == 0) (void)xb_add(&bar[XB_XCNT(b.x)], 1u);
    return b;
}
__device__ __forceinline__ void xcd_barrier_complete(unsigned* bar, unsigned x, unsigned& nloc, unsigned& nx) {
    const unsigned G = gridDim.x * gridDim.y * gridDim.z;
    unsigned sum, cnt, mine, sp = 0u;
    for (;;) {
        sum = 0u; cnt = 0u; mine = 0u;
#pragma unroll
        for (unsigned j = 0; j < 16; ++j) { const unsigned c = xb_ld(&bar[XB_XCNT(j)]); sum += c; cnt += (c > 0u) ? 1u : 0u; mine = (j == x) ? c : mine; }
        if (sum == G) break;
        __builtin_amdgcn_s_sleep(1);
        if ((++sp & 255u) == 0u) { if (xb_ld(&bar[XB_TMO])) break; if (sp > XB_SPIN_CAP) { atomicAdd(&bar[XB_TMO], 1u); break; } }
    }
    nloc = mine > 0u ? mine : 1u; nx = cnt > 0u ? cnt : 1u;
}

__device__ __forceinline__ void xcd_barrier(const XcdBarrier& b) {
    asm volatile("s_waitcnt vmcnt(0)" ::: "memory");
    __syncthreads();
    if (threadIdx.x == 0) {
        unsigned* bar = b.bar;
        __builtin_amdgcn_s_waitcnt(0);
        unsigned nloc = b.st[0], nx = b.st[1];
        if (nloc == 0u) { xcd_barrier_complete(bar, b.x, nloc, nx); b.st[0] = nloc; b.st[1] = nx; }
        const unsigned old = xb_add(&bar[XB_XSUB(b.x)], 1u);
        const unsigned gen = old / nloc;
        if (old + 1u == (gen + 1u) * nloc) {
            __builtin_amdgcn_fence(__ATOMIC_RELEASE, "agent");
            asm volatile("s_waitcnt vmcnt(0)" ::: "memory");
            const unsigned og = xb_add(&bar[XB_TOP], 1u);
            const unsigned tg = og / nx;
            if (og + 1u == (tg + 1u) * nx) xb_add(&bar[XB_TOPGEN], 1u);
            else XB_SPIN(xb_ld(&bar[XB_TOPGEN]) == tg, bar);
            __builtin_amdgcn_fence(__ATOMIC_ACQUIRE, "agent");
            xb_add(&bar[XB_XGEN(b.x)], 1u);
            asm volatile("s_waitcnt vmcnt(0)" ::: "memory");
        } else {
            XB_SPIN(xb_ld(&bar[XB_XGEN(b.x)]) == gen, bar);
            __builtin_amdgcn_fence(__ATOMIC_ACQUIRE, "agent");
            asm volatile("s_waitcnt vmcnt(0)" ::: "memory");
        }
    }
    __syncthreads();
}

struct Frame {
    LAS unsigned char* lds;
    volatile LAS unsigned* MISC;
    gu32* ctl;
    int tid, lane, wave;
    int vcu, G;
};
__device__ __forceinline__ float wave_sum(float v) {
#pragma unroll
    for (int o = 1; o < 64; o <<= 1) v += __shfl_xor(v, o);
    return v;
}
struct MapIdent { int off; __device__ __forceinline__ int src(int n) const { return n + off; } };
struct MapFfnIn { __device__ __forceinline__ int src(int n) const { const int pn = n >> 8, j = n & 255; return (j >> 7) * DFF + pn * 128 + (j & 127); } };
struct MapProj { __device__ __forceinline__ int src(int n) const { const int pn = n >> 8, j = n & 255;
    if (pn < 2) return O_QA + n; if (pn < 4) return O_QI + (n - 512); if (pn == 4) return O_CQ + j;
    if (pn == 5) return j < 128 ? O_CQ + 256 + j : O_CKV + (j - 128);
    if (pn == 6) return j < 128 ? O_CKV + 128 + j : (j < 192 ? O_KA + (j - 128) : O_VA + (j - 192));
    if (pn == 7) { if (j < 64) return O_KI + j; if (j < 96) { const int jj = j - 64; return O_KR + (jj >> 1) + 16 * (jj & 1); } if (j < 104) return O_WI + (j - 96); return -1; }
    return O_GATE + (n - 2048); } };
struct MapUq { __device__ __forceinline__ int src(int n) const { const int h = n / 96, w = n % 96; if (w < 64) return n; const int jj = w - 64; return h * 96 + 64 + (jj >> 1) + 16 * (jj & 1); } };
template <class Map> __device__ __forceinline__ void p0_transpose_item(const float* W, int K, int Nsrc, int nblk, const float* kscale, bf16* WT, const Map mp, LAS float* scr, int item, int lane) {
    const int kb = item / nblk, nb = item % nblk, k0 = 64 * kb, n0 = 32 * nb;
    const int sc = mp.src(n0 + (lane & 31));
    float vv[32];
#pragma unroll
    for (int i = 0; i < 32; ++i) { const int kk = 2 * i + (lane >> 5); vv[i] = sc >= 0 ? W[(size_t)(k0 + kk) * Nsrc + sc] : 0.f; }
#pragma unroll
    for (int i = 0; i < 32; ++i) { const int kk = 2 * i + (lane >> 5); float v = vv[i]; if (kscale) v *= kscale[k0 + kk]; scr[kk * 33 + (lane & 31)] = v; }
    LDS_WAIT(); asm volatile("" ::: "memory");
    const int c = lane & 7;
#pragma unroll
    for (int j = 0; j < 4; ++j) { const int n = (lane >> 3) + 8 * j; const LAS float* s = scr + (8 * c) * 33 + n;
        v4u o; o.x = pk2(s[0 * 33], s[1 * 33]); o.y = pk2(s[2 * 33], s[3 * 33]); o.z = pk2(s[4 * 33], s[5 * 33]); o.w = pk2(s[6 * 33], s[7 * 33]);
        *(GAS v4u*)(WT + (size_t)(n0 + n) * K + k0 + 8 * c) = o; }
    LDS_WAIT(); asm volatile("" ::: "memory");
}
struct Args { const void* in[23]; float* out; unsigned char* ws; int ph_lo, ph_hi, li, pad; };

__device__ __forceinline__ void p0_prologue(Frame& F, const Args& A) {
    LAS float* scr = (LAS float*)(F.lds + RING_OFF + F.wave * 16384);
    const int gw = F.vcu * NWAVES + F.wave, NGW = F.G * NWAVES;
    unsigned char* ws = A.ws;
    {
        const float* c = (const float*)A.in[1]; const float* w = (const float*)A.in[3]; const float* bias = (const float*)A.in[4]; float* mod = (float*)(ws + WS_MOD);
        for (int cg = F.vcu; cg < 256; cg += F.G) {
            const bool act = F.lane < 36; const int n = cg * 36 + (act ? F.lane : 0), k0 = F.wave * 128;
#pragma unroll
            for (int b = 0; b < 4; ++b)
#pragma unroll
                for (int h = 0; h < 2; ++h) { const float v = c[b * D + k0 + h * 64 + F.lane]; scr[b * 128 + h * 64 + F.lane] = v / (1.f + __expf(-v)); }
            LDS_WAIT(); asm volatile("" ::: "memory");
            float a0 = 0.f, a1 = 0.f, a2 = 0.f, a3 = 0.f;
#pragma unroll 8
            for (int k = 0; k < 128; ++k) { const float wv = act ? w[(size_t)(k0 + k) * 9216 + n] : 0.f; a0 += scr[k] * wv; a1 += scr[128 + k] * wv; a2 += scr[256 + k] * wv; a3 += scr[384 + k] * wv; }
            scr[1024 + F.lane] = a0; scr[1088 + F.lane] = a1; scr[1152 + F.lane] = a2; scr[1216 + F.lane] = a3;
            __syncthreads();
            if (F.wave < 4 && act) { float t = bias[n];
#pragma unroll
                for (int ww = 0; ww < 8; ++ww) t += ((LAS float*)(F.lds + RING_OFF + ww * 16384))[1024 + F.wave * 64 + F.lane];
                mod[F.wave * 9216 + n] = t; }
            __syncthreads();
        }
    }
    {
        const float* w1a = (const float*)A.in[6]; const float* w1d = (const float*)A.in[7]; const float* win = (const float*)A.in[9]; const float* gcq = (const float*)A.in[10];
        const float* wuq = (const float*)A.in[11]; const float* gckv = (const float*)A.in[12]; const float* wuk = (const float*)A.in[13]; const float* wuv = (const float*)A.in[14];
        const float* woa = (const float*)A.in[16]; const float* wob = (const float*)A.in[17]; const float* wout = (const float*)A.in[18]; const float* w2a = (const float*)A.in[20]; const float* w2d = (const float*)A.in[21];
        constexpr int I_A = 16 * 176, I_D = 44 * 32, I_IN = 16 * 128, I_UQ = 6 * 24, I_UK = 4 * 16, I_O = 8 * 32, I_OUT = 16 * 32;
        constexpr int NITEMS = 2 * I_A + 2 * I_D + I_IN + I_UQ + 2 * I_UK + 2 * I_O + I_OUT;
        for (int it = gw; it < NITEMS; it += NGW) {
            int r = it;
            if (r < I_A) { p0_transpose_item(w1a, D, 2 * DFF, 176, nullptr, (bf16*)(ws + WS_W1A), MapFfnIn{}, scr, r, F.lane); continue; } r -= I_A;
            if (r < I_A) { p0_transpose_item(w2a, D, 2 * DFF, 176, nullptr, (bf16*)(ws + WS_W2A), MapFfnIn{}, scr, r, F.lane); continue; } r -= I_A;
            if (r < I_D) { p0_transpose_item(w1d, DFF, D, 32, nullptr, (bf16*)(ws + WS_W1D), MapIdent{0}, scr, r, F.lane); continue; } r -= I_D;
            if (r < I_D) { p0_transpose_item(w2d, DFF, D, 32, nullptr, (bf16*)(ws + WS_W2D), MapIdent{0}, scr, r, F.lane); continue; } r -= I_D;
            if (r < I_IN) { p0_transpose_item(win, D, INC, 128, nullptr, (bf16*)(ws + WS_WIN), MapProj{}, scr, r, F.lane); continue; } r -= I_IN;
            if (r < I_UQ) { p0_transpose_item(wuq, 384, 768, 24, gcq, (bf16*)(ws + WS_WUQ), MapUq{}, scr, r, F.lane); continue; } r -= I_UQ;
            if (r < I_UK) { p0_transpose_item(wuk, 256, 512, 16, gckv, (bf16*)(ws + WS_WUKV), MapIdent{0}, scr, r, F.lane); continue; } r -= I_UK;
            if (r < I_UK) { p0_transpose_item(wuv, 256, 512, 16, gckv, (bf16*)(ws + WS_WUKV) + (size_t)512 * 256, MapIdent{0}, scr, r, F.lane); continue; } r -= I_UK;
            if (r < I_O) { p0_transpose_item(woa, 512, D, 32, nullptr, (bf16*)(ws + WS_WOA), MapIdent{0}, scr, r, F.lane); continue; } r -= I_O;
            if (r < I_O) { p0_transpose_item(wob, 512, D, 32, nullptr, (bf16*)(ws + WS_WOB), MapIdent{0}, scr, r, F.lane); continue; } r -= I_O;
            p0_transpose_item(wout, D, D, 32, nullptr, (bf16*)(ws + WS_WOUT), MapIdent{0}, scr, r, F.lane);
        }
    }
    {
        const int* pos = (const int*)A.in[2]; float* rc = (float*)(ws + WS_RCOS); float* rs = (float*)(ws + WS_RSIN);
        for (int idx = gw * 64 + F.lane; idx < M * 16; idx += NGW * 64) { const int t = idx >> 4, i = idx & 15;
            const float freq = powf(10000.0f, -2.0f * (float)i / 32.0f); const float ang = (float)pos[t] * freq;
            rc[idx] = cosf(ang); rs[idx] = sinf(ang); }
    }
}
__device__ __forceinline__ void norm_mod_phase(Frame& F, const float* xin, const float* g, const float* mod, int shoff, int scoff, bf16* out) {
    const int gw = F.vcu * NWAVES + F.wave, NGW = F.G * NWAVES;
    for (int m = gw; m < M; m += NGW) {
        const int b = m >> 13;
        const GAS f32x4* xr = (const GAS f32x4*)(xin + (size_t)m * D) + F.lane;
        const GAS f32x4* g4 = (const GAS f32x4*)g + F.lane; const GAS f32x4* sc4 = (const GAS f32x4*)(mod + b * 9216 + scoff) + F.lane; const GAS f32x4* sh4 = (const GAS f32x4*)(mod + b * 9216 + shoff) + F.lane;
        f32x4 v[4]; float s = 0.f;
#pragma unroll
        for (int j = 0; j < 4; ++j) { v[j] = xr[64 * j]; s += (v[j].x * v[j].x + v[j].y * v[j].y) + (v[j].z * v[j].z + v[j].w * v[j].w); }
        const float rs = __builtin_amdgcn_rsqf(wave_sum(s) * (1.f / D) + EPS);
        GAS unsigned long long* o8 = (GAS unsigned long long*)(out + (size_t)m * D) + F.lane;
#pragma unroll
        for (int j = 0; j < 4; ++j) { const f32x4 o = v[j] * rs * g4[64 * j] * (sc4[64 * j] + 1.f) + sh4[64 * j];
            o8[64 * j] = (unsigned long long)pk2(o.x, o.y) | ((unsigned long long)pk2(o.z, o.w) << 32); }
    }
}
__device__ __forceinline__ void final_norm_phase(Frame& F, const float* xin, const float* g, float* out) {
    const int gw = F.vcu * NWAVES + F.wave, NGW = F.G * NWAVES;
    for (int m = gw; m < M; m += NGW) {
        const GAS f32x4* xr = (const GAS f32x4*)(xin + (size_t)m * D) + F.lane; const GAS f32x4* g4 = (const GAS f32x4*)g + F.lane;
        f32x4 v[4]; float s = 0.f;
#pragma unroll
        for (int j = 0; j < 4; ++j) { v[j] = xr[64 * j]; s += (v[j].x * v[j].x + v[j].y * v[j].y) + (v[j].z * v[j].z + v[j].w * v[j].w); }
        const float rs = __builtin_amdgcn_rsqf(wave_sum(s) * (1.f / D) + EPS);
        GAS f32x4* o4 = (GAS f32x4*)(out + (size_t)m * D) + F.lane;
#pragma unroll
        for (int j = 0; j < 4; ++j) o4[64 * j] = v[j] * rs * g4[64 * j];
    }
}

namespace mla {
typedef unsigned u32x4 __attribute__((ext_vector_type(4)));
typedef short bf16x8 __attribute__((ext_vector_type(8)));
typedef short s16x4 __attribute__((ext_vector_type(4)));
typedef float f32x16 __attribute__((ext_vector_type(16)));
constexpr int KSLOT = 12288, VSLOT = 8192;
constexpr int L_K = 0, L_V = 3 * KSLOT, L_WS = L_V + 3 * VSLOT, L_OST = L_WS + 2048, L_END = L_OST + 8 * 4096;
static_assert(L_END <= RING_BYTES, "attention LDS");
__device__ __forceinline__ int crow(int r, int hi) { return (r & 3) + 8 * (r >> 2) + 4 * hi; }
__device__ __forceinline__ float xhalf(float v) { return __shfl_xor(v, 32); }
__device__ __forceinline__ void pv(f32x16* o, int vb, bf16x8 pa0, bf16x8 pa1, bf16x8 pa2, bf16x8 pa3) {
#pragma unroll
    for (int d0 = 0; d0 < 2; ++d0) { s16x4 lo[4], hi[4];
#pragma unroll
        for (int ks = 0; ks < 4; ++ks) {
            asm volatile("ds_read_b64_tr_b16 %0,%1 offset:%c2" : "=&v"(lo[ks]) : "v"(vb), "i"(d0 * 4096 + ks * 1024) : "memory");
            asm volatile("ds_read_b64_tr_b16 %0,%1 offset:%c2" : "=&v"(hi[ks]) : "v"(vb), "i"(d0 * 4096 + ks * 1024 + 512) : "memory"); }
        asm volatile("s_waitcnt lgkmcnt(0)" ::: "memory"); __builtin_amdgcn_sched_barrier(0);
#define MLA_PK(k) (bf16x8){lo[k][0], lo[k][1], lo[k][2], lo[k][3], hi[k][0], hi[k][1], hi[k][2], hi[k][3]}
        o[d0] = __builtin_amdgcn_mfma_f32_32x32x16_bf16(pa0, MLA_PK(0), o[d0], 0, 0, 0);
        o[d0] = __builtin_amdgcn_mfma_f32_32x32x16_bf16(pa1, MLA_PK(1), o[d0], 0, 0, 0);
        o[d0] = __builtin_amdgcn_mfma_f32_32x32x16_bf16(pa2, MLA_PK(2), o[d0], 0, 0, 0);
        o[d0] = __builtin_amdgcn_mfma_f32_32x32x16_bf16(pa3, MLA_PK(3), o[d0], 0, 0, 0);
#undef MLA_PK
    }
}
__device__ __forceinline__ void attn_unit(int b, int h, int qb, const bf16* QB, const bf16* KN, const bf16* KPE, const bf16* VB, bf16* OB, LAS unsigned char* lds) {
    const int tid = threadIdx.x, lane = tid & 63, r32 = lane & 31, hi = lane >> 5; const int wid = __builtin_amdgcn_readfirstlane(tid >> 6);
    const size_t rowbase = (size_t)b * T; const int q0 = qb * 256;
    const int NT = 4 * (qb + 1), my_last = 4 * qb + (wid >> 1);
    LAS float* wsf = (LAS float*)(lds + L_WS) + wid * 64;
#define MLA_DMA(t, slot) do { const size_t krow_ = rowbase + (size_t)(t) * 64 + lane; \
        __builtin_amdgcn_global_load_lds((const unsigned*)(KN + krow_ * 512 + h * 64 + wid * 8), (LAS unsigned*)(lds + L_K + (slot) * KSLOT + wid * 1024), 16, 0, 0); \
        if (wid < 4) __builtin_amdgcn_global_load_lds((const unsigned*)(KPE + krow_ * 32 + wid * 8), (LAS unsigned*)(lds + L_K + (slot) * KSLOT + (8 + wid) * 1024), 16, 0, 0); \
        const size_t vrow_ = rowbase + (size_t)(t) * 64 + 16 * (wid & 3) + (lane >> 2); \
        __builtin_amdgcn_global_load_lds((const unsigned*)(VB + vrow_ * 512 + h * 64 + (wid >> 2) * 32 + (lane & 3) * 8), (LAS unsigned*)(lds + L_V + (slot) * VSLOT + wid * 1024), 16, 0, 0); } while (0)
    bf16x8 qr[6];
    { const bf16* Qw = QB + (rowbase + q0 + wid * 32 + r32) * 768 + h * 96 + hi * 8;
#pragma unroll
      for (int d0 = 0; d0 < 6; ++d0) qr[d0] = *(const bf16x8*)(Qw + d0 * 16); }
    MLA_DMA(0, 0); MLA_DMA(1, 1);
    int slot = 0, slot2 = 2;
    float m = 0.f, l = 0.f; f32x16 o[2], negm;
#pragma unroll
    for (int r = 0; r < 16; ++r) { o[0][r] = 0.f; o[1][r] = 0.f; negm[r] = 0.f; }
    const int kofs = hi * 1024 + r32 * 16;
    const int vb0 = (int)(unsigned)(uintptr_t)(lds + L_V) + ((lane >> 4) & 1) * 32 + (lane & 3) * 8 + (4 * hi + ((lane & 15) >> 2)) * 64;
    for (int t = 0; t < NT; ++t) {
        if (t + 1 < NT) { if (wid < 4) asm volatile("s_waitcnt vmcnt(3) lgkmcnt(0)\n\ts_barrier" ::: "memory"); else asm volatile("s_waitcnt vmcnt(2) lgkmcnt(0)\n\ts_barrier" ::: "memory"); }
        else asm volatile("s_waitcnt vmcnt(0) lgkmcnt(0)\n\ts_barrier" ::: "memory");
        if (t + 2 < NT) MLA_DMA(t + 2, slot2);
        const int cslot = slot; slot = (slot == 2) ? 0 : slot + 1; slot2 = (slot2 == 2) ? 0 : slot2 + 1;
        if (t <= my_last) {
            const int slot = cslot;
            const LAS unsigned char* kb = lds + L_K + slot * KSLOT + kofs;
            f32x16 p0, p1;
#pragma unroll
            for (int d0 = 0; d0 < 6; ++d0) {
                const bf16x8 b0 = *(const LAS bf16x8*)(kb + d0 * 2048), b1 = *(const LAS bf16x8*)(kb + d0 * 2048 + 512);
                if (d0 == 0) { p0 = __builtin_amdgcn_mfma_f32_32x32x16_bf16(b0, qr[0], negm, 0, 0, 0); p1 = __builtin_amdgcn_mfma_f32_32x32x16_bf16(b1, qr[0], negm, 0, 0, 0); }
                else { p0 = __builtin_amdgcn_mfma_f32_32x32x16_bf16(b0, qr[d0], p0, 0, 0, 0); p1 = __builtin_amdgcn_mfma_f32_32x32x16_bf16(b1, qr[d0], p1, 0, 0, 0); } }
#define MLA_MX3(a, b, c) __builtin_fmaxf(__builtin_fmaxf((a), (b)), (c))
            float ra = MLA_MX3(p0[0], p0[1], p1[0]), rb = MLA_MX3(p0[2], p0[3], p1[1]); ra = MLA_MX3(ra, p1[2], p1[3]);
#pragma unroll
            for (int r = 4; r < 16; r += 4) { ra = MLA_MX3(ra, p0[r], p0[r + 1]); rb = MLA_MX3(rb, p0[r + 2], p0[r + 3]); ra = MLA_MX3(ra, p1[r], p1[r + 1]); rb = MLA_MX3(rb, p1[r + 2], p1[r + 3]); }
#undef MLA_MX3
            float rm = __builtin_fmaxf(ra, rb);
            rm = __builtin_fmaxf(rm, xhalf(rm));
            if (t == 0 || __any(rm > 0.f)) {
                const float dl = (t == 0) ? rm : __builtin_fmaxf(rm, 0.f), f = __builtin_amdgcn_exp2f(-dl);
                m += dl; l *= f;
#pragma unroll
                for (int r = 0; r < 16; ++r) { p0[r] -= dl; p1[r] -= dl; negm[r] = -m; }
                if (t != 0) {
                    if (hi == 0) wsf[r32] = f;
                    asm volatile("s_waitcnt lgkmcnt(0)" ::: "memory");
#pragma unroll
                    for (int r = 0; r < 16; ++r) { const float fr_ = wsf[crow(r, hi)]; o[0][r] *= fr_; o[1][r] *= fr_; }
                }
            }
            float sacc = 0.f;
#pragma unroll
            for (int r = 0; r < 16; ++r) { p0[r] = __builtin_amdgcn_exp2f(p0[r]); p1[r] = __builtin_amdgcn_exp2f(p1[r]); sacc += p0[r] + p1[r]; }
            l += sacc;
            u32x4 pw0, pw1, pw2, pw3;
            pw0 = (u32x4){pg8::cvt_pk_bf16(p0[0], p0[1]), pg8::cvt_pk_bf16(p0[2], p0[3]), pg8::cvt_pk_bf16(p0[4], p0[5]), pg8::cvt_pk_bf16(p0[6], p0[7])};
            pw1 = (u32x4){pg8::cvt_pk_bf16(p0[8], p0[9]), pg8::cvt_pk_bf16(p0[10], p0[11]), pg8::cvt_pk_bf16(p0[12], p0[13]), pg8::cvt_pk_bf16(p0[14], p0[15])};
            pw2 = (u32x4){pg8::cvt_pk_bf16(p1[0], p1[1]), pg8::cvt_pk_bf16(p1[2], p1[3]), pg8::cvt_pk_bf16(p1[4], p1[5]), pg8::cvt_pk_bf16(p1[6], p1[7])};
            pw3 = (u32x4){pg8::cvt_pk_bf16(p1[8], p1[9]), pg8::cvt_pk_bf16(p1[10], p1[11]), pg8::cvt_pk_bf16(p1[12], p1[13]), pg8::cvt_pk_bf16(p1[14], p1[15])};
            pv(o, vb0 + slot * VSLOT, __builtin_bit_cast(bf16x8, pw0), __builtin_bit_cast(bf16x8, pw1), __builtin_bit_cast(bf16x8, pw2), __builtin_bit_cast(bf16x8, pw3));
        }
    }
#undef MLA_DMA
    l += xhalf(l);
    if (hi == 0) wsf[32 + r32] = l;
    asm volatile("s_waitcnt lgkmcnt(0)" ::: "memory");
    LAS bf16* stg = (LAS bf16*)(lds + L_OST) + wid * 2048;
#pragma unroll
    for (int r = 0; r < 16; ++r) { const int orow = crow(r, hi); const float rl = __builtin_amdgcn_rcpf(wsf[32 + orow]);
        stg[orow * 64 + r32] = (bf16)(pg8::cvt_pk_bf16(o[0][r] * rl, 0.f) & 0xffffu); stg[orow * 64 + 32 + r32] = (bf16)(pg8::cvt_pk_bf16(o[1][r] * rl, 0.f) & 0xffffu); }
    asm volatile("s_waitcnt lgkmcnt(0)" ::: "memory");
    bf16* Ow = OB + (rowbase + q0 + wid * 32) * 512 + h * 64;
#pragma unroll
    for (int i = 0; i < 4; ++i) { const int row = i * 8 + (lane >> 3), ch = lane & 7; const u32x4 v = *(const LAS u32x4*)(stg + row * 64 + ch * 8); *(u32x4*)(Ow + (size_t)row * 512 + ch * 8) = v; }
    asm volatile("s_waitcnt lgkmcnt(0)\n\ts_barrier" ::: "memory");
}
__device__ __forceinline__ void phase(int vcu, int G, const bf16* QB, const bf16* KN, const bf16* KPE, const bf16* VB, bf16* OB, LAS unsigned char* lds) {
    for (int u = vcu; u < 1024; u += G) { const int i = u >> 8, v = u & 255, bh = v >> 3, s = v & 7;
        const int qb = (i == 0) ? s : (i == 1) ? 15 - s : (i == 2) ? 16 + s : 31 - s;
        attn_unit(bh >> 3, bh & 7, qb, QB, KN, KPE, VB, OB, lds); }
}
}

namespace idx {
typedef short bf16x8 __attribute__((ext_vector_type(8)));
typedef float f32x16 __attribute__((ext_vector_type(16)));
typedef unsigned u32x2 __attribute__((ext_vector_type(2)));
constexpr int CAP = 576, TRIG = CAP - 64, NE = (CAP + 63) / 64;
constexpr int L_CAND = 0, L_TRASH = 32 * CAP * 8, L_END = L_TRASH + 8 * 512;
constexpr int KEEP_MAX = 272, SCHED_MIN = 304;
static_assert(L_END <= RING_BYTES, "indexer LDS");
__device__ __forceinline__ unsigned okey(float f) { const unsigned u = __float_as_uint(f); return (u & 0x80000000u) ? ~u : (u | 0x80000000u); }
__device__ __forceinline__ float ikey(unsigned k) { return __uint_as_float((k & 0x80000000u) ? (k ^ 0x80000000u) : ~k); }
__device__ __forceinline__ int prefix64(unsigned long long m) { return (int)__builtin_amdgcn_mbcnt_hi((unsigned)(m >> 32), __builtin_amdgcn_mbcnt_lo((unsigned)m, 0u)); }
__device__ __forceinline__ int count_ge(const unsigned (&k)[8], unsigned thr) { int c = 0;
#pragma unroll
    for (int j = 0; j < 8; ++j) c += __popcll(__ballot(k[j] >= thr));
    return c; }
template <bool FINAL> __device__ __forceinline__ int select(LAS u32x2* cand, int n, int lane, unsigned& thr_key, unsigned short* sel_out) {
    unsigned k[8], ix[8]; float sc[8];
#pragma unroll
    for (int j = 0; j < 8; ++j) { const int e = lane + 64 * j; const bool v = e < n; const u32x2 en = cand[v ? e : 0]; sc[j] = __uint_as_float(en.x); ix[j] = en.y; k[j] = v ? okey(sc[j]) : 0u; }
    unsigned kmin = 0xffffffffu, kmax = 0u;
#pragma unroll
    for (int j = 0; j < 8; ++j) { if (k[j] != 0u) { kmin = min(kmin, k[j]); kmax = max(kmax, k[j]); } }
#pragma unroll
    for (int o = 1; o < 64; o <<= 1) { kmin = min(kmin, (unsigned)__shfl_xor((int)kmin, o)); kmax = max(kmax, (unsigned)__shfl_xor((int)kmax, o)); }
    unsigned lo = kmin, hx = kmax + 1u; int c_lo = n;
    const int accept = FINAL ? 256 : KEEP_MAX;
    for (int it = 0; it < 40 && c_lo > accept && hx - lo > 1u; ++it) {
        const unsigned mid = lo + ((hx - lo) >> 1); const int c = count_ge(k, mid);
        if (c >= 256) { lo = mid; c_lo = c; } else hx = mid; }
    const unsigned Tk = lo;
    int r_eq = 1 << 30;
    if (FINAL || c_lo > accept) r_eq = 256 - count_ge(k, Tk + 1u);
    int running = 0, eqrun = 0;
#pragma unroll
    for (int j = 0; j < 8; ++j) {
        const bool gt = k[j] > Tk, eq = (k[j] == Tk);
        const unsigned long long meq = __ballot(eq);
        const bool take = gt || (eq && (eqrun + prefix64(meq)) < r_eq);
        const unsigned long long mt = __ballot(take);
        const int pos = running + prefix64(mt);
        if (take) { if (FINAL) { if (pos < 256) sel_out[pos] = (unsigned short)ix[j]; } else cand[pos] = (u32x2){__float_as_uint(sc[j]), ix[j]}; }
        running += __popcll(mt); eqrun += __popcll(meq);
    }
    thr_key = Tk;
    return running;
}

__device__ __forceinline__ unsigned wave_umax(unsigned v) {
    v = max(v, (unsigned)__builtin_amdgcn_update_dpp(0, (int)v, 0xB1, 0xf, 0xf, false)); v = max(v, (unsigned)__builtin_amdgcn_update_dpp(0, (int)v, 0x4E, 0xf, 0xf, false));
    v = max(v, (unsigned)__builtin_amdgcn_update_dpp(0, (int)v, 0x141, 0xf, 0xf, false)); v = max(v, (unsigned)__builtin_amdgcn_update_dpp(0, (int)v, 0x140, 0xf, 0xf, false));
    return max(max((unsigned)__builtin_amdgcn_readlane((int)v, 0), (unsigned)__builtin_amdgcn_readlane((int)v, 16)), max((unsigned)__builtin_amdgcn_readlane((int)v, 32), (unsigned)__builtin_amdgcn_readlane((int)v, 48)));
}
__device__ __forceinline__ unsigned wave_umin(unsigned v) { return ~wave_umax(~v); }
__device__ __forceinline__ unsigned wave_usum(unsigned v) {
    v += (unsigned)__builtin_amdgcn_update_dpp(0, (int)v, 0xB1, 0xf, 0xf, false); v += (unsigned)__builtin_amdgcn_update_dpp(0, (int)v, 0x4E, 0xf, 0xf, false);
    v += (unsigned)__builtin_amdgcn_update_dpp(0, (int)v, 0x141, 0xf, 0xf, false); v += (unsigned)__builtin_amdgcn_update_dpp(0, (int)v, 0x140, 0xf, 0xf, false);
    return ((unsigned)__builtin_amdgcn_readlane((int)v, 0) + (unsigned)__builtin_amdgcn_readlane((int)v, 16)) + ((unsigned)__builtin_amdgcn_readlane((int)v, 32) + (unsigned)__builtin_amdgcn_readlane((int)v, 48));
}
__device__ __forceinline__ int count_ge_v(const unsigned (&k)[8], unsigned thr) { unsigned c = 0;
#pragma unroll
    for (int j = 0; j < 8; ++j) c += (k[j] >= thr) ? 1u : 0u;
    return (int)wave_usum(c); }
template <bool FINAL> __device__ __forceinline__ void select4(LAS u32x2* cb, int (&n)[4], unsigned (&tk)[4], int lane, unsigned short* sel_out, LAS u32x2* trash, unsigned short* gtrash) {
    unsigned k[4][NE], ix[4][NE];
#pragma unroll
    for (int q = 0; q < 4; ++q)
#pragma unroll
        for (int j = 0; j < NE; ++j) { const int e = lane + 64 * j; const bool v = e < n[q]; const u32x2 en = cb[(size_t)q * CAP + (v ? e : 0)]; ix[q][j] = en.y; k[q][j] = v ? okey(__uint_as_float(en.x)) : 0u; }
    unsigned lo[4], hx[4]; int clo[4];
#pragma unroll
    for (int q = 0; q < 4; ++q) { unsigned mn = 0xffffffffu, mxv = 0u;
#pragma unroll
        for (int j = 0; j < NE; ++j) { mxv = max(mxv, k[q][j]); mn = min(mn, k[q][j] ? k[q][j] : 0xffffffffu); }
        lo[q] = wave_umin(mn); hx[q] = wave_umax(mxv) + 1u; clo[q] = n[q]; }
    const int accept = FINAL ? 256 : KEEP_MAX;
    for (int it = 0; it < 40; ++it) {
        unsigned mid[4]; int c[4]; bool any = false;
#pragma unroll
        for (int q = 0; q < 4; ++q) mid[q] = lo[q] + ((hx[q] - lo[q]) >> 1);
#pragma unroll
        for (int q = 0; q < 4; ++q) { unsigned cl = 0;
#pragma unroll
            for (int j = 0; j < NE; ++j) cl += (k[q][j] >= mid[q]) ? 1u : 0u;
            c[q] = (int)wave_usum(cl); }
#pragma unroll
        for (int q = 0; q < 4; ++q) { const bool upd = (clo[q] > accept) && (hx[q] - lo[q] > 1u), ge = c[q] >= 256;
            lo[q] = (upd && ge) ? mid[q] : lo[q]; clo[q] = (upd && ge) ? c[q] : clo[q]; hx[q] = (upd && !ge) ? mid[q] : hx[q]; any = any || upd; }
        if (!any) break;
    }
#pragma unroll
    for (int q = 0; q < 4; ++q) {
        const unsigned Tk = lo[q];
        const bool ties = FINAL ? (clo[q] != 256) : (clo[q] > accept);
        int running = 0;
        if (!ties) {
#pragma unroll
            for (int j = 0; j < NE; ++j) {
                const bool take = k[q][j] >= Tk;
                const unsigned long long mt = __ballot(take);
                const int pos = running + prefix64(mt);
                if (FINAL) { unsigned short* dst = take ? sel_out + (size_t)q * 256 + pos : gtrash + lane; *dst = (unsigned short)ix[q][j]; }
                else { LAS u32x2* dst = take ? cb + (size_t)q * CAP + pos : trash + lane; *dst = (u32x2){__float_as_uint(ikey(k[q][j])), ix[q][j]}; }
                running += __popcll(mt);
            }
        } else {
            unsigned cg = 0;
#pragma unroll
            for (int j = 0; j < NE; ++j) cg += (k[q][j] > Tk) ? 1u : 0u;
            const int r_eq = 256 - (int)wave_usum(cg); int eqrun = 0;
#pragma unroll
            for (int j = 0; j < NE; ++j) {
                const bool gt = k[q][j] > Tk, eq = (k[q][j] == Tk);
                const unsigned long long meq = __ballot(eq);
                const bool take = gt || (eq && (eqrun + prefix64(meq)) < r_eq);
                const unsigned long long mt = __ballot(take);
                const int pos = running + prefix64(mt);
                if (FINAL) { unsigned short* dst = (take && pos < 256) ? sel_out + (size_t)q * 256 + pos : gtrash + lane; *dst = (unsigned short)ix[q][j]; }
                else { LAS u32x2* dst = take ? cb + (size_t)q * CAP + pos : trash + lane; *dst = (u32x2){__float_as_uint(ikey(k[q][j])), ix[q][j]}; }
                running += __popcll(mt); eqrun += __popcll(meq);
            }
        }
        tk[q] = Tk; n[q] = running;
    }
}
__device__ __forceinline__ void unit(int b, int g, const bf16* QI, const bf16* KI, const float* WI, unsigned short* SEL, unsigned short* gtrash, LAS unsigned char* lds, int variant) {
    const int q0 = g * 32, L = 64 * (q0 / 64 + 1);
    if (L <= 256) return;
    const int tid = threadIdx.x, lane = tid & 63, c = lane & 31, hi = lane >> 5; const int wid = __builtin_amdgcn_readfirstlane(tid >> 6);
    const size_t rowbase = (size_t)b * T; const int ntile = L / 64;
    bf16x8 Af[4];
    { const int r = c, jq = ((r >> 2) & 1) + 2 * (r >> 4), hd = (r & 3) + 4 * ((r >> 3) & 1);
      const bf16* qp = QI + (rowbase + q0 + 4 * wid + jq) * 512 + hd * 64 + 8 * hi;
#pragma unroll
      for (int s = 0; s < 4; ++s) Af[s] = *(const bf16x8*)(qp + 16 * s); }
    float wv[2][8];
#pragma unroll
    for (int u = 0; u < 2; ++u) { const float* wp = WI + (rowbase + q0 + 4 * wid + hi + 2 * u) * 8; const f32x4 a = *(const f32x4*)wp, bq = *(const f32x4*)(wp + 4);
#pragma unroll
        for (int i = 0; i < 4; ++i) { wv[u][i] = a[i] * (0.125f * 0.35355339059327373f); wv[u][4 + i] = bq[i] * (0.125f * 0.35355339059327373f); } }
    float tau[2] = {-INFINITY, -INFINITY}; int cnt[2] = {0, 0};
    LAS u32x2* cbase = (LAS u32x2*)(lds + L_CAND) + (size_t)(wid * 4) * CAP;
    LAS u32x2* trash = (LAS u32x2*)(lds + L_TRASH) + wid * 64;
    const bf16* kp = KI + (rowbase + c) * 64 + 8 * hi;
    bf16x8 Ba[8], Bb[8];
#define IDX_LOAD(dst, tt) do { _Pragma("unroll") for (int i_ = 0; i_ < 8; ++i_) dst[i_] = *(const bf16x8*)(kp + (size_t)((tt) * 64 + (i_ >> 2) * 32) * 64 + 16 * (i_ & 3)); } while (0)
#define IDX_TILE(Bf, tt) do { \
        f32x16 acc0, acc1; \
        _Pragma("unroll") for (int r_ = 0; r_ < 16; ++r_) { acc0[r_] = 0.f; acc1[r_] = 0.f; } \
        _Pragma("unroll") for (int s4 = 0; s4 < 4; ++s4) { acc0 = __builtin_amdgcn_mfma_f32_32x32x16_bf16(Af[s4], Bf[s4], acc0, 0, 0, 0); acc1 = __builtin_amdgcn_mfma_f32_32x32x16_bf16(Af[s4], Bf[4 + s4], acc1, 0, 0, 0); } \
        float sv[2][2]; \
        _Pragma("unroll") for (int u = 0; u < 2; ++u) { float a_ = 0.f, b_ = 0.f; \
            _Pragma("unroll") for (int i = 0; i < 8; ++i) { a_ = fmaf(__builtin_amdgcn_fmed3f(acc0[8 * u + i], 0.f, 3.0e38f), wv[u][i], a_); b_ = fmaf(__builtin_amdgcn_fmed3f(acc1[8 * u + i], 0.f, 3.0e38f), wv[u][i], b_); } \
            sv[u][0] = a_; sv[u][1] = b_; } \
        bool ps[2][2]; unsigned long long mk[2][2]; \
        _Pragma("unroll") for (int u = 0; u < 2; ++u) _Pragma("unroll") for (int kh = 0; kh < 2; ++kh) { ps[u][kh] = (sv[u][kh] > tau[u]) && !(variant & 2); mk[u][kh] = __ballot(ps[u][kh]); } \
        if ((mk[0][0] | mk[0][1] | mk[1][0] | mk[1][1]) != 0ull) { \
            _Pragma("unroll") for (int u = 0; u < 2; ++u) _Pragma("unroll") for (int kh = 0; kh < 2; ++kh) { \
                const unsigned mlo = (unsigned)mk[u][kh], mhi = (unsigned)(mk[u][kh] >> 32); \
                const int pre = (int)__builtin_amdgcn_mbcnt_hi(mhi, __builtin_amdgcn_mbcnt_lo(mlo, 0u)) - (hi ? __popc(mlo) : 0);     \
                LAS u32x2* dst = ps[u][kh] ? cbase + (size_t)(hi + 2 * u) * CAP + cnt[u] + pre : trash + lane; \
                *dst = (u32x2){__float_as_uint(sv[u][kh]), (unsigned)((tt) * 64 + kh * 32 + c)}; \
                cnt[u] += hi ? __popc(mhi) : __popc(mlo); } } \
    } while (0)
    IDX_LOAD(Ba, 0); IDX_LOAD(Bb, 1);
    for (int t = 0; t < ntile; t += 2) {
#define IDX_CHECK() do { const int n0 = __builtin_amdgcn_readlane(cnt[0], 0), n1 = __builtin_amdgcn_readlane(cnt[0], 32), n2 = __builtin_amdgcn_readlane(cnt[1], 0), n3 = __builtin_amdgcn_readlane(cnt[1], 32); \
          if (max(max(n0, n1), max(n2, n3)) > TRIG && !(variant & 1)) { int n4[4] = {n0, n1, n2, n3}; unsigned tk4[4]; \
            PROF_T0(1); select4<false>(cbase, n4, tk4, lane, nullptr, trash, gtrash); PROF_T1(1, lds, wid, lane); \
            cnt[0] = hi ? n4[1] : n4[0]; cnt[1] = hi ? n4[3] : n4[2]; tau[0] = ikey(hi ? tk4[1] : tk4[0]); tau[1] = ikey(hi ? tk4[3] : tk4[2]); } } while (0)
        IDX_CHECK();
        IDX_TILE(Ba, t);
        if (t + 2 < ntile) IDX_LOAD(Ba, t + 2);
        if (t + 1 < ntile) { IDX_CHECK(); IDX_TILE(Bb, t + 1); if (t + 3 < ntile) IDX_LOAD(Bb, t + 3); }
    }
#undef IDX_LOAD
#undef IDX_TILE
#undef IDX_CHECK
    asm volatile("s_waitcnt lgkmcnt(0)" ::: "memory");
    if (!(variant & 9)) { int n4[4] = {__builtin_amdgcn_readlane(cnt[0], 0), __builtin_amdgcn_readlane(cnt[0], 32), __builtin_amdgcn_readlane(cnt[1], 0), __builtin_amdgcn_readlane(cnt[1], 32)}; unsigned tk4[4];
      PROF_T0(2); select4<true>(cbase, n4, tk4, lane, SEL + (rowbase + q0 + 4 * wid) * 256, trash, gtrash); PROF_T1(2, lds, wid, lane); }
    asm volatile("s_waitcnt lgkmcnt(0)" ::: "memory");
}
__device__ __forceinline__ void phase(int vcu, int G, const bf16* QI, const bf16* KI, const float* WI, unsigned short* SEL, unsigned short* gtrash, LAS unsigned char* lds, int variant) {
    PROF_T0(7);
    for (int u = vcu; u < 1024; u += G) { const int i = u >> 8, v = u & 255, b = v >> 6, s = v & 63;
        const int g = (i == 0) ? s : (i == 1) ? 127 - s : (i == 2) ? 128 + s : 255 - s;
        unit(b, g, QI, KI, WI, SEL, gtrash, lds, variant); }
    PROF_T1(7, lds, (int)__builtin_amdgcn_readfirstlane(threadIdx.x >> 6), (int)(threadIdx.x & 63));
    __syncthreads();
}
}

namespace dsa {
typedef unsigned u32x4m __attribute__((ext_vector_type(4)));
typedef unsigned u32x2m __attribute__((ext_vector_type(2)));
typedef short bf16x8 __attribute__((ext_vector_type(8)));
typedef short v4i16 __attribute__((ext_vector_type(4)));
constexpr int WREG = 17408, L_BIAS = 8 * WREG, L_END = L_BIAS + 33 * 8 * 4;
static_assert(L_END <= RING_BYTES, "dsa LDS");
constexpr float LOG2E = 1.4426950408889634f;
__device__ __forceinline__ int t5_bucket(int rel) {
    const int n = rel < 0 ? -rel : rel; const int r = rel > 0 ? 16 : 0;
    if (n < 8) return r + n;
    int lg = (31 - __clz(n * n)) - 6; if (n >= 128 || lg > 7) lg = 7;
    return r + 8 + lg;
}
__device__ __forceinline__ void phase(int vcu, int G, const bf16* QA, const bf16* KA, const bf16* VA, const unsigned short* SEL, const int* positions, const float* rel_bias, bf16* OA, LAS unsigned char* lds) {
    const int tid = threadIdx.x, lane = tid & 63, l15 = lane & 15, kq = lane >> 4; const int wid = __builtin_amdgcn_readfirstlane(tid >> 6);
    LAS float* bt = (LAS float*)(lds + L_BIAS);
    for (int i = tid; i < 33 * 8; i += NWAVES * 64) bt[i] = (i < 256) ? rel_bias[i] * LOG2E : -INFINITY;
    __syncthreads();
    LAS unsigned char* wl = lds + wid * WREG;
    LAS unsigned short* selL = (LAS unsigned short*)(wl + 16384); LAS unsigned char* bktL = wl + 16384 + 512;
    const int gw = vcu * NWAVES + wid, NGW = G * NWAVES;
    const int trofs = ((l15 >> 2) + 4 * kq) * 128 + (l15 & 3) * 8;
    unsigned short seln[4];
#pragma unroll
    for (int j = 0; j < 4; ++j) seln[j] = (gw < M) ? SEL[(size_t)gw * 256 + lane + 64 * j] : (unsigned short)0;
    for (int q = gw; q < M; q += NGW) {
        const int b = q >> 13, t = q & (T - 1); const size_t rowbase = (size_t)b * T;
        const int limit = 64 * (t / 64 + 1), nvalid = limit < 256 ? limit : 256; const int posq = positions[q];
        int svv[4];
#pragma unroll
        for (int j = 0; j < 4; ++j) { const int k = lane + 64 * j; svv[j] = (limit <= 256) ? (k < limit ? k : limit - 1) : (int)seln[j]; }
        { const int qn = q + NGW;
#pragma unroll
          for (int j = 0; j < 4; ++j) seln[j] = (qn < M) ? SEL[(size_t)qn * 256 + lane + 64 * j] : (unsigned short)0; }
#pragma unroll
        for (int j = 0; j < 4; ++j) { const int k = lane + 64 * j; const int sv = svv[j];
            const int bk = (k < nvalid) ? t5_bucket(positions[rowbase + sv] - posq) : 32; selL[k] = (unsigned short)sv; bktL[k] = (unsigned char)bk; }
        asm volatile("s_waitcnt lgkmcnt(0)" ::: "memory");
#define DSA_VDMA(cch, buf) do { _Pragma("unroll") for (int i_ = 0; i_ < 4; ++i_) { const int row_ = selL[32 * (cch) + 8 * i_ + (lane >> 3)]; \
            __builtin_amdgcn_global_load_lds((const unsigned*)(VA + (rowbase + row_) * 64 + (lane & 7) * 8), (LAS unsigned*)(wl + (buf) * 4096 + i_ * 1024), 16, 0, 0); } } while (0)
        DSA_VDMA(0, 0); DSA_VDMA(1, 1); DSA_VDMA(2, 2); DSA_VDMA(3, 3);
        bf16x8 Qf[2];
#pragma unroll
        for (int s = 0; s < 2; ++s) { Qf[s] = (bf16x8){0, 0, 0, 0, 0, 0, 0, 0}; if (l15 < 8) Qf[s] = *(const bf16x8*)(QA + (size_t)q * 512 + l15 * 64 + 32 * s + 8 * kq); }
        f32x4 St[16];
#pragma unroll
        for (int half = 0; half < 2; ++half) {
            bf16x8 Ka[8][2];
#pragma unroll
            for (int i = 0; i < 8; ++i) { const int row = selL[16 * (8 * half + i) + l15]; const bf16* kp = KA + (rowbase + row) * 64 + 8 * kq;
                Ka[i][0] = *(const bf16x8*)kp; Ka[i][1] = *(const bf16x8*)(kp + 32); }
#pragma unroll
            for (int i = 0; i < 8; ++i) { f32x4 a = {0.f, 0.f, 0.f, 0.f};
                a = __builtin_amdgcn_mfma_f32_16x16x32_bf16(Ka[i][0], Qf[0], a, 0, 0, 0); a = __builtin_amdgcn_mfma_f32_16x16x32_bf16(Ka[i][1], Qf[1], a, 0, 0, 0); St[8 * half + i] = a; }
        }
        float mx = -INFINITY;
#pragma unroll
        for (int kt = 0; kt < 16; ++kt) { const unsigned bk4 = *(const LAS unsigned*)(bktL + 16 * kt + 4 * kq);
#pragma unroll
            for (int i = 0; i < 4; ++i) { const float s = St[kt][i] * (0.125f * LOG2E) + bt[((bk4 >> (8 * i)) & 255u) * 8 + (l15 & 7)]; St[kt][i] = s; mx = fmaxf(mx, s); } }
        mx = fmaxf(mx, __shfl_xor(mx, 16)); mx = fmaxf(mx, __shfl_xor(mx, 32));
        float lsum = 0.f;
#pragma unroll
        for (int kt = 0; kt < 16; ++kt)
#pragma unroll
            for (int i = 0; i < 4; ++i) { const float p = __builtin_amdgcn_exp2f(St[kt][i] - mx); St[kt][i] = p; lsum += p; }
        lsum += __shfl_xor(lsum, 16); lsum += __shfl_xor(lsum, 32);
        f32x4 O[4];
#pragma unroll
        for (int dt = 0; dt < 4; ++dt) O[dt] = (f32x4){0.f, 0.f, 0.f, 0.f};
#pragma unroll
        for (int kk = 0; kk < 8; ++kk) {
            if (kk < 5) asm volatile("s_waitcnt vmcnt(12)" ::: "memory"); else if (kk == 5) asm volatile("s_waitcnt vmcnt(8)" ::: "memory"); else if (kk == 6) asm volatile("s_waitcnt vmcnt(4)" ::: "memory"); else asm volatile("s_waitcnt vmcnt(0)" ::: "memory");
            const LAS unsigned char* vb = wl + (kk & 3) * 4096 + trofs;
            const f32x4 pa = St[2 * kk], pb = St[2 * kk + 1];
            u32x4m pw; pw.x = pg8::cvt_pk_bf16(pa[0], pa[1]); pw.y = pg8::cvt_pk_bf16(pa[2], pa[3]); pw.z = pg8::cvt_pk_bf16(pb[0], pb[1]); pw.w = pg8::cvt_pk_bf16(pb[2], pb[3]);
            const bf16x8 Pf = __builtin_bit_cast(bf16x8, pw);
#pragma unroll
            for (int dt = 0; dt < 4; ++dt) {
                const v4i16 v0 = __builtin_amdgcn_ds_read_tr16_b64_v4i16((LAS v4i16*)(vb + dt * 32));
                const v4i16 v1 = __builtin_amdgcn_ds_read_tr16_b64_v4i16((LAS v4i16*)(vb + 2048 + dt * 32));
                const bf16x8 Vf = (bf16x8){v0[0], v0[1], v0[2], v0[3], v1[0], v1[1], v1[2], v1[3]};
                O[dt] = __builtin_amdgcn_mfma_f32_16x16x32_bf16(Vf, Pf, O[dt], 0, 0, 0); }
            if (kk < 4) { asm volatile("s_waitcnt lgkmcnt(0)" ::: "memory"); DSA_VDMA(kk + 4, kk); }
        }
#undef DSA_VDMA
        if (l15 < 8) { const float rl = __builtin_amdgcn_rcpf(lsum);
#pragma unroll
            for (int dt = 0; dt < 4; ++dt) { u32x2m w; w.x = pg8::cvt_pk_bf16(O[dt][0] * rl, O[dt][1] * rl); w.y = pg8::cvt_pk_bf16(O[dt][2] * rl, O[dt][3] * rl);
                *(u32x2m*)(OA + (size_t)q * 512 + l15 * 64 + 16 * dt + 4 * kq) = w; } }
        asm volatile("s_waitcnt lgkmcnt(0)" ::: "memory");
    }
}
}

struct PhaseTimer { unsigned long long t0; int k; LAS unsigned char* l; int w, ln; bool once;
    __device__ __forceinline__ PhaseTimer(int k_, LAS unsigned char* l_, int w_, int ln_) : t0(0), k(k_), l(l_), w(w_), ln(ln_), once(true) { if (PROF_SEL == 20 + k) t0 = __builtin_amdgcn_s_memrealtime(); }
    __device__ __forceinline__ void stop() { once = false; if (PROF_SEL == 20 + k) { const unsigned d = (unsigned)(__builtin_amdgcn_s_memrealtime() - t0); if (ln == 0) *PROF_WORD(l, w) += d; } } };
constexpr int NPHASE = 16;
__global__ void __launch_bounds__(NWAVES * 64, 2) mk_fwd(Args args) {
    extern __shared__ __attribute__((aligned(16))) unsigned char lds[];
    Frame F;
    F.lds = (LAS unsigned char*)lds;
    F.MISC = (volatile LAS unsigned*)(F.lds + MISC_OFF);
    F.tid = threadIdx.x; F.lane = F.tid & 63; F.wave = __builtin_amdgcn_readfirstlane(F.tid >> 6);
    F.G = gridDim.x; { const int bx = blockIdx.x; F.vcu = (F.G % 8 == 0) ? (bx % 8) * (F.G / 8) + bx / 8 : bx; }
    unsigned char* ws = args.ws;
    F.ctl = (gu32*)(ws + WS_CTL);
    for (int u = F.tid; u < (LDS_BYTES - LDSCTL_OFF) / 4; u += NWAVES * 64) ((LAS unsigned*)(F.lds + LDSCTL_OFF))[u] = 0u;
    __syncthreads();
    XcdBarrier bar; bar.bar = (unsigned*)(F.ctl + CW_BAR); bar.x = 0; bar.st = nullptr;
    if (MK_FUSED) bar = xcd_barrier_post((unsigned*)(F.ctl + CW_BAR), F.MISC + 8);
#define GRID_BAR() do { if (MK_FUSED) { PROF_T0(50); xcd_barrier(bar); PROF_T1(50, F.lds + RING_OFF, F.wave, F.lane); } } while (0)
    const int lo = args.ph_lo, hi = args.ph_hi;
#ifdef ONLY_PH
#define IN(k) ((k) == ONLY_PH && lo <= (k) && (k) < hi)
#else
#define IN(k) (lo <= (k) && (k) < hi)
#endif
#define BOTH(k) (IN(k) && IN((k) + 1))
#ifndef DUP_PH
#define DUP_PH -1
#endif
#ifndef P7_VARIANT
#define P7_VARIANT 0
#endif
#define PHASE_TIMED(k) for (PhaseTimer pt_((k), F.lds + RING_OFF, F.wave, F.lane); pt_.once; pt_.stop())
#define REP(k) for (int rep_ = 0; rep_ < ((k) == DUP_PH ? 2 : 1); ++rep_)
    const float* x = (const float*)args.in[0];
    const float* mod = (const float*)(ws + WS_MOD);
    bf16* XN = (bf16*)(ws + WS_XN); bf16* ACT = (bf16*)(ws + WS_ACT);
    float* X1 = args.out;
    const float* rcos = (const float*)(ws + WS_RCOS); const float* rsin = (const float*)(ws + WS_RSIN);
    float* ssq_q = (float*)(ws + WS_SSQQ); float* ssq_kv = (float*)(ws + WS_SSQKV);

    if (IN(0)) REP(0) PHASE_TIMED(0) { p0_prologue(F, args); if (BOTH(0)) GRID_BAR(); }
#ifdef EXTRA_BARS
    for (int eb_ = 0; eb_ < EXTRA_BARS; ++eb_) GRID_BAR();
#endif
    if (IN(1)) REP(1) PHASE_TIMED(1) { norm_mod_phase(F, x, (const float*)args.in[5], mod, 0 * D, 1 * D, XN); if (BOTH(1)) GRID_BAR(); }
    if (IN(2)) REP(2) PHASE_TIMED(2) {
        pg8::Gemm g{XN, (const bf16*)(ws + WS_W1A), M, 2 * DFF, D}; pg8::StaticOrder S; S.init(M, 2 * DFF, F.G, (int)blockIdx.x);
        pg8::EpiSwiglu E{ACT, DFF};
        pg8::gemm_phase<pg8::EpiSwiglu, pg8::StaticOrder, true, true>(F.lds + RING_OFF, g, S, E);
        if (BOTH(2)) GRID_BAR(); }
    if (IN(3)) REP(3) PHASE_TIMED(3) {
        pg8::Gemm g{ACT, (const bf16*)(ws + WS_W1D), M, D, DFF}; pg8::StaticOrder S; S.init(M, D, F.G, (int)blockIdx.x);
        pg8::EpiResid E{x, X1, mod, 2 * D, 0.5f};
        pg8::gemm_phase<pg8::EpiResid, pg8::StaticOrder, true, true>(F.lds + RING_OFF, g, S, E);
        if (BOTH(3)) GRID_BAR(); }
    if (IN(4)) REP(4) PHASE_TIMED(4) { norm_mod_phase(F, X1, (const float*)args.in[8], mod, 3 * D, 4 * D, XN); if (BOTH(4)) GRID_BAR(); }
    if (IN(5)) REP(5) PHASE_TIMED(5) {
        pg8::Gemm g{XN, (const bf16*)(ws + WS_WIN), M, NPROJ, D}; pg8::StaticOrder S; S.init(M, NPROJ, F.G, (int)blockIdx.x);
        pg8::EpiProj E{(bf16*)(ws + WS_QA), (bf16*)(ws + WS_QI), (bf16*)(ws + WS_CQ), (bf16*)(ws + WS_CKV), (bf16*)(ws + WS_KA), (bf16*)(ws + WS_VA), (bf16*)(ws + WS_KI), (bf16*)(ws + WS_KPE), (bf16*)(ws + WS_G),
                       (float*)(ws + WS_WI), ssq_q, ssq_kv, rcos, rsin};
        pg8::gemm_phase<pg8::EpiProj, pg8::StaticOrder, true, true>(F.lds + RING_OFF, g, S, E);
        if (BOTH(5)) GRID_BAR(); }
    if (IN(6)) REP(6) PHASE_TIMED(6) {
        { pg8::Gemm g{(const bf16*)(ws + WS_CQ), (const bf16*)(ws + WS_WUQ), M, 768, 384}; pg8::StaticOrder S; S.init(M, 768, F.G, (int)blockIdx.x);
          pg8::EpiUpQ E{(bf16*)(ws + WS_QB), ssq_q, rcos, rsin};
          pg8::gemm_phase<pg8::EpiUpQ, pg8::StaticOrder, true, true>(F.lds + RING_OFF, g, S, E); }
        __syncthreads();
        { pg8::Gemm g{(const bf16*)(ws + WS_CKV), (const bf16*)(ws + WS_WUKV), M, 1024, 256}; pg8::StaticOrder S; S.init(M, 1024, F.G, (int)blockIdx.x);
          pg8::EpiUpKV E{(bf16*)(ws + WS_KN), (bf16*)(ws + WS_VB), ssq_kv};
          pg8::gemm_phase<pg8::EpiUpKV, pg8::StaticOrder, true, true>(F.lds + RING_OFF, g, S, E); }
        __syncthreads(); }
    if (IN(7)) REP(7) PHASE_TIMED(7) { idx::phase(F.vcu, F.G, (const bf16*)(ws + WS_QI), (const bf16*)(ws + WS_KI), (const float*)(ws + WS_WI), (unsigned short*)(ws + WS_SEL), (unsigned short*)(ws + WS_END), F.lds + RING_OFF, (DUP_PH == 7 && rep_ == 0) ? P7_VARIANT : 0); if (BOTH(7)) GRID_BAR(); }
    if (IN(8)) REP(8) PHASE_TIMED(8) { dsa::phase(F.vcu, F.G, (const bf16*)(ws + WS_QA), (const bf16*)(ws + WS_KA), (const bf16*)(ws + WS_VA), (const unsigned short*)(ws + WS_SEL), (const int*)args.in[2], (const float*)args.in[15], (bf16*)(ws + WS_OA), F.lds + RING_OFF); __syncthreads(); }
    if (IN(9)) REP(9) PHASE_TIMED(9) { mla::phase(F.vcu, F.G, (const bf16*)(ws + WS_QB), (const bf16*)(ws + WS_KN), (const bf16*)(ws + WS_KPE), (const bf16*)(ws + WS_VB), (bf16*)(ws + WS_OB), F.lds + RING_OFF); if (BOTH(9)) GRID_BAR(); }
    if (IN(10)) REP(10) PHASE_TIMED(10) {
        { pg8::Gemm g{(const bf16*)(ws + WS_OA), (const bf16*)(ws + WS_WOA), M, D, 512}; pg8::StaticOrder S; S.init(M, D, F.G, (int)blockIdx.x);
          pg8::EpiGate<false> E{(const bf16*)(ws + WS_G), 0, nullptr, (bf16*)(ws + WS_Y1)};
          pg8::gemm_phase<pg8::EpiGate<false>, pg8::StaticOrder, true, true>(F.lds + RING_OFF, g, S, E); }
        VM_WAIT(); __syncthreads();
        { pg8::Gemm g{(const bf16*)(ws + WS_OB), (const bf16*)(ws + WS_WOB), M, D, 512}; pg8::StaticOrder S; S.init(M, D, F.G, (int)blockIdx.x);
          pg8::EpiGate<true> E{(const bf16*)(ws + WS_G), 1024, (const bf16*)(ws + WS_Y1), (bf16*)(ws + WS_Y)};
          pg8::gemm_phase<pg8::EpiGate<true>, pg8::StaticOrder, true, true>(F.lds + RING_OFF, g, S, E); }
        if (BOTH(10)) GRID_BAR(); }
    if (IN(11)) PHASE_TIMED(11) {
        pg8::Gemm g{(const bf16*)(ws + WS_Y), (const bf16*)(ws + WS_WOUT), M, D, D}; pg8::StaticOrder S; S.init(M, D, F.G, (int)blockIdx.x);
        pg8::EpiResid E{X1, X1, mod, 5 * D, 1.0f};
        pg8::gemm_phase<pg8::EpiResid, pg8::StaticOrder, true, true>(F.lds + RING_OFF, g, S, E);
        if (BOTH(11)) GRID_BAR(); }
    if (IN(12)) REP(12) PHASE_TIMED(12) { norm_mod_phase(F, X1, (const float*)args.in[19], mod, 6 * D, 7 * D, XN); if (BOTH(12)) GRID_BAR(); }
    if (IN(13)) REP(13) PHASE_TIMED(13) {
        pg8::Gemm g{XN, (const bf16*)(ws + WS_W2A), M, 2 * DFF, D}; pg8::StaticOrder S; S.init(M, 2 * DFF, F.G, (int)blockIdx.x);
        pg8::EpiSwiglu E{ACT, DFF};
        pg8::gemm_phase<pg8::EpiSwiglu, pg8::StaticOrder, true, true>(F.lds + RING_OFF, g, S, E);
        if (BOTH(13)) GRID_BAR(); }
    if (IN(14)) PHASE_TIMED(14) {
        pg8::Gemm g{ACT, (const bf16*)(ws + WS_W2D), M, D, DFF}; pg8::StaticOrder S; S.init(M, D, F.G, (int)blockIdx.x);
        pg8::EpiResid E{X1, X1, mod, 8 * D, 0.5f};
        pg8::gemm_phase<pg8::EpiResid, pg8::StaticOrder, true, true>(F.lds + RING_OFF, g, S, E);
        if (BOTH(14)) GRID_BAR(); }
    if (IN(15)) PHASE_TIMED(15) { final_norm_phase(F, X1, (const float*)args.in[22], args.out); }
    if (PROF_SEL != 0) { asm volatile("s_waitcnt lgkmcnt(0)" ::: "memory"); const unsigned a_ = *PROF_WORD(F.lds + RING_OFF, F.wave); const unsigned long long t0_ = __builtin_amdgcn_s_memrealtime();
        while (__builtin_amdgcn_s_memrealtime() - t0_ < (unsigned long long)a_ * PROF_MULT) __builtin_amdgcn_s_sleep(32); }
#undef IN
#undef BOTH
}

extern "C" void kernel_launch(void* const* d_in, const int* in_sizes, int n_in, void* d_out, int out_size, void* d_ws, size_t ws_size, hipStream_t stream) {
    static int grid = 0;
    if (grid == 0) {
        if (n_in != 23 || out_size != M * D || ws_size < WS_END) { fprintf(stderr, "kernel_launch: unexpected problem shape (n_in %d, out %d, ws %zu)\n", n_in, out_size, ws_size); grid = -1; return; }
        int dev = 0, cus = 0, per_cu = 0;
        if (hipGetDevice(&dev) != hipSuccess || hipDeviceGetAttribute(&cus, hipDeviceAttributeMultiprocessorCount, dev) != hipSuccess) { grid = -1; return; }
        if (hipFuncSetAttribute((const void*)mk_fwd, hipFuncAttributeMaxDynamicSharedMemorySize, LDS_BYTES) != hipSuccess) { fprintf(stderr, "kernel_launch: hipFuncSetAttribute failed\n"); grid = -1; return; }
        if (hipOccupancyMaxActiveBlocksPerMultiprocessor(&per_cu, (const void*)mk_fwd, NWAVES * 64, LDS_BYTES) != hipSuccess || per_cu < 1) fprintf(stderr, "kernel_launch: occupancy query reports %d\n", per_cu);
        (void)hipGetLastError();
        grid = cus;
    }
    if (grid < 0) return;
    (void)in_sizes;
    if (hipMemsetAsync((char*)d_ws + WS_CTL, 0, CTL_ZERO_BYTES, stream) != hipSuccess) return;
    Args a{};
    for (int i = 0; i < 23; ++i) a.in[i] = d_in[i];
    a.out = (float*)d_out; a.ws = (unsigned char*)d_ws;
    auto launch = [&](int lo, int hi) { a.ph_lo = lo; a.ph_hi = hi; a.li = 0; hipLaunchKernelGGL(mk_fwd, dim3(grid), dim3(NWAVES * 64), LDS_BYTES, stream, a); };
#if MK_FUSED
    launch(0, NPHASE);
#else
    for (int p = 0; p < NPHASE; ++p) launch(p, p + 1);
#endif
}
```

```cpp
#include <hip/hip_runtime.h>
#include <cstdio>
#include <cstdint>
namespace pg8 {
#define PG8_LAS __attribute__((address_space(3)))
typedef unsigned short bf16_t;
typedef short bf16x8 __attribute__((ext_vector_type(8)));
typedef float f32x4 __attribute__((ext_vector_type(4)));
typedef unsigned u32x4 __attribute__((ext_vector_type(4)));
constexpr int BM = 256, BK = 64, HALF = 128, HTB = HALF * BK * 2  , STAGE_BYTES = 8 * HTB, NXCD = 8, WGM = 8;

__host__ __device__ __forceinline__ int lds_byte(int r, int c) { const int st = (r >> 4) * 2 + (c >> 5), rr = r & 15, cc = c & 31, ob = rr * 64 + cc * 2; return st * 1024 + (ob ^ (((ob >> 9) & 1) << 5)); }
__host__ __device__ __forceinline__ void stage_rc(int b, int& R, int& C) { const int st = b / 1024, sb = b % 1024, swz = sb ^ (((sb >> 9) & 1) << 5); R = (st >> 1) * 16 + swz / 64; C = (st & 1) * 32 + (swz % 64) / 2; }
__host__ __device__ __forceinline__ int perm32(int rho) { const int n = rho >> 4, i = rho & 15; return 8 * (i >> 2) + 4 * n + (i & 3); }

struct Unit { int pm, pn; };
struct Gemm { const bf16_t* A; const bf16_t* Bt; int M, N, K; };

struct StaticOrder {
    int nM, nN, nwg, G, c;
    __host__ __device__ void init(int M, int N, int G_, int c_) { nM = M / BM; nN = N / BM; nwg = nM * nN; G = G_; c = c_; }
    __host__ __device__ bool next(int i, Unit& u) const {
        const long L = (long)i * G + c; if (L >= nwg) return false;
        int wgid = (int)L; { const int q = nwg / NXCD, r = nwg % NXCD, xcd = wgid % NXCD, off = wgid / NXCD; wgid = (xcd < r ? xcd * (q + 1) : r * (q + 1) + (xcd - r) * q) + off; }
        const int nig = WGM * nN, gid = wgid / nig, fm = gid * WGM, gsz = (nM - fm) < WGM ? (nM - fm) : WGM;
        u.pm = fm + ((wgid % nig) % gsz); u.pn = (wgid % nig) / gsz; return true;
    }
    __device__ __forceinline__ void a_ready(const Unit&) const {}
    __device__ __forceinline__ void done(const Unit&) const {}
};

typedef float f32x2 __attribute__((ext_vector_type(2)));
typedef __bf16 bf16x2_cv __attribute__((ext_vector_type(2)));
__device__ __forceinline__ unsigned cvt_pk_bf16(float lo, float hi) { const f32x2 v = {lo, hi}; const bf16x2_cv b = __builtin_convertvector(v, bf16x2_cv); return __builtin_bit_cast(unsigned, b); }

__device__ __forceinline__ u32x4 pack8(const f32x4 a, const f32x4 b) { u32x4 w; w.x = cvt_pk_bf16(a[0], a[1]); w.y = cvt_pk_bf16(a[2], a[3]); w.z = cvt_pk_bf16(b[0], b[1]); w.w = cvt_pk_bf16(b[2], b[3]); return w; }
__device__ __forceinline__ float sigm(float v) { return __builtin_amdgcn_rcpf(1.f + __builtin_amdgcn_exp2f(-1.4426950408889634f * v)); }
__device__ __forceinline__ f32x4 sigm4(const f32x4 v) { return (f32x4){sigm(v[0]), sigm(v[1]), sigm(v[2]), sigm(v[3])}; }
__device__ __forceinline__ void unpack8(const u32x4 w, f32x4& a, f32x4& b) {
    a = (f32x4){__uint_as_float(w.x << 16), __uint_as_float(w.x & 0xffff0000u), __uint_as_float(w.y << 16), __uint_as_float(w.y & 0xffff0000u)};
    b = (f32x4){__uint_as_float(w.z << 16), __uint_as_float(w.z & 0xffff0000u), __uint_as_float(w.w << 16), __uint_as_float(w.w & 0xffff0000u)}; }
constexpr float EPS_RMS = 1e-6f;
constexpr float QSCALE = 0.10206207261596575f * 1.4426950408889634f;

struct EpiSwiglu {
    static constexpr bool PERM = true, AFTER_DRAIN = false;
    bf16_t* O; int ldc;
    __device__ __forceinline__ void operator()(const f32x4 (&acc)[2][2][4][2], const Unit& u, int wr, int wc, int fr, int fq) const {
        const int row0 = u.pm * BM + wr * 64 + fr, col0 = u.pn * HALF + wc * 32 + 8 * fq;
#pragma unroll
        for (int ai = 0; ai < 2; ++ai)
#pragma unroll
            for (int m = 0; m < 4; ++m) {
                const f32x4 g0 = acc[ai][0][m][0], g1 = acc[ai][0][m][1], u0 = acc[ai][1][m][0], u1 = acc[ai][1][m][1];
                const f32x4 v0 = g0 * sigm4(g0) * u0, v1 = g1 * sigm4(g1) * u1;
                *(u32x4*)(O + (size_t)(row0 + ai * HALF + m * 16) * ldc + col0) = pack8(v0, v1); }
    }
};
struct EpiResid {
    static constexpr bool PERM = false, AFTER_DRAIN = false;
    const float* base; float* out; const float* mod; int goff; float scale;
    __device__ __forceinline__ void operator()(const f32x4 (&acc)[2][2][4][2], const Unit& u, int wr, int wc, int fr, int fq) const {
        const float* gate = mod + (u.pm >> 5) * 9216 + goff;
        const int col0 = u.pn * BM + wc * 32 + 4 * fq;
        f32x4 gv[2][2];
#pragma unroll
        for (int bj = 0; bj < 2; ++bj)
#pragma unroll
            for (int n = 0; n < 2; ++n) gv[bj][n] = *(const f32x4*)(gate + col0 + bj * HALF + n * 16) * scale;
#pragma unroll
        for (int ai = 0; ai < 2; ++ai)
#pragma unroll
            for (int m = 0; m < 4; ++m) { const size_t off = (size_t)(u.pm * BM + ai * HALF + wr * 64 + m * 16 + fr) * 1024 + col0;
#pragma unroll
                for (int bj = 0; bj < 2; ++bj)
#pragma unroll
                    for (int n = 0; n < 2; ++n) { const f32x4 bs = *(const f32x4*)(base + off + bj * HALF + n * 16); *(f32x4*)(out + off + bj * HALF + n * 16) = bs + gv[bj][n] * acc[ai][bj][m][n]; } }
    }
};
struct EpiProj {
    static constexpr bool PERM = true, AFTER_DRAIN = false;
    bf16_t *QA, *QI, *CQ, *CKV, *KA, *VA, *KI, *KPE, *G; float *WI, *ssq_q, *ssq_kv; const float *rcos, *rsin;
    __device__ __forceinline__ void operator()(const f32x4 (&acc)[2][2][4][2], const Unit& u, int wr, int wc, int fr, int fq) const {
        const int row0 = u.pm * BM + wr * 64 + fr, pn = u.pn, c32 = wc * 32 + 8 * fq;
#pragma unroll
        for (int ai = 0; ai < 2; ++ai)
#pragma unroll
            for (int m = 0; m < 4; ++m) {
                const size_t r = (size_t)(row0 + ai * HALF + m * 16);
                const f32x4 a0 = acc[ai][0][m][0], a1 = acc[ai][0][m][1], b0 = acc[ai][1][m][0], b1 = acc[ai][1][m][1];
                const float sa = (a0[0] * a0[0] + a0[1] * a0[1]) + (a0[2] * a0[2] + a0[3] * a0[3]) + (a1[0] * a1[0] + a1[1] * a1[1]) + (a1[2] * a1[2] + a1[3] * a1[3]);
                const float sb = (b0[0] * b0[0] + b0[1] * b0[1]) + (b0[2] * b0[2] + b0[3] * b0[3]) + (b1[0] * b1[0] + b1[1] * b1[1]) + (b1[2] * b1[2] + b1[3] * b1[3]);
                if (pn < 2) { bf16_t* p = QA + r * 512 + pn * 256 + c32; *(u32x4*)p = pack8(a0, a1); *(u32x4*)(p + HALF) = pack8(b0, b1); }
                else if (pn < 4) { bf16_t* p = QI + r * 512 + (pn - 2) * 256 + c32; *(u32x4*)p = pack8(a0, a1); *(u32x4*)(p + HALF) = pack8(b0, b1); }
                else if (pn == 4) { bf16_t* p = CQ + r * 384 + c32; *(u32x4*)p = pack8(a0, a1); *(u32x4*)(p + HALF) = pack8(b0, b1);
                    float s = sa + sb; s += __shfl_xor(s, 16); s += __shfl_xor(s, 32); if (fq == 0) ssq_q[r * 8 + wc] = s; }
                else if (pn == 5) { *(u32x4*)(CQ + r * 384 + 256 + c32) = pack8(a0, a1); *(u32x4*)(CKV + r * 256 + c32) = pack8(b0, b1);
                    float s = sa; s += __shfl_xor(s, 16); s += __shfl_xor(s, 32); float t = sb; t += __shfl_xor(t, 16); t += __shfl_xor(t, 32);
                    if (fq == 0) { ssq_q[r * 8 + 4 + wc] = s; ssq_kv[r * 8 + wc] = t; } }
                else if (pn == 6) { *(u32x4*)(CKV + r * 256 + 128 + c32) = pack8(a0, a1);
                    float s = sa; s += __shfl_xor(s, 16); s += __shfl_xor(s, 32); if (fq == 0) ssq_kv[r * 8 + 4 + wc] = s;
                    if (wc < 2) *(u32x4*)(KA + r * 64 + c32) = pack8(b0, b1); else *(u32x4*)(VA + r * 64 + (c32 - 64)) = pack8(b0, b1); }
                else if (pn == 7) {
                    if (wc < 2) *(u32x4*)(KI + r * 64 + c32) = pack8(a0, a1);
                    else if (wc == 2) {
                        const f32x4 c4 = *(const f32x4*)(rcos + r * 16 + 4 * fq), s4 = *(const f32x4*)(rsin + r * 16 + 4 * fq);
                        const f32x4 o0 = (f32x4){a0[0] * c4[0] - a0[1] * s4[0], a0[1] * c4[0] + a0[0] * s4[0], a0[2] * c4[1] - a0[3] * s4[1], a0[3] * c4[1] + a0[2] * s4[1]};
                        const f32x4 o1 = (f32x4){a1[0] * c4[2] - a1[1] * s4[2], a1[1] * c4[2] + a1[0] * s4[2], a1[2] * c4[3] - a1[3] * s4[3], a1[3] * c4[3] + a1[2] * s4[3]};
                        *(u32x4*)(KPE + r * 32 + 8 * fq) = pack8(o0, o1); }
                    else if (fq == 0) { *(f32x4*)(WI + r * 8) = a0; *(f32x4*)(WI + r * 8 + 4) = a1; }
                }
                else { bf16_t* p = G + r * 2048 + (pn - 8) * 256 + c32; *(u32x4*)p = pack8(sigm4(a0), sigm4(a1)); *(u32x4*)(p + HALF) = pack8(sigm4(b0), sigm4(b1)); }
            }
    }
};
struct EpiUpQ {
    static constexpr bool PERM = true, AFTER_DRAIN = false;
    bf16_t* QB; const float* ssq; const float *rcos, *rsin;
    __device__ __forceinline__ void operator()(const f32x4 (&acc)[2][2][4][2], const Unit& u, int wr, int wc, int fr, int fq) const {
        const int row0 = u.pm * BM + wr * 64 + fr;
#pragma unroll
        for (int ai = 0; ai < 2; ++ai)
#pragma unroll
            for (int m = 0; m < 4; ++m) {
                const size_t r = (size_t)(row0 + ai * HALF + m * 16);
                const f32x4 pa = *(const f32x4*)(ssq + r * 8), pb = *(const f32x4*)(ssq + r * 8 + 4);
                const float rs = __builtin_amdgcn_rsqf((((pa[0] + pa[1]) + (pa[2] + pa[3])) + ((pb[0] + pb[1]) + (pb[2] + pb[3]))) * (1.f / 384.f) + EPS_RMS) * QSCALE;
#pragma unroll
                for (int bj = 0; bj < 2; ++bj) {
                    const int c = u.pn * BM + bj * HALF + wc * 32 + 8 * fq;
                    const bool pe = ((u.pn * 8 + bj * 4 + wc) % 3) == 2;
                    f32x4 v0 = acc[ai][bj][m][0] * rs, v1 = acc[ai][bj][m][1] * rs;
                    if (pe) { const int i0 = 4 * fq;
                        const f32x4 c4 = *(const f32x4*)(rcos + r * 16 + i0), s4 = *(const f32x4*)(rsin + r * 16 + i0);
                        const f32x4 o0 = (f32x4){v0[0] * c4[0] - v0[1] * s4[0], v0[1] * c4[0] + v0[0] * s4[0], v0[2] * c4[1] - v0[3] * s4[1], v0[3] * c4[1] + v0[2] * s4[1]};
                        const f32x4 o1 = (f32x4){v1[0] * c4[2] - v1[1] * s4[2], v1[1] * c4[2] + v1[0] * s4[2], v1[2] * c4[3] - v1[3] * s4[3], v1[3] * c4[3] + v1[2] * s4[3]};
                        v0 = o0; v1 = o1; }
                    *(u32x4*)(QB + r * 768 + c) = pack8(v0, v1); }
                asm volatile("" ::: "memory"); }
    }
};
struct EpiUpKV {
    static constexpr bool PERM = true, AFTER_DRAIN = false;
    bf16_t *KN, *VB; const float* ssq;
    __device__ __forceinline__ void operator()(const f32x4 (&acc)[2][2][4][2], const Unit& u, int wr, int wc, int fr, int fq) const {
        const int row0 = u.pm * BM + wr * 64 + fr; bf16_t* dst = (u.pn < 2) ? KN : VB; const int c0 = (u.pn & 1) * BM + wc * 32 + 8 * fq;
#pragma unroll
        for (int ai = 0; ai < 2; ++ai)
#pragma unroll
            for (int m = 0; m < 4; ++m) {
                const size_t r = (size_t)(row0 + ai * HALF + m * 16);
                const f32x4 pa = *(const f32x4*)(ssq + r * 8), pb = *(const f32x4*)(ssq + r * 8 + 4);
                const float rs = __builtin_amdgcn_rsqf((((pa[0] + pa[1]) + (pa[2] + pa[3])) + ((pb[0] + pb[1]) + (pb[2] + pb[3]))) * (1.f / 256.f) + EPS_RMS);
#pragma unroll
                for (int bj = 0; bj < 2; ++bj) *(u32x4*)(dst + r * 512 + c0 + bj * HALF) = pack8(acc[ai][bj][m][0] * rs, acc[ai][bj][m][1] * rs);
                asm volatile("" ::: "memory"); }
    }
};
template <bool ADD> struct EpiGate {
    static constexpr bool PERM = true, AFTER_DRAIN = false;
    const bf16_t* G; int goff; const bf16_t* Yin; bf16_t* Y;
    __device__ __forceinline__ void operator()(const f32x4 (&acc)[2][2][4][2], const Unit& u, int wr, int wc, int fr, int fq) const {
        const int row0 = u.pm * BM + wr * 64 + fr, c0 = u.pn * BM + wc * 32 + 8 * fq;
#pragma unroll
        for (int ai = 0; ai < 2; ++ai)
#pragma unroll
            for (int m = 0; m < 4; ++m) {
                const size_t r = (size_t)(row0 + ai * HALF + m * 16);
#pragma unroll
                for (int bj = 0; bj < 2; ++bj) { const int c = c0 + bj * HALF;
                    f32x4 g0, g1; unpack8(*(const u32x4*)(G + r * 2048 + goff + c), g0, g1);
                    f32x4 v0 = g0 * acc[ai][bj][m][0], v1 = g1 * acc[ai][bj][m][1];
                    if (ADD) { f32x4 y0, y1; unpack8(*(const u32x4*)(Yin + r * 1024 + c), y0, y1); v0 += y0; v1 += y1; }
                    *(u32x4*)(Y + r * 1024 + c) = pack8(v0, v1); } }
    }
};

template <class Epi, class Sched, bool ALIGN_EPI = false, bool SP2 = false>
__device__ __forceinline__ void gemm_phase(PG8_LAS unsigned char* lds, const Gemm g, const Sched& S, const Epi& E) {
    const int tid = threadIdx.x, wid = __builtin_amdgcn_readfirstlane(tid >> 6), lane = tid & 63, wr = wid >> 2, wc = wid & 3, fr = lane & 15, fq = lane >> 4;
    const int K = g.K, nt = K / BK;
    unsigned voffA[2], voffB[2];
#pragma unroll
    for (int i = 0; i < 2; ++i) { int R, C; stage_rc(tid * 16 + i * 8192, R, C); const int Rb = Epi::PERM ? ((R & ~31) + perm32(R & 31)) : R;
        voffA[i] = (unsigned)(R * K + C) * 2u; voffB[i] = (unsigned)(Rb * K + C) * 2u; }
    const size_t kstep = (size_t)(BK * 2);
    const size_t hstep = (size_t)HALF * K * 2;
    const size_t tstep = 2 * hstep;
    const unsigned ldsw = (unsigned)wid * 1024u;
    const int aoff = lds_byte(wr * 64 + fr, fq * 8), boff = lds_byte(wc * 32 + fr, fq * 8);
#define PG8_SA(b, h) (((b) * 2 + (h)) * HTB)
#define PG8_SB(b, h) ((4 + (b) * 2 + (h)) * HTB)
#define PG8_STAGE(bufoff, gbase, voff) do { _Pragma("unroll") for (int _i = 0; _i < 2; ++_i) \
        __builtin_amdgcn_global_load_lds((const unsigned*)((const char*)(gbase) + (voff)[_i]), (PG8_LAS unsigned*)(lds + (bufoff) + ldsw + _i * 8192), 16, 0, 0); } while (0)
#define PG8_LDA(dst, b, h) do { _Pragma("unroll") for (int m = 0; m < 4; ++m) _Pragma("unroll") for (int k = 0; k < 2; ++k) dst[m][k] = *(const PG8_LAS bf16x8*)(lds + PG8_SA(b, h) + aoff + m * 2048 + k * 1024); } while (0)
#define PG8_LDB(dst, b, h) do { _Pragma("unroll") for (int n = 0; n < 2; ++n) _Pragma("unroll") for (int k = 0; k < 2; ++k) dst[n][k] = *(const PG8_LAS bf16x8*)(lds + PG8_SB(b, h) + boff + n * 2048 + k * 1024); } while (0)
#define PG8_MMA(ai, bj, At, Bt) do { __builtin_amdgcn_s_setprio(1); _Pragma("unroll") for (int m = 0; m < 4; ++m) _Pragma("unroll") for (int n = 0; n < 2; ++n) _Pragma("unroll") for (int k = 0; k < 2; ++k) \
        acc[ai][bj][m][n] = __builtin_amdgcn_mfma_f32_16x16x32_bf16(Bt[n][k], At[m][k], acc[ai][bj][m][n], 0, 0, 0); __builtin_amdgcn_s_setprio(0); } while (0)
#define PG8_WAIT_V(n) asm volatile("s_waitcnt vmcnt(" #n ")" ::: "memory")
#define PG8_WAIT_L(n) asm volatile("s_waitcnt lgkmcnt(" #n ")" ::: "memory")
#define PG8_BAR __builtin_amdgcn_s_barrier()
#define PG8_SCHED __builtin_amdgcn_sched_barrier(0)
    Unit cur, nxt; int ui = 0;
    if (!S.next(0, cur)) return;
    f32x4 acc[2][2][4][2];
#pragma unroll
    for (int a = 0; a < 2; ++a)
#pragma unroll
        for (int b = 0; b < 2; ++b)
#pragma unroll
            for (int m = 0; m < 4; ++m)
#pragma unroll
                for (int n = 0; n < 2; ++n) acc[a][b][m][n] = (f32x4){0.f, 0.f, 0.f, 0.f};
    bf16x8 At[4][2], B0[2][2], B1[2][2];
    const char* cA = (const char*)g.A + (size_t)cur.pm * tstep; const char* cB = (const char*)g.Bt + (size_t)cur.pn * tstep;
    S.a_ready(cur);
    if constexpr (SP2) {
        PG8_STAGE(PG8_SB(0, 0), cB, voffB); PG8_STAGE(PG8_SB(0, 1), cB + hstep, voffB); PG8_STAGE(PG8_SA(0, 0), cA, voffA); PG8_STAGE(PG8_SA(0, 1), cA + hstep, voffA);
        if (wr == 1) PG8_BAR;
        PG8_WAIT_V(2); PG8_BAR;
        PG8_STAGE(PG8_SB(1, 0), cB + kstep, voffB); PG8_STAGE(PG8_SA(1, 0), cA + kstep, voffA); PG8_STAGE(PG8_SB(1, 1), cB + hstep + kstep, voffB);
        PG8_WAIT_V(6); PG8_BAR;
    } else {
        PG8_STAGE(PG8_SB(0, 0), cB, voffB); PG8_STAGE(PG8_SA(0, 0), cA, voffA); PG8_STAGE(PG8_SB(0, 1), cB + hstep, voffB); PG8_STAGE(PG8_SA(0, 1), cA + hstep, voffA);
        if (wr == 1) PG8_BAR;
        PG8_WAIT_V(4); PG8_BAR;
        PG8_STAGE(PG8_SB(1, 0), cB + kstep, voffB); PG8_STAGE(PG8_SA(1, 0), cA + kstep, voffA); PG8_STAGE(PG8_SB(1, 1), cB + hstep + kstep, voffB);
        PG8_WAIT_V(6); PG8_BAR;
    }
    for (;;) {
        const bool has_next = S.next(ui + 1, nxt);
        const char* nA = has_next ? (const char*)g.A + (size_t)nxt.pm * tstep : cA; const char* nB = has_next ? (const char*)g.Bt + (size_t)nxt.pn * tstep : cB;
#pragma nounroll
        for (int t = 0; t < nt; t += 2) {
            const bool last = (t == nt - 2);
            const char* a1 = cA + (size_t)(t + 1) * kstep;
            const char* a2 = last ? nA : cA + (size_t)(t + 2) * kstep; const char* b2 = last ? nB : cB + (size_t)(t + 2) * kstep;
            const char* a3 = a2 + kstep; const char* b3 = b2 + kstep;
            if (last && has_next) S.a_ready(nxt);
            if constexpr (SP2) {
            PG8_LDB(B0, 0, 0); PG8_LDB(B1, 0, 1); PG8_SCHED; PG8_LDA(At, 0, 0); PG8_STAGE(PG8_SA(1, 1), a1 + hstep, voffA);
            PG8_WAIT_V(8); PG8_WAIT_L(0); PG8_BAR; PG8_MMA(0, 0, At, B0); PG8_MMA(0, 1, At, B1); PG8_BAR; PG8_SCHED;
            PG8_LDA(At, 0, 1); PG8_STAGE(PG8_SB(0, 0), b2, voffB); PG8_STAGE(PG8_SB(0, 1), b2 + hstep, voffB); PG8_STAGE(PG8_SA(0, 0), a2, voffA);
            PG8_WAIT_V(8); PG8_WAIT_L(0); PG8_BAR; PG8_MMA(1, 0, At, B0); PG8_MMA(1, 1, At, B1); PG8_BAR; PG8_SCHED;
            PG8_LDB(B0, 1, 0); PG8_LDB(B1, 1, 1); PG8_SCHED; PG8_LDA(At, 1, 0); PG8_STAGE(PG8_SA(0, 1), a2 + hstep, voffA);
            PG8_WAIT_V(8); PG8_WAIT_L(0); PG8_BAR; PG8_MMA(0, 0, At, B0); PG8_MMA(0, 1, At, B1); PG8_BAR; PG8_SCHED;
            PG8_LDA(At, 1, 1); PG8_STAGE(PG8_SB(1, 0), b3, voffB); PG8_STAGE(PG8_SB(1, 1), b3 + hstep, voffB); PG8_STAGE(PG8_SA(1, 0), a3, voffA);
            PG8_WAIT_V(8); PG8_WAIT_L(0); PG8_BAR; PG8_MMA(1, 0, At, B0); PG8_MMA(1, 1, At, B1); PG8_BAR; PG8_SCHED;
            } else {
            PG8_LDB(B0, 0, 0); PG8_SCHED; PG8_LDA(At, 0, 0); PG8_STAGE(PG8_SA(1, 1), a1 + hstep, voffA);
            PG8_WAIT_L(8); PG8_BAR; PG8_WAIT_L(0); PG8_MMA(0, 0, At, B0); PG8_BAR; PG8_SCHED;
            PG8_LDB(B1, 0, 1); PG8_STAGE(PG8_SB(0, 0), b2, voffB);
            PG8_BAR; PG8_WAIT_L(0); PG8_MMA(0, 1, At, B1); PG8_BAR;
            PG8_LDA(At, 0, 1); PG8_STAGE(PG8_SA(0, 0), a2, voffA);
            PG8_BAR; PG8_WAIT_L(0); PG8_MMA(1, 0, At, B0); PG8_BAR; PG8_SCHED;
            PG8_STAGE(PG8_SB(0, 1), b2 + hstep, voffB);
            PG8_WAIT_V(6); PG8_BAR; PG8_MMA(1, 1, At, B1); PG8_BAR;
            PG8_LDB(B0, 1, 0); PG8_SCHED; PG8_LDA(At, 1, 0); PG8_STAGE(PG8_SA(0, 1), a2 + hstep, voffA);
            PG8_WAIT_L(8); PG8_BAR; PG8_WAIT_L(0); PG8_MMA(0, 0, At, B0); PG8_BAR; PG8_SCHED;
            PG8_LDB(B1, 1, 1); PG8_STAGE(PG8_SB(1, 0), b3, voffB);
            PG8_BAR; PG8_WAIT_L(0); PG8_MMA(0, 1, At, B1); PG8_BAR;
            PG8_LDA(At, 1, 1); PG8_STAGE(PG8_SA(1, 0), a3, voffA);
            PG8_BAR; PG8_WAIT_L(0); PG8_MMA(1, 0, At, B0); PG8_BAR; PG8_SCHED;
            PG8_STAGE(PG8_SB(1, 1), b3 + hstep, voffB);
            PG8_WAIT_V(6); PG8_BAR; PG8_MMA(1, 1, At, B1); PG8_BAR;
            }
        }
        if constexpr (ALIGN_EPI) { if (wr == 0) PG8_BAR; }
        if constexpr (!Epi::AFTER_DRAIN) { E(acc, cur, wr, wc, fr, fq); S.done(cur); }
        if (!has_next) break;
#pragma unroll
        for (int a = 0; a < 2; ++a)
#pragma unroll
            for (int b = 0; b < 2; ++b)
#pragma unroll
                for (int m = 0; m < 4; ++m)
#pragma unroll
                    for (int n = 0; n < 2; ++n) acc[a][b][m][n] = (f32x4){0.f, 0.f, 0.f, 0.f};
        cur = nxt; cA = nA; cB = nB; ++ui;
        if constexpr (ALIGN_EPI) { if (wr == 1) PG8_BAR; }
    }
    PG8_WAIT_V(0);
    if constexpr (!ALIGN_EPI) { if (wr == 0) PG8_BAR; }
    PG8_BAR;
    if constexpr (Epi::AFTER_DRAIN) { E.fused(acc, cur, wr, wc, fr, fq, lds, wid, lane); S.done(cur); }
#undef PG8_SA
#undef PG8_SB
#undef PG8_STAGE
#undef PG8_LDA
#undef PG8_LDB
#undef PG8_MMA
#undef PG8_WAIT_V
#undef PG8_WAIT_L
#undef PG8_BAR
#undef PG8_SCHED
}
}

constexpr int NWAVES = 8;
constexpr int BATCH = 4, T = 8192, D = 1024, DFF = 2816, M = BATCH * T;
constexpr int INC = 3944, NPROJ = 4096;
constexpr int O_QA = 0, O_KA = 512, O_VA = 576, O_QI = 640, O_KI = 1152, O_WI = 1216, O_CQ = 1224, O_CKV = 1608, O_KR = 1864, O_GATE = 1896;
constexpr float EPS = 1e-6f;
#ifndef MK_FUSED
#define MK_FUSED 1
#endif

constexpr size_t MiB = 1u << 20;
constexpr size_t WS_CTL = 0, CTL_ZERO_BYTES = 2 * MiB;
constexpr size_t WS_MOD = 256 * 1024;
constexpr size_t WS_SSQQ = 49 * MiB, WS_SSQKV = 50 * MiB;
constexpr size_t WS_W1A = 2 * MiB, SZ_WA = (size_t)2 * DFF * D * 2, SZ_WD = (size_t)D * DFF * 2;
constexpr size_t WS_W1D = WS_W1A + SZ_WA, WS_WIN = WS_W1D + SZ_WD, WS_WUQ = WS_WIN + (size_t)NPROJ * D * 2, WS_WUKV = WS_WUQ + (size_t)768 * 384 * 2;
constexpr size_t WS_WOA = WS_WUKV + (size_t)1024 * 256 * 2, WS_WOB = WS_WOA + (size_t)D * 512 * 2, WS_WOUT = WS_WOB + (size_t)D * 512 * 2;
constexpr size_t WS_W2A = WS_WOUT + (size_t)D * D * 2, WS_W2D = WS_W2A + SZ_WA, WS_WEND = WS_W2D + SZ_WD;
static_assert(WS_WEND <= 49 * MiB, "weights");
constexpr size_t WS_RCOS = 51 * MiB, WS_RSIN = 53 * MiB;
constexpr size_t WS_XN = 55 * MiB;
constexpr size_t WS_ACT = 119 * MiB;
constexpr size_t WS_QA = WS_ACT, WS_QI = WS_QA + 32 * MiB, WS_CQ = WS_QI + 32 * MiB, WS_CKV = WS_CQ + 24 * MiB, WS_KA = WS_CKV + 16 * MiB, WS_VA = WS_KA + 4 * MiB;
constexpr size_t WS_KI = WS_VA + 4 * MiB, WS_KPE = WS_KI + 4 * MiB, WS_WI = WS_KPE + 2 * MiB, WS_QB = WS_WI + 1 * MiB, WS_MIXEND = WS_QB + 48 * MiB;
static_assert(WS_MIXEND <= WS_ACT + 176 * MiB, "mixer overlay");
constexpr size_t WS_G = 295 * MiB;
constexpr size_t WS_KN = 423 * MiB, WS_VB = 455 * MiB;
constexpr size_t WS_SEL = 487 * MiB;
constexpr size_t WS_END = 503 * MiB;
static_assert(WS_XN + 64 * MiB <= WS_ACT && WS_ACT + 176 * MiB <= WS_G && WS_G + 128 * MiB <= WS_KN && WS_VB + 32 * MiB <= WS_SEL, "d_ws map");
constexpr size_t WS_OA = WS_CQ, WS_OB = WS_QI, WS_Y1 = WS_KN, WS_Y = WS_XN;
constexpr int CW_TMO = 0, CW_CODE = 1, CW_BAR = 4096;

constexpr int RING_OFF = 0, RING_BYTES = 151552;
constexpr int LDSCTL_OFF = RING_BYTES, MISC_OFF = LDSCTL_OFF + 320;
constexpr int LDS_BYTES = RING_BYTES + 1024;
#ifndef PROF_SEL
#define PROF_SEL 0
#endif
#ifndef PROF_MULT
#define PROF_MULT 4
#endif
#define PROF_WORD(ldsring, wid_) ((LAS unsigned*)((ldsring) + (MISC_OFF - RING_OFF) + 64) + (wid_))
#define PROF_T0(id) unsigned long long pt_##id = 0ull; if (PROF_SEL == (id)) pt_##id = __builtin_amdgcn_s_memrealtime()
#define PROF_T1(id, ldsring, wid_, lane_) do { if (PROF_SEL == (id)) { const unsigned d_ = (unsigned)(__builtin_amdgcn_s_memrealtime() - pt_##id); if ((lane_) == 0) *PROF_WORD(ldsring, wid_) += d_; } } while (0)
#define GAS __attribute__((address_space(1)))
#define LAS __attribute__((address_space(3)))
typedef unsigned short bf16;
typedef unsigned v4u __attribute__((ext_vector_type(4)));
typedef float f32x4 __attribute__((ext_vector_type(4)));
typedef short bf16x8 __attribute__((ext_vector_type(8)));
typedef GAS unsigned gu32;
typedef GAS unsigned long long gu64;
#define RLX_AGENT __ATOMIC_RELAXED, __HIP_MEMORY_SCOPE_AGENT
#define LDS_WAIT() asm volatile("s_waitcnt lgkmcnt(0)" ::: "memory")
#define VM_WAIT() asm volatile("s_waitcnt vmcnt(0)" ::: "memory")
__device__ __forceinline__ unsigned long long rt() { return __builtin_amdgcn_s_memrealtime(); }
__device__ __forceinline__ unsigned f2bf(float f) { unsigned u = __builtin_bit_cast(unsigned, f); return (u + 0x7fffu + ((u >> 16) & 1u)) >> 16; }
__device__ __forceinline__ unsigned pk2(float lo, float hi) { return f2bf(lo) | (f2bf(hi) << 16); }

#define XB_TMO      128
#define XB_XCNT(j)  (256  + 64 * (j))
#define XB_XSUB(j)  (1280 + 64 * (j))
#define XB_XGEN(j)  (2304 + 64 * (j))
#define XB_TOP      3328
#define XB_TOPGEN   3392
#define XCD_BAR_WORDS 3456
#define XB_SPIN_CAP (1u << 18)

__device__ __forceinline__ unsigned xb_ld(unsigned* p)              { return __hip_atomic_load(p, __ATOMIC_RELAXED, __HIP_MEMORY_SCOPE_AGENT); }
__device__ __forceinline__ unsigned xb_add(unsigned* p, unsigned v) { return __hip_atomic_fetch_add(p, v, __ATOMIC_RELAXED, __HIP_MEMORY_SCOPE_AGENT); }
__device__ __forceinline__ unsigned xb_xcc_id() { return (unsigned)__builtin_amdgcn_s_getreg((3 << 11) | 20) & 0xFu; }
#define XB_SPIN(cond, bar) do { unsigned _sp = 0; while (cond) { __builtin_amdgcn_s_sleep(1); \
    if ((++_sp & 255u) == 0u) { if (xb_ld(&(bar)[XB_TMO])) break; if (_sp > XB_SPIN_CAP) { atomicAdd(&(bar)[XB_TMO], 1u); break; } } } } while (0)

struct XcdBarrier {
    unsigned* bar; unsigned x;
    volatile LAS unsigned* st;
};

__device__ __forceinline__ XcdBarrier xcd_barrier_post(unsigned* bar, volatile LAS unsigned* st) {
    XcdBarrier b; b.bar = bar; b.x = xb_xcc_id(); b.st = st;
    if (threadIdx.x == 0) (void)xb_add(&bar[XB_XCNT(b.x)], 1u);
    return b;
}
__device__ __forceinline__ void xcd_barrier_complete(unsigned* bar, unsigned x, unsigned& nloc, unsigned& nx) {
    const unsigned G = gridDim.x * gridDim.y * gridDim.z;
    unsigned sum, cnt, mine, sp = 0u;
    for (;;) {
        sum = 0u; cnt = 0u; mine = 0u;
#pragma unroll
        for (unsigned j = 0; j < 16; ++j) { const unsigned c = xb_ld(&bar[XB_XCNT(j)]); sum += c; cnt += (c > 0u) ? 1u : 0u; mine = (j == x) ? c : mine; }
        if (sum == G) break;
        __builtin_amdgcn_s_sleep(1);
        if ((++sp & 255u) == 0u) { if (xb_ld(&bar[XB_TMO])) break; if (sp > XB_SPIN_CAP) { atomicAdd(&bar[XB_TMO], 1u); break; } }
    }
    nloc = mine > 0u ? mine : 1u; nx = cnt > 0u ? cnt : 1u;
}

__device__ __forceinline__ void xcd_barrier(const XcdBarrier& b) {
    asm volatile("s_waitcnt vmcnt(0)" ::: "memory");
    __syncthreads();
    if (threadIdx.x == 0) {
        unsigned* bar = b.bar;
        __builtin_amdgcn_s_waitcnt(0);
        unsigned nloc = b.st[0], nx = b.st[1];
        if (nloc == 0u) { xcd_barrier_complete(bar, b.x, nloc, nx); b.st[0] = nloc; b.st[1] = nx; }
        const unsigned old = xb_add(&bar[XB_XSUB(b.x)], 1u);
        const unsigned gen = old / nloc;
        if (old + 1u == (gen + 1u) * nloc) {
            __builtin_amdgcn_fence(__ATOMIC_RELEASE, "agent");
            asm volatile("s_waitcnt vmcnt(0)" ::: "memory");
            const unsigned og = xb_add(&bar[XB_TOP], 1u);
            const unsigned tg = og / nx;
            if (og + 1u == (tg + 1u) * nx) xb_add(&bar[XB_TOPGEN], 1u);
            else XB_SPIN(xb_ld(&bar[XB_TOPGEN]) == tg, bar);
            __builtin_amdgcn_fence(__ATOMIC_ACQUIRE, "agent");
            xb_add(&bar[XB_XGEN(b.x)], 1u);
            asm volatile("s_waitcnt vmcnt(0)" ::: "memory");
        } else {
            XB_SPIN(xb_ld(&bar[XB_XGEN(b.x)]) == gen, bar);
            __builtin_amdgcn_fence(__ATOMIC_ACQUIRE, "agent");
            asm volatile("s_waitcnt vmcnt(0)" ::: "memory");
        }
    }
    __syncthreads();
}

struct Frame {
    LAS unsigned char* lds;
    volatile LAS unsigned* MISC;
    gu32* ctl;
    int tid, lane, wave;
    int vcu, G;
};
__device__ __forceinline__ float wave_sum(float v) {
#pragma unroll
    for (int o = 1; o < 64; o <<= 1) v += __shfl_xor(v, o);
    return v;
}
struct MapIdent { int off; __device__ __forceinline__ int src(int n) const { return n + off; } };
struct MapFfnIn { __device__ __forceinline__ int src(int n) const { const int pn = n >> 8, j = n & 255; return (j >> 7) * DFF + pn * 128 + (j & 127); } };
struct MapProj { __device__ __forceinline__ int src(int n) const { const int pn = n >> 8, j = n & 255;
    if (pn < 2) return O_QA + n; if (pn < 4) return O_QI + (n - 512); if (pn == 4) return O_CQ + j;
    if (pn == 5) return j < 128 ? O_CQ + 256 + j : O_CKV + (j - 128);
    if (pn == 6) return j < 128 ? O_CKV + 128 + j : (j < 192 ? O_KA + (j - 128) : O_VA + (j - 192));
    if (pn == 7) { if (j < 64) return O_KI + j; if (j < 96) { const int jj = j - 64; return O_KR + (jj >> 1) + 16 * (jj & 1); } if (j < 104) return O_WI + (j - 96); return -1; }
    return O_GATE + (n - 2048); } };
struct MapUq { __device__ __forceinline__ int src(int n) const { const int h = n / 96, w = n % 96; if (w < 64) return n; const int jj = w - 64; return h * 96 + 64 + (jj >> 1) + 16 * (jj & 1); } };
template <class Map> __device__ __forceinline__ void p0_transpose_item(const float* W, int K, int Nsrc, int nblk, const float* kscale, bf16* WT, const Map mp, LAS float* scr, int item, int lane) {
    const int kb = item / nblk, nb = item % nblk, k0 = 64 * kb, n0 = 32 * nb;
    const int sc = mp.src(n0 + (lane & 31));
    float vv[32];
#pragma unroll
    for (int i = 0; i < 32; ++i) { const int kk = 2 * i + (lane >> 5); vv[i] = sc >= 0 ? W[(size_t)(k0 + kk) * Nsrc + sc] : 0.f; }
#pragma unroll
    for (int i = 0; i < 32; ++i) { const int kk = 2 * i + (lane >> 5); float v = vv[i]; if (kscale) v *= kscale[k0 + kk]; scr[kk * 33 + (lane & 31)] = v; }
    LDS_WAIT(); asm volatile("" ::: "memory");
    const int c = lane & 7;
#pragma unroll
    for (int j = 0; j < 4; ++j) { const int n = (lane >> 3) + 8 * j; const LAS float* s = scr + (8 * c) * 33 + n;
        v4u o; o.x = pk2(s[0 * 33], s[1 * 33]); o.y = pk2(s[2 * 33], s[3 * 33]); o.z = pk2(s[4 * 33], s[5 * 33]); o.w = pk2(s[6 * 33], s[7 * 33]);
        *(GAS v4u*)(WT + (size_t)(n0 + n) * K + k0 + 8 * c) = o; }
    LDS_WAIT(); asm volatile("" ::: "memory");
}
struct Args { const void* in[23]; float* out; unsigned char* ws; int ph_lo, ph_hi, li, pad; };

__device__ __forceinline__ void p0_prologue(Frame& F, const Args& A) {
    LAS float* scr = (LAS float*)(F.lds + RING_OFF + F.wave * 16384);
    const int gw = F.vcu * NWAVES + F.wave, NGW = F.G * NWAVES;
    unsigned char* ws = A.ws;
    {
        const float* c = (const float*)A.in[1]; const float* w = (const float*)A.in[3]; const float* bias = (const float*)A.in[4]; float* mod = (float*)(ws + WS_MOD);
        for (int cg = F.vcu; cg < 256; cg += F.G) {
            const bool act = F.lane < 36; const int n = cg * 36 + (act ? F.lane : 0), k0 = F.wave * 128;
#pragma unroll
            for (int b = 0; b < 4; ++b)
#pragma unroll
                for (int h = 0; h < 2; ++h) { const float v = c[b * D + k0 + h * 64 + F.lane]; scr[b * 128 + h * 64 + F.lane] = v / (1.f + __expf(-v)); }
            LDS_WAIT(); asm volatile("" ::: "memory");
            float a0 = 0.f, a1 = 0.f, a2 = 0.f, a3 = 0.f;
#pragma unroll 8
            for (int k = 0; k < 128; ++k) { const float wv = act ? w[(size_t)(k0 + k) * 9216 + n] : 0.f; a0 += scr[k] * wv; a1 += scr[128 + k] * wv; a2 += scr[256 + k] * wv; a3 += scr[384 + k] * wv; }
            scr[1024 + F.lane] = a0; scr[1088 + F.lane] = a1; scr[1152 + F.lane] = a2; scr[1216 + F.lane] = a3;
            __syncthreads();
            if (F.wave < 4 && act) { float t = bias[n];
#pragma unroll
                for (int ww = 0; ww < 8; ++ww) t += ((LAS float*)(F.lds + RING_OFF + ww * 16384))[1024 + F.wave * 64 + F.lane];
                mod[F.wave * 9216 + n] = t; }
            __syncthreads();
        }
    }
    {
        const float* w1a = (const float*)A.in[6]; const float* w1d = (const float*)A.in[7]; const float* win = (const float*)A.in[9]; const float* gcq = (const float*)A.in[10];
        const float* wuq = (const float*)A.in[11]; const float* gckv = (const float*)A.in[12]; const float* wuk = (const float*)A.in[13]; const float* wuv = (const float*)A.in[14];
        const float* woa = (const float*)A.in[16]; const float* wob = (const float*)A.in[17]; const float* wout = (const float*)A.in[18]; const float* w2a = (const float*)A.in[20]; const float* w2d = (const float*)A.in[21];
        constexpr int I_A = 16 * 176, I_D = 44 * 32, I_IN = 16 * 128, I_UQ = 6 * 24, I_UK = 4 * 16, I_O = 8 * 32, I_OUT = 16 * 32;
        constexpr int NITEMS = 2 * I_A + 2 * I_D + I_IN + I_UQ + 2 * I_UK + 2 * I_O + I_OUT;
        for (int it = gw; it < NITEMS; it += NGW) {
            int r = it;
            if (r < I_A) { p0_transpose_item(w1a, D, 2 * DFF, 176, nullptr, (bf16*)(ws + WS_W1A), MapFfnIn{}, scr, r, F.lane); continue; } r -= I_A;
            if (r < I_A) { p0_transpose_item(w2a, D, 2 * DFF, 176, nullptr, (bf16*)(ws + WS_W2A), MapFfnIn{}, scr, r, F.lane); continue; } r -= I_A;
            if (r < I_D) { p0_transpose_item(w1d, DFF, D, 32, nullptr, (bf16*)(ws + WS_W1D), MapIdent{0}, scr, r, F.lane); continue; } r -= I_D;
            if (r < I_D) { p0_transpose_item(w2d, DFF, D, 32, nullptr, (bf16*)(ws + WS_W2D), MapIdent{0}, scr, r, F.lane); continue; } r -= I_D;
            if (r < I_IN) { p0_transpose_item(win, D, INC, 128, nullptr, (bf16*)(ws + WS_WIN), MapProj{}, scr, r, F.lane); continue; } r -= I_IN;
            if (r < I_UQ) { p0_transpose_item(wuq, 384, 768, 24, gcq, (bf16*)(ws + WS_WUQ), MapUq{}, scr, r, F.lane); continue; } r -= I_UQ;
            if (r < I_UK) { p0_transpose_item(wuk, 256, 512, 16, gckv, (bf16*)(ws + WS_WUKV), MapIdent{0}, scr, r, F.lane); continue; } r -= I_UK;
            if (r < I_UK) { p0_transpose_item(wuv, 256, 512, 16, gckv, (bf16*)(ws + WS_WUKV) + (size_t)512 * 256, MapIdent{0}, scr, r, F.lane); continue; } r -= I_UK;
            if (r < I_O) { p0_transpose_item(woa, 512, D, 32, nullptr, (bf16*)(ws + WS_WOA), MapIdent{0}, scr, r, F.lane); continue; } r -= I_O;
            if (r < I_O) { p0_transpose_item(wob, 512, D, 32, nullptr, (bf16*)(ws + WS_WOB), MapIdent{0}, scr, r, F.lane); continue; } r -= I_O;
            p0_transpose_item(wout, D, D, 32, nullptr, (bf16*)(ws + WS_WOUT), MapIdent{0}, scr, r, F.lane);
        }
    }
    {
        const int* pos = (const int*)A.in[2]; float* rc = (float*)(ws + WS_RCOS); float* rs = (float*)(ws + WS_RSIN);
        for (int idx = gw * 64 + F.lane; idx < M * 16; idx += NGW * 64) { const int t = idx >> 4, i = idx & 15;
            const float freq = powf(10000.0f, -2.0f * (float)i / 32.0f); const float ang = (float)pos[t] * freq;
            rc[idx] = cosf(ang); rs[idx] = sinf(ang); }
    }
}
__device__ __forceinline__ void norm_mod_phase(Frame& F, const float* xin, const float* g, const float* mod, int shoff, int scoff, bf16* out) {
    const int gw = F.vcu * NWAVES + F.wave, NGW = F.G * NWAVES;
    for (int m = gw; m < M; m += NGW) {
        const int b = m >> 13;
        const GAS f32x4* xr = (const GAS f32x4*)(xin + (size_t)m * D) + F.lane;
        const GAS f32x4* g4 = (const GAS f32x4*)g + F.lane; const GAS f32x4* sc4 = (const GAS f32x4*)(mod + b * 9216 + scoff) + F.lane; const GAS f32x4* sh4 = (const GAS f32x4*)(mod + b * 9216 + shoff) + F.lane;
        f32x4 v[4]; float s = 0.f;
#pragma unroll
        for (int j = 0; j < 4; ++j) { v[j] = xr[64 * j]; s += (v[j].x * v[j].x + v[j].y * v[j].y) + (v[j].z * v[j].z + v[j].w * v[j].w); }
        const float rs = __builtin_amdgcn_rsqf(wave_sum(s) * (1.f / D) + EPS);
        GAS unsigned long long* o8 = (GAS unsigned long long*)(out + (size_t)m * D) + F.lane;
#pragma unroll
        for (int j = 0; j < 4; ++j) { const f32x4 o = v[j] * rs * g4[64 * j] * (sc4[64 * j] + 1.f) + sh4[64 * j];
            o8[64 * j] = (unsigned long long)pk2(o.x, o.y) | ((unsigned long long)pk2(o.z, o.w) << 32); }
    }
}
__device__ __forceinline__ void final_norm_phase(Frame& F, const float* xin, const float* g, float* out) {
    const int gw = F.vcu * NWAVES + F.wave, NGW = F.G * NWAVES;
    for (int m = gw; m < M; m += NGW) {
        const GAS f32x4* xr = (const GAS f32x4*)(xin + (size_t)m * D) + F.lane; const GAS f32x4* g4 = (const GAS f32x4*)g + F.lane;
        f32x4 v[4]; float s = 0.f;
#pragma unroll
        for (int j = 0; j < 4; ++j) { v[j] = xr[64 * j]; s += (v[j].x * v[j].x + v[j].y * v[j].y) + (v[j].z * v[j].z + v[j].w * v[j].w); }
        const float rs = __builtin_amdgcn_rsqf(wave_sum(s) * (1.f / D) + EPS);
        GAS f32x4* o4 = (GAS f32x4*)(out + (size_t)m * D) + F.lane;
#pragma unroll
        for (int j = 0; j < 4; ++j) o4[64 * j] = v[j] * rs * g4[64 * j];
    }
}

namespace mla {
typedef unsigned u32x4 __attribute__((ext_vector_type(4)));
typedef short bf16x8 __attribute__((ext_vector_type(8)));
typedef short s16x4 __attribute__((ext_vector_type(4)));
typedef float f32x16 __attribute__((ext_vector_type(16)));
constexpr int KSLOT = 12288, VSLOT = 8192;
constexpr int L_K = 0, L_V = 3 * KSLOT, L_WS = L_V + 3 * VSLOT, L_OST = L_WS + 2048, L_END = L_OST + 8 * 4096;
static_assert(L_END <= RING_BYTES, "attention LDS");
__device__ __forceinline__ int crow(int r, int hi) { return (r & 3) + 8 * (r >> 2) + 4 * hi; }
__device__ __forceinline__ float xhalf(float v) { return __shfl_xor(v, 32); }
__device__ __forceinline__ void pv(f32x16* o, int vb, bf16x8 pa0, bf16x8 pa1, bf16x8 pa2, bf16x8 pa3) {
#pragma unroll
    for (int d0 = 0; d0 < 2; ++d0) { s16x4 lo[4], hi[4];
#pragma unroll
        for (int ks = 0; ks < 4; ++ks) {
            asm volatile("ds_read_b64_tr_b16 %0,%1 offset:%c2" : "=&v"(lo[ks]) : "v"(vb), "i"(d0 * 4096 + ks * 1024) : "memory");
            asm volatile("ds_read_b64_tr_b16 %0,%1 offset:%c2" : "=&v"(hi[ks]) : "v"(vb), "i"(d0 * 4096 + ks * 1024 + 512) : "memory"); }
        asm volatile("s_waitcnt lgkmcnt(0)" ::: "memory"); __builtin_amdgcn_sched_barrier(0);
#define MLA_PK(k) (bf16x8){lo[k][0], lo[k][1], lo[k][2], lo[k][3], hi[k][0], hi[k][1], hi[k][2], hi[k][3]}
        o[d0] = __builtin_amdgcn_mfma_f32_32x32x16_bf16(pa0, MLA_PK(0), o[d0], 0, 0, 0);
        o[d0] = __builtin_amdgcn_mfma_f32_32x32x16_bf16(pa1, MLA_PK(1), o[d0], 0, 0, 0);
        o[d0] = __builtin_amdgcn_mfma_f32_32x32x16_bf16(pa2, MLA_PK(2), o[d0], 0, 0, 0);
        o[d0] = __builtin_amdgcn_mfma_f32_32x32x16_bf16(pa3, MLA_PK(3), o[d0], 0, 0, 0);
#undef MLA_PK
    }
}
__device__ __forceinline__ void attn_unit(int b, int h, int qb, const bf16* QB, const bf16* KN, const bf16* KPE, const bf16* VB, bf16* OB, LAS unsigned char* lds) {
    const int tid = threadIdx.x, lane = tid & 63, r32 = lane & 31, hi = lane >> 5; const int wid = __builtin_amdgcn_readfirstlane(tid >> 6);
    const size_t rowbase = (size_t)b * T; const int q0 = qb * 256;
    const int NT = 4 * (qb + 1), my_last = 4 * qb + (wid >> 1);
    LAS float* wsf = (LAS float*)(lds + L_WS) + wid * 64;
#define MLA_DMA(t, slot) do { const size_t krow_ = rowbase + (size_t)(t) * 64 + lane; \
        __builtin_amdgcn_global_load_lds((const unsigned*)(KN + krow_ * 512 + h * 64 + wid * 8), (LAS unsigned*)(lds + L_K + (slot) * KSLOT + wid * 1024), 16, 0, 0); \
        if (wid < 4) __builtin_amdgcn_global_load_lds((const unsigned*)(KPE + krow_ * 32 + wid * 8), (LAS unsigned*)(lds + L_K + (slot) * KSLOT + (8 + wid) * 1024), 16, 0, 0); \
        const size_t vrow_ = rowbase + (size_t)(t) * 64 + 16 * (wid & 3) + (lane >> 2); \
        __builtin_amdgcn_global_load_lds((const unsigned*)(VB + vrow_ * 512 + h * 64 + (wid >> 2) * 32 + (lane & 3) * 8), (LAS unsigned*)(lds + L_V + (slot) * VSLOT + wid * 1024), 16, 0, 0); } while (0)
    bf16x8 qr[6];
    { const bf16* Qw = QB + (rowbase + q0 + wid * 32 + r32) * 768 + h * 96 + hi * 8;
#pragma unroll
      for (int d0 = 0; d0 < 6; ++d0) qr[d0] = *(const bf16x8*)(Qw + d0 * 16); }
    MLA_DMA(0, 0); MLA_DMA(1, 1);
    int slot = 0, slot2 = 2;
    float m = 0.f, l = 0.f; f32x16 o[2], negm;
#pragma unroll
    for (int r = 0; r < 16; ++r) { o[0][r] = 0.f; o[1][r] = 0.f; negm[r] = 0.f; }
    const int kofs = hi * 1024 + r32 * 16;
    const int vb0 = (int)(unsigned)(uintptr_t)(lds + L_V) + ((lane >> 4) & 1) * 32 + (lane & 3) * 8 + (4 * hi + ((lane & 15) >> 2)) * 64;
    for (int t = 0; t < NT; ++t) {
        if (t + 1 < NT) { if (wid < 4) asm volatile("s_waitcnt vmcnt(3) lgkmcnt(0)\n\ts_barrier" ::: "memory"); else asm volatile("s_waitcnt vmcnt(2) lgkmcnt(0)\n\ts_barrier" ::: "memory"); }
        else asm volatile("s_waitcnt vmcnt(0) lgkmcnt(0)\n\ts_barrier" ::: "memory");
        if (t + 2 < NT) MLA_DMA(t + 2, slot2);
        const int cslot = slot; slot = (slot == 2) ? 0 : slot + 1; slot2 = (slot2 == 2) ? 0 : slot2 + 1;
        if (t <= my_last) {
            const int slot = cslot;
            const LAS unsigned char* kb = lds + L_K + slot * KSLOT + kofs;
            f32x16 p0, p1;
#pragma unroll
            for (int d0 = 0; d0 < 6; ++d0) {
                const bf16x8 b0 = *(const LAS bf16x8*)(kb + d0 * 2048), b1 = *(const LAS bf16x8*)(kb + d0 * 2048 + 512);
                if (d0 == 0) { p0 = __builtin_amdgcn_mfma_f32_32x32x16_bf16(b0, qr[0], negm, 0, 0, 0); p1 = __builtin_amdgcn_mfma_f32_32x32x16_bf16(b1, qr[0], negm, 0, 0, 0); }
                else { p0 = __builtin_amdgcn_mfma_f32_32x32x16_bf16(b0, qr[d0], p0, 0, 0, 0); p1 = __builtin_amdgcn_mfma_f32_32x32x16_bf16(b1, qr[d0], p1, 0, 0, 0); } }
#define MLA_MX3(a, b, c) __builtin_fmaxf(__builtin_fmaxf((a), (b)), (c))
            float ra = MLA_MX3(p0[0], p0[1], p1[0]), rb = MLA_MX3(p0[2], p0[3], p1[1]); ra = MLA_MX3(ra, p1[2], p1[3]);
#pragma unroll
            for (int r = 4; r < 16; r += 4) { ra = MLA_MX3(ra, p0[r], p0[r + 1]); rb = MLA_MX3(rb, p0[r + 2], p0[r + 3]); ra = MLA_MX3(ra, p1[r], p1[r + 1]); rb = MLA_MX3(rb, p1[r + 2], p1[r + 3]); }
#undef MLA_MX3
            float rm = __builtin_fmaxf(ra, rb);
            rm = __builtin_fmaxf(rm, xhalf(rm));
            if (t == 0 || __any(rm > 0.f)) {
                const float dl = (t == 0) ? rm : __builtin_fmaxf(rm, 0.f), f = __builtin_amdgcn_exp2f(-dl);
                m += dl; l *= f;
#pragma unroll
                for (int r = 0; r < 16; ++r) { p0[r] -= dl; p1[r] -= dl; negm[r] = -m; }
                if (t != 0) {
                    if (hi == 0) wsf[r32] = f;
                    asm volatile("s_waitcnt lgkmcnt(0)" ::: "memory");
#pragma unroll
                    for (int r = 0; r < 16; ++r) { const float fr_ = wsf[crow(r, hi)]; o[0][r] *= fr_; o[1][r] *= fr_; }
                }
            }
            float sacc = 0.f;
#pragma unroll
            for (int r = 0; r < 16; ++r) { p0[r] = __builtin_amdgcn_exp2f(p0[r]); p1[r] = __builtin_amdgcn_exp2f(p1[r]); sacc += p0[r] + p1[r]; }
            l += sacc;
            u32x4 pw0, pw1, pw2, pw3;
            pw0 = (u32x4){pg8::cvt_pk_bf16(p0[0], p0[1]), pg8::cvt_pk_bf16(p0[2], p0[3]), pg8::cvt_pk_bf16(p0[4], p0[5]), pg8::cvt_pk_bf16(p0[6], p0[7])};
            pw1 = (u32x4){pg8::cvt_pk_bf16(p0[8], p0[9]), pg8::cvt_pk_bf16(p0[10], p0[11]), pg8::cvt_pk_bf16(p0[12], p0[13]), pg8::cvt_pk_bf16(p0[14], p0[15])};
            pw2 = (u32x4){pg8::cvt_pk_bf16(p1[0], p1[1]), pg8::cvt_pk_bf16(p1[2], p1[3]), pg8::cvt_pk_bf16(p1[4], p1[5]), pg8::cvt_pk_bf16(p1[6], p1[7])};
            pw3 = (u32x4){pg8::cvt_pk_bf16(p1[8], p1[9]), pg8::cvt_pk_bf16(p1[10], p1[11]), pg8::cvt_pk_bf16(p1[12], p1[13]), pg8::cvt_pk_bf16(p1[14], p1[15])};
            pv(o, vb0 + slot * VSLOT, __builtin_bit_cast(bf16x8, pw0), __builtin_bit_cast(bf16x8, pw1), __builtin_bit_cast(bf16x8, pw2), __builtin_bit_cast(bf16x8, pw3));
        }
    }
#undef MLA_DMA
    l += xhalf(l);
    if (hi == 0) wsf[32 + r32] = l;
    asm volatile("s_waitcnt lgkmcnt(0)" ::: "memory");
    LAS bf16* stg = (LAS bf16*)(lds + L_OST) + wid * 2048;
#pragma unroll
    for (int r = 0; r < 16; ++r) { const int orow = crow(r, hi); const float rl = __builtin_amdgcn_rcpf(wsf[32 + orow]);
        stg[orow * 64 + r32] = (bf16)(pg8::cvt_pk_bf16(o[0][r] * rl, 0.f) & 0xffffu); stg[orow * 64 + 32 + r32] = (bf16)(pg8::cvt_pk_bf16(o[1][r] * rl, 0.f) & 0xffffu); }
    asm volatile("s_waitcnt lgkmcnt(0)" ::: "memory");
    bf16* Ow = OB + (rowbase + q0 + wid * 32) * 512 + h * 64;
#pragma unroll
    for (int i = 0; i < 4; ++i) { const int row = i * 8 + (lane >> 3), ch = lane & 7; const u32x4 v = *(const LAS u32x4*)(stg + row * 64 + ch * 8); *(u32x4*)(Ow + (size_t)row * 512 + ch * 8) = v; }
    asm volatile("s_waitcnt lgkmcnt(0)\n\ts_barrier" ::: "memory");
}
__device__ __forceinline__ void phase(int vcu, int G, const bf16* QB, const bf16* KN, const bf16* KPE, const bf16* VB, bf16* OB, LAS unsigned char* lds) {
    for (int u = vcu; u < 1024; u += G) { const int i = u >> 8, v = u & 255, bh = v >> 3, s = v & 7;
        const int qb = (i == 0) ? s : (i == 1) ? 15 - s : (i == 2) ? 16 + s : 31 - s;
        attn_unit(bh >> 3, bh & 7, qb, QB, KN, KPE, VB, OB, lds); }
}
}

namespace idx {
typedef short bf16x8 __attribute__((ext_vector_type(8)));
typedef float f32x16 __attribute__((ext_vector_type(16)));
typedef unsigned u32x2 __attribute__((ext_vector_type(2)));
constexpr int CAP = 576, TRIG = CAP - 64, NE = (CAP + 63) / 64;
constexpr int L_CAND = 0, L_TRASH = 32 * CAP * 8, L_END = L_TRASH + 8 * 512;
constexpr int KEEP_MAX = 272, SCHED_MIN = 304;
static_assert(L_END <= RING_BYTES, "indexer LDS");
__device__ __forceinline__ unsigned okey(float f) { const unsigned u = __float_as_uint(f); return (u & 0x80000000u) ? ~u : (u | 0x80000000u); }
__device__ __forceinline__ float ikey(unsigned k) { return __uint_as_float((k & 0x80000000u) ? (k ^ 0x80000000u) : ~k); }
__device__ __forceinline__ int prefix64(unsigned long long m) { return (int)__builtin_amdgcn_mbcnt_hi((unsigned)(m >> 32), __builtin_amdgcn_mbcnt_lo((unsigned)m, 0u)); }
__device__ __forceinline__ unsigned wave_umax(unsigned v) {
    v = max(v, (unsigned)__builtin_amdgcn_update_dpp(0, (int)v, 0xB1, 0xf, 0xf, false)); v = max(v, (unsigned)__builtin_amdgcn_update_dpp(0, (int)v, 0x4E, 0xf, 0xf, false));
    v = max(v, (unsigned)__builtin_amdgcn_update_dpp(0, (int)v, 0x141, 0xf, 0xf, false)); v = max(v, (unsigned)__builtin_amdgcn_update_dpp(0, (int)v, 0x140, 0xf, 0xf, false));
    return max(max((unsigned)__builtin_amdgcn_readlane((int)v, 0), (unsigned)__builtin_amdgcn_readlane((int)v, 16)), max((unsigned)__builtin_amdgcn_readlane((int)v, 32), (unsigned)__builtin_amdgcn_readlane((int)v, 48)));
}
__device__ __forceinline__ unsigned wave_umin(unsigned v) { return ~wave_umax(~v); }
__device__ __forceinline__ unsigned wave_usum(unsigned v) {
    v += (unsigned)__builtin_amdgcn_update_dpp(0, (int)v, 0xB1, 0xf, 0xf, false); v += (unsigned)__builtin_amdgcn_update_dpp(0, (int)v, 0x4E, 0xf, 0xf, false);
    v += (unsigned)__builtin_amdgcn_update_dpp(0, (int)v, 0x141, 0xf, 0xf, false); v += (unsigned)__builtin_amdgcn_update_dpp(0, (int)v, 0x140, 0xf, 0xf, false);
    return ((unsigned)__builtin_amdgcn_readlane((int)v, 0) + (unsigned)__builtin_amdgcn_readlane((int)v, 16)) + ((unsigned)__builtin_amdgcn_readlane((int)v, 32) + (unsigned)__builtin_amdgcn_readlane((int)v, 48));
}
__device__ __forceinline__ int count_ge_v(const unsigned (&k)[8], unsigned thr) { unsigned c = 0;
#pragma unroll
    for (int j = 0; j < 8; ++j) c += (k[j] >= thr) ? 1u : 0u;
    return (int)wave_usum(c); }
template <bool FINAL> __device__ __forceinline__ void select4(LAS u32x2* cb, int (&n)[4], unsigned (&tk)[4], int lane, unsigned short* sel_out, LAS u32x2* trash, unsigned short* gtrash) {
    unsigned k[4][NE], ix[4][NE];
#pragma unroll
    for (int q = 0; q < 4; ++q)
#pragma unroll
        for (int j = 0; j < NE; ++j) { const int e = lane + 64 * j; const bool v = e < n[q]; const u32x2 en = cb[(size_t)q * CAP + (v ? e : 0)]; ix[q][j] = en.y; k[q][j] = v ? okey(__uint_as_float(en.x)) : 0u; }
    unsigned lo[4], hx[4]; int clo[4];
#pragma unroll
    for (int q = 0; q < 4; ++q) { unsigned mn = 0xffffffffu, mxv = 0u;
#pragma unroll
        for (int j = 0; j < NE; ++j) { mxv = max(mxv, k[q][j]); mn = min(mn, k[q][j] ? k[q][j] : 0xffffffffu); }
        lo[q] = wave_umin(mn); hx[q] = wave_umax(mxv) + 1u; clo[q] = n[q]; }
    const int accept = FINAL ? 256 : KEEP_MAX;
    for (int it = 0; it < 40; ++it) {
        unsigned mid[4]; int c[4]; bool any = false;
#pragma unroll
        for (int q = 0; q < 4; ++q) mid[q] = lo[q] + ((hx[q] - lo[q]) >> 1);
#pragma unroll
        for (int q = 0; q < 4; ++q) { unsigned cl = 0;
#pragma unroll
            for (int j = 0; j < NE; ++j) cl += (k[q][j] >= mid[q]) ? 1u : 0u;
            c[q] = (int)wave_usum(cl); }
#pragma unroll
        for (int q = 0; q < 4; ++q) { const bool upd = (clo[q] > accept) && (hx[q] - lo[q] > 1u), ge = c[q] >= 256;
            lo[q] = (upd && ge) ? mid[q] : lo[q]; clo[q] = (upd && ge) ? c[q] : clo[q]; hx[q] = (upd && !ge) ? mid[q] : hx[q]; any = any || upd; }
        if (!any) break;
    }
#pragma unroll
    for (int q = 0; q < 4; ++q) {
        const unsigned Tk = lo[q];
        const bool ties = FINAL ? (clo[q] != 256) : (clo[q] > accept);
        int running = 0;
        if (!ties) {
#pragma unroll
            for (int j = 0; j < NE; ++j) {
                const bool take = k[q][j] >= Tk;
                const unsigned long long mt = __ballot(take);
                const int pos = running + prefix64(mt);
                if (FINAL) { unsigned short* dst = take ? sel_out + (size_t)q * 256 + pos : gtrash + lane; *dst = (unsigned short)ix[q][j]; }
                else { LAS u32x2* dst = take ? cb + (size_t)q * CAP + pos : trash + lane; *dst = (u32x2){__float_as_uint(ikey(k[q][j])), ix[q][j]}; }
                running += __popcll(mt);
            }
        } else {
            unsigned cg = 0;
#pragma unroll
            for (int j = 0; j < NE; ++j) cg += (k[q][j] > Tk) ? 1u : 0u;
            const int r_eq = 256 - (int)wave_usum(cg); int eqrun = 0;
#pragma unroll
            for (int j = 0; j < NE; ++j) {
                const bool gt = k[q][j] > Tk, eq = (k[q][j] == Tk);
                const unsigned long long meq = __ballot(eq);
                const bool take = gt || (eq && (eqrun + prefix64(meq)) < r_eq);
                const unsigned long long mt = __ballot(take);
                const int pos = running + prefix64(mt);
                if (FINAL) { unsigned short* dst = (take && pos < 256) ? sel_out + (size_t)q * 256 + pos : gtrash + lane; *dst = (unsigned short)ix[q][j]; }
                else { LAS u32x2* dst = take ? cb + (size_t)q * CAP + pos : trash + lane; *dst = (u32x2){__float_as_uint(ikey(k[q][j])), ix[q][j]}; }
                running += __popcll(mt); eqrun += __popcll(meq);
            }
        }
        tk[q] = Tk; n[q] = running;
    }
}
__device__ __forceinline__ void unit(int b, int g, const bf16* QI, const bf16* KI, const float* WI, unsigned short* SEL, unsigned short* gtrash, LAS unsigned char* lds, int variant) {
    const int q0 = g * 32, L = 64 * (q0 / 64 + 1);
    if (L <= 256) return;
    const int tid = threadIdx.x, lane = tid & 63, c = lane & 31, hi = lane >> 5; const int wid = __builtin_amdgcn_readfirstlane(tid >> 6);
    const size_t rowbase = (size_t)b * T; const int ntile = L / 64;
    bf16x8 Af[4];
    { const int r = c, jq = ((r >> 2) & 1) + 2 * (r >> 4), hd = (r & 3) + 4 * ((r >> 3) & 1);
      const bf16* qp = QI + (rowbase + q0 + 4 * wid + jq) * 512 + hd * 64 + 8 * hi;
#pragma unroll
      for (int s = 0; s < 4; ++s) Af[s] = *(const bf16x8*)(qp + 16 * s); }
    float wv[2][8];
#pragma unroll
    for (int u = 0; u < 2; ++u) { const float* wp = WI + (rowbase + q0 + 4 * wid + hi + 2 * u) * 8; const f32x4 a = *(const f32x4*)wp, bq = *(const f32x4*)(wp + 4);
#pragma unroll
        for (int i = 0; i < 4; ++i) { wv[u][i] = a[i] * (0.125f * 0.35355339059327373f); wv[u][4 + i] = bq[i] * (0.125f * 0.35355339059327373f); } }
    float tau[2] = {-INFINITY, -INFINITY}; int cnt[2] = {0, 0};
    LAS u32x2* cbase = (LAS u32x2*)(lds + L_CAND) + (size_t)(wid * 4) * CAP;
    LAS u32x2* trash = (LAS u32x2*)(lds + L_TRASH) + wid * 64;
    const bf16* kp = KI + (rowbase + c) * 64 + 8 * hi;
    bf16x8 Ba[8], Bb[8];
#define IDX_LOAD(dst, tt) do { _Pragma("unroll") for (int i_ = 0; i_ < 8; ++i_) dst[i_] = *(const bf16x8*)(kp + (size_t)((tt) * 64 + (i_ >> 2) * 32) * 64 + 16 * (i_ & 3)); } while (0)
#define IDX_TILE(Bf, tt) do { \
        f32x16 acc0, acc1; \
        _Pragma("unroll") for (int r_ = 0; r_ < 16; ++r_) { acc0[r_] = 0.f; acc1[r_] = 0.f; } \
        _Pragma("unroll") for (int s4 = 0; s4 < 4; ++s4) { acc0 = __builtin_amdgcn_mfma_f32_32x32x16_bf16(Af[s4], Bf[s4], acc0, 0, 0, 0); acc1 = __builtin_amdgcn_mfma_f32_32x32x16_bf16(Af[s4], Bf[4 + s4], acc1, 0, 0, 0); } \
        float sv[2][2]; \
        _Pragma("unroll") for (int u = 0; u < 2; ++u) { float a_ = 0.f, b_ = 0.f; \
            _Pragma("unroll") for (int i = 0; i < 8; ++i) { a_ = fmaf(__builtin_amdgcn_fmed3f(acc0[8 * u + i], 0.f, 3.0e38f), wv[u][i], a_); b_ = fmaf(__builtin_amdgcn_fmed3f(acc1[8 * u + i], 0.f, 3.0e38f), wv[u][i], b_); } \
            sv[u][0] = a_; sv[u][1] = b_; } \
        bool ps[2][2]; unsigned long long mk[2][2]; \
        _Pragma("unroll") for (int u = 0; u < 2; ++u) _Pragma("unroll") for (int kh = 0; kh < 2; ++kh) { ps[u][kh] = (sv[u][kh] > tau[u]) && !(variant & 2); mk[u][kh] = __ballot(ps[u][kh]); } \
        if ((mk[0][0] | mk[0][1] | mk[1][0] | mk[1][1]) != 0ull) { \
            _Pragma("unroll") for (int u = 0; u < 2; ++u) _Pragma("unroll") for (int kh = 0; kh < 2; ++kh) { \
                const unsigned mlo = (unsigned)mk[u][kh], mhi = (unsigned)(mk[u][kh] >> 32); \
                const int pre = (int)__builtin_amdgcn_mbcnt_hi(mhi, __builtin_amdgcn_mbcnt_lo(mlo, 0u)) - (hi ? __popc(mlo) : 0);     \
                LAS u32x2* dst = ps[u][kh] ? cbase + (size_t)(hi + 2 * u) * CAP + cnt[u] + pre : trash + lane; \
                *dst = (u32x2){__float_as_uint(sv[u][kh]), (unsigned)((tt) * 64 + kh * 32 + c)}; \
                cnt[u] += hi ? __popc(mhi) : __popc(mlo); } } \
    } while (0)
    IDX_LOAD(Ba, 0); IDX_LOAD(Bb, 1);
    for (int t = 0; t < ntile; t += 2) {
#define IDX_CHECK() do { const int n0 = __builtin_amdgcn_readlane(cnt[0], 0), n1 = __builtin_amdgcn_readlane(cnt[0], 32), n2 = __builtin_amdgcn_readlane(cnt[1], 0), n3 = __builtin_amdgcn_readlane(cnt[1], 32); \
          if (max(max(n0, n1), max(n2, n3)) > TRIG && !(variant & 1)) { int n4[4] = {n0, n1, n2, n3}; unsigned tk4[4]; \
            PROF_T0(1); select4<false>(cbase, n4, tk4, lane, nullptr, trash, gtrash); PROF_T1(1, lds, wid, lane); \
            cnt[0] = hi ? n4[1] : n4[0]; cnt[1] = hi ? n4[3] : n4[2]; tau[0] = ikey(hi ? tk4[1] : tk4[0]); tau[1] = ikey(hi ? tk4[3] : tk4[2]); } } while (0)
        IDX_CHECK();
        IDX_TILE(Ba, t);
        if (t + 2 < ntile) IDX_LOAD(Ba, t + 2);
        if (t + 1 < ntile) { IDX_CHECK(); IDX_TILE(Bb, t + 1); if (t + 3 < ntile) IDX_LOAD(Bb, t + 3); }
    }
#undef IDX_LOAD
#undef IDX_TILE
#undef IDX_CHECK
    asm volatile("s_waitcnt lgkmcnt(0)" ::: "memory");
    if (!(variant & 9)) { int n4[4] = {__builtin_amdgcn_readlane(cnt[0], 0), __builtin_amdgcn_readlane(cnt[0], 32), __builtin_amdgcn_readlane(cnt[1], 0), __builtin_amdgcn_readlane(cnt[1], 32)}; unsigned tk4[4];
      PROF_T0(2); select4<true>(cbase, n4, tk4, lane, SEL + (rowbase + q0 + 4 * wid) * 256, trash, gtrash); PROF_T1(2, lds, wid, lane); }
    asm volatile("s_waitcnt lgkmcnt(0)" ::: "memory");
}
__device__ __forceinline__ void phase(int vcu, int G, const bf16* QI, const bf16* KI, const float* WI, unsigned short* SEL, unsigned short* gtrash, LAS unsigned char* lds, int variant) {
    PROF_T0(7);
    for (int u = vcu; u < 1024; u += G) { const int i = u >> 8, v = u & 255, b = v >> 6, s = v & 63;
        const int g = (i == 0) ? s : (i == 1) ? 127 - s : (i == 2) ? 128 + s : 255 - s;
        unit(b, g, QI, KI, WI, SEL, gtrash, lds, variant); }
    PROF_T1(7, lds, (int)__builtin_amdgcn_readfirstlane(threadIdx.x >> 6), (int)(threadIdx.x & 63));
    __syncthreads();
}
}

namespace dsa {
typedef unsigned u32x4m __attribute__((ext_vector_type(4)));
typedef unsigned u32x2m __attribute__((ext_vector_type(2)));
typedef short bf16x8 __attribute__((ext_vector_type(8)));
typedef short v4i16 __attribute__((ext_vector_type(4)));
constexpr int WREG = 17408, L_BIAS = 8 * WREG, L_END = L_BIAS + 33 * 8 * 4;
static_assert(L_END <= RING_BYTES, "dsa LDS");
constexpr float LOG2E = 1.4426950408889634f;
__device__ __forceinline__ int t5_bucket(int rel) {
    const int n = rel < 0 ? -rel : rel; const int r = rel > 0 ? 16 : 0;
    if (n < 8) return r + n;
    int lg = (31 - __clz(n * n)) - 6; if (n >= 128 || lg > 7) lg = 7;
    return r + 8 + lg;
}
__device__ __forceinline__ void phase(int vcu, int G, const bf16* QA, const bf16* KA, const bf16* VA, const unsigned short* SEL, const int* positions, const float* rel_bias, bf16* OA, LAS unsigned char* lds) {
    const int tid = threadIdx.x, lane = tid & 63, l15 = lane & 15, kq = lane >> 4; const int wid = __builtin_amdgcn_readfirstlane(tid >> 6);
    LAS float* bt = (LAS float*)(lds + L_BIAS);
    for (int i = tid; i < 33 * 8; i += NWAVES * 64) bt[i] = (i < 256) ? rel_bias[i] * LOG2E : -INFINITY;
    __syncthreads();
    LAS unsigned char* wl = lds + wid * WREG;
    LAS unsigned short* selL = (LAS unsigned short*)(wl + 16384); LAS unsigned char* bktL = wl + 16384 + 512;
    const int gw = vcu * NWAVES + wid, NGW = G * NWAVES;
    const int trofs = ((l15 >> 2) + 4 * kq) * 128 + (l15 & 3) * 8;
    unsigned short seln[4];
#pragma unroll
    for (int j = 0; j < 4; ++j) seln[j] = (gw < M) ? SEL[(size_t)gw * 256 + lane + 64 * j] : (unsigned short)0;
    for (int q = gw; q < M; q += NGW) {
        const int b = q >> 13, t = q & (T - 1); const size_t rowbase = (size_t)b * T;
        const int limit = 64 * (t / 64 + 1), nvalid = limit < 256 ? limit : 256; const int posq = positions[q];
        int svv[4];
#pragma unroll
        for (int j = 0; j < 4; ++j) { const int k = lane + 64 * j; svv[j] = (limit <= 256) ? (k < limit ? k : limit - 1) : (int)seln[j]; }
        { const int qn = q + NGW;
#pragma unroll
          for (int j = 0; j < 4; ++j) seln[j] = (qn < M) ? SEL[(size_t)qn * 256 + lane + 64 * j] : (unsigned short)0; }
#pragma unroll
        for (int j = 0; j < 4; ++j) { const int k = lane + 64 * j; const int sv = svv[j];
            const int bk = (k < nvalid) ? t5_bucket(positions[rowbase + sv] - posq) : 32; selL[k] = (unsigned short)sv; bktL[k] = (unsigned char)bk; }
        asm volatile("s_waitcnt lgkmcnt(0)" ::: "memory");
#define DSA_VDMA(cch, buf) do { _Pragma("unroll") for (int i_ = 0; i_ < 4; ++i_) { const int row_ = selL[32 * (cch) + 8 * i_ + (lane >> 3)]; \
            __builtin_amdgcn_global_load_lds((const unsigned*)(VA + (rowbase + row_) * 64 + (lane & 7) * 8), (LAS unsigned*)(wl + (buf) * 4096 + i_ * 1024), 16, 0, 0); } } while (0)
        DSA_VDMA(0, 0); DSA_VDMA(1, 1); DSA_VDMA(2, 2); DSA_VDMA(3, 3);
        bf16x8 Qf[2];
#pragma unroll
        for (int s = 0; s < 2; ++s) { Qf[s] = (bf16x8){0, 0, 0, 0, 0, 0, 0, 0}; if (l15 < 8) Qf[s] = *(const bf16x8*)(QA + (size_t)q * 512 + l15 * 64 + 32 * s + 8 * kq); }
        f32x4 St[16];
#pragma unroll
        for (int half = 0; half < 2; ++half) {
            bf16x8 Ka[8][2];
#pragma unroll
            for (int i = 0; i < 8; ++i) { const int row = selL[16 * (8 * half + i) + l15]; const bf16* kp = KA + (rowbase + row) * 64 + 8 * kq;
                Ka[i][0] = *(const bf16x8*)kp; Ka[i][1] = *(const bf16x8*)(kp + 32); }
#pragma unroll
            for (int i = 0; i < 8; ++i) { f32x4 a = {0.f, 0.f, 0.f, 0.f};
                a = __builtin_amdgcn_mfma_f32_16x16x32_bf16(Ka[i][0], Qf[0], a, 0, 0, 0); a = __builtin_amdgcn_mfma_f32_16x16x32_bf16(Ka[i][1], Qf[1], a, 0, 0, 0); St[8 * half + i] = a; }
        }
        float mx = -INFINITY;
#pragma unroll
        for (int kt = 0; kt < 16; ++kt) { const unsigned bk4 = *(const LAS unsigned*)(bktL + 16 * kt + 4 * kq);
#pragma unroll
            for (int i = 0; i < 4; ++i) { const float s = St[kt][i] * (0.125f * LOG2E) + bt[((bk4 >> (8 * i)) & 255u) * 8 + (l15 & 7)]; St[kt][i] = s; mx = fmaxf(mx, s); } }
        mx = fmaxf(mx, __shfl_xor(mx, 16)); mx = fmaxf(mx, __shfl_xor(mx, 32));
        float lsum = 0.f;
#pragma unroll
        for (int kt = 0; kt < 16; ++kt)
#pragma unroll
            for (int i = 0; i < 4; ++i) { const float p = __builtin_amdgcn_exp2f(St[kt][i] - mx); St[kt][i] = p; lsum += p; }
        lsum += __shfl_xor(lsum, 16); lsum += __shfl_xor(lsum, 32);
        f32x4 O[4];
#pragma unroll
        for (int dt = 0; dt < 4; ++dt) O[dt] = (f32x4){0.f, 0.f, 0.f, 0.f};
#pragma unroll
        for (int kk = 0; kk < 8; ++kk) {
            if (kk < 5) asm volatile("s_waitcnt vmcnt(12)" ::: "memory"); else if (kk == 5) asm volatile("s_waitcnt vmcnt(8)" ::: "memory"); else if (kk == 6) asm volatile("s_waitcnt vmcnt(4)" ::: "memory"); else asm volatile("s_waitcnt vmcnt(0)" ::: "memory");
            const LAS unsigned char* vb = wl + (kk & 3) * 4096 + trofs;
            const f32x4 pa = St[2 * kk], pb = St[2 * kk + 1];
            u32x4m pw; pw.x = pg8::cvt_pk_bf16(pa[0], pa[1]); pw.y = pg8::cvt_pk_bf16(pa[2], pa[3]); pw.z = pg8::cvt_pk_bf16(pb[0], pb[1]); pw.w = pg8::cvt_pk_bf16(pb[2], pb[3]);
            const bf16x8 Pf = __builtin_bit_cast(bf16x8, pw);
#pragma unroll
            for (int dt = 0; dt < 4; ++dt) {
                const v4i16 v0 = __builtin_amdgcn_ds_read_tr16_b64_v4i16((LAS v4i16*)(vb + dt * 32));
                const v4i16 v1 = __builtin_amdgcn_ds_read_tr16_b64_v4i16((LAS v4i16*)(vb + 2048 + dt * 32));
                const bf16x8 Vf = (bf16x8){v0[0], v0[1], v0[2], v0[3], v1[0], v1[1], v1[2], v1[3]};
                O[dt] = __builtin_amdgcn_mfma_f32_16x16x32_bf16(Vf, Pf, O[dt], 0, 0, 0); }
            if (kk < 4) { asm volatile("s_waitcnt lgkmcnt(0)" ::: "memory"); DSA_VDMA(kk + 4, kk); }
        }
#undef DSA_VDMA
        if (l15 < 8) { const float rl = __builtin_amdgcn_rcpf(lsum);
#pragma unroll
            for (int dt = 0; dt < 4; ++dt) { u32x2m w; w.x = pg8::cvt_pk_bf16(O[dt][0] * rl, O[dt][1] * rl); w.y = pg8::cvt_pk_bf16(O[dt][2] * rl, O[dt][3] * rl);
                *(u32x2m*)(OA + (size_t)q * 512 + l15 * 64 + 16 * dt + 4 * kq) = w; } }
        asm volatile("s_waitcnt lgkmcnt(0)" ::: "memory");
    }
}
}

struct PhaseTimer { unsigned long long t0; int k; LAS unsigned char* l; int w, ln; bool once;
    __device__ __forceinline__ PhaseTimer(int k_, LAS unsigned char* l_, int w_, int ln_) : t0(0), k(k_), l(l_), w(w_), ln(ln_), once(true) { if (PROF_SEL == 20 + k) t0 = __builtin_amdgcn_s_memrealtime(); }
    __device__ __forceinline__ void stop() { once = false; if (PROF_SEL == 20 + k) { const unsigned d = (unsigned)(__builtin_amdgcn_s_memrealtime() - t0); if (ln == 0) *PROF_WORD(l, w) += d; } } };
constexpr int NPHASE = 16;
__global__ void __launch_bounds__(NWAVES * 64, 2) mk_fwd(Args args) {
    extern __shared__ __attribute__((aligned(16))) unsigned char lds[];
    Frame F;
    F.lds = (LAS unsigned char*)lds;
    F.MISC = (volatile LAS unsigned*)(F.lds + MISC_OFF);
    F.tid = threadIdx.x; F.lane = F.tid & 63; F.wave = __builtin_amdgcn_readfirstlane(F.tid >> 6);
    F.G = gridDim.x; { const int bx = blockIdx.x; F.vcu = (F.G % 8 == 0) ? (bx % 8) * (F.G / 8) + bx / 8 : bx; }
    unsigned char* ws = args.ws;
    F.ctl = (gu32*)(ws + WS_CTL);
    for (int u = F.tid; u < (LDS_BYTES - LDSCTL_OFF) / 4; u += NWAVES * 64) ((LAS unsigned*)(F.lds + LDSCTL_OFF))[u] = 0u;
    __syncthreads();
    XcdBarrier bar; bar.bar = (unsigned*)(F.ctl + CW_BAR); bar.x = 0; bar.st = nullptr;
    if (MK_FUSED) bar = xcd_barrier_post((unsigned*)(F.ctl + CW_BAR), F.MISC + 8);
#define GRID_BAR() do { if (MK_FUSED) { PROF_T0(50); xcd_barrier(bar); PROF_T1(50, F.lds + RING_OFF, F.wave, F.lane); } } while (0)
    const int lo = args.ph_lo, hi = args.ph_hi;
#ifdef ONLY_PH
#define IN(k) ((k) == ONLY_PH && lo <= (k) && (k) < hi)
#else
#define IN(k) (lo <= (k) && (k) < hi)
#endif
#define BOTH(k) (IN(k) && IN((k) + 1))
#ifndef DUP_PH
#define DUP_PH -1
#endif
#ifndef P7_VARIANT
#define P7_VARIANT 0
#endif
#define PHASE_TIMED(k) for (PhaseTimer pt_((k), F.lds + RING_OFF, F.wave, F.lane); pt_.once; pt_.stop())
#define REP(k) for (int rep_ = 0; rep_ < ((k) == DUP_PH ? 2 : 1); ++rep_)
    const float* x = (const float*)args.in[0];
    const float* mod = (const float*)(ws + WS_MOD);
    bf16* XN = (bf16*)(ws + WS_XN); bf16* ACT = (bf16*)(ws + WS_ACT);
    float* X1 = args.out;
    const float* rcos = (const float*)(ws + WS_RCOS); const float* rsin = (const float*)(ws + WS_RSIN);
    float* ssq_q = (float*)(ws + WS_SSQQ); float* ssq_kv = (float*)(ws + WS_SSQKV);

    if (IN(0)) REP(0) PHASE_TIMED(0) { p0_prologue(F, args); if (BOTH(0)) GRID_BAR(); }
    if (IN(1)) REP(1) PHASE_TIMED(1) { norm_mod_phase(F, x, (const float*)args.in[5], mod, 0 * D, 1 * D, XN); if (BOTH(1)) GRID_BAR(); }
    if (IN(2)) REP(2) PHASE_TIMED(2) {
        pg8::Gemm g{XN, (const bf16*)(ws + WS_W1A), M, 2 * DFF, D}; pg8::StaticOrder S; S.init(M, 2 * DFF, F.G, (int)blockIdx.x);
        pg8::EpiSwiglu E{ACT, DFF};
        pg8::gemm_phase<pg8::EpiSwiglu, pg8::StaticOrder, true, true>(F.lds + RING_OFF, g, S, E);
        if (BOTH(2)) GRID_BAR(); }
    if (IN(3)) REP(3) PHASE_TIMED(3) {
        pg8::Gemm g{ACT, (const bf16*)(ws + WS_W1D), M, D, DFF}; pg8::StaticOrder S; S.init(M, D, F.G, (int)blockIdx.x);
        pg8::EpiResid E{x, X1, mod, 2 * D, 0.5f};
        pg8::gemm_phase<pg8::EpiResid, pg8::StaticOrder, true, true>(F.lds + RING_OFF, g, S, E);
        if (BOTH(3)) GRID_BAR(); }
    if (IN(4)) REP(4) PHASE_TIMED(4) { norm_mod_phase(F, X1, (const float*)args.in[8], mod, 3 * D, 4 * D, XN); if (BOTH(4)) GRID_BAR(); }
    if (IN(5)) REP(5) PHASE_TIMED(5) {
        pg8::Gemm g{XN, (const bf16*)(ws + WS_WIN), M, NPROJ, D}; pg8::StaticOrder S; S.init(M, NPROJ, F.G, (int)blockIdx.x);
        pg8::EpiProj E{(bf16*)(ws + WS_QA), (bf16*)(ws + WS_QI), (bf16*)(ws + WS_CQ), (bf16*)(ws + WS_CKV), (bf16*)(ws + WS_KA), (bf16*)(ws + WS_VA), (bf16*)(ws + WS_KI), (bf16*)(ws + WS_KPE), (bf16*)(ws + WS_G),
                       (float*)(ws + WS_WI), ssq_q, ssq_kv, rcos, rsin};
        pg8::gemm_phase<pg8::EpiProj, pg8::StaticOrder, true, true>(F.lds + RING_OFF, g, S, E);
        if (BOTH(5)) GRID_BAR(); }
    if (IN(6)) REP(6) PHASE_TIMED(6) {
        { pg8::Gemm g{(const bf16*)(ws + WS_CQ), (const bf16*)(ws + WS_WUQ), M, 768, 384}; pg8::StaticOrder S; S.init(M, 768, F.G, (int)blockIdx.x);
          pg8::EpiUpQ E{(bf16*)(ws + WS_QB), ssq_q, rcos, rsin};
          pg8::gemm_phase<pg8::EpiUpQ, pg8::StaticOrder, true, true>(F.lds + RING_OFF, g, S, E); }
        __syncthreads();
        { pg8::Gemm g{(const bf16*)(ws + WS_CKV), (const bf16*)(ws + WS_WUKV), M, 1024, 256}; pg8::StaticOrder S; S.init(M, 1024, F.G, (int)blockIdx.x);
          pg8::EpiUpKV E{(bf16*)(ws + WS_KN), (bf16*)(ws + WS_VB), ssq_kv};
          pg8::gemm_phase<pg8::EpiUpKV, pg8::StaticOrder, true, true>(F.lds + RING_OFF, g, S, E); }
        __syncthreads(); }
    if (IN(7)) REP(7) PHASE_TIMED(7) { idx::phase(F.vcu, F.G, (const bf16*)(ws + WS_QI), (const bf16*)(ws + WS_KI), (const float*)(ws + WS_WI), (unsigned short*)(ws + WS_SEL), (unsigned short*)(ws + WS_END), F.lds + RING_OFF, (DUP_PH == 7 && rep_ == 0) ? P7_VARIANT : 0); if (BOTH(7)) GRID_BAR(); }
    if (IN(8)) REP(8) PHASE_TIMED(8) { dsa::phase(F.vcu, F.G, (const bf16*)(ws + WS_QA), (const bf16*)(ws + WS_KA), (const bf16*)(ws + WS_VA), (const unsigned short*)(ws + WS_SEL), (const int*)args.in[2], (const float*)args.in[15], (bf16*)(ws + WS_OA), F.lds + RING_OFF); __syncthreads(); }
    if (IN(9)) REP(9) PHASE_TIMED(9) { mla::phase(F.vcu, F.G, (const bf16*)(ws + WS_QB), (const bf16*)(ws + WS_KN), (const bf16*)(ws + WS_KPE), (const bf16*)(ws + WS_VB), (bf16*)(ws + WS_OB), F.lds + RING_OFF); if (BOTH(9)) GRID_BAR(); }
    if (IN(10)) REP(10) PHASE_TIMED(10) {
        { pg8::Gemm g{(const bf16*)(ws + WS_OA), (const bf16*)(ws + WS_WOA), M, D, 512}; pg8::StaticOrder S; S.init(M, D, F.G, (int)blockIdx.x);
          pg8::EpiGate<false> E{(const bf16*)(ws + WS_G), 0, nullptr, (bf16*)(ws + WS_Y1)};
          pg8::gemm_phase<pg8::EpiGate<false>, pg8::StaticOrder, true, true>(F.lds + RING_OFF, g, S, E); }
        VM_WAIT(); __syncthreads();
        { pg8::Gemm g{(const bf16*)(ws + WS_OB), (const bf16*)(ws + WS_WOB), M, D, 512}; pg8::StaticOrder S; S.init(M, D, F.G, (int)blockIdx.x);
          pg8::EpiGate<true> E{(const bf16*)(ws + WS_G), 1024, (const bf16*)(ws + WS_Y1), (bf16*)(ws + WS_Y)};
          pg8::gemm_phase<pg8::EpiGate<true>, pg8::StaticOrder, true, true>(F.lds + RING_OFF, g, S, E); }
        if (BOTH(10)) GRID_BAR(); }
    if (IN(11)) PHASE_TIMED(11) {
        pg8::Gemm g{(const bf16*)(ws + WS_Y), (const bf16*)(ws + WS_WOUT), M, D, D}; pg8::StaticOrder S; S.init(M, D, F.G, (int)blockIdx.x);
        pg8::EpiResid E{X1, X1, mod, 5 * D, 1.0f};
        pg8::gemm_phase<pg8::EpiResid, pg8::StaticOrder, true, true>(F.lds + RING_OFF, g, S, E);
        if (BOTH(11)) GRID_BAR(); }
    if (IN(12)) REP(12) PHASE_TIMED(12) { norm_mod_phase(F, X1, (const float*)args.in[19], mod, 6 * D, 7 * D, XN); if (BOTH(12)) GRID_BAR(); }
    if (IN(13)) REP(13) PHASE_TIMED(13) {
        pg8::Gemm g{XN, (const bf16*)(ws + WS_W2A), M, 2 * DFF, D}; pg8::StaticOrder S; S.init(M, 2 * DFF, F.G, (int)blockIdx.x);
        pg8::EpiSwiglu E{ACT, DFF};
        pg8::gemm_phase<pg8::EpiSwiglu, pg8::StaticOrder, true, true>(F.lds + RING_OFF, g, S, E);
        if (BOTH(13)) GRID_BAR(); }
    if (IN(14)) PHASE_TIMED(14) {
        pg8::Gemm g{ACT, (const bf16*)(ws + WS_W2D), M, D, DFF}; pg8::StaticOrder S; S.init(M, D, F.G, (int)blockIdx.x);
        pg8::EpiResid E{X1, X1, mod, 8 * D, 0.5f};
        pg8::gemm_phase<pg8::EpiResid, pg8::StaticOrder, true, true>(F.lds + RING_OFF, g, S, E);
        if (BOTH(14)) GRID_BAR(); }
    if (IN(15)) PHASE_TIMED(15) { final_norm_phase(F, X1, (const float*)args.in[22], args.out); }
    if (PROF_SEL != 0) { asm volatile("s_waitcnt lgkmcnt(0)" ::: "memory"); const unsigned a_ = *PROF_WORD(F.lds + RING_OFF, F.wave); const unsigned long long t0_ = __builtin_amdgcn_s_memrealtime();
        while (__builtin_amdgcn_s_memrealtime() - t0_ < (unsigned long long)a_ * PROF_MULT) __builtin_amdgcn_s_sleep(32); }
#undef IN
#undef BOTH
}

extern "C" void kernel_launch(void* const* d_in, const int* in_sizes, int n_in, void* d_out, int out_size, void* d_ws, size_t ws_size, hipStream_t stream) {
    static int grid = 0;
    if (grid == 0) {
        if (n_in != 23 || out_size != M * D || ws_size < WS_END + 4096) { fprintf(stderr, "kernel_launch: unexpected problem shape (n_in %d, out %d, ws %zu)\n", n_in, out_size, ws_size); grid = -1; return; }
        int dev = 0, cus = 0, per_cu = 0;
        if (hipGetDevice(&dev) != hipSuccess || hipDeviceGetAttribute(&cus, hipDeviceAttributeMultiprocessorCount, dev) != hipSuccess) { grid = -1; return; }
        if (hipFuncSetAttribute((const void*)mk_fwd, hipFuncAttributeMaxDynamicSharedMemorySize, LDS_BYTES) != hipSuccess) { fprintf(stderr, "kernel_launch: hipFuncSetAttribute failed\n"); grid = -1; return; }
        if (hipOccupancyMaxActiveBlocksPerMultiprocessor(&per_cu, (const void*)mk_fwd, NWAVES * 64, LDS_BYTES) != hipSuccess || per_cu < 1) fprintf(stderr, "kernel_launch: occupancy query reports %d\n", per_cu);
        (void)hipGetLastError();
        grid = cus;
    }
    if (grid < 0) return;
    (void)in_sizes;
    if (hipMemsetAsync((char*)d_ws + WS_CTL, 0, CTL_ZERO_BYTES, stream) != hipSuccess) return;
    Args a{};
    for (int i = 0; i < 23; ++i) a.in[i] = d_in[i];
    a.out = (float*)d_out; a.ws = (unsigned char*)d_ws;
    auto launch = [&](int lo, int hi) { a.ph_lo = lo; a.ph_hi = hi; a.li = 0; hipLaunchKernelGGL(mk_fwd, dim3(grid), dim3(NWAVES * 64), LDS_BYTES, stream, a); };
#if MK_FUSED
    launch(0, NPHASE);
#else
    for (int p = 0; p < NPHASE; ++p) launch(p, p + 1);
#endif
}
```

```cpp
#include <hip/hip_runtime.h>
#include <cstdio>
#include <cstdint>
namespace pg8 {
#define PG8_LAS __attribute__((address_space(3)))
typedef unsigned short bf16_t;
typedef short bf16x8 __attribute__((ext_vector_type(8)));
typedef float f32x4 __attribute__((ext_vector_type(4)));
typedef unsigned u32x4 __attribute__((ext_vector_type(4)));
constexpr int BM = 256, BK = 64, HALF = 128, HTB = HALF * BK * 2  , STAGE_BYTES = 8 * HTB, NXCD = 8, WGM = 8;

__host__ __device__ __forceinline__ int lds_byte(int r, int c) { const int st = (r >> 4) * 2 + (c >> 5), rr = r & 15, cc = c & 31, ob = rr * 64 + cc * 2; return st * 1024 + (ob ^ (((ob >> 9) & 1) << 5)); }
__host__ __device__ __forceinline__ void stage_rc(int b, int& R, int& C) { const int st = b / 1024, sb = b % 1024, swz = sb ^ (((sb >> 9) & 1) << 5); R = (st >> 1) * 16 + swz / 64; C = (st & 1) * 32 + (swz % 64) / 2; }
__host__ __device__ __forceinline__ int perm32(int rho) { const int n = rho >> 4, i = rho & 15; return 8 * (i >> 2) + 4 * n + (i & 3); }

struct Unit { int pm, pn; };
struct Gemm { const bf16_t* A; const bf16_t* Bt; int M, N, K; };

struct StaticOrder {
    int nM, nN, nwg, G, c;
    __host__ __device__ void init(int M, int N, int G_, int c_) { nM = M / BM; nN = N / BM; nwg = nM * nN; G = G_; c = c_; }
    __host__ __device__ bool next(int i, Unit& u) const {
        const long L = (long)i * G + c; if (L >= nwg) return false;
        int wgid = (int)L; { const int q = nwg / NXCD, r = nwg % NXCD, xcd = wgid % NXCD, off = wgid / NXCD; wgid = (xcd < r ? xcd * (q + 1) : r * (q + 1) + (xcd - r) * q) + off; }
        const int nig = WGM * nN, gid = wgid / nig, fm = gid * WGM, gsz = (nM - fm) < WGM ? (nM - fm) : WGM;
        u.pm = fm + ((wgid % nig) % gsz); u.pn = (wgid % nig) / gsz; return true;
    }
    __device__ __forceinline__ void a_ready(const Unit&) const {}
    __device__ __forceinline__ void done(const Unit&) const {}
};

typedef float f32x2 __attribute__((ext_vector_type(2)));
typedef __bf16 bf16x2_cv __attribute__((ext_vector_type(2)));
__device__ __forceinline__ unsigned cvt_pk_bf16(float lo, float hi) { const f32x2 v = {lo, hi}; const bf16x2_cv b = __builtin_convertvector(v, bf16x2_cv); return __builtin_bit_cast(unsigned, b); }

__device__ __forceinline__ u32x4 pack8(const f32x4 a, const f32x4 b) { u32x4 w; w.x = cvt_pk_bf16(a[0], a[1]); w.y = cvt_pk_bf16(a[2], a[3]); w.z = cvt_pk_bf16(b[0], b[1]); w.w = cvt_pk_bf16(b[2], b[3]); return w; }
__device__ __forceinline__ float sigm(float v) { return __builtin_amdgcn_rcpf(1.f + __builtin_amdgcn_exp2f(-1.4426950408889634f * v)); }
__device__ __forceinline__ f32x4 sigm4(const f32x4 v) { return (f32x4){sigm(v[0]), sigm(v[1]), sigm(v[2]), sigm(v[3])}; }
__device__ __forceinline__ void unpack8(const u32x4 w, f32x4& a, f32x4& b) {
    a = (f32x4){__uint_as_float(w.x << 16), __uint_as_float(w.x & 0xffff0000u), __uint_as_float(w.y << 16), __uint_as_float(w.y & 0xffff0000u)};
    b = (f32x4){__uint_as_float(w.z << 16), __uint_as_float(w.z & 0xffff0000u), __uint_as_float(w.w << 16), __uint_as_float(w.w & 0xffff0000u)}; }
constexpr float EPS_RMS = 1e-6f;
constexpr float QSCALE = 0.10206207261596575f * 1.4426950408889634f;

struct EpiSwiglu {
    static constexpr bool PERM = true, AFTER_DRAIN = false;
    bf16_t* O; int ldc;
    __device__ __forceinline__ void operator()(const f32x4 (&acc)[2][2][4][2], const Unit& u, int wr, int wc, int fr, int fq) const {
        const int row0 = u.pm * BM + wr * 64 + fr, col0 = u.pn * HALF + wc * 32 + 8 * fq;
#pragma unroll
        for (int ai = 0; ai < 2; ++ai)
#pragma unroll
            for (int m = 0; m < 4; ++m) {
                const f32x4 g0 = acc[ai][0][m][0], g1 = acc[ai][0][m][1], u0 = acc[ai][1][m][0], u1 = acc[ai][1][m][1];
                const f32x4 v0 = g0 * sigm4(g0) * u0, v1 = g1 * sigm4(g1) * u1;
                *(u32x4*)(O + (size_t)(row0 + ai * HALF + m * 16) * ldc + col0) = pack8(v0, v1); }
    }
};
struct EpiResid {
    static constexpr bool PERM = false, AFTER_DRAIN = false;
    const float* base; float* out; const float* mod; int goff; float scale;
    __device__ __forceinline__ void operator()(const f32x4 (&acc)[2][2][4][2], const Unit& u, int wr, int wc, int fr, int fq) const {
        const float* gate = mod + (u.pm >> 5) * 9216 + goff;
        const int col0 = u.pn * BM + wc * 32 + 4 * fq;
        f32x4 gv[2][2];
#pragma unroll
        for (int bj = 0; bj < 2; ++bj)
#pragma unroll
            for (int n = 0; n < 2; ++n) gv[bj][n] = *(const f32x4*)(gate + col0 + bj * HALF + n * 16) * scale;
#pragma unroll
        for (int ai = 0; ai < 2; ++ai)
#pragma unroll
            for (int m = 0; m < 4; ++m) { const size_t off = (size_t)(u.pm * BM + ai * HALF + wr * 64 + m * 16 + fr) * 1024 + col0;
#pragma unroll
                for (int bj = 0; bj < 2; ++bj)
#pragma unroll
                    for (int n = 0; n < 2; ++n) { const f32x4 bs = *(const f32x4*)(base + off + bj * HALF + n * 16); *(f32x4*)(out + off + bj * HALF + n * 16) = bs + gv[bj][n] * acc[ai][bj][m][n]; } }
    }
};
struct EpiProj {
    static constexpr bool PERM = true, AFTER_DRAIN = false;
    bf16_t *QA, *QI, *CQ, *CKV, *KA, *VA, *KI, *KPE, *G; float *WI, *ssq_q, *ssq_kv; const float *rcos, *rsin;
    __device__ __forceinline__ void operator()(const f32x4 (&acc)[2][2][4][2], const Unit& u, int wr, int wc, int fr, int fq) const {
        const int row0 = u.pm * BM + wr * 64 + fr, pn = u.pn, c32 = wc * 32 + 8 * fq;
#pragma unroll
        for (int ai = 0; ai < 2; ++ai)
#pragma unroll
            for (int m = 0; m < 4; ++m) {
                const size_t r = (size_t)(row0 + ai * HALF + m * 16);
                const f32x4 a0 = acc[ai][0][m][0], a1 = acc[ai][0][m][1], b0 = acc[ai][1][m][0], b1 = acc[ai][1][m][1];
                const float sa = (a0[0] * a0[0] + a0[1] * a0[1]) + (a0[2] * a0[2] + a0[3] * a0[3]) + (a1[0] * a1[0] + a1[1] * a1[1]) + (a1[2] * a1[2] + a1[3] * a1[3]);
                const float sb = (b0[0] * b0[0] + b0[1] * b0[1]) + (b0[2] * b0[2] + b0[3] * b0[3]) + (b1[0] * b1[0] + b1[1] * b1[1]) + (b1[2] * b1[2] + b1[3] * b1[3]);
                if (pn < 2) { bf16_t* p = QA + r * 512 + pn * 256 + c32; *(u32x4*)p = pack8(a0, a1); *(u32x4*)(p + HALF) = pack8(b0, b1); }
                else if (pn < 4) { bf16_t* p = QI + r * 512 + (pn - 2) * 256 + c32; *(u32x4*)p = pack8(a0, a1); *(u32x4*)(p + HALF) = pack8(b0, b1); }
                else if (pn == 4) { bf16_t* p = CQ + r * 384 + c32; *(u32x4*)p = pack8(a0, a1); *(u32x4*)(p + HALF) = pack8(b0, b1);
                    float s = sa + sb; s += __shfl_xor(s, 16); s += __shfl_xor(s, 32); if (fq == 0) ssq_q[r * 8 + wc] = s; }
                else if (pn == 5) { *(u32x4*)(CQ + r * 384 + 256 + c32) = pack8(a0, a1); *(u32x4*)(CKV + r * 256 + c32) = pack8(b0, b1);
                    float s = sa; s += __shfl_xor(s, 16); s += __shfl_xor(s, 32); float t = sb; t += __shfl_xor(t, 16); t += __shfl_xor(t, 32);
                    if (fq == 0) { ssq_q[r * 8 + 4 + wc] = s; ssq_kv[r * 8 + wc] = t; } }
                else if (pn == 6) { *(u32x4*)(CKV + r * 256 + 128 + c32) = pack8(a0, a1);
                    float s = sa; s += __shfl_xor(s, 16); s += __shfl_xor(s, 32); if (fq == 0) ssq_kv[r * 8 + 4 + wc] = s;
                    if (wc < 2) *(u32x4*)(KA + r * 64 + c32) = pack8(b0, b1); else *(u32x4*)(VA + r * 64 + (c32 - 64)) = pack8(b0, b1); }
                else if (pn == 7) {
                    if (wc < 2) *(u32x4*)(KI + r * 64 + c32) = pack8(a0, a1);
                    else if (wc == 2) {
                        const f32x4 c4 = *(const f32x4*)(rcos + r * 16 + 4 * fq), s4 = *(const f32x4*)(rsin + r * 16 + 4 * fq);
                        const f32x4 o0 = (f32x4){a0[0] * c4[0] - a0[1] * s4[0], a0[1] * c4[0] + a0[0] * s4[0], a0[2] * c4[1] - a0[3] * s4[1], a0[3] * c4[1] + a0[2] * s4[1]};
                        const f32x4 o1 = (f32x4){a1[0] * c4[2] - a1[1] * s4[2], a1[1] * c4[2] + a1[0] * s4[2], a1[2] * c4[3] - a1[3] * s4[3], a1[3] * c4[3] + a1[2] * s4[3]};
                        *(u32x4*)(KPE + r * 32 + 8 * fq) = pack8(o0, o1); }
                    else if (fq == 0) { *(f32x4*)(WI + r * 8) = a0; *(f32x4*)(WI + r * 8 + 4) = a1; }
                }
                else { bf16_t* p = G + r * 2048 + (pn - 8) * 256 + c32; *(u32x4*)p = pack8(sigm4(a0), sigm4(a1)); *(u32x4*)(p + HALF) = pack8(sigm4(b0), sigm4(b1)); }
            }
    }
};
struct EpiUpQ {
    static constexpr bool PERM = true, AFTER_DRAIN = false;
    bf16_t* QB; const float* ssq; const float *rcos, *rsin;
    __device__ __forceinline__ void operator()(const f32x4 (&acc)[2][2][4][2], const Unit& u, int wr, int wc, int fr, int fq) const {
        const int row0 = u.pm * BM + wr * 64 + fr;
#pragma unroll
        for (int ai = 0; ai < 2; ++ai)
#pragma unroll
            for (int m = 0; m < 4; ++m) {
                const size_t r = (size_t)(row0 + ai * HALF + m * 16);
                const f32x4 pa = *(const f32x4*)(ssq + r * 8), pb = *(const f32x4*)(ssq + r * 8 + 4);
                const float rs = __builtin_amdgcn_rsqf((((pa[0] + pa[1]) + (pa[2] + pa[3])) + ((pb[0] + pb[1]) + (pb[2] + pb[3]))) * (1.f / 384.f) + EPS_RMS) * QSCALE;
#pragma unroll
                for (int bj = 0; bj < 2; ++bj) {
                    const int c = u.pn * BM + bj * HALF + wc * 32 + 8 * fq;
                    const bool pe = ((u.pn * 8 + bj * 4 + wc) % 3) == 2;
                    f32x4 v0 = acc[ai][bj][m][0] * rs, v1 = acc[ai][bj][m][1] * rs;
                    if (pe) { const int i0 = 4 * fq;
                        const f32x4 c4 = *(const f32x4*)(rcos + r * 16 + i0), s4 = *(const f32x4*)(rsin + r * 16 + i0);
                        const f32x4 o0 = (f32x4){v0[0] * c4[0] - v0[1] * s4[0], v0[1] * c4[0] + v0[0] * s4[0], v0[2] * c4[1] - v0[3] * s4[1], v0[3] * c4[1] + v0[2] * s4[1]};
                        const f32x4 o1 = (f32x4){v1[0] * c4[2] - v1[1] * s4[2], v1[1] * c4[2] + v1[0] * s4[2], v1[2] * c4[3] - v1[3] * s4[3], v1[3] * c4[3] + v1[2] * s4[3]};
                        v0 = o0; v1 = o1; }
                    *(u32x4*)(QB + r * 768 + c) = pack8(v0, v1); }
                asm volatile("" ::: "memory"); }
    }
};
struct EpiUpKV {
    static constexpr bool PERM = true, AFTER_DRAIN = false;
    bf16_t *KN, *VB; const float* ssq;
    __device__ __forceinline__ void operator()(const f32x4 (&acc)[2][2][4][2], const Unit& u, int wr, int wc, int fr, int fq) const {
        const int row0 = u.pm * BM + wr * 64 + fr; bf16_t* dst = (u.pn < 2) ? KN : VB; const int c0 = (u.pn & 1) * BM + wc * 32 + 8 * fq;
#pragma unroll
        for (int ai = 0; ai < 2; ++ai)
#pragma unroll
            for (int m = 0; m < 4; ++m) {
                const size_t r = (size_t)(row0 + ai * HALF + m * 16);
                const f32x4 pa = *(const f32x4*)(ssq + r * 8), pb = *(const f32x4*)(ssq + r * 8 + 4);
                const float rs = __builtin_amdgcn_rsqf((((pa[0] + pa[1]) + (pa[2] + pa[3])) + ((pb[0] + pb[1]) + (pb[2] + pb[3]))) * (1.f / 256.f) + EPS_RMS);
#pragma unroll
                for (int bj = 0; bj < 2; ++bj) *(u32x4*)(dst + r * 512 + c0 + bj * HALF) = pack8(acc[ai][bj][m][0] * rs, acc[ai][bj][m][1] * rs);
                asm volatile("" ::: "memory"); }
    }
};
template <bool ADD> struct EpiGate {
    static constexpr bool PERM = true, AFTER_DRAIN = false;
    const bf16_t* G; int goff; const bf16_t* Yin; bf16_t* Y;
    __device__ __forceinline__ void operator()(const f32x4 (&acc)[2][2][4][2], const Unit& u, int wr, int wc, int fr, int fq) const {
        const int row0 = u.pm * BM + wr * 64 + fr, c0 = u.pn * BM + wc * 32 + 8 * fq;
#pragma unroll
        for (int ai = 0; ai < 2; ++ai)
#pragma unroll
            for (int m = 0; m < 4; ++m) {
                const size_t r = (size_t)(row0 + ai * HALF + m * 16);
#pragma unroll
                for (int bj = 0; bj < 2; ++bj) { const int c = c0 + bj * HALF;
                    f32x4 g0, g1; unpack8(*(const u32x4*)(G + r * 2048 + goff + c), g0, g1);
                    f32x4 v0 = g0 * acc[ai][bj][m][0], v1 = g1 * acc[ai][bj][m][1];
                    if (ADD) { f32x4 y0, y1; unpack8(*(const u32x4*)(Yin + r * 1024 + c), y0, y1); v0 += y0; v1 += y1; }
                    *(u32x4*)(Y + r * 1024 + c) = pack8(v0, v1); } }
    }
};

template <class Epi, class Sched, bool ALIGN_EPI = false, bool SP2 = false>
__device__ __forceinline__ void gemm_phase(PG8_LAS unsigned char* lds, const Gemm g, const Sched& S, const Epi& E) {
    const int tid = threadIdx.x, wid = __builtin_amdgcn_readfirstlane(tid >> 6), lane = tid & 63, wr = wid >> 2, wc = wid & 3, fr = lane & 15, fq = lane >> 4;
    const int K = g.K, nt = K / BK;
    unsigned voffA[2], voffB[2];
#pragma unroll
    for (int i = 0; i < 2; ++i) { int R, C; stage_rc(tid * 16 + i * 8192, R, C); const int Rb = Epi::PERM ? ((R & ~31) + perm32(R & 31)) : R;
        voffA[i] = (unsigned)(R * K + C) * 2u; voffB[i] = (unsigned)(Rb * K + C) * 2u; }
    const size_t kstep = (size_t)(BK * 2);
    const size_t hstep = (size_t)HALF * K * 2;
    const size_t tstep = 2 * hstep;
    const unsigned ldsw = (unsigned)wid * 1024u;
    const int aoff = lds_byte(wr * 64 + fr, fq * 8), boff = lds_byte(wc * 32 + fr, fq * 8);
#define PG8_SA(b, h) (((b) * 2 + (h)) * HTB)
#define PG8_SB(b, h) ((4 + (b) * 2 + (h)) * HTB)
#define PG8_STAGE(bufoff, gbase, voff) do { _Pragma("unroll") for (int _i = 0; _i < 2; ++_i) \
        __builtin_amdgcn_global_load_lds((const unsigned*)((const char*)(gbase) + (voff)[_i]), (PG8_LAS unsigned*)(lds + (bufoff) + ldsw + _i * 8192), 16, 0, 0); } while (0)
#define PG8_LDA(dst, b, h) do { _Pragma("unroll") for (int m = 0; m < 4; ++m) _Pragma("unroll") for (int k = 0; k < 2; ++k) dst[m][k] = *(const PG8_LAS bf16x8*)(lds + PG8_SA(b, h) + aoff + m * 2048 + k * 1024); } while (0)
#define PG8_LDB(dst, b, h) do { _Pragma("unroll") for (int n = 0; n < 2; ++n) _Pragma("unroll") for (int k = 0; k < 2; ++k) dst[n][k] = *(const PG8_LAS bf16x8*)(lds + PG8_SB(b, h) + boff + n * 2048 + k * 1024); } while (0)
#define PG8_MMA(ai, bj, At, Bt) do { __builtin_amdgcn_s_setprio(1); _Pragma("unroll") for (int m = 0; m < 4; ++m) _Pragma("unroll") for (int n = 0; n < 2; ++n) _Pragma("unroll") for (int k = 0; k < 2; ++k) \
        acc[ai][bj][m][n] = __builtin_amdgcn_mfma_f32_16x16x32_bf16(Bt[n][k], At[m][k], acc[ai][bj][m][n], 0, 0, 0); __builtin_amdgcn_s_setprio(0); } while (0)
#define PG8_WAIT_V(n) asm volatile("s_waitcnt vmcnt(" #n ")" ::: "memory")
#define PG8_WAIT_L(n) asm volatile("s_waitcnt lgkmcnt(" #n ")" ::: "memory")
#define PG8_BAR __builtin_amdgcn_s_barrier()
#define PG8_SCHED __builtin_amdgcn_sched_barrier(0)
    Unit cur, nxt; int ui = 0;
    if (!S.next(0, cur)) return;
    f32x4 acc[2][2][4][2];
#pragma unroll
    for (int a = 0; a < 2; ++a)
#pragma unroll
        for (int b = 0; b < 2; ++b)
#pragma unroll
            for (int m = 0; m < 4; ++m)
#pragma unroll
                for (int n = 0; n < 2; ++n) acc[a][b][m][n] = (f32x4){0.f, 0.f, 0.f, 0.f};
    bf16x8 At[4][2], B0[2][2], B1[2][2];
    const char* cA = (const char*)g.A + (size_t)cur.pm * tstep; const char* cB = (const char*)g.Bt + (size_t)cur.pn * tstep;
    S.a_ready(cur);
    if constexpr (SP2) {
        PG8_STAGE(PG8_SB(0, 0), cB, voffB); PG8_STAGE(PG8_SB(0, 1), cB + hstep, voffB); PG8_STAGE(PG8_SA(0, 0), cA, voffA); PG8_STAGE(PG8_SA(0, 1), cA + hstep, voffA);
        if (wr == 1) PG8_BAR;
        PG8_WAIT_V(2); PG8_BAR;
        PG8_STAGE(PG8_SB(1, 0), cB + kstep, voffB); PG8_STAGE(PG8_SA(1, 0), cA + kstep, voffA); PG8_STAGE(PG8_SB(1, 1), cB + hstep + kstep, voffB);
        PG8_WAIT_V(6); PG8_BAR;
    } else {
        PG8_STAGE(PG8_SB(0, 0), cB, voffB); PG8_STAGE(PG8_SA(0, 0), cA, voffA); PG8_STAGE(PG8_SB(0, 1), cB + hstep, voffB); PG8_STAGE(PG8_SA(0, 1), cA + hstep, voffA);
        if (wr == 1) PG8_BAR;
        PG8_WAIT_V(4); PG8_BAR;
        PG8_STAGE(PG8_SB(1, 0), cB + kstep, voffB); PG8_STAGE(PG8_SA(1, 0), cA + kstep, voffA); PG8_STAGE(PG8_SB(1, 1), cB + hstep + kstep, voffB);
        PG8_WAIT_V(6); PG8_BAR;
    }
    for (;;) {
        const bool has_next = S.next(ui + 1, nxt);
        const char* nA = has_next ? (const char*)g.A + (size_t)nxt.pm * tstep : cA; const char* nB = has_next ? (const char*)g.Bt + (size_t)nxt.pn * tstep : cB;
#pragma nounroll
        for (int t = 0; t < nt; t += 2) {
            const bool last = (t == nt - 2);
            const char* a1 = cA + (size_t)(t + 1) * kstep;
            const char* a2 = last ? nA : cA + (size_t)(t + 2) * kstep; const char* b2 = last ? nB : cB + (size_t)(t + 2) * kstep;
            const char* a3 = a2 + kstep; const char* b3 = b2 + kstep;
            if (last && has_next) S.a_ready(nxt);
            if constexpr (SP2) {
            PG8_LDB(B0, 0, 0); PG8_LDB(B1, 0, 1); PG8_SCHED; PG8_LDA(At, 0, 0); PG8_STAGE(PG8_SA(1, 1), a1 + hstep, voffA);
            PG8_WAIT_V(8); PG8_WAIT_L(0); PG8_BAR; PG8_MMA(0, 0, At, B0); PG8_MMA(0, 1, At, B1); PG8_BAR; PG8_SCHED;
            PG8_LDA(At, 0, 1); PG8_STAGE(PG8_SB(0, 0), b2, voffB); PG8_STAGE(PG8_SB(0, 1), b2 + hstep, voffB); PG8_STAGE(PG8_SA(0, 0), a2, voffA);
            PG8_WAIT_V(8); PG8_WAIT_L(0); PG8_BAR; PG8_MMA(1, 0, At, B0); PG8_MMA(1, 1, At, B1); PG8_BAR; PG8_SCHED;
            PG8_LDB(B0, 1, 0); PG8_LDB(B1, 1, 1); PG8_SCHED; PG8_LDA(At, 1, 0); PG8_STAGE(PG8_SA(0, 1), a2 + hstep, voffA);
            PG8_WAIT_V(8); PG8_WAIT_L(0); PG8_BAR; PG8_MMA(0, 0, At, B0); PG8_MMA(0, 1, At, B1); PG8_BAR; PG8_SCHED;
            PG8_LDA(At, 1, 1); PG8_STAGE(PG8_SB(1, 0), b3, voffB); PG8_STAGE(PG8_SB(1, 1), b3 + hstep, voffB); PG8_STAGE(PG8_SA(1, 0), a3, voffA);
            PG8_WAIT_V(8); PG8_WAIT_L(0); PG8_BAR; PG8_MMA(1, 0, At, B0); PG8_MMA(1, 1, At, B1); PG8_BAR; PG8_SCHED;
            } else {
            PG8_LDB(B0, 0, 0); PG8_SCHED; PG8_LDA(At, 0, 0); PG8_STAGE(PG8_SA(1, 1), a1 + hstep, voffA);
            PG8_WAIT_L(8); PG8_BAR; PG8_WAIT_L(0); PG8_MMA(0, 0, At, B0); PG8_BAR; PG8_SCHED;
            PG8_LDB(B1, 0, 1); PG8_STAGE(PG8_SB(0, 0), b2, voffB);
            PG8_BAR; PG8_WAIT_L(0); PG8_MMA(0, 1, At, B1); PG8_BAR;
            PG8_LDA(At, 0, 1); PG8_STAGE(PG8_SA(0, 0), a2, voffA);
            PG8_BAR; PG8_WAIT_L(0); PG8_MMA(1, 0, At, B0); PG8_BAR; PG8_SCHED;
            PG8_STAGE(PG8_SB(0, 1), b2 + hstep, voffB);
            PG8_WAIT_V(6); PG8_BAR; PG8_MMA(1, 1, At, B1); PG8_BAR;
            PG8_LDB(B0, 1, 0); PG8_SCHED; PG8_LDA(At, 1, 0); PG8_STAGE(PG8_SA(0, 1), a2 + hstep, voffA);
            PG8_WAIT_L(8); PG8_BAR; PG8_WAIT_L(0); PG8_MMA(0, 0, At, B0); PG8_BAR; PG8_SCHED;
            PG8_LDB(B1, 1, 1); PG8_STAGE(PG8_SB(1, 0), b3, voffB);
            PG8_BAR; PG8_WAIT_L(0); PG8_MMA(0, 1, At, B1); PG8_BAR;
            PG8_LDA(At, 1, 1); PG8_STAGE(PG8_SA(1, 0), a3, voffA);
            PG8_BAR; PG8_WAIT_L(0); PG8_MMA(1, 0, At, B0); PG8_BAR; PG8_SCHED;
            PG8_STAGE(PG8_SB(1, 1), b3 + hstep, voffB);
            PG8_WAIT_V(6); PG8_BAR; PG8_MMA(1, 1, At, B1); PG8_BAR;
            }
        }
        if constexpr (ALIGN_EPI) { if (wr == 0) PG8_BAR; }
        if constexpr (!Epi::AFTER_DRAIN) { E(acc, cur, wr, wc, fr, fq); S.done(cur); }
        if (!has_next) break;
#pragma unroll
        for (int a = 0; a < 2; ++a)
#pragma unroll
            for (int b = 0; b < 2; ++b)
#pragma unroll
                for (int m = 0; m < 4; ++m)
#pragma unroll
                    for (int n = 0; n < 2; ++n) acc[a][b][m][n] = (f32x4){0.f, 0.f, 0.f, 0.f};
        cur = nxt; cA = nA; cB = nB; ++ui;
        if constexpr (ALIGN_EPI) { if (wr == 1) PG8_BAR; }
    }
    PG8_WAIT_V(0);
    if constexpr (!ALIGN_EPI) { if (wr == 0) PG8_BAR; }
    PG8_BAR;
    if constexpr (Epi::AFTER_DRAIN) { E.fused(acc, cur, wr, wc, fr, fq, lds, wid, lane); S.done(cur); }
#undef PG8_SA
#undef PG8_SB
#undef PG8_STAGE
#undef PG8_LDA
#undef PG8_LDB
#undef PG8_MMA
#undef PG8_WAIT_V
#undef PG8_WAIT_L
#undef PG8_BAR
#undef PG8_SCHED
}
}

constexpr int NWAVES = 8;
constexpr int BATCH = 4, T = 8192, D = 1024, DFF = 2816, M = BATCH * T;
constexpr int INC = 3944, NPROJ = 4096;
constexpr int O_QA = 0, O_KA = 512, O_VA = 576, O_QI = 640, O_KI = 1152, O_WI = 1216, O_CQ = 1224, O_CKV = 1608, O_KR = 1864, O_GATE = 1896;
constexpr float EPS = 1e-6f;
#ifndef MK_FUSED
#define MK_FUSED 1
#endif

constexpr size_t MiB = 1u << 20;
constexpr size_t WS_CTL = 0, CTL_ZERO_BYTES = 2 * MiB;
constexpr size_t WS_MOD = 256 * 1024;
constexpr size_t WS_SSQQ = 49 * MiB, WS_SSQKV = 50 * MiB;
constexpr size_t WS_W1A = 2 * MiB, SZ_WA = (size_t)2 * DFF * D * 2, SZ_WD = (size_t)D * DFF * 2;
constexpr size_t WS_W1D = WS_W1A + SZ_WA, WS_WIN = WS_W1D + SZ_WD, WS_WUQ = WS_WIN + (size_t)NPROJ * D * 2, WS_WUKV = WS_WUQ + (size_t)768 * 384 * 2;
constexpr size_t WS_WOA = WS_WUKV + (size_t)1024 * 256 * 2, WS_WOB = WS_WOA + (size_t)D * 512 * 2, WS_WOUT = WS_WOB + (size_t)D * 512 * 2;
constexpr size_t WS_W2A = WS_WOUT + (size_t)D * D * 2, WS_W2D = WS_W2A + SZ_WA, WS_WEND = WS_W2D + SZ_WD;
static_assert(WS_WEND <= 49 * MiB, "weights");
constexpr size_t WS_RCOS = 51 * MiB, WS_RSIN = 53 * MiB;
constexpr size_t WS_XN = 55 * MiB;
constexpr size_t WS_ACT = 119 * MiB;
constexpr size_t WS_QA = WS_ACT, WS_QI = WS_QA + 32 * MiB, WS_CQ = WS_QI + 32 * MiB, WS_CKV = WS_CQ + 24 * MiB, WS_KA = WS_CKV + 16 * MiB, WS_VA = WS_KA + 4 * MiB;
constexpr size_t WS_KI = WS_VA + 4 * MiB, WS_KPE = WS_KI + 4 * MiB, WS_WI = WS_KPE + 2 * MiB, WS_QB = WS_WI + 1 * MiB, WS_MIXEND = WS_QB + 48 * MiB;
static_assert(WS_MIXEND <= WS_ACT + 176 * MiB, "mixer overlay");
constexpr size_t WS_G = 295 * MiB;
constexpr size_t WS_KN = 423 * MiB, WS_VB = 455 * MiB;
constexpr size_t WS_SEL = 487 * MiB;
constexpr size_t WS_END = 503 * MiB;
static_assert(WS_XN + 64 * MiB <= WS_ACT && WS_ACT + 176 * MiB <= WS_G && WS_G + 128 * MiB <= WS_KN && WS_VB + 32 * MiB <= WS_SEL, "d_ws map");
constexpr size_t WS_OA = WS_CQ, WS_OB = WS_QI, WS_Y1 = WS_KN, WS_Y = WS_XN;
constexpr int CW_TMO = 0, CW_CODE = 1, CW_BAR = 4096;

constexpr int RING_OFF = 0, RING_BYTES = 151552;
constexpr int LDSCTL_OFF = RING_BYTES, MISC_OFF = LDSCTL_OFF + 320;
constexpr int LDS_BYTES = RING_BYTES + 1024;
#ifndef PROF_SEL
#define PROF_SEL 0
#endif
#ifndef PROF_MULT
#define PROF_MULT 4
#endif
#define PROF_WORD(ldsring, wid_) ((LAS unsigned*)((ldsring) + (MISC_OFF - RING_OFF) + 64) + (wid_))
#define PROF_T0(id) unsigned long long pt_##id = 0ull; if (PROF_SEL == (id)) pt_##id = __builtin_amdgcn_s_memrealtime()
#define PROF_T1(id, ldsring, wid_, lane_) do { if (PROF_SEL == (id)) { const unsigned d_ = (unsigned)(__builtin_amdgcn_s_memrealtime() - pt_##id); if ((lane_) == 0) *PROF_WORD(ldsring, wid_) += d_; } } while (0)
#define GAS __attribute__((address_space(1)))
#define LAS __attribute__((address_space(3)))
typedef unsigned short bf16;
typedef unsigned v4u __attribute__((ext_vector_type(4)));
typedef float f32x4 __attribute__((ext_vector_type(4)));
typedef short bf16x8 __attribute__((ext_vector_type(8)));
typedef GAS unsigned gu32;
typedef GAS unsigned long long gu64;
#define RLX_AGENT __ATOMIC_RELAXED, __HIP_MEMORY_SCOPE_AGENT
#define LDS_WAIT() asm volatile("s_waitcnt lgkmcnt(0)" ::: "memory")
#define VM_WAIT() asm volatile("s_waitcnt vmcnt(0)" ::: "memory")
__device__ __forceinline__ unsigned long long rt() { return __builtin_amdgcn_s_memrealtime(); }
__device__ __forceinline__ unsigned f2bf(float f) { unsigned u = __builtin_bit_cast(unsigned, f); return (u + 0x7fffu + ((u >> 16) & 1u)) >> 16; }
__device__ __forceinline__ unsigned pk2(float lo, float hi) { return f2bf(lo) | (f2bf(hi) << 16); }

#define XB_TMO      128
#define XB_XCNT(j)  (256  + 64 * (j))
#define XB_XSUB(j)  (1280 + 64 * (j))
#define XB_XGEN(j)  (2304 + 64 * (j))
#define XB_TOP      3328
#define XB_TOPGEN   3392
#define XCD_BAR_WORDS 3456
#define XB_SPIN_CAP (1u << 18)

__device__ __forceinline__ unsigned xb_ld(unsigned* p)              { return __hip_atomic_load(p, __ATOMIC_RELAXED, __HIP_MEMORY_SCOPE_AGENT); }
__device__ __forceinline__ unsigned xb_add(unsigned* p, unsigned v) { return __hip_atomic_fetch_add(p, v, __ATOMIC_RELAXED, __HIP_MEMORY_SCOPE_AGENT); }
__device__ __forceinline__ unsigned xb_xcc_id() { return (unsigned)__builtin_amdgcn_s_getreg((3 << 11) | 20) & 0xFu; }
#define XB_SPIN(cond, bar) do { unsigned _sp = 0; while (cond) { __builtin_amdgcn_s_sleep(1); \
    if ((++_sp & 255u) == 0u) { if (xb_ld(&(bar)[XB_TMO])) break; if (_sp > XB_SPIN_CAP) { atomicAdd(&(bar)[XB_TMO], 1u); break; } } } } while (0)

struct XcdBarrier {
    unsigned* bar; unsigned x;
    volatile LAS unsigned* st;
};

__device__ __forceinline__ XcdBarrier xcd_barrier_post(unsigned* bar, volatile LAS unsigned* st) {
    XcdBarrier b; b.bar = bar; b.x = xb_xcc_id(); b.st = st;
    if (threadIdx.x == 0) (void)xb_add(&bar[XB_XCNT(b.x)], 1u);
    return b;
}
__device__ __forceinline__ void xcd_barrier_complete(unsigned* bar, unsigned x, unsigned& nloc, unsigned& nx) {
    const unsigned G = gridDim.x * gridDim.y * gridDim.z;
    unsigned sum, cnt, mine, sp = 0u;
    for (;;) {
        sum = 0u; cnt = 0u; mine = 0u;
#pragma unroll
        for (unsigned j = 0; j < 16; ++j) { const unsigned c = xb_ld(&bar[XB_XCNT(j)]); sum += c; cnt += (c > 0u) ? 1u : 0u; mine = (j == x) ? c : mine; }
        if (sum == G) break;
        __builtin_amdgcn_s_sleep(1);
        if ((++sp & 255u) == 0u) { if (xb_ld(&bar[XB_TMO])) break; if (sp > XB_SPIN_CAP) { atomicAdd(&bar[XB_TMO], 1u); break; } }
    }
    nloc = mine > 0u ? mine : 1u; nx = cnt > 0u ? cnt : 1u;
}

__device__ __forceinline__ void xcd_barrier(const XcdBarrier& b) {
    asm volatile("s_waitcnt vmcnt(0)" ::: "memory");
    __syncthreads();
    if (threadIdx.x == 0) {
        unsigned* bar = b.bar;
        __builtin_amdgcn_s_waitcnt(0);
        unsigned nloc = b.st[0], nx = b.st[1];
        if (nloc == 0u) { xcd_barrier_complete(bar, b.x, nloc, nx); b.st[0] = nloc; b.st[1] = nx; }
        const unsigned old = xb_add(&bar[XB_XSUB(b.x)], 1u);
        const unsigned gen = old / nloc;
        if (old + 1u == (gen + 1u) * nloc) {
            __builtin_amdgcn_fence(__ATOMIC_RELEASE, "agent");
            asm volatile("s_waitcnt vmcnt(0)" ::: "memory");
            const unsigned og = xb_add(&bar[XB_TOP], 1u);
            const unsigned tg = og / nx;
            if (og + 1u == (tg + 1u) * nx) xb_add(&bar[XB_TOPGEN], 1u);
            else XB_SPIN(xb_ld(&bar[XB_TOPGEN]) == tg, bar);
            __builtin_amdgcn_fence(__ATOMIC_ACQUIRE, "agent");
            xb_add(&bar[XB_XGEN(b.x)], 1u);
            asm volatile("s_waitcnt vmcnt(0)" ::: "memory");
        } else {
            XB_SPIN(xb_ld(&bar[XB_XGEN(b.x)]) == gen, bar);
            __builtin_amdgcn_fence(__ATOMIC_ACQUIRE, "agent");
            asm volatile("s_waitcnt vmcnt(0)" ::: "memory");
        }
    }
    __syncthreads();
}

struct Frame {
    LAS unsigned char* lds;
    volatile LAS unsigned* MISC;
    gu32* ctl;
    int tid, lane, wave;
    int vcu, G;
};
__device__ __forceinline__ float wave_sum(float v) {
#pragma unroll
    for (int o = 1; o < 64; o <<= 1) v += __shfl_xor(v, o);
    return v;
}
struct MapIdent { int off; __device__ __forceinline__ int src(int n) const { return n + off; } };
struct MapFfnIn { __device__ __forceinline__ int src(int n) const { const int pn = n >> 8, j = n & 255; return (j >> 7) * DFF + pn * 128 + (j & 127); } };
struct MapProj { __device__ __forceinline__ int src(int n) const { const int pn = n >> 8, j = n & 255;
    if (pn < 2) return O_QA + n; if (pn < 4) return O_QI + (n - 512); if (pn == 4) return O_CQ + j;
    if (pn == 5) return j < 128 ? O_CQ + 256 + j : O_CKV + (j - 128);
    if (pn == 6) return j < 128 ? O_CKV + 128 + j : (j < 192 ? O_KA + (j - 128) : O_VA + (j - 192));
    if (pn == 7) { if (j < 64) return O_KI + j; if (j < 96) { const int jj = j - 64; return O_KR + (jj >> 1) + 16 * (jj & 1); } if (j < 104) return O_WI + (j - 96); return -1; }
    return O_GATE + (n - 2048); } };
struct MapUq { __device__ __forceinline__ int src(int n) const { const int h = n / 96, w = n % 96; if (w < 64) return n; const int jj = w - 64; return h * 96 + 64 + (jj >> 1) + 16 * (jj & 1); } };
template <class Map> __device__ __forceinline__ void p0_transpose_item(const float* W, int K, int Nsrc, int nblk, const float* kscale, bf16* WT, const Map mp, LAS float* scr, int item, int lane) {
    const int kb = item / nblk, nb = item % nblk, k0 = 64 * kb, n0 = 32 * nb;
    const int sc = mp.src(n0 + (lane & 31));
    float vv[32];
#pragma unroll
    for (int i = 0; i < 32; ++i) { const int kk = 2 * i + (lane >> 5); vv[i] = sc >= 0 ? W[(size_t)(k0 + kk) * Nsrc + sc] : 0.f; }
#pragma unroll
    for (int i = 0; i < 32; ++i) { const int kk = 2 * i + (lane >> 5); float v = vv[i]; if (kscale) v *= kscale[k0 + kk]; scr[kk * 33 + (lane & 31)] = v; }
    LDS_WAIT(); asm volatile("" ::: "memory");
    const int c = lane & 7;
#pragma unroll
    for (int j = 0; j < 4; ++j) { const int n = (lane >> 3) + 8 * j; const LAS float* s = scr + (8 * c) * 33 + n;
        v4u o; o.x = pk2(s[0 * 33], s[1 * 33]); o.y = pk2(s[2 * 33], s[3 * 33]); o.z = pk2(s[4 * 33], s[5 * 33]); o.w = pk2(s[6 * 33], s[7 * 33]);
        *(GAS v4u*)(WT + (size_t)(n0 + n) * K + k0 + 8 * c) = o; }
    LDS_WAIT(); asm volatile("" ::: "memory");
}
struct Args { const void* in[23]; float* out; unsigned char* ws; int ph_lo, ph_hi, li, pad; };

__device__ __forceinline__ void p0_prologue(Frame& F, const Args& A) {
    LAS float* scr = (LAS float*)(F.lds + RING_OFF + F.wave * 16384);
    const int gw = F.vcu * NWAVES + F.wave, NGW = F.G * NWAVES;
    unsigned char* ws = A.ws;
    {
        const float* c = (const float*)A.in[1]; const float* w = (const float*)A.in[3]; const float* bias = (const float*)A.in[4]; float* mod = (float*)(ws + WS_MOD);
        for (int cg = F.vcu; cg < 256; cg += F.G) {
            const bool act = F.lane < 36; const int n = cg * 36 + (act ? F.lane : 0), k0 = F.wave * 128;
#pragma unroll
            for (int b = 0; b < 4; ++b)
#pragma unroll
                for (int h = 0; h < 2; ++h) { const float v = c[b * D + k0 + h * 64 + F.lane]; scr[b * 128 + h * 64 + F.lane] = v / (1.f + __expf(-v)); }
            LDS_WAIT(); asm volatile("" ::: "memory");
            float a0 = 0.f, a1 = 0.f, a2 = 0.f, a3 = 0.f;
#pragma unroll 8
            for (int k = 0; k < 128; ++k) { const float wv = act ? w[(size_t)(k0 + k) * 9216 + n] : 0.f; a0 += scr[k] * wv; a1 += scr[128 + k] * wv; a2 += scr[256 + k] * wv; a3 += scr[384 + k] * wv; }
            scr[1024 + F.lane] = a0; scr[1088 + F.lane] = a1; scr[1152 + F.lane] = a2; scr[1216 + F.lane] = a3;
            __syncthreads();
            if (F.wave < 4 && act) { float t = bias[n];
#pragma unroll
                for (int ww = 0; ww < 8; ++ww) t += ((LAS float*)(F.lds + RING_OFF + ww * 16384))[1024 + F.wave * 64 + F.lane];
                mod[F.wave * 9216 + n] = t; }
            __syncthreads();
        }
    }
    {
        const float* w1a = (const float*)A.in[6]; const float* w1d = (const float*)A.in[7]; const float* win = (const float*)A.in[9]; const float* gcq = (const float*)A.in[10];
        const float* wuq = (const float*)A.in[11]; const float* gckv = (const float*)A.in[12]; const float* wuk = (const float*)A.in[13]; const float* wuv = (const float*)A.in[14];
        const float* woa = (const float*)A.in[16]; const float* wob = (const float*)A.in[17]; const float* wout = (const float*)A.in[18]; const float* w2a = (const float*)A.in[20]; const float* w2d = (const float*)A.in[21];
        constexpr int I_A = 16 * 176, I_D = 44 * 32, I_IN = 16 * 128, I_UQ = 6 * 24, I_UK = 4 * 16, I_O = 8 * 32, I_OUT = 16 * 32;
        constexpr int NITEMS = 2 * I_A + 2 * I_D + I_IN + I_UQ + 2 * I_UK + 2 * I_O + I_OUT;
        for (int it = gw; it < NITEMS; it += NGW) {
            int r = it;
            if (r < I_A) { p0_transpose_item(w1a, D, 2 * DFF, 176, nullptr, (bf16*)(ws + WS_W1A), MapFfnIn{}, scr, r, F.lane); continue; } r -= I_A;
            if (r < I_A) { p0_transpose_item(w2a, D, 2 * DFF, 176, nullptr, (bf16*)(ws + WS_W2A), MapFfnIn{}, scr, r, F.lane); continue; } r -= I_A;
            if (r < I_D) { p0_transpose_item(w1d, DFF, D, 32, nullptr, (bf16*)(ws + WS_W1D), MapIdent{0}, scr, r, F.lane); continue; } r -= I_D;
            if (r < I_D) { p0_transpose_item(w2d, DFF, D, 32, nullptr, (bf16*)(ws + WS_W2D), MapIdent{0}, scr, r, F.lane); continue; } r -= I_D;
            if (r < I_IN) { p0_transpose_item(win, D, INC, 128, nullptr, (bf16*)(ws + WS_WIN), MapProj{}, scr, r, F.lane); continue; } r -= I_IN;
            if (r < I_UQ) { p0_transpose_item(wuq, 384, 768, 24, gcq, (bf16*)(ws + WS_WUQ), MapUq{}, scr, r, F.lane); continue; } r -= I_UQ;
            if (r < I_UK) { p0_transpose_item(wuk, 256, 512, 16, gckv, (bf16*)(ws + WS_WUKV), MapIdent{0}, scr, r, F.lane); continue; } r -= I_UK;
            if (r < I_UK) { p0_transpose_item(wuv, 256, 512, 16, gckv, (bf16*)(ws + WS_WUKV) + (size_t)512 * 256, MapIdent{0}, scr, r, F.lane); continue; } r -= I_UK;
            if (r < I_O) { p0_transpose_item(woa, 512, D, 32, nullptr, (bf16*)(ws + WS_WOA), MapIdent{0}, scr, r, F.lane); continue; } r -= I_O;
            if (r < I_O) { p0_transpose_item(wob, 512, D, 32, nullptr, (bf16*)(ws + WS_WOB), MapIdent{0}, scr, r, F.lane); continue; } r -= I_O;
            p0_transpose_item(wout, D, D, 32, nullptr, (bf16*)(ws + WS_WOUT), MapIdent{0}, scr, r, F.lane);
        }
    }
    {
        const int* pos = (const int*)A.in[2]; float* rc = (float*)(ws + WS_RCOS); float* rs = (float*)(ws + WS_RSIN);
        for (int idx = gw * 64 + F.lane; idx < M * 16; idx += NGW * 64) { const int t = idx >> 4, i = idx & 15;
            const float freq = powf(10000.0f, -2.0f * (float)i / 32.0f); const float ang = (float)pos[t] * freq;
            rc[idx] = cosf(ang); rs[idx] = sinf(ang); }
    }
}
__device__ __forceinline__ void norm_mod_phase(Frame& F, const float* xin, const float* g, const float* mod, int shoff, int scoff, bf16* out) {
    const int gw = F.vcu * NWAVES + F.wave, NGW = F.G * NWAVES;
    for (int m = gw; m < M; m += NGW) {
        const int b = m >> 13;
        const GAS f32x4* xr = (const GAS f32x4*)(xin + (size_t)m * D) + F.lane;
        const GAS f32x4* g4 = (const GAS f32x4*)g + F.lane; const GAS f32x4* sc4 = (const GAS f32x4*)(mod + b * 9216 + scoff) + F.lane; const GAS f32x4* sh4 = (const GAS f32x4*)(mod + b * 9216 + shoff) + F.lane;
        f32x4 v[4]; float s = 0.f;
#pragma unroll
        for (int j = 0; j < 4; ++j) { v[j] = xr[64 * j]; s += (v[j].x * v[j].x + v[j].y * v[j].y) + (v[j].z * v[j].z + v[j].w * v[j].w); }
        const float rs = __builtin_amdgcn_rsqf(wave_sum(s) * (1.f / D) + EPS);
        GAS unsigned long long* o8 = (GAS unsigned long long*)(out + (size_t)m * D) + F.lane;
#pragma unroll
        for (int j = 0; j < 4; ++j) { const f32x4 o = v[j] * rs * g4[64 * j] * (sc4[64 * j] + 1.f) + sh4[64 * j];
            o8[64 * j] = (unsigned long long)pk2(o.x, o.y) | ((unsigned long long)pk2(o.z, o.w) << 32); }
    }
}
__device__ __forceinline__ void final_norm_phase(Frame& F, const float* xin, const float* g, float* out) {
    const int gw = F.vcu * NWAVES + F.wave, NGW = F.G * NWAVES;
    for (int m = gw; m < M; m += NGW) {
        const GAS f32x4* xr = (const GAS f32x4*)(xin + (size_t)m * D) + F.lane; const GAS f32x4* g4 = (const GAS f32x4*)g + F.lane;
        f32x4 v[4]; float s = 0.f;
#pragma unroll
        for (int j = 0; j < 4; ++j) { v[j] = xr[64 * j]; s += (v[j].x * v[j].x + v[j].y * v[j].y) + (v[j].z * v[j].z + v[j].w * v[j].w); }
        const float rs = __builtin_amdgcn_rsqf(wave_sum(s) * (1.f / D) + EPS);
        GAS f32x4* o4 = (GAS f32x4*)(out + (size_t)m * D) + F.lane;
#pragma unroll
        for (int j = 0; j < 4; ++j) o4[64 * j] = v[j] * rs * g4[64 * j];
    }
}

namespace mla {
typedef unsigned u32x4 __attribute__((ext_vector_type(4)));
typedef short bf16x8 __attribute__((ext_vector_type(8)));
typedef short s16x4 __attribute__((ext_vector_type(4)));
typedef float f32x16 __attribute__((ext_vector_type(16)));
constexpr int KSLOT = 12288, VSLOT = 8192;
constexpr int L_K = 0, L_V = 3 * KSLOT, L_WS = L_V + 3 * VSLOT, L_OST = L_WS + 2048, L_END = L_OST + 8 * 4096;
static_assert(L_END <= RING_BYTES, "attention LDS");
__device__ __forceinline__ int crow(int r, int hi) { return (r & 3) + 8 * (r >> 2) + 4 * hi; }
__device__ __forceinline__ float xhalf(float v) { return __shfl_xor(v, 32); }
__device__ __forceinline__ void pv(f32x16* o, int vb, bf16x8 pa0, bf16x8 pa1, bf16x8 pa2, bf16x8 pa3) {
#pragma unroll
    for (int d0 = 0; d0 < 2; ++d0) { s16x4 lo[4], hi[4];
#pragma unroll
        for (int ks = 0; ks < 4; ++ks) {
            asm volatile("ds_read_b64_tr_b16 %0,%1 offset:%c2" : "=&v"(lo[ks]) : "v"(vb), "i"(d0 * 4096 + ks * 1024) : "memory");
            asm volatile("ds_read_b64_tr_b16 %0,%1 offset:%c2" : "=&v"(hi[ks]) : "v"(vb), "i"(d0 * 4096 + ks * 1024 + 512) : "memory"); }
        asm volatile("s_waitcnt lgkmcnt(0)" ::: "memory"); __builtin_amdgcn_sched_barrier(0);
#define MLA_PK(k) (bf16x8){lo[k][0], lo[k][1], lo[k][2], lo[k][3], hi[k][0], hi[k][1], hi[k][2], hi[k][3]}
        o[d0] = __builtin_amdgcn_mfma_f32_32x32x16_bf16(pa0, MLA_PK(0), o[d0], 0, 0, 0);
        o[d0] = __builtin_amdgcn_mfma_f32_32x32x16_bf16(pa1, MLA_PK(1), o[d0], 0, 0, 0);
        o[d0] = __builtin_amdgcn_mfma_f32_32x32x16_bf16(pa2, MLA_PK(2), o[d0], 0, 0, 0);
        o[d0] = __builtin_amdgcn_mfma_f32_32x32x16_bf16(pa3, MLA_PK(3), o[d0], 0, 0, 0);
#undef MLA_PK
    }
}
__device__ __forceinline__ void attn_unit(int b, int h, int qb, const bf16* QB, const bf16* KN, const bf16* KPE, const bf16* VB, bf16* OB, LAS unsigned char* lds) {
    const int tid = threadIdx.x, lane = tid & 63, r32 = lane & 31, hi = lane >> 5; const int wid = __builtin_amdgcn_readfirstlane(tid >> 6);
    const size_t rowbase = (size_t)b * T; const int q0 = qb * 256;
    const int NT = 4 * (qb + 1), my_last = 4 * qb + (wid >> 1);
    LAS float* wsf = (LAS float*)(lds + L_WS) + wid * 64;
#define MLA_DMA(t, slot) do { const size_t krow_ = rowbase + (size_t)(t) * 64 + lane; \
        __builtin_amdgcn_global_load_lds((const unsigned*)(KN + krow_ * 512 + h * 64 + wid * 8), (LAS unsigned*)(lds + L_K + (slot) * KSLOT + wid * 1024), 16, 0, 0); \
        if (wid < 4) __builtin_amdgcn_global_load_lds((const unsigned*)(KPE + krow_ * 32 + wid * 8), (LAS unsigned*)(lds + L_K + (slot) * KSLOT + (8 + wid) * 1024), 16, 0, 0); \
        const size_t vrow_ = rowbase + (size_t)(t) * 64 + 16 * (wid & 3) + (lane >> 2); \
        __builtin_amdgcn_global_load_lds((const unsigned*)(VB + vrow_ * 512 + h * 64 + (wid >> 2) * 32 + (lane & 3) * 8), (LAS unsigned*)(lds + L_V + (slot) * VSLOT + wid * 1024), 16, 0, 0); } while (0)
    bf16x8 qr[6];
    { const bf16* Qw = QB + (rowbase + q0 + wid * 32 + r32) * 768 + h * 96 + hi * 8;
#pragma unroll
      for (int d0 = 0; d0 < 6; ++d0) qr[d0] = *(const bf16x8*)(Qw + d0 * 16); }
    MLA_DMA(0, 0); MLA_DMA(1, 1);
    int slot = 0, slot2 = 2;
    float m = 0.f, l = 0.f; f32x16 o[2], negm;
#pragma unroll
    for (int r = 0; r < 16; ++r) { o[0][r] = 0.f; o[1][r] = 0.f; negm[r] = 0.f; }
    const int kofs = hi * 1024 + r32 * 16;
    const int vb0 = (int)(unsigned)(uintptr_t)(lds + L_V) + ((lane >> 4) & 1) * 32 + (lane & 3) * 8 + (4 * hi + ((lane & 15) >> 2)) * 64;
    for (int t = 0; t < NT; ++t) {
        if (t + 1 < NT) { if (wid < 4) asm volatile("s_waitcnt vmcnt(3) lgkmcnt(0)\n\ts_barrier" ::: "memory"); else asm volatile("s_waitcnt vmcnt(2) lgkmcnt(0)\n\ts_barrier" ::: "memory"); }
        else asm volatile("s_waitcnt vmcnt(0) lgkmcnt(0)\n\ts_barrier" ::: "memory");
        if (t + 2 < NT) MLA_DMA(t + 2, slot2);
        const int cslot = slot; slot = (slot == 2) ? 0 : slot + 1; slot2 = (slot2 == 2) ? 0 : slot2 + 1;
        if (t <= my_last) {
            const int slot = cslot;
            const LAS unsigned char* kb = lds + L_K + slot * KSLOT + kofs;
            f32x16 p0, p1;
#pragma unroll
            for (int d0 = 0; d0 < 6; ++d0) {
                const bf16x8 b0 = *(const LAS bf16x8*)(kb + d0 * 2048), b1 = *(const LAS bf16x8*)(kb + d0 * 2048 + 512);
                if (d0 == 0) { p0 = __builtin_amdgcn_mfma_f32_32x32x16_bf16(b0, qr[0], negm, 0, 0, 0); p1 = __builtin_amdgcn_mfma_f32_32x32x16_bf16(b1, qr[0], negm, 0, 0, 0); }
                else { p0 = __builtin_amdgcn_mfma_f32_32x32x16_bf16(b0, qr[d0], p0, 0, 0, 0); p1 = __builtin_amdgcn_mfma_f32_32x32x16_bf16(b1, qr[d0], p1, 0, 0, 0); } }
#define MLA_MX3(a, b, c) __builtin_fmaxf(__builtin_fmaxf((a), (b)), (c))
            float ra = MLA_MX3(p0[0], p0[1], p1[0]), rb = MLA_MX3(p0[2], p0[3], p1[1]); ra = MLA_MX3(ra, p1[2], p1[3]);
#pragma unroll
            for (int r = 4; r < 16; r += 4) { ra = MLA_MX3(ra, p0[r], p0[r + 1]); rb = MLA_MX3(rb, p0[r + 2], p0[r + 3]); ra = MLA_MX3(ra, p1[r], p1[r + 1]); rb = MLA_MX3(rb, p1[r + 2], p1[r + 3]); }
#undef MLA_MX3
            float rm = __builtin_fmaxf(ra, rb);
            rm = __builtin_fmaxf(rm, xhalf(rm));
            if (t == 0 || __any(rm > 0.f)) {
                const float dl = (t == 0) ? rm : __builtin_fmaxf(rm, 0.f), f = __builtin_amdgcn_exp2f(-dl);
                m += dl; l *= f;
#pragma unroll
                for (int r = 0; r < 16; ++r) { p0[r] -= dl; p1[r] -= dl; negm[r] = -m; }
                if (t != 0) {
                    if (hi == 0) wsf[r32] = f;
                    asm volatile("s_waitcnt lgkmcnt(0)" ::: "memory");
#pragma unroll
                    for (int r = 0; r < 16; ++r) { const float fr_ = wsf[crow(r, hi)]; o[0][r] *= fr_; o[1][r] *= fr_; }
                }
            }
            float sacc = 0.f;
#pragma unroll
            for (int r = 0; r < 16; ++r) { p0[r] = __builtin_amdgcn_exp2f(p0[r]); p1[r] = __builtin_amdgcn_exp2f(p1[r]); sacc += p0[r] + p1[r]; }
            l += sacc;
            u32x4 pw0, pw1, pw2, pw3;
            pw0 = (u32x4){pg8::cvt_pk_bf16(p0[0], p0[1]), pg8::cvt_pk_bf16(p0[2], p0[3]), pg8::cvt_pk_bf16(p0[4], p0[5]), pg8::cvt_pk_bf16(p0[6], p0[7])};
            pw1 = (u32x4){pg8::cvt_pk_bf16(p0[8], p0[9]), pg8::cvt_pk_bf16(p0[10], p0[11]), pg8::cvt_pk_bf16(p0[12], p0[13]), pg8::cvt_pk_bf16(p0[14], p0[15])};
            pw2 = (u32x4){pg8::cvt_pk_bf16(p1[0], p1[1]), pg8::cvt_pk_bf16(p1[2], p1[3]), pg8::cvt_pk_bf16(p1[4], p1[5]), pg8::cvt_pk_bf16(p1[6], p1[7])};
            pw3 = (u32x4){pg8::cvt_pk_bf16(p1[8], p1[9]), pg8::cvt_pk_bf16(p1[10], p1[11]), pg8::cvt_pk_bf16(p1[12], p1[13]), pg8::cvt_pk_bf16(p1[14], p1[15])};
            pv(o, vb0 + slot * VSLOT, __builtin_bit_cast(bf16x8, pw0), __builtin_bit_cast(bf16x8, pw1), __builtin_bit_cast(bf16x8, pw2), __builtin_bit_cast(bf16x8, pw3));
        }
    }
#undef MLA_DMA
    l += xhalf(l);
    if (hi == 0) wsf[32 + r32] = l;
    asm volatile("s_waitcnt lgkmcnt(0)" ::: "memory");
    LAS bf16* stg = (LAS bf16*)(lds + L_OST) + wid * 2048;
#pragma unroll
    for (int r = 0; r < 16; ++r) { const int orow = crow(r, hi); const float rl = __builtin_amdgcn_rcpf(wsf[32 + orow]);
        stg[orow * 64 + r32] = (bf16)(pg8::cvt_pk_bf16(o[0][r] * rl, 0.f) & 0xffffu); stg[orow * 64 + 32 + r32] = (bf16)(pg8::cvt_pk_bf16(o[1][r] * rl, 0.f) & 0xffffu); }
    asm volatile("s_waitcnt lgkmcnt(0)" ::: "memory");
    bf16* Ow = OB + (rowbase + q0 + wid * 32) * 512 + h * 64;
#pragma unroll
    for (int i = 0; i < 4; ++i) { const int row = i * 8 + (lane >> 3), ch = lane & 7; const u32x4 v = *(const LAS u32x4*)(stg + row * 64 + ch * 8); *(u32x4*)(Ow + (size_t)row * 512 + ch * 8) = v; }
    asm volatile("s_waitcnt lgkmcnt(0)\n\ts_barrier" ::: "memory");
}
__device__ __forceinline__ void phase(int vcu, int G, const bf16* QB, const bf16* KN, const bf16* KPE, const bf16* VB, bf16* OB, LAS unsigned char* lds) {
    for (int u = vcu; u < 1024; u += G) { const int i = u >> 8, v = u & 255, bh = v >> 3, s = v & 7;
        const int qb = (i == 0) ? s : (i == 1) ? 15 - s : (i == 2) ? 16 + s : 31 - s;
        attn_unit(bh >> 3, bh & 7, qb, QB, KN, KPE, VB, OB, lds); }
}
}

namespace idx {
typedef short bf16x8 __attribute__((ext_vector_type(8)));
typedef float f32x16 __attribute__((ext_vector_type(16)));
typedef unsigned u32x2 __attribute__((ext_vector_type(2)));
constexpr int CAP = 576, TRIG = CAP - 64, NE = (CAP + 63) / 64;
constexpr int L_CAND = 0, L_TRASH = 32 * CAP * 8, L_END = L_TRASH + 8 * 512;
constexpr int KEEP_MAX = 272, SCHED_MIN = 304;
static_assert(L_END <= RING_BYTES, "indexer LDS");
__device__ __forceinline__ unsigned okey(float f) { const unsigned u = __float_as_uint(f); return (u & 0x80000000u) ? ~u : (u | 0x80000000u); }
__device__ __forceinline__ float ikey(unsigned k) { return __uint_as_float((k & 0x80000000u) ? (k ^ 0x80000000u) : ~k); }
__device__ __forceinline__ int prefix64(unsigned long long m) { return (int)__builtin_amdgcn_mbcnt_hi((unsigned)(m >> 32), __builtin_amdgcn_mbcnt_lo((unsigned)m, 0u)); }
__device__ __forceinline__ unsigned wave_umax(unsigned v) {
    v = max(v, (unsigned)__builtin_amdgcn_update_dpp(0, (int)v, 0xB1, 0xf, 0xf, false)); v = max(v, (unsigned)__builtin_amdgcn_update_dpp(0, (int)v, 0x4E, 0xf, 0xf, false));
    v = max(v, (unsigned)__builtin_amdgcn_update_dpp(0, (int)v, 0x141, 0xf, 0xf, false)); v = max(v, (unsigned)__builtin_amdgcn_update_dpp(0, (int)v, 0x140, 0xf, 0xf, false));
    return max(max((unsigned)__builtin_amdgcn_readlane((int)v, 0), (unsigned)__builtin_amdgcn_readlane((int)v, 16)), max((unsigned)__builtin_amdgcn_readlane((int)v, 32), (unsigned)__builtin_amdgcn_readlane((int)v, 48)));
}
__device__ __forceinline__ unsigned wave_umin(unsigned v) { return ~wave_umax(~v); }
__device__ __forceinline__ unsigned wave_usum(unsigned v) {
    v += (unsigned)__builtin_amdgcn_update_dpp(0, (int)v, 0xB1, 0xf, 0xf, false); v += (unsigned)__builtin_amdgcn_update_dpp(0, (int)v, 0x4E, 0xf, 0xf, false);
    v += (unsigned)__builtin_amdgcn_update_dpp(0, (int)v, 0x141, 0xf, 0xf, false); v += (unsigned)__builtin_amdgcn_update_dpp(0, (int)v, 0x140, 0xf, 0xf, false);
    return ((unsigned)__builtin_amdgcn_readlane((int)v, 0) + (unsigned)__builtin_amdgcn_readlane((int)v, 16)) + ((unsigned)__builtin_amdgcn_readlane((int)v, 32) + (unsigned)__builtin_amdgcn_readlane((int)v, 48));
}
__device__ __forceinline__ int count_ge_v(const unsigned (&k)[8], unsigned thr) { unsigned c = 0;
#pragma unroll
    for (int j = 0; j < 8; ++j) c += (k[j] >= thr) ? 1u : 0u;
    return (int)wave_usum(c); }
template <bool FINAL> __device__ __forceinline__ void select4(LAS u32x2* cb, int (&n)[4], unsigned (&tk)[4], int lane, unsigned short* sel_out, LAS u32x2* trash, unsigned short* gtrash) {
    unsigned k[4][NE], ix[4][NE];
#pragma unroll
    for (int q = 0; q < 4; ++q)
#pragma unroll
        for (int j = 0; j < NE; ++j) { const int e = lane + 64 * j; const bool v = e < n[q]; const u32x2 en = cb[(size_t)q * CAP + (v ? e : 0)]; ix[q][j] = en.y; k[q][j] = v ? okey(__uint_as_float(en.x)) : 0u; }
    unsigned lo[4], hx[4]; int clo[4];
#pragma unroll
    for (int q = 0; q < 4; ++q) { unsigned mn = 0xffffffffu, mxv = 0u;
#pragma unroll
        for (int j = 0; j < NE; ++j) { mxv = max(mxv, k[q][j]); mn = min(mn, k[q][j] ? k[q][j] : 0xffffffffu); }
        lo[q] = wave_umin(mn); hx[q] = wave_umax(mxv) + 1u; clo[q] = n[q]; }
    const int accept = FINAL ? 256 : KEEP_MAX;
    for (int it = 0; it < 40; ++it) {
        unsigned mid[4]; int c[4]; bool any = false;
#pragma unroll
        for (int q = 0; q < 4; ++q) mid[q] = lo[q] + ((hx[q] - lo[q]) >> 1);
        {
            unsigned v = 0;
#pragma unroll
            for (int q = 0; q < 4; ++q) { unsigned cl = 0;
#pragma unroll
                for (int j = 0; j < NE; ++j) cl += (k[q][j] >= mid[q]) ? 1u : 0u;
                v |= cl << (8 * q); }
            v += (unsigned)__builtin_amdgcn_update_dpp(0, (int)v, 0xB1, 0xf, 0xf, false); v += (unsigned)__builtin_amdgcn_update_dpp(0, (int)v, 0x4E, 0xf, 0xf, false);
            v += (unsigned)__builtin_amdgcn_update_dpp(0, (int)v, 0x141, 0xf, 0xf, false); v += (unsigned)__builtin_amdgcn_update_dpp(0, (int)v, 0x140, 0xf, 0xf, false);
            unsigned ev = 0, od = 0;
#pragma unroll
            for (int r = 0; r < 4; ++r) { const unsigned x = (unsigned)__builtin_amdgcn_readlane((int)v, 16 * r); ev += x & 0x00ff00ffu; od += (x >> 8) & 0x00ff00ffu; }
            c[0] = (int)(ev & 0xffffu); c[2] = (int)(ev >> 16); c[1] = (int)(od & 0xffffu); c[3] = (int)(od >> 16);
        }
#pragma unroll
        for (int q = 0; q < 4; ++q) { const bool upd = (clo[q] > accept) && (hx[q] - lo[q] > 1u), ge = c[q] >= 256;
            lo[q] = (upd && ge) ? mid[q] : lo[q]; clo[q] = (upd && ge) ? c[q] : clo[q]; hx[q] = (upd && !ge) ? mid[q] : hx[q]; any = any || upd; }
        if (!any) break;
    }
#pragma unroll
    for (int q = 0; q < 4; ++q) {
        const unsigned Tk = lo[q];
        const bool ties = FINAL ? (clo[q] != 256) : (clo[q] > accept);
        int running = 0;
        if (!ties) {
#pragma unroll
            for (int j = 0; j < NE; ++j) {
                const bool take = k[q][j] >= Tk;
                const unsigned long long mt = __ballot(take);
                const int pos = running + prefix64(mt);
                if (FINAL) { unsigned short* dst = take ? sel_out + (size_t)q * 256 + pos : gtrash + lane; *dst = (unsigned short)ix[q][j]; }
                else { LAS u32x2* dst = take ? cb + (size_t)q * CAP + pos : trash + lane; *dst = (u32x2){__float_as_uint(ikey(k[q][j])), ix[q][j]}; }
                running += __popcll(mt);
            }
        } else {
            unsigned cg = 0;
#pragma unroll
            for (int j = 0; j < NE; ++j) cg += (k[q][j] > Tk) ? 1u : 0u;
            const int r_eq = 256 - (int)wave_usum(cg); int eqrun = 0;
#pragma unroll
            for (int j = 0; j < NE; ++j) {
                const bool gt = k[q][j] > Tk, eq = (k[q][j] == Tk);
                const unsigned long long meq = __ballot(eq);
                const bool take = gt || (eq && (eqrun + prefix64(meq)) < r_eq);
                const unsigned long long mt = __ballot(take);
                const int pos = running + prefix64(mt);
                if (FINAL) { unsigned short* dst = (take && pos < 256) ? sel_out + (size_t)q * 256 + pos : gtrash + lane; *dst = (unsigned short)ix[q][j]; }
                else { LAS u32x2* dst = take ? cb + (size_t)q * CAP + pos : trash + lane; *dst = (u32x2){__float_as_uint(ikey(k[q][j])), ix[q][j]}; }
                running += __popcll(mt); eqrun += __popcll(meq);
            }
        }
        tk[q] = Tk; n[q] = running;
    }
}
__device__ __forceinline__ void unit(int b, int g, const bf16* QI, const bf16* KI, const float* WI, unsigned short* SEL, unsigned short* gtrash, LAS unsigned char* lds, int variant) {
    const int q0 = g * 32, L = 64 * (q0 / 64 + 1);
    if (L <= 256) return;
    const int tid = threadIdx.x, lane = tid & 63, c = lane & 31, hi = lane >> 5; const int wid = __builtin_amdgcn_readfirstlane(tid >> 6);
    const size_t rowbase = (size_t)b * T; const int ntile = L / 64;
    bf16x8 Af[4];
    { const int r = c, jq = ((r >> 2) & 1) + 2 * (r >> 4), hd = (r & 3) + 4 * ((r >> 3) & 1);
      const bf16* qp = QI + (rowbase + q0 + 4 * wid + jq) * 512 + hd * 64 + 8 * hi;
#pragma unroll
      for (int s = 0; s < 4; ++s) Af[s] = *(const bf16x8*)(qp + 16 * s); }
    float wv[2][8];
#pragma unroll
    for (int u = 0; u < 2; ++u) { const float* wp = WI + (rowbase + q0 + 4 * wid + hi + 2 * u) * 8; const f32x4 a = *(const f32x4*)wp, bq = *(const f32x4*)(wp + 4);
#pragma unroll
        for (int i = 0; i < 4; ++i) { wv[u][i] = a[i] * (0.125f * 0.35355339059327373f); wv[u][4 + i] = bq[i] * (0.125f * 0.35355339059327373f); } }
    float tau[2] = {-INFINITY, -INFINITY}; int cnt[2] = {0, 0};
    LAS u32x2* cbase = (LAS u32x2*)(lds + L_CAND) + (size_t)(wid * 4) * CAP;
    LAS u32x2* trash = (LAS u32x2*)(lds + L_TRASH) + wid * 64;
    const bf16* kp = KI + (rowbase + c) * 64 + 8 * hi;
    bf16x8 Ba[8], Bb[8];
#define IDX_LOAD(dst, tt) do { _Pragma("unroll") for (int i_ = 0; i_ < 8; ++i_) dst[i_] = *(const bf16x8*)(kp + (size_t)((tt) * 64 + (i_ >> 2) * 32) * 64 + 16 * (i_ & 3)); } while (0)
#define IDX_TILE(Bf, tt) do { \
        f32x16 acc0, acc1; \
        _Pragma("unroll") for (int r_ = 0; r_ < 16; ++r_) { acc0[r_] = 0.f; acc1[r_] = 0.f; } \
        _Pragma("unroll") for (int s4 = 0; s4 < 4; ++s4) { acc0 = __builtin_amdgcn_mfma_f32_32x32x16_bf16(Af[s4], Bf[s4], acc0, 0, 0, 0); acc1 = __builtin_amdgcn_mfma_f32_32x32x16_bf16(Af[s4], Bf[4 + s4], acc1, 0, 0, 0); } \
        float sv[2][2]; \
        _Pragma("unroll") for (int u = 0; u < 2; ++u) { float a_ = 0.f, b_ = 0.f; \
            _Pragma("unroll") for (int i = 0; i < 8; ++i) { a_ = fmaf(__builtin_amdgcn_fmed3f(acc0[8 * u + i], 0.f, 3.0e38f), wv[u][i], a_); b_ = fmaf(__builtin_amdgcn_fmed3f(acc1[8 * u + i], 0.f, 3.0e38f), wv[u][i], b_); } \
            sv[u][0] = a_; sv[u][1] = b_; } \
        bool ps[2][2]; unsigned long long mk[2][2]; \
        _Pragma("unroll") for (int u = 0; u < 2; ++u) _Pragma("unroll") for (int kh = 0; kh < 2; ++kh) { ps[u][kh] = (sv[u][kh] > tau[u]) && !(variant & 2); mk[u][kh] = __ballot(ps[u][kh]); } \
        if ((mk[0][0] | mk[0][1] | mk[1][0] | mk[1][1]) != 0ull) { \
            _Pragma("unroll") for (int u = 0; u < 2; ++u) _Pragma("unroll") for (int kh = 0; kh < 2; ++kh) { \
                const unsigned mlo = (unsigned)mk[u][kh], mhi = (unsigned)(mk[u][kh] >> 32); \
                const int pre = (int)__builtin_amdgcn_mbcnt_hi(mhi, __builtin_amdgcn_mbcnt_lo(mlo, 0u)) - (hi ? __popc(mlo) : 0);     \
                LAS u32x2* dst = ps[u][kh] ? cbase + (size_t)(hi + 2 * u) * CAP + cnt[u] + pre : trash + lane; \
                *dst = (u32x2){__float_as_uint(sv[u][kh]), (unsigned)((tt) * 64 + kh * 32 + c)}; \
                cnt[u] += hi ? __popc(mhi) : __popc(mlo); } } \
    } while (0)
    IDX_LOAD(Ba, 0); IDX_LOAD(Bb, 1);
    for (int t = 0; t < ntile; t += 2) {
#define IDX_CHECK() do { const int n0 = __builtin_amdgcn_readlane(cnt[0], 0), n1 = __builtin_amdgcn_readlane(cnt[0], 32), n2 = __builtin_amdgcn_readlane(cnt[1], 0), n3 = __builtin_amdgcn_readlane(cnt[1], 32); \
          if (max(max(n0, n1), max(n2, n3)) > TRIG && !(variant & 1)) { int n4[4] = {n0, n1, n2, n3}; unsigned tk4[4]; \
            PROF_T0(1); select4<false>(cbase, n4, tk4, lane, nullptr, trash, gtrash); PROF_T1(1, lds, wid, lane); \
            cnt[0] = hi ? n4[1] : n4[0]; cnt[1] = hi ? n4[3] : n4[2]; tau[0] = ikey(hi ? tk4[1] : tk4[0]); tau[1] = ikey(hi ? tk4[3] : tk4[2]); } } while (0)
        IDX_CHECK();
        IDX_TILE(Ba, t);
        if (t + 2 < ntile) IDX_LOAD(Ba, t + 2);
        if (t + 1 < ntile) { IDX_CHECK(); IDX_TILE(Bb, t + 1); if (t + 3 < ntile) IDX_LOAD(Bb, t + 3); }
    }
#undef IDX_LOAD
#undef IDX_TILE
#undef IDX_CHECK
    asm volatile("s_waitcnt lgkmcnt(0)" ::: "memory");
    if (!(variant & 9)) { int n4[4] = {__builtin_amdgcn_readlane(cnt[0], 0), __builtin_amdgcn_readlane(cnt[0], 32), __builtin_amdgcn_readlane(cnt[1], 0), __builtin_amdgcn_readlane(cnt[1], 32)}; unsigned tk4[4];
      PROF_T0(2); select4<true>(cbase, n4, tk4, lane, SEL + (rowbase + q0 + 4 * wid) * 256, trash, gtrash); PROF_T1(2, lds, wid, lane); }
    asm volatile("s_waitcnt lgkmcnt(0)" ::: "memory");
}
__device__ __forceinline__ void phase(int vcu, int G, const bf16* QI, const bf16* KI, const float* WI, unsigned short* SEL, unsigned short* gtrash, LAS unsigned char* lds, int variant) {
    PROF_T0(7);
    for (int u = vcu; u < 1024; u += G) { const int i = u >> 8, v = u & 255, b = v >> 6, s = v & 63;
        const int g = (i == 0) ? s : (i == 1) ? 127 - s : (i == 2) ? 128 + s : 255 - s;
        unit(b, g, QI, KI, WI, SEL, gtrash, lds, variant); }
    PROF_T1(7, lds, (int)__builtin_amdgcn_readfirstlane(threadIdx.x >> 6), (int)(threadIdx.x & 63));
    __syncthreads();
}
}

namespace dsa {
typedef unsigned u32x4m __attribute__((ext_vector_type(4)));
typedef unsigned u32x2m __attribute__((ext_vector_type(2)));
typedef short bf16x8 __attribute__((ext_vector_type(8)));
typedef short v4i16 __attribute__((ext_vector_type(4)));
constexpr int WREG = 17408, L_BIAS = 8 * WREG, L_END = L_BIAS + 33 * 8 * 4;
static_assert(L_END <= RING_BYTES, "dsa LDS");
constexpr float LOG2E = 1.4426950408889634f;
__device__ __forceinline__ int t5_bucket(int rel) {
    const int n = rel < 0 ? -rel : rel; const int r = rel > 0 ? 16 : 0;
    if (n < 8) return r + n;
    int lg = 7; if (n < 128) lg = (31 - __clz(n * n)) - 6;
    return r + 8 + lg;
}
__device__ __forceinline__ void phase(int vcu, int G, const bf16* QA, const bf16* KA, const bf16* VA, const unsigned short* SEL, const int* positions, const float* rel_bias, bf16* OA, LAS unsigned char* lds) {
    const int tid = threadIdx.x, lane = tid & 63, l15 = lane & 15, kq = lane >> 4; const int wid = __builtin_amdgcn_readfirstlane(tid >> 6);
    LAS float* bt = (LAS float*)(lds + L_BIAS);
    for (int i = tid; i < 33 * 8; i += NWAVES * 64) bt[i] = (i < 256) ? rel_bias[i] * LOG2E : -INFINITY;
    __syncthreads();
    LAS unsigned char* wl = lds + wid * WREG;
    LAS unsigned short* selL = (LAS unsigned short*)(wl + 16384); LAS unsigned char* bktL = wl + 16384 + 512;
    const int gw = vcu * NWAVES + wid, NGW = G * NWAVES;
    const int trofs = ((l15 >> 2) + 4 * kq) * 128 + (l15 & 3) * 8;
    unsigned short seln[4];
#pragma unroll
    for (int j = 0; j < 4; ++j) seln[j] = (gw < M) ? SEL[(size_t)gw * 256 + lane + 64 * j] : (unsigned short)0;
    for (int q = gw; q < M; q += NGW) {
        const int b = q >> 13, t = q & (T - 1); const size_t rowbase = (size_t)b * T;
        const int limit = 64 * (t / 64 + 1), nvalid = limit < 256 ? limit : 256; const int posq = positions[q];
        int svv[4];
#pragma unroll
        for (int j = 0; j < 4; ++j) { const int k = lane + 64 * j; svv[j] = (limit <= 256) ? (k < limit ? k : limit - 1) : (int)seln[j]; }
        { const int qn = q + NGW;
#pragma unroll
          for (int j = 0; j < 4; ++j) seln[j] = (qn < M) ? SEL[(size_t)qn * 256 + lane + 64 * j] : (unsigned short)0; }
#pragma unroll
        for (int j = 0; j < 4; ++j) { const int k = lane + 64 * j; const int sv = svv[j];
            const int bk = (k < nvalid) ? t5_bucket(positions[rowbase + sv] - posq) : 32; selL[k] = (unsigned short)sv; bktL[k] = (unsigned char)bk; }
        asm volatile("s_waitcnt lgkmcnt(0)" ::: "memory");
#define DSA_VDMA(cch, buf) do { _Pragma("unroll") for (int i_ = 0; i_ < 4; ++i_) { const int row_ = selL[32 * (cch) + 8 * i_ + (lane >> 3)]; \
            __builtin_amdgcn_global_load_lds((const unsigned*)(VA + (rowbase + row_) * 64 + (lane & 7) * 8), (LAS unsigned*)(wl + (buf) * 4096 + i_ * 1024), 16, 0, 0); } } while (0)
        DSA_VDMA(0, 0); DSA_VDMA(1, 1); DSA_VDMA(2, 2); DSA_VDMA(3, 3);
        bf16x8 Qf[2];
#pragma unroll
        for (int s = 0; s < 2; ++s) { Qf[s] = (bf16x8){0, 0, 0, 0, 0, 0, 0, 0}; if (l15 < 8) Qf[s] = *(const bf16x8*)(QA + (size_t)q * 512 + l15 * 64 + 32 * s + 8 * kq); }
        f32x4 St[16];
#pragma unroll
        for (int half = 0; half < 2; ++half) {
            bf16x8 Ka[8][2];
#pragma unroll
            for (int i = 0; i < 8; ++i) { const int row = selL[16 * (8 * half + i) + l15]; const bf16* kp = KA + (rowbase + row) * 64 + 8 * kq;
                Ka[i][0] = *(const bf16x8*)kp; Ka[i][1] = *(const bf16x8*)(kp + 32); }
#pragma unroll
            for (int i = 0; i < 8; ++i) { f32x4 a = {0.f, 0.f, 0.f, 0.f};
                a = __builtin_amdgcn_mfma_f32_16x16x32_bf16(Ka[i][0], Qf[0], a, 0, 0, 0); a = __builtin_amdgcn_mfma_f32_16x16x32_bf16(Ka[i][1], Qf[1], a, 0, 0, 0); St[8 * half + i] = a; }
        }
        float mx = -INFINITY;
#pragma unroll
        for (int kt = 0; kt < 16; ++kt) { const unsigned bk4 = *(const LAS unsigned*)(bktL + 16 * kt + 4 * kq);
#pragma unroll
            for (int i = 0; i < 4; ++i) { const float s = St[kt][i] * (0.125f * LOG2E) + bt[((bk4 >> (8 * i)) & 255u) * 8 + (l15 & 7)]; St[kt][i] = s; mx = fmaxf(mx, s); } }
        mx = fmaxf(mx, __shfl_xor(mx, 16)); mx = fmaxf(mx, __shfl_xor(mx, 32));
        float lsum = 0.f;
#pragma unroll
        for (int kt = 0; kt < 16; ++kt)
#pragma unroll
            for (int i = 0; i < 4; ++i) { const float p = __builtin_amdgcn_exp2f(St[kt][i] - mx); St[kt][i] = p; lsum += p; }
        lsum += __shfl_xor(lsum, 16); lsum += __shfl_xor(lsum, 32);
        f32x4 O[4];
#pragma unroll
        for (int dt = 0; dt < 4; ++dt) O[dt] = (f32x4){0.f, 0.f, 0.f, 0.f};
#pragma unroll
        for (int kk = 0; kk < 8; ++kk) {
            if (kk < 5) asm volatile("s_waitcnt vmcnt(12)" ::: "memory"); else if (kk == 5) asm volatile("s_waitcnt vmcnt(8)" ::: "memory"); else if (kk == 6) asm volatile("s_waitcnt vmcnt(4)" ::: "memory"); else asm volatile("s_waitcnt vmcnt(0)" ::: "memory");
            const LAS unsigned char* vb = wl + (kk & 3) * 4096 + trofs;
            const f32x4 pa = St[2 * kk], pb = St[2 * kk + 1];
            u32x4m pw; pw.x = pg8::cvt_pk_bf16(pa[0], pa[1]); pw.y = pg8::cvt_pk_bf16(pa[2], pa[3]); pw.z = pg8::cvt_pk_bf16(pb[0], pb[1]); pw.w = pg8::cvt_pk_bf16(pb[2], pb[3]);
            const bf16x8 Pf = __builtin_bit_cast(bf16x8, pw);
#pragma unroll
            for (int dt = 0; dt < 4; ++dt) {
                const v4i16 v0 = __builtin_amdgcn_ds_read_tr16_b64_v4i16((LAS v4i16*)(vb + dt * 32));
                const v4i16 v1 = __builtin_amdgcn_ds_read_tr16_b64_v4i16((LAS v4i16*)(vb + 2048 + dt * 32));
                const bf16x8 Vf = (bf16x8){v0[0], v0[1], v0[2], v0[3], v1[0], v1[1], v1[2], v1[3]};
                O[dt] = __builtin_amdgcn_mfma_f32_16x16x32_bf16(Vf, Pf, O[dt], 0, 0, 0); }
            if (kk < 4) { asm volatile("s_waitcnt lgkmcnt(0)" ::: "memory"); DSA_VDMA(kk + 4, kk); }
        }
#undef DSA_VDMA
        if (l15 < 8) { const float rl = __builtin_amdgcn_rcpf(lsum);
#pragma unroll
            for (int dt = 0; dt < 4; ++dt) { u32x2m w; w.x = pg8::cvt_pk_bf16(O[dt][0] * rl, O[dt][1] * rl); w.y = pg8::cvt_pk_bf16(O[dt][2] * rl, O[dt][3] * rl);
                *(u32x2m*)(OA + (size_t)q * 512 + l15 * 64 + 16 * dt + 4 * kq) = w; } }
        asm volatile("s_waitcnt lgkmcnt(0)" ::: "memory");
    }
}
}

struct PhaseTimer { unsigned long long t0; int k; LAS unsigned char* l; int w, ln; bool once;
    __device__ __forceinline__ PhaseTimer(int k_, LAS unsigned char* l_, int w_, int ln_) : t0(0), k(k_), l(l_), w(w_), ln(ln_), once(true) { if (PROF_SEL == 20 + k) t0 = __builtin_amdgcn_s_memrealtime(); }
    __device__ __forceinline__ void stop() { once = false; if (PROF_SEL == 20 + k) { const unsigned d = (unsigned)(__builtin_amdgcn_s_memrealtime() - t0); if (ln == 0) *PROF_WORD(l, w) += d; } } };
constexpr int NPHASE = 16;
__global__ void __launch_bounds__(NWAVES * 64, 2) mk_fwd(Args args) {
    extern __shared__ __attribute__((aligned(16))) unsigned char lds[];
    Frame F;
    F.lds = (LAS unsigned char*)lds;
    F.MISC = (volatile LAS unsigned*)(F.lds + MISC_OFF);
    F.tid = threadIdx.x; F.lane = F.tid & 63; F.wave = __builtin_amdgcn_readfirstlane(F.tid >> 6);
    F.G = gridDim.x; { const int bx = blockIdx.x; F.vcu = (F.G % 8 == 0) ? (bx % 8) * (F.G / 8) + bx / 8 : bx; }
    unsigned char* ws = args.ws;
    F.ctl = (gu32*)(ws + WS_CTL);
    for (int u = F.tid; u < (LDS_BYTES - LDSCTL_OFF) / 4; u += NWAVES * 64) ((LAS unsigned*)(F.lds + LDSCTL_OFF))[u] = 0u;
    __syncthreads();
    XcdBarrier bar; bar.bar = (unsigned*)(F.ctl + CW_BAR); bar.x = 0; bar.st = nullptr;
    if (MK_FUSED) bar = xcd_barrier_post((unsigned*)(F.ctl + CW_BAR), F.MISC + 8);
#define GRID_BAR() do { if (MK_FUSED) { PROF_T0(50); xcd_barrier(bar); PROF_T1(50, F.lds + RING_OFF, F.wave, F.lane); } } while (0)
    const int lo = args.ph_lo, hi = args.ph_hi;
#ifdef ONLY_PH
#define IN(k) ((k) == ONLY_PH && lo <= (k) && (k) < hi)
#else
#define IN(k) (lo <= (k) && (k) < hi)
#endif
#define BOTH(k) (IN(k) && IN((k) + 1))
#ifndef DUP_PH
#define DUP_PH -1
#endif
#ifndef P7_VARIANT
#define P7_VARIANT 0
#endif
#define PHASE_TIMED(k) for (PhaseTimer pt_((k), F.lds + RING_OFF, F.wave, F.lane); pt_.once; pt_.stop())
#define REP(k) for (int rep_ = 0; rep_ < ((k) == DUP_PH ? 2 : 1); ++rep_)
    const float* x = (const float*)args.in[0];
    const float* mod = (const float*)(ws + WS_MOD);
    bf16* XN = (bf16*)(ws + WS_XN); bf16* ACT = (bf16*)(ws + WS_ACT);
    float* X1 = args.out;
    const float* rcos = (const float*)(ws + WS_RCOS); const float* rsin = (const float*)(ws + WS_RSIN);
    float* ssq_q = (float*)(ws + WS_SSQQ); float* ssq_kv = (float*)(ws + WS_SSQKV);

    if (IN(0)) REP(0) PHASE_TIMED(0) { p0_prologue(F, args); if (BOTH(0)) GRID_BAR(); }
    if (IN(1)) REP(1) PHASE_TIMED(1) { norm_mod_phase(F, x, (const float*)args.in[5], mod, 0 * D, 1 * D, XN); if (BOTH(1)) GRID_BAR(); }
    if (IN(2)) REP(2) PHASE_TIMED(2) {
        pg8::Gemm g{XN, (const bf16*)(ws + WS_W1A), M, 2 * DFF, D}; pg8::StaticOrder S; S.init(M, 2 * DFF, F.G, (int)blockIdx.x);
        pg8::EpiSwiglu E{ACT, DFF};
        pg8::gemm_phase<pg8::EpiSwiglu, pg8::StaticOrder, true, true>(F.lds + RING_OFF, g, S, E);
        if (BOTH(2)) GRID_BAR(); }
    if (IN(3)) REP(3) PHASE_TIMED(3) {
        pg8::Gemm g{ACT, (const bf16*)(ws + WS_W1D), M, D, DFF}; pg8::StaticOrder S; S.init(M, D, F.G, (int)blockIdx.x);
        pg8::EpiResid E{x, X1, mod, 2 * D, 0.5f};
        pg8::gemm_phase<pg8::EpiResid, pg8::StaticOrder, true, true>(F.lds + RING_OFF, g, S, E);
        if (BOTH(3)) GRID_BAR(); }
    if (IN(4)) REP(4) PHASE_TIMED(4) { norm_mod_phase(F, X1, (const float*)args.in[8], mod, 3 * D, 4 * D, XN); if (BOTH(4)) GRID_BAR(); }
    if (IN(5)) REP(5) PHASE_TIMED(5) {
        pg8::Gemm g{XN, (const bf16*)(ws + WS_WIN), M, NPROJ, D}; pg8::StaticOrder S; S.init(M, NPROJ, F.G, (int)blockIdx.x);
        pg8::EpiProj E{(bf16*)(ws + WS_QA), (bf16*)(ws + WS_QI), (bf16*)(ws + WS_CQ), (bf16*)(ws + WS_CKV), (bf16*)(ws + WS_KA), (bf16*)(ws + WS_VA), (bf16*)(ws + WS_KI), (bf16*)(ws + WS_KPE), (bf16*)(ws + WS_G),
                       (float*)(ws + WS_WI), ssq_q, ssq_kv, rcos, rsin};
        pg8::gemm_phase<pg8::EpiProj, pg8::StaticOrder, true, true>(F.lds + RING_OFF, g, S, E);
        if (BOTH(5)) GRID_BAR(); }
    if (IN(6)) REP(6) PHASE_TIMED(6) {
        { pg8::Gemm g{(const bf16*)(ws + WS_CQ), (const bf16*)(ws + WS_WUQ), M, 768, 384}; pg8::StaticOrder S; S.init(M, 768, F.G, (int)blockIdx.x);
          pg8::EpiUpQ E{(bf16*)(ws + WS_QB), ssq_q, rcos, rsin};
          pg8::gemm_phase<pg8::EpiUpQ, pg8::StaticOrder, true, true>(F.lds + RING_OFF, g, S, E); }
        __syncthreads();
        { pg8::Gemm g{(const bf16*)(ws + WS_CKV), (const bf16*)(ws + WS_WUKV), M, 1024, 256}; pg8::StaticOrder S; S.init(M, 1024, F.G, (int)blockIdx.x);
          pg8::EpiUpKV E{(bf16*)(ws + WS_KN), (bf16*)(ws + WS_VB), ssq_kv};
          pg8::gemm_phase<pg8::EpiUpKV, pg8::StaticOrder, true, true>(F.lds + RING_OFF, g, S, E); }
        __syncthreads(); }
    if (IN(7)) REP(7) PHASE_TIMED(7) { idx::phase(F.vcu, F.G, (const bf16*)(ws + WS_QI), (const bf16*)(ws + WS_KI), (const float*)(ws + WS_WI), (unsigned short*)(ws + WS_SEL), (unsigned short*)(ws + WS_END), F.lds + RING_OFF, (DUP_PH == 7 && rep_ == 0) ? P7_VARIANT : 0); if (BOTH(7)) GRID_BAR(); }
    if (IN(8)) REP(8) PHASE_TIMED(8) { dsa::phase(F.vcu, F.G, (const bf16*)(ws + WS_QA), (const bf16*)(ws + WS_KA), (const bf16*)(ws + WS_VA), (const unsigned short*)(ws + WS_SEL), (const int*)args.in[2], (const float*)args.in[15], (bf16*)(ws + WS_OA), F.lds + RING_OFF); __syncthreads(); }
    if (IN(9)) REP(9) PHASE_TIMED(9) { mla::phase(F.vcu, F.G, (const bf16*)(ws + WS_QB), (const bf16*)(ws + WS_KN), (const bf16*)(ws + WS_KPE), (const bf16*)(ws + WS_VB), (bf16*)(ws + WS_OB), F.lds + RING_OFF); if (BOTH(9)) GRID_BAR(); }
    if (IN(10)) REP(10) PHASE_TIMED(10) {
        { pg8::Gemm g{(const bf16*)(ws + WS_OA), (const bf16*)(ws + WS_WOA), M, D, 512}; pg8::StaticOrder S; S.init(M, D, F.G, (int)blockIdx.x);
          pg8::EpiGate<false> E{(const bf16*)(ws + WS_G), 0, nullptr, (bf16*)(ws + WS_Y1)};
          pg8::gemm_phase<pg8::EpiGate<false>, pg8::StaticOrder, true, true>(F.lds + RING_OFF, g, S, E); }
        VM_WAIT(); __syncthreads();
        { pg8::Gemm g{(const bf16*)(ws + WS_OB), (const bf16*)(ws + WS_WOB), M, D, 512}; pg8::StaticOrder S; S.init(M, D, F.G, (int)blockIdx.x);
          pg8::EpiGate<true> E{(const bf16*)(ws + WS_G), 1024, (const bf16*)(ws + WS_Y1), (bf16*)(ws + WS_Y)};
          pg8::gemm_phase<pg8::EpiGate<true>, pg8::StaticOrder, true, true>(F.lds + RING_OFF, g, S, E); }
        if (BOTH(10)) GRID_BAR(); }
    if (IN(11)) PHASE_TIMED(11) {
        pg8::Gemm g{(const bf16*)(ws + WS_Y), (const bf16*)(ws + WS_WOUT), M, D, D}; pg8::StaticOrder S; S.init(M, D, F.G, (int)blockIdx.x);
        pg8::EpiResid E{X1, X1, mod, 5 * D, 1.0f};
        pg8::gemm_phase<pg8::EpiResid, pg8::StaticOrder, true, true>(F.lds + RING_OFF, g, S, E);
        if (BOTH(11)) GRID_BAR(); }
    if (IN(12)) REP(12) PHASE_TIMED(12) { norm_mod_phase(F, X1, (const float*)args.in[19], mod, 6 * D, 7 * D, XN); if (BOTH(12)) GRID_BAR(); }
    if (IN(13)) REP(13) PHASE_TIMED(13) {
        pg8::Gemm g{XN, (const bf16*)(ws + WS_W2A), M, 2 * DFF, D}; pg8::StaticOrder S; S.init(M, 2 * DFF, F.G, (int)blockIdx.x);
        pg8::EpiSwiglu E{ACT, DFF};
        pg8::gemm_phase<pg8::EpiSwiglu, pg8::StaticOrder, true, true>(F.lds + RING_OFF, g, S, E);
        if (BOTH(13)) GRID_BAR(); }
    if (IN(14)) PHASE_TIMED(14) {
        pg8::Gemm g{ACT, (const bf16*)(ws + WS_W2D), M, D, DFF}; pg8::StaticOrder S; S.init(M, D, F.G, (int)blockIdx.x);
        pg8::EpiResid E{X1, X1, mod, 8 * D, 0.5f};
        pg8::gemm_phase<pg8::EpiResid, pg8::StaticOrder, true, true>(F.lds + RING_OFF, g, S, E);
        if (BOTH(14)) GRID_BAR(); }
    if (IN(15)) PHASE_TIMED(15) { final_norm_phase(F, X1, (const float*)args.in[22], args.out); }
    if (PROF_SEL != 0) { asm volatile("s_waitcnt lgkmcnt(0)" ::: "memory"); const unsigned a_ = *PROF_WORD(F.lds + RING_OFF, F.wave); const unsigned long long t0_ = __builtin_amdgcn_s_memrealtime();
        while (__builtin_amdgcn_s_memrealtime() - t0_ < (unsigned long long)a_ * PROF_MULT) __builtin_amdgcn_s_sleep(32); }
#undef IN
#undef BOTH
}

extern "C" void kernel_launch(void* const* d_in, const int* in_sizes, int n_in, void* d_out, int out_size, void* d_ws, size_t ws_size, hipStream_t stream) {
    static int grid = 0;
    if (grid == 0) {
        if (n_in != 23 || out_size != M * D || ws_size < WS_END + 4096) { fprintf(stderr, "kernel_launch: unexpected problem shape (n_in %d, out %d, ws %zu)\n", n_in, out_size, ws_size); grid = -1; return; }
        int dev = 0, cus = 0, per_cu = 0;
        if (hipGetDevice(&dev) != hipSuccess || hipDeviceGetAttribute(&cus, hipDeviceAttributeMultiprocessorCount, dev) != hipSuccess) { grid = -1; return; }
        if (hipFuncSetAttribute((const void*)mk_fwd, hipFuncAttributeMaxDynamicSharedMemorySize, LDS_BYTES) != hipSuccess) { fprintf(stderr, "kernel_launch: hipFuncSetAttribute failed\n"); grid = -1; return; }
        if (hipOccupancyMaxActiveBlocksPerMultiprocessor(&per_cu, (const void*)mk_fwd, NWAVES * 64, LDS_BYTES) != hipSuccess || per_cu < 1) fprintf(stderr, "kernel_launch: occupancy query reports %d\n", per_cu);
        (void)hipGetLastError();
        grid = cus;
    }
    if (grid < 0) return;
    (void)in_sizes;
    if (hipMemsetAsync((char*)d_ws + WS_CTL, 0, CTL_ZERO_BYTES, stream) != hipSuccess) return;
    Args a{};
    for (int i = 0; i < 23; ++i) a.in[i] = d_in[i];
    a.out = (float*)d_out; a.ws = (unsigned char*)d_ws;
    auto launch = [&](int lo, int hi) { a.ph_lo = lo; a.ph_hi = hi; a.li = 0; hipLaunchKernelGGL(mk_fwd, dim3(grid), dim3(NWAVES * 64), LDS_BYTES, stream, a); };
#if MK_FUSED
    launch(0, NPHASE);
#else
    for (int p = 0; p < NPHASE; ++p) launch(p, p + 1);
#endif
}
```

```cpp
#include <hip/hip_runtime.h>
#include <cstdio>
#include <cstdint>
namespace pg8 {
#define PG8_LAS __attribute__((address_space(3)))
typedef unsigned short bf16_t;
typedef short bf16x8 __attribute__((ext_vector_type(8)));
typedef float f32x4 __attribute__((ext_vector_type(4)));
typedef unsigned u32x4 __attribute__((ext_vector_type(4)));
constexpr int BM = 256, BK = 64, HALF = 128, HTB = HALF * BK * 2  , STAGE_BYTES = 8 * HTB, NXCD = 8, WGM = 8;

__host__ __device__ __forceinline__ int lds_byte(int r, int c) { const int st = (r >> 4) * 2 + (c >> 5), rr = r & 15, cc = c & 31, ob = rr * 64 + cc * 2; return st * 1024 + (ob ^ (((ob >> 9) & 1) << 5)); }
__host__ __device__ __forceinline__ void stage_rc(int b, int& R, int& C) { const int st = b / 1024, sb = b % 1024, swz = sb ^ (((sb >> 9) & 1) << 5); R = (st >> 1) * 16 + swz / 64; C = (st & 1) * 32 + (swz % 64) / 2; }
__host__ __device__ __forceinline__ int perm32(int rho) { const int n = rho >> 4, i = rho & 15; return 8 * (i >> 2) + 4 * n + (i & 3); }

struct Unit { int pm, pn; };
struct Gemm { const bf16_t* A; const bf16_t* Bt; int M, N, K; };

struct StaticOrder {
    int nM, nN, nwg, G, c;
    __host__ __device__ void init(int M, int N, int G_, int c_) { nM = M / BM; nN = N / BM; nwg = nM * nN; G = G_; c = c_; }
    __host__ __device__ bool next(int i, Unit& u) const {
        const long L = (long)i * G + c; if (L >= nwg) return false;
        int wgid = (int)L; { const int q = nwg / NXCD, r = nwg % NXCD, xcd = wgid % NXCD, off = wgid / NXCD; wgid = (xcd < r ? xcd * (q + 1) : r * (q + 1) + (xcd - r) * q) + off; }
        const int nig = WGM * nN, gid = wgid / nig, fm = gid * WGM, gsz = (nM - fm) < WGM ? (nM - fm) : WGM;
        u.pm = fm + ((wgid % nig) % gsz); u.pn = (wgid % nig) / gsz; return true;
    }
    __device__ __forceinline__ void a_ready(const Unit&) const {}
    __device__ __forceinline__ void done(const Unit&) const {}
};

typedef float f32x2 __attribute__((ext_vector_type(2)));
typedef __bf16 bf16x2_cv __attribute__((ext_vector_type(2)));
__device__ __forceinline__ unsigned cvt_pk_bf16(float lo, float hi) { const f32x2 v = {lo, hi}; const bf16x2_cv b = __builtin_convertvector(v, bf16x2_cv); return __builtin_bit_cast(unsigned, b); }

__device__ __forceinline__ u32x4 pack8(const f32x4 a, const f32x4 b) { u32x4 w; w.x = cvt_pk_bf16(a[0], a[1]); w.y = cvt_pk_bf16(a[2], a[3]); w.z = cvt_pk_bf16(b[0], b[1]); w.w = cvt_pk_bf16(b[2], b[3]); return w; }
__device__ __forceinline__ float sigm(float v) { return __builtin_amdgcn_rcpf(1.f + __builtin_amdgcn_exp2f(-1.4426950408889634f * v)); }
__device__ __forceinline__ f32x4 sigm4(const f32x4 v) { return (f32x4){sigm(v[0]), sigm(v[1]), sigm(v[2]), sigm(v[3])}; }
__device__ __forceinline__ void unpack8(const u32x4 w, f32x4& a, f32x4& b) {
    a = (f32x4){__uint_as_float(w.x << 16), __uint_as_float(w.x & 0xffff0000u), __uint_as_float(w.y << 16), __uint_as_float(w.y & 0xffff0000u)};
    b = (f32x4){__uint_as_float(w.z << 16), __uint_as_float(w.z & 0xffff0000u), __uint_as_float(w.w << 16), __uint_as_float(w.w & 0xffff0000u)}; }
constexpr float EPS_RMS = 1e-6f;
constexpr float QSCALE = 0.10206207261596575f * 1.4426950408889634f;

struct EpiSwiglu {
    static constexpr bool PERM = true, AFTER_DRAIN = false;
    bf16_t* O; int ldc;
    __device__ __forceinline__ void operator()(const f32x4 (&acc)[2][2][4][2], const Unit& u, int wr, int wc, int fr, int fq) const {
        const int row0 = u.pm * BM + wr * 64 + fr, col0 = u.pn * HALF + wc * 32 + 8 * fq;
#pragma unroll
        for (int ai = 0; ai < 2; ++ai)
#pragma unroll
            for (int m = 0; m < 4; ++m) {
                const f32x4 g0 = acc[ai][0][m][0], g1 = acc[ai][0][m][1], u0 = acc[ai][1][m][0], u1 = acc[ai][1][m][1];
                const f32x4 v0 = g0 * sigm4(g0) * u0, v1 = g1 * sigm4(g1) * u1;
                *(u32x4*)(O + (size_t)(row0 + ai * HALF + m * 16) * ldc + col0) = pack8(v0, v1); }
    }
};
struct EpiResid {
    static constexpr bool PERM = false, AFTER_DRAIN = false;
    const float* base; float* out; const float* mod; int goff; float scale;
    __device__ __forceinline__ void operator()(const f32x4 (&acc)[2][2][4][2], const Unit& u, int wr, int wc, int fr, int fq) const {
        const float* gate = mod + (u.pm >> 5) * 9216 + goff;
        const int col0 = u.pn * BM + wc * 32 + 4 * fq;
        f32x4 gv[2][2];
#pragma unroll
        for (int bj = 0; bj < 2; ++bj)
#pragma unroll
            for (int n = 0; n < 2; ++n) gv[bj][n] = *(const f32x4*)(gate + col0 + bj * HALF + n * 16) * scale;
#pragma unroll
        for (int ai = 0; ai < 2; ++ai)
#pragma unroll
            for (int m = 0; m < 4; ++m) { const size_t off = (size_t)(u.pm * BM + ai * HALF + wr * 64 + m * 16 + fr) * 1024 + col0;
#pragma unroll
                for (int bj = 0; bj < 2; ++bj)
#pragma unroll
                    for (int n = 0; n < 2; ++n) { const f32x4 bs = *(const f32x4*)(base + off + bj * HALF + n * 16); *(f32x4*)(out + off + bj * HALF + n * 16) = bs + gv[bj][n] * acc[ai][bj][m][n]; } }
    }
};
struct EpiProj {
    static constexpr bool PERM = true, AFTER_DRAIN = false;
    bf16_t *QA, *QI, *CQ, *CKV, *KA, *VA, *KI, *KPE, *G; float *WI, *ssq_q, *ssq_kv; const float *rcos, *rsin;
    __device__ __forceinline__ void operator()(const f32x4 (&acc)[2][2][4][2], const Unit& u, int wr, int wc, int fr, int fq) const {
        const int row0 = u.pm * BM + wr * 64 + fr, pn = u.pn, c32 = wc * 32 + 8 * fq;
#pragma unroll
        for (int ai = 0; ai < 2; ++ai)
#pragma unroll
            for (int m = 0; m < 4; ++m) {
                const size_t r = (size_t)(row0 + ai * HALF + m * 16);
                const f32x4 a0 = acc[ai][0][m][0], a1 = acc[ai][0][m][1], b0 = acc[ai][1][m][0], b1 = acc[ai][1][m][1];
                const float sa = (a0[0] * a0[0] + a0[1] * a0[1]) + (a0[2] * a0[2] + a0[3] * a0[3]) + (a1[0] * a1[0] + a1[1] * a1[1]) + (a1[2] * a1[2] + a1[3] * a1[3]);
                const float sb = (b0[0] * b0[0] + b0[1] * b0[1]) + (b0[2] * b0[2] + b0[3] * b0[3]) + (b1[0] * b1[0] + b1[1] * b1[1]) + (b1[2] * b1[2] + b1[3] * b1[3]);
                if (pn < 2) { bf16_t* p = QA + r * 512 + pn * 256 + c32; *(u32x4*)p = pack8(a0, a1); *(u32x4*)(p + HALF) = pack8(b0, b1); }
                else if (pn < 4) { bf16_t* p = QI + r * 512 + (pn - 2) * 256 + c32; *(u32x4*)p = pack8(a0, a1); *(u32x4*)(p + HALF) = pack8(b0, b1); }
                else if (pn == 4) { bf16_t* p = CQ + r * 384 + c32; *(u32x4*)p = pack8(a0, a1); *(u32x4*)(p + HALF) = pack8(b0, b1);
                    float s = sa + sb; s += __shfl_xor(s, 16); s += __shfl_xor(s, 32); if (fq == 0) ssq_q[r * 8 + wc] = s; }
                else if (pn == 5) { *(u32x4*)(CQ + r * 384 + 256 + c32) = pack8(a0, a1); *(u32x4*)(CKV + r * 256 + c32) = pack8(b0, b1);
                    float s = sa; s += __shfl_xor(s, 16); s += __shfl_xor(s, 32); float t = sb; t += __shfl_xor(t, 16); t += __shfl_xor(t, 32);
                    if (fq == 0) { ssq_q[r * 8 + 4 + wc] = s; ssq_kv[r * 8 + wc] = t; } }
                else if (pn == 6) { *(u32x4*)(CKV + r * 256 + 128 + c32) = pack8(a0, a1);
                    float s = sa; s += __shfl_xor(s, 16); s += __shfl_xor(s, 32); if (fq == 0) ssq_kv[r * 8 + 4 + wc] = s;
                    if (wc < 2) *(u32x4*)(KA + r * 64 + c32) = pack8(b0, b1); else *(u32x4*)(VA + r * 64 + (c32 - 64)) = pack8(b0, b1); }
                else if (pn == 7) {
                    if (wc < 2) { const int ch = 4 * wc + fq;
                        *(u32x4*)(KI + ((r >> 5) * 4 + (ch >> 1)) * 512 + (ch & 1) * 256 + (r & 31) * 8) = pack8(a0, a1); }
                    else if (wc == 2) {
                        const f32x4 c4 = *(const f32x4*)(rcos + r * 16 + 4 * fq), s4 = *(const f32x4*)(rsin + r * 16 + 4 * fq);
                        const f32x4 o0 = (f32x4){a0[0] * c4[0] - a0[1] * s4[0], a0[1] * c4[0] + a0[0] * s4[0], a0[2] * c4[1] - a0[3] * s4[1], a0[3] * c4[1] + a0[2] * s4[1]};
                        const f32x4 o1 = (f32x4){a1[0] * c4[2] - a1[1] * s4[2], a1[1] * c4[2] + a1[0] * s4[2], a1[2] * c4[3] - a1[3] * s4[3], a1[3] * c4[3] + a1[2] * s4[3]};
                        *(u32x4*)(KPE + r * 32 + 8 * fq) = pack8(o0, o1); }
                    else if (fq == 0) { *(f32x4*)(WI + r * 8) = a0; *(f32x4*)(WI + r * 8 + 4) = a1; }
                }
                else { bf16_t* p = G + r * 2048 + (pn - 8) * 256 + c32; *(u32x4*)p = pack8(sigm4(a0), sigm4(a1)); *(u32x4*)(p + HALF) = pack8(sigm4(b0), sigm4(b1)); }
            }
    }
};
struct EpiUpQ {
    static constexpr bool PERM = true, AFTER_DRAIN = false;
    bf16_t* QB; const float* ssq; const float *rcos, *rsin;
    __device__ __forceinline__ void operator()(const f32x4 (&acc)[2][2][4][2], const Unit& u, int wr, int wc, int fr, int fq) const {
        const int row0 = u.pm * BM + wr * 64 + fr;
#pragma unroll
        for (int ai = 0; ai < 2; ++ai)
#pragma unroll
            for (int m = 0; m < 4; ++m) {
                const size_t r = (size_t)(row0 + ai * HALF + m * 16);
                const f32x4 pa = *(const f32x4*)(ssq + r * 8), pb = *(const f32x4*)(ssq + r * 8 + 4);
                const float rs = __builtin_amdgcn_rsqf((((pa[0] + pa[1]) + (pa[2] + pa[3])) + ((pb[0] + pb[1]) + (pb[2] + pb[3]))) * (1.f / 384.f) + EPS_RMS) * QSCALE;
#pragma unroll
                for (int bj = 0; bj < 2; ++bj) {
                    const int c = u.pn * BM + bj * HALF + wc * 32 + 8 * fq;
                    const bool pe = ((u.pn * 8 + bj * 4 + wc) % 3) == 2;
                    f32x4 v0 = acc[ai][bj][m][0] * rs, v1 = acc[ai][bj][m][1] * rs;
                    if (pe) { const int i0 = 4 * fq;
                        const f32x4 c4 = *(const f32x4*)(rcos + r * 16 + i0), s4 = *(const f32x4*)(rsin + r * 16 + i0);
                        const f32x4 o0 = (f32x4){v0[0] * c4[0] - v0[1] * s4[0], v0[1] * c4[0] + v0[0] * s4[0], v0[2] * c4[1] - v0[3] * s4[1], v0[3] * c4[1] + v0[2] * s4[1]};
                        const f32x4 o1 = (f32x4){v1[0] * c4[2] - v1[1] * s4[2], v1[1] * c4[2] + v1[0] * s4[2], v1[2] * c4[3] - v1[3] * s4[3], v1[3] * c4[3] + v1[2] * s4[3]};
                        v0 = o0; v1 = o1; }
                    *(u32x4*)(QB + r * 768 + c) = pack8(v0, v1); }
                asm volatile("" ::: "memory"); }
    }
};
struct EpiUpKV {
    static constexpr bool PERM = true, AFTER_DRAIN = false;
    bf16_t *KN, *VB; const float* ssq;
    __device__ __forceinline__ void operator()(const f32x4 (&acc)[2][2][4][2], const Unit& u, int wr, int wc, int fr, int fq) const {
        const int row0 = u.pm * BM + wr * 64 + fr; bf16_t* dst = (u.pn < 2) ? KN : VB; const int c0 = (u.pn & 1) * BM + wc * 32 + 8 * fq;
#pragma unroll
        for (int ai = 0; ai < 2; ++ai)
#pragma unroll
            for (int m = 0; m < 4; ++m) {
                const size_t r = (size_t)(row0 + ai * HALF + m * 16);
                const f32x4 pa = *(const f32x4*)(ssq + r * 8), pb = *(const f32x4*)(ssq + r * 8 + 4);
                const float rs = __builtin_amdgcn_rsqf((((pa[0] + pa[1]) + (pa[2] + pa[3])) + ((pb[0] + pb[1]) + (pb[2] + pb[3]))) * (1.f / 256.f) + EPS_RMS);
#pragma unroll
                for (int bj = 0; bj < 2; ++bj) *(u32x4*)(dst + r * 512 + c0 + bj * HALF) = pack8(acc[ai][bj][m][0] * rs, acc[ai][bj][m][1] * rs);
                asm volatile("" ::: "memory"); }
    }
};
template <bool ADD> struct EpiGate {
    static constexpr bool PERM = true, AFTER_DRAIN = false;
    const bf16_t* G; int goff; const bf16_t* Yin; bf16_t* Y;
    __device__ __forceinline__ void operator()(const f32x4 (&acc)[2][2][4][2], const Unit& u, int wr, int wc, int fr, int fq) const {
        const int row0 = u.pm * BM + wr * 64 + fr, c0 = u.pn * BM + wc * 32 + 8 * fq;
#pragma unroll
        for (int ai = 0; ai < 2; ++ai)
#pragma unroll
            for (int m = 0; m < 4; ++m) {
                const size_t r = (size_t)(row0 + ai * HALF + m * 16);
#pragma unroll
                for (int bj = 0; bj < 2; ++bj) { const int c = c0 + bj * HALF;
                    f32x4 g0, g1; unpack8(*(const u32x4*)(G + r * 2048 + goff + c), g0, g1);
                    f32x4 v0 = g0 * acc[ai][bj][m][0], v1 = g1 * acc[ai][bj][m][1];
                    if (ADD) { f32x4 y0, y1; unpack8(*(const u32x4*)(Yin + r * 1024 + c), y0, y1); v0 += y0; v1 += y1; }
                    *(u32x4*)(Y + r * 1024 + c) = pack8(v0, v1); } }
    }
};

template <class Epi, class Sched, bool ALIGN_EPI = false, bool SP2 = false>
__device__ __forceinline__ void gemm_phase(PG8_LAS unsigned char* lds, const Gemm g, const Sched& S, const Epi& E) {
    const int tid = threadIdx.x, wid = __builtin_amdgcn_readfirstlane(tid >> 6), lane = tid & 63, wr = wid >> 2, wc = wid & 3, fr = lane & 15, fq = lane >> 4;
    const int K = g.K, nt = K / BK;
    unsigned voffA[2], voffB[2];
#pragma unroll
    for (int i = 0; i < 2; ++i) { int R, C; stage_rc(tid * 16 + i * 8192, R, C); const int Rb = Epi::PERM ? ((R & ~31) + perm32(R & 31)) : R;
        voffA[i] = (unsigned)(R * K + C) * 2u; voffB[i] = (unsigned)(Rb * K + C) * 2u; }
    const size_t kstep = (size_t)(BK * 2);
    const size_t hstep = (size_t)HALF * K * 2;
    const size_t tstep = 2 * hstep;
    const unsigned ldsw = (unsigned)wid * 1024u;
    const int aoff = lds_byte(wr * 64 + fr, fq * 8), boff = lds_byte(wc * 32 + fr, fq * 8);
#define PG8_SA(b, h) (((b) * 2 + (h)) * HTB)
#define PG8_SB(b, h) ((4 + (b) * 2 + (h)) * HTB)
#define PG8_STAGE(bufoff, gbase, voff) do { _Pragma("unroll") for (int _i = 0; _i < 2; ++_i) \
        __builtin_amdgcn_global_load_lds((const unsigned*)((const char*)(gbase) + (voff)[_i]), (PG8_LAS unsigned*)(lds + (bufoff) + ldsw + _i * 8192), 16, 0, 0); } while (0)
#define PG8_LDA(dst, b, h) do { _Pragma("unroll") for (int m = 0; m < 4; ++m) _Pragma("unroll") for (int k = 0; k < 2; ++k) dst[m][k] = *(const PG8_LAS bf16x8*)(lds + PG8_SA(b, h) + aoff + m * 2048 + k * 1024); } while (0)
#define PG8_LDB(dst, b, h) do { _Pragma("unroll") for (int n = 0; n < 2; ++n) _Pragma("unroll") for (int k = 0; k < 2; ++k) dst[n][k] = *(const PG8_LAS bf16x8*)(lds + PG8_SB(b, h) + boff + n * 2048 + k * 1024); } while (0)
#define PG8_MMA(ai, bj, At, Bt) do { __builtin_amdgcn_s_setprio(1); _Pragma("unroll") for (int m = 0; m < 4; ++m) _Pragma("unroll") for (int n = 0; n < 2; ++n) _Pragma("unroll") for (int k = 0; k < 2; ++k) \
        acc[ai][bj][m][n] = __builtin_amdgcn_mfma_f32_16x16x32_bf16(Bt[n][k], At[m][k], acc[ai][bj][m][n], 0, 0, 0); __builtin_amdgcn_s_setprio(0); } while (0)
#define PG8_WAIT_V(n) asm volatile("s_waitcnt vmcnt(" #n ")" ::: "memory")
#define PG8_WAIT_L(n) asm volatile("s_waitcnt lgkmcnt(" #n ")" ::: "memory")
#define PG8_BAR __builtin_amdgcn_s_barrier()
#define PG8_SCHED __builtin_amdgcn_sched_barrier(0)
    Unit cur, nxt; int ui = 0;
    if (!S.next(0, cur)) return;
    f32x4 acc[2][2][4][2];
#pragma unroll
    for (int a = 0; a < 2; ++a)
#pragma unroll
        for (int b = 0; b < 2; ++b)
#pragma unroll
            for (int m = 0; m < 4; ++m)
#pragma unroll
                for (int n = 0; n < 2; ++n) acc[a][b][m][n] = (f32x4){0.f, 0.f, 0.f, 0.f};
    bf16x8 At[4][2], B0[2][2], B1[2][2];
    const char* cA = (const char*)g.A + (size_t)cur.pm * tstep; const char* cB = (const char*)g.Bt + (size_t)cur.pn * tstep;
    S.a_ready(cur);
    if constexpr (SP2) {
        PG8_STAGE(PG8_SB(0, 0), cB, voffB); PG8_STAGE(PG8_SB(0, 1), cB + hstep, voffB); PG8_STAGE(PG8_SA(0, 0), cA, voffA); PG8_STAGE(PG8_SA(0, 1), cA + hstep, voffA);
        if (wr == 1) PG8_BAR;
        PG8_WAIT_V(2); PG8_BAR;
        PG8_STAGE(PG8_SB(1, 0), cB + kstep, voffB); PG8_STAGE(PG8_SA(1, 0), cA + kstep, voffA); PG8_STAGE(PG8_SB(1, 1), cB + hstep + kstep, voffB);
        PG8_WAIT_V(6); PG8_BAR;
    } else {
        PG8_STAGE(PG8_SB(0, 0), cB, voffB); PG8_STAGE(PG8_SA(0, 0), cA, voffA); PG8_STAGE(PG8_SB(0, 1), cB + hstep, voffB); PG8_STAGE(PG8_SA(0, 1), cA + hstep, voffA);
        if (wr == 1) PG8_BAR;
        PG8_WAIT_V(4); PG8_BAR;
        PG8_STAGE(PG8_SB(1, 0), cB + kstep, voffB); PG8_STAGE(PG8_SA(1, 0), cA + kstep, voffA); PG8_STAGE(PG8_SB(1, 1), cB + hstep + kstep, voffB);
        PG8_WAIT_V(6); PG8_BAR;
    }
    for (;;) {
        const bool has_next = S.next(ui + 1, nxt);
        const char* nA = has_next ? (const char*)g.A + (size_t)nxt.pm * tstep : cA; const char* nB = has_next ? (const char*)g.Bt + (size_t)nxt.pn * tstep : cB;
#pragma nounroll
        for (int t = 0; t < nt; t += 2) {
            const bool last = (t == nt - 2);
            const char* a1 = cA + (size_t)(t + 1) * kstep;
            const char* a2 = last ? nA : cA + (size_t)(t + 2) * kstep; const char* b2 = last ? nB : cB + (size_t)(t + 2) * kstep;
            const char* a3 = a2 + kstep; const char* b3 = b2 + kstep;
            if (last && has_next) S.a_ready(nxt);
            if constexpr (SP2) {
            PG8_LDB(B0, 0, 0); PG8_LDB(B1, 0, 1); PG8_SCHED; PG8_LDA(At, 0, 0); PG8_STAGE(PG8_SA(1, 1), a1 + hstep, voffA);
            PG8_WAIT_V(8); PG8_WAIT_L(0); PG8_BAR; PG8_MMA(0, 0, At, B0); PG8_MMA(0, 1, At, B1); PG8_BAR; PG8_SCHED;
            PG8_LDA(At, 0, 1); PG8_STAGE(PG8_SB(0, 0), b2, voffB); PG8_STAGE(PG8_SB(0, 1), b2 + hstep, voffB); PG8_STAGE(PG8_SA(0, 0), a2, voffA);
            PG8_WAIT_V(8); PG8_WAIT_L(0); PG8_BAR; PG8_MMA(1, 0, At, B0); PG8_MMA(1, 1, At, B1); PG8_BAR; PG8_SCHED;
            PG8_LDB(B0, 1, 0); PG8_LDB(B1, 1, 1); PG8_SCHED; PG8_LDA(At, 1, 0); PG8_STAGE(PG8_SA(0, 1), a2 + hstep, voffA);
            PG8_WAIT_V(8); PG8_WAIT_L(0); PG8_BAR; PG8_MMA(0, 0, At, B0); PG8_MMA(0, 1, At, B1); PG8_BAR; PG8_SCHED;
            PG8_LDA(At, 1, 1); PG8_STAGE(PG8_SB(1, 0), b3, voffB); PG8_STAGE(PG8_SB(1, 1), b3 + hstep, voffB); PG8_STAGE(PG8_SA(1, 0), a3, voffA);
            PG8_WAIT_V(8); PG8_WAIT_L(0); PG8_BAR; PG8_MMA(1, 0, At, B0); PG8_MMA(1, 1, At, B1); PG8_BAR; PG8_SCHED;
            } else {
            PG8_LDB(B0, 0, 0); PG8_SCHED; PG8_LDA(At, 0, 0); PG8_STAGE(PG8_SA(1, 1), a1 + hstep, voffA);
            PG8_WAIT_L(8); PG8_BAR; PG8_WAIT_L(0); PG8_MMA(0, 0, At, B0); PG8_BAR; PG8_SCHED;
            PG8_LDB(B1, 0, 1); PG8_STAGE(PG8_SB(0, 0), b2, voffB);
            PG8_BAR; PG8_WAIT_L(0); PG8_MMA(0, 1, At, B1); PG8_BAR;
            PG8_LDA(At, 0, 1); PG8_STAGE(PG8_SA(0, 0), a2, voffA);
            PG8_BAR; PG8_WAIT_L(0); PG8_MMA(1, 0, At, B0); PG8_BAR; PG8_SCHED;
            PG8_STAGE(PG8_SB(0, 1), b2 + hstep, voffB);
            PG8_WAIT_V(6); PG8_BAR; PG8_MMA(1, 1, At, B1); PG8_BAR;
            PG8_LDB(B0, 1, 0); PG8_SCHED; PG8_LDA(At, 1, 0); PG8_STAGE(PG8_SA(0, 1), a2 + hstep, voffA);
            PG8_WAIT_L(8); PG8_BAR; PG8_WAIT_L(0); PG8_MMA(0, 0, At, B0); PG8_BAR; PG8_SCHED;
            PG8_LDB(B1, 1, 1); PG8_STAGE(PG8_SB(1, 0), b3, voffB);
            PG8_BAR; PG8_WAIT_L(0); PG8_MMA(0, 1, At, B1); PG8_BAR;
            PG8_LDA(At, 1, 1); PG8_STAGE(PG8_SA(1, 0), a3, voffA);
            PG8_BAR; PG8_WAIT_L(0); PG8_MMA(1, 0, At, B0); PG8_BAR; PG8_SCHED;
            PG8_STAGE(PG8_SB(1, 1), b3 + hstep, voffB);
            PG8_WAIT_V(6); PG8_BAR; PG8_MMA(1, 1, At, B1); PG8_BAR;
            }
        }
        if constexpr (ALIGN_EPI) { if (wr == 0) PG8_BAR; }
        if constexpr (!Epi::AFTER_DRAIN) { E(acc, cur, wr, wc, fr, fq); S.done(cur); }
        if (!has_next) break;
#pragma unroll
        for (int a = 0; a < 2; ++a)
#pragma unroll
            for (int b = 0; b < 2; ++b)
#pragma unroll
                for (int m = 0; m < 4; ++m)
#pragma unroll
                    for (int n = 0; n < 2; ++n) acc[a][b][m][n] = (f32x4){0.f, 0.f, 0.f, 0.f};
        cur = nxt; cA = nA; cB = nB; ++ui;
        if constexpr (ALIGN_EPI) { if (wr == 1) PG8_BAR; }
    }
    PG8_WAIT_V(0);
    if constexpr (!ALIGN_EPI) { if (wr == 0) PG8_BAR; }
    PG8_BAR;
    if constexpr (Epi::AFTER_DRAIN) { E.fused(acc, cur, wr, wc, fr, fq, lds, wid, lane); S.done(cur); }
#undef PG8_SA
#undef PG8_SB
#undef PG8_STAGE
#undef PG8_LDA
#undef PG8_LDB
#undef PG8_MMA
#undef PG8_WAIT_V
#undef PG8_WAIT_L
#undef PG8_BAR
#undef PG8_SCHED
}
}

constexpr int NWAVES = 8;
constexpr int BATCH = 4, T = 8192, D = 1024, DFF = 2816, M = BATCH * T;
constexpr int INC = 3944, NPROJ = 4096;
constexpr int O_QA = 0, O_KA = 512, O_VA = 576, O_QI = 640, O_KI = 1152, O_WI = 1216, O_CQ = 1224, O_CKV = 1608, O_KR = 1864, O_GATE = 1896;
constexpr float EPS = 1e-6f;
#ifndef MK_FUSED
#define MK_FUSED 1
#endif

constexpr size_t MiB = 1u << 20;
constexpr size_t WS_CTL = 0, CTL_ZERO_BYTES = 2 * MiB;
constexpr size_t WS_MOD = 256 * 1024;
constexpr size_t WS_SSQQ = 49 * MiB, WS_SSQKV = 50 * MiB;
constexpr size_t WS_W1A = 2 * MiB, SZ_WA = (size_t)2 * DFF * D * 2, SZ_WD = (size_t)D * DFF * 2;
constexpr size_t WS_W1D = WS_W1A + SZ_WA, WS_WIN = WS_W1D + SZ_WD, WS_WUQ = WS_WIN + (size_t)NPROJ * D * 2, WS_WUKV = WS_WUQ + (size_t)768 * 384 * 2;
constexpr size_t WS_WOA = WS_WUKV + (size_t)1024 * 256 * 2, WS_WOB = WS_WOA + (size_t)D * 512 * 2, WS_WOUT = WS_WOB + (size_t)D * 512 * 2;
constexpr size_t WS_W2A = WS_WOUT + (size_t)D * D * 2, WS_W2D = WS_W2A + SZ_WA, WS_WEND = WS_W2D + SZ_WD;
static_assert(WS_WEND <= 49 * MiB, "weights");
constexpr size_t WS_RCOS = 51 * MiB, WS_RSIN = 53 * MiB;
constexpr size_t WS_XN = 55 * MiB;
constexpr size_t WS_ACT = 119 * MiB;
constexpr size_t WS_QA = WS_ACT, WS_QI = WS_QA + 32 * MiB, WS_CQ = WS_QI + 32 * MiB, WS_CKV = WS_CQ + 24 * MiB, WS_KA = WS_CKV + 16 * MiB, WS_VA = WS_KA + 4 * MiB;
constexpr size_t WS_KI = WS_VA + 4 * MiB, WS_KPE = WS_KI + 4 * MiB, WS_WI = WS_KPE + 2 * MiB, WS_QB = WS_WI + 1 * MiB, WS_MIXEND = WS_QB + 48 * MiB;
static_assert(WS_MIXEND <= WS_ACT + 176 * MiB, "mixer overlay");
constexpr size_t WS_G = 295 * MiB;
constexpr size_t WS_KN = 423 * MiB, WS_VB = 455 * MiB;
constexpr size_t WS_SEL = 487 * MiB;
constexpr size_t WS_END = 503 * MiB;
static_assert(WS_XN + 64 * MiB <= WS_ACT && WS_ACT + 176 * MiB <= WS_G && WS_G + 128 * MiB <= WS_KN && WS_VB + 32 * MiB <= WS_SEL, "d_ws map");
constexpr size_t WS_OA = WS_QA, WS_OB = WS_QI, WS_Y1 = WS_KN, WS_Y = WS_XN;
constexpr int CW_TMO = 0, CW_CODE = 1, CW_BAR = 4096;

constexpr int RING_OFF = 0, RING_BYTES = 152704;
constexpr int LDSCTL_OFF = RING_BYTES, MISC_OFF = LDSCTL_OFF + 320;
constexpr int LDS_BYTES = RING_BYTES + 1024;
#ifndef PROF_SEL
#define PROF_SEL 0
#endif
#ifndef PROF_MULT
#define PROF_MULT 4
#endif
#define PROF_WORD(ldsring, wid_) ((LAS unsigned*)((ldsring) + (MISC_OFF - RING_OFF) + 64) + (wid_))
#define PROF_T0(id) unsigned long long pt_##id = 0ull; if (PROF_SEL == (id)) pt_##id = __builtin_amdgcn_s_memrealtime()
#define PROF_T1(id, ldsring, wid_, lane_) do { if (PROF_SEL == (id)) { const unsigned d_ = (unsigned)(__builtin_amdgcn_s_memrealtime() - pt_##id); if ((lane_) == 0) *PROF_WORD(ldsring, wid_) += d_; } } while (0)
#define GAS __attribute__((address_space(1)))
#define LAS __attribute__((address_space(3)))
typedef unsigned short bf16;
typedef unsigned v4u __attribute__((ext_vector_type(4)));
typedef float f32x4 __attribute__((ext_vector_type(4)));
typedef short bf16x8 __attribute__((ext_vector_type(8)));
typedef GAS unsigned gu32;
typedef GAS unsigned long long gu64;
#define RLX_AGENT __ATOMIC_RELAXED, __HIP_MEMORY_SCOPE_AGENT
#define LDS_WAIT() asm volatile("s_waitcnt lgkmcnt(0)" ::: "memory")
#define VM_WAIT() asm volatile("s_waitcnt vmcnt(0)" ::: "memory")
__device__ __forceinline__ unsigned long long rt() { return __builtin_amdgcn_s_memrealtime(); }
__device__ __forceinline__ unsigned f2bf(float f) { unsigned u = __builtin_bit_cast(unsigned, f); return (u + 0x7fffu + ((u >> 16) & 1u)) >> 16; }
__device__ __forceinline__ unsigned pk2(float lo, float hi) { return f2bf(lo) | (f2bf(hi) << 16); }

#define XB_TMO      128
#define XB_XCNT(j)  (256  + 64 * (j))
#define XB_XSUB(j)  (1280 + 64 * (j))
#define XB_XGEN(j)  (2304 + 64 * (j))
#define XB_TOP      3328
#define XB_TOPGEN   3392
#define XCD_BAR_WORDS 3456
#define XB_SPIN_CAP (1u << 18)

__device__ __forceinline__ unsigned xb_ld(unsigned* p)              { return __hip_atomic_load(p, __ATOMIC_RELAXED, __HIP_MEMORY_SCOPE_AGENT); }
__device__ __forceinline__ unsigned xb_add(unsigned* p, unsigned v) { return __hip_atomic_fetch_add(p, v, __ATOMIC_RELAXED, __HIP_MEMORY_SCOPE_AGENT); }
__device__ __forceinline__ unsigned xb_xcc_id() { return (unsigned)__builtin_amdgcn_s_getreg((3 << 11) | 20) & 0xFu; }
#define XB_SPIN(cond, bar) do { unsigned _sp = 0; while (cond) { __builtin_amdgcn_s_sleep(1); \
    if ((++_sp & 255u) == 0u) { if (xb_ld(&(bar)[XB_TMO])) break; if (_sp > XB_SPIN_CAP) { atomicAdd(&(bar)[XB_TMO], 1u); break; } } } } while (0)

struct XcdBarrier {
    unsigned* bar; unsigned x;
    volatile LAS unsigned* st;
};

__device__ __forceinline__ XcdBarrier xcd_barrier_post(unsigned* bar, volatile LAS unsigned* st) {
    XcdBarrier b; b.bar = bar; b.x = xb_xcc_id(); b.st = st;
    if (threadIdx.x == 0) (void)xb_add(&bar[XB_XCNT(b.x)], 1u);
    return b;
}
__device__ __forceinline__ void xcd_barrier_complete(unsigned* bar, unsigned x, unsigned& nloc, unsigned& nx) {
    const unsigned G = gridDim.x * gridDim.y * gridDim.z;
    unsigned sum, cnt, mine, sp = 0u;
    for (;;) {
        sum = 0u; cnt = 0u; mine = 0u;
#pragma unroll
        for (unsigned j = 0; j < 16; ++j) { const unsigned c = xb_ld(&bar[XB_XCNT(j)]); sum += c; cnt += (c > 0u) ? 1u : 0u; mine = (j == x) ? c : mine; }
        if (sum == G) break;
        __builtin_amdgcn_s_sleep(1);
        if ((++sp & 255u) == 0u) { if (xb_ld(&bar[XB_TMO])) break; if (sp > XB_SPIN_CAP) { atomicAdd(&bar[XB_TMO], 1u); break; } }
    }
    nloc = mine > 0u ? mine : 1u; nx = cnt > 0u ? cnt : 1u;
}

__device__ __forceinline__ void xcd_barrier(const XcdBarrier& b) {
    asm volatile("s_waitcnt vmcnt(0)" ::: "memory");
    __syncthreads();
    if (threadIdx.x == 0) {
        unsigned* bar = b.bar;
        __builtin_amdgcn_s_waitcnt(0);
        unsigned nloc = b.st[0], nx = b.st[1];
        if (nloc == 0u) { xcd_barrier_complete(bar, b.x, nloc, nx); b.st[0] = nloc; b.st[1] = nx; }
        const unsigned old = xb_add(&bar[XB_XSUB(b.x)], 1u);
        const unsigned gen = old / nloc;
        if (old + 1u == (gen + 1u) * nloc) {
            __builtin_amdgcn_fence(__ATOMIC_RELEASE, "agent");
            asm volatile("s_waitcnt vmcnt(0)" ::: "memory");
            const unsigned og = xb_add(&bar[XB_TOP], 1u);
            const unsigned tg = og / nx;
            if (og + 1u == (tg + 1u) * nx) xb_add(&bar[XB_TOPGEN], 1u);
            else XB_SPIN(xb_ld(&bar[XB_TOPGEN]) == tg, bar);
            __builtin_amdgcn_fence(__ATOMIC_ACQUIRE, "agent");
            xb_add(&bar[XB_XGEN(b.x)], 1u);
            asm volatile("s_waitcnt vmcnt(0)" ::: "memory");
        } else {
            XB_SPIN(xb_ld(&bar[XB_XGEN(b.x)]) == gen, bar);
            __builtin_amdgcn_fence(__ATOMIC_ACQUIRE, "agent");
            asm volatile("s_waitcnt vmcnt(0)" ::: "memory");
        }
    }
    __syncthreads();
}

struct Frame {
    LAS unsigned char* lds;
    volatile LAS unsigned* MISC;
    gu32* ctl;
    int tid, lane, wave;
    int vcu, G;
};
__device__ __forceinline__ float wave_sum(float v) {
#pragma unroll
    for (int o = 1; o < 64; o <<= 1) v += __shfl_xor(v, o);
    return v;
}
struct MapIdent { int off; __device__ __forceinline__ int src(int n) const { return n + off; } };
struct MapFfnIn { __device__ __forceinline__ int src(int n) const { const int pn = n >> 8, j = n & 255; return (j >> 7) * DFF + pn * 128 + (j & 127); } };
struct MapProj { __device__ __forceinline__ int src(int n) const { const int pn = n >> 8, j = n & 255;
    if (pn < 2) return O_QA + n; if (pn < 4) return O_QI + (n - 512); if (pn == 4) return O_CQ + j;
    if (pn == 5) return j < 128 ? O_CQ + 256 + j : O_CKV + (j - 128);
    if (pn == 6) return j < 128 ? O_CKV + 128 + j : (j < 192 ? O_KA + (j - 128) : O_VA + (j - 192));
    if (pn == 7) { if (j < 64) return O_KI + j; if (j < 96) { const int jj = j - 64; return O_KR + (jj >> 1) + 16 * (jj & 1); } if (j < 104) return O_WI + (j - 96); return -1; }
    return O_GATE + (n - 2048); } };
struct MapUq { __device__ __forceinline__ int src(int n) const { const int h = n / 96, w = n % 96; if (w < 64) return n; const int jj = w - 64; return h * 96 + 64 + (jj >> 1) + 16 * (jj & 1); } };
template <class Map> __device__ __forceinline__ void p0_transpose_item(const float* W, int K, int Nsrc, int nblk, const float* kscale, bf16* WT, const Map mp, LAS float* scr, int item, int lane) {
    const int kb = item / nblk, nb = item % nblk, k0 = 64 * kb, n0 = 32 * nb;
    const int sc = mp.src(n0 + (lane & 31));
    float vv[32];
#pragma unroll
    for (int i = 0; i < 32; ++i) { const int kk = 2 * i + (lane >> 5); vv[i] = sc >= 0 ? W[(size_t)(k0 + kk) * Nsrc + sc] : 0.f; }
#pragma unroll
    for (int i = 0; i < 32; ++i) { const int kk = 2 * i + (lane >> 5); float v = vv[i]; if (kscale) v *= kscale[k0 + kk]; scr[kk * 33 + (lane & 31)] = v; }
    LDS_WAIT(); asm volatile("" ::: "memory");
    const int c = lane & 7;
#pragma unroll
    for (int j = 0; j < 4; ++j) { const int n = (lane >> 3) + 8 * j; const LAS float* s = scr + (8 * c) * 33 + n;
        v4u o; o.x = pk2(s[0 * 33], s[1 * 33]); o.y = pk2(s[2 * 33], s[3 * 33]); o.z = pk2(s[4 * 33], s[5 * 33]); o.w = pk2(s[6 * 33], s[7 * 33]);
        *(GAS v4u*)(WT + (size_t)(n0 + n) * K + k0 + 8 * c) = o; }
    LDS_WAIT(); asm volatile("" ::: "memory");
}
struct Args { const void* in[23]; float* out; unsigned char* ws; int ph_lo, ph_hi, li, pad; };

__device__ __forceinline__ void p0_prologue(Frame& F, const Args& A) {
    LAS float* scr = (LAS float*)(F.lds + RING_OFF + F.wave * 16384);
    const int gw = F.vcu * NWAVES + F.wave, NGW = F.G * NWAVES;
    unsigned char* ws = A.ws;
    {
        const float* c = (const float*)A.in[1]; const float* w = (const float*)A.in[3]; const float* bias = (const float*)A.in[4]; float* mod = (float*)(ws + WS_MOD);
        for (int cg = F.vcu; cg < 256; cg += F.G) {
            const bool act = F.lane < 36; const int n = cg * 36 + (act ? F.lane : 0), k0 = F.wave * 128;
#pragma unroll
            for (int b = 0; b < 4; ++b)
#pragma unroll
                for (int h = 0; h < 2; ++h) { const float v = c[b * D + k0 + h * 64 + F.lane]; scr[b * 128 + h * 64 + F.lane] = v / (1.f + __expf(-v)); }
            LDS_WAIT(); asm volatile("" ::: "memory");
            float a0 = 0.f, a1 = 0.f, a2 = 0.f, a3 = 0.f;
#pragma unroll 8
            for (int k = 0; k < 128; ++k) { const float wv = act ? w[(size_t)(k0 + k) * 9216 + n] : 0.f; a0 += scr[k] * wv; a1 += scr[128 + k] * wv; a2 += scr[256 + k] * wv; a3 += scr[384 + k] * wv; }
            scr[1024 + F.lane] = a0; scr[1088 + F.lane] = a1; scr[1152 + F.lane] = a2; scr[1216 + F.lane] = a3;
            __syncthreads();
            if (F.wave < 4 && act) { float t = bias[n];
#pragma unroll
                for (int ww = 0; ww < 8; ++ww) t += ((LAS float*)(F.lds + RING_OFF + ww * 16384))[1024 + F.wave * 64 + F.lane];
                mod[F.wave * 9216 + n] = t; }
            __syncthreads();
        }
    }
    {
        const float* w1a = (const float*)A.in[6]; const float* w1d = (const float*)A.in[7]; const float* win = (const float*)A.in[9]; const float* gcq = (const float*)A.in[10];
        const float* wuq = (const float*)A.in[11]; const float* gckv = (const float*)A.in[12]; const float* wuk = (const float*)A.in[13]; const float* wuv = (const float*)A.in[14];
        const float* woa = (const float*)A.in[16]; const float* wob = (const float*)A.in[17]; const float* wout = (const float*)A.in[18]; const float* w2a = (const float*)A.in[20]; const float* w2d = (const float*)A.in[21];
        constexpr int I_A = 16 * 176, I_D = 44 * 32, I_IN = 16 * 128, I_UQ = 6 * 24, I_UK = 4 * 16, I_O = 8 * 32, I_OUT = 16 * 32;
        constexpr int NITEMS = 2 * I_A + 2 * I_D + I_IN + I_UQ + 2 * I_UK + 2 * I_O + I_OUT;
        for (int it = gw; it < NITEMS; it += NGW) {
            int r = it;
            if (r < I_A) { p0_transpose_item(w1a, D, 2 * DFF, 176, nullptr, (bf16*)(ws + WS_W1A), MapFfnIn{}, scr, r, F.lane); continue; } r -= I_A;
            if (r < I_A) { p0_transpose_item(w2a, D, 2 * DFF, 176, nullptr, (bf16*)(ws + WS_W2A), MapFfnIn{}, scr, r, F.lane); continue; } r -= I_A;
            if (r < I_D) { p0_transpose_item(w1d, DFF, D, 32, nullptr, (bf16*)(ws + WS_W1D), MapIdent{0}, scr, r, F.lane); continue; } r -= I_D;
            if (r < I_D) { p0_transpose_item(w2d, DFF, D, 32, nullptr, (bf16*)(ws + WS_W2D), MapIdent{0}, scr, r, F.lane); continue; } r -= I_D;
            if (r < I_IN) { p0_transpose_item(win, D, INC, 128, nullptr, (bf16*)(ws + WS_WIN), MapProj{}, scr, r, F.lane); continue; } r -= I_IN;
            if (r < I_UQ) { p0_transpose_item(wuq, 384, 768, 24, gcq, (bf16*)(ws + WS_WUQ), MapUq{}, scr, r, F.lane); continue; } r -= I_UQ;
            if (r < I_UK) { p0_transpose_item(wuk, 256, 512, 16, gckv, (bf16*)(ws + WS_WUKV), MapIdent{0}, scr, r, F.lane); continue; } r -= I_UK;
            if (r < I_UK) { p0_transpose_item(wuv, 256, 512, 16, gckv, (bf16*)(ws + WS_WUKV) + (size_t)512 * 256, MapIdent{0}, scr, r, F.lane); continue; } r -= I_UK;
            if (r < I_O) { p0_transpose_item(woa, 512, D, 32, nullptr, (bf16*)(ws + WS_WOA), MapIdent{0}, scr, r, F.lane); continue; } r -= I_O;
            if (r < I_O) { p0_transpose_item(wob, 512, D, 32, nullptr, (bf16*)(ws + WS_WOB), MapIdent{0}, scr, r, F.lane); continue; } r -= I_O;
            p0_transpose_item(wout, D, D, 32, nullptr, (bf16*)(ws + WS_WOUT), MapIdent{0}, scr, r, F.lane);
        }
    }
    {
        const int* pos = (const int*)A.in[2]; float* rc = (float*)(ws + WS_RCOS); float* rs = (float*)(ws + WS_RSIN);
        for (int idx = gw * 64 + F.lane; idx < M * 16; idx += NGW * 64) { const int t = idx >> 4, i = idx & 15;
            const float freq = powf(10000.0f, -2.0f * (float)i / 32.0f); const float ang = (float)pos[t] * freq;
            rc[idx] = cosf(ang); rs[idx] = sinf(ang); }
    }
}
__device__ __forceinline__ void norm_mod_phase(Frame& F, const float* xin, const float* g, const float* mod, int shoff, int scoff, bf16* out) {
    const int gw = F.vcu * NWAVES + F.wave, NGW = F.G * NWAVES;
    for (int m = gw; m < M; m += NGW) {
        const int b = m >> 13;
        const GAS f32x4* xr = (const GAS f32x4*)(xin + (size_t)m * D) + F.lane;
        const GAS f32x4* g4 = (const GAS f32x4*)g + F.lane; const GAS f32x4* sc4 = (const GAS f32x4*)(mod + b * 9216 + scoff) + F.lane; const GAS f32x4* sh4 = (const GAS f32x4*)(mod + b * 9216 + shoff) + F.lane;
        f32x4 v[4]; float s = 0.f;
#pragma unroll
        for (int j = 0; j < 4; ++j) { v[j] = xr[64 * j]; s += (v[j].x * v[j].x + v[j].y * v[j].y) + (v[j].z * v[j].z + v[j].w * v[j].w); }
        const float rs = __builtin_amdgcn_rsqf(wave_sum(s) * (1.f / D) + EPS);
        GAS unsigned long long* o8 = (GAS unsigned long long*)(out + (size_t)m * D) + F.lane;
#pragma unroll
        for (int j = 0; j < 4; ++j) { const f32x4 o = v[j] * rs * g4[64 * j] * (sc4[64 * j] + 1.f) + sh4[64 * j];
            o8[64 * j] = (unsigned long long)pk2(o.x, o.y) | ((unsigned long long)pk2(o.z, o.w) << 32); }
    }
}
__device__ __forceinline__ void final_norm_phase(Frame& F, const float* xin, const float* g, float* out) {
    const int gw = F.vcu * NWAVES + F.wave, NGW = F.G * NWAVES;
    for (int m = gw; m < M; m += NGW) {
        const GAS f32x4* xr = (const GAS f32x4*)(xin + (size_t)m * D) + F.lane; const GAS f32x4* g4 = (const GAS f32x4*)g + F.lane;
        f32x4 v[4]; float s = 0.f;
#pragma unroll
        for (int j = 0; j < 4; ++j) { v[j] = xr[64 * j]; s += (v[j].x * v[j].x + v[j].y * v[j].y) + (v[j].z * v[j].z + v[j].w * v[j].w); }
        const float rs = __builtin_amdgcn_rsqf(wave_sum(s) * (1.f / D) + EPS);
        GAS f32x4* o4 = (GAS f32x4*)(out + (size_t)m * D) + F.lane;
#pragma unroll
        for (int j = 0; j < 4; ++j) o4[64 * j] = v[j] * rs * g4[64 * j];
    }
}

namespace mla {
typedef unsigned u32x4 __attribute__((ext_vector_type(4)));
typedef short bf16x8 __attribute__((ext_vector_type(8)));
typedef short s16x4 __attribute__((ext_vector_type(4)));
typedef float f32x16 __attribute__((ext_vector_type(16)));
constexpr int KSLOT = 12288, VSLOT = 8192;
constexpr int L_K = 0, L_V = 3 * KSLOT, L_WS = L_V + 3 * VSLOT, L_OST = L_WS + 2048, L_END = L_OST + 8 * 4096;
static_assert(L_END <= RING_BYTES, "attention LDS");
__device__ __forceinline__ int crow(int r, int hi) { return (r & 3) + 8 * (r >> 2) + 4 * hi; }
__device__ __forceinline__ float xhalf(float v) { return __shfl_xor(v, 32); }
__device__ __forceinline__ void pv(f32x16* o, int vb, bf16x8 pa0, bf16x8 pa1, bf16x8 pa2, bf16x8 pa3) {
#pragma unroll
    for (int d0 = 0; d0 < 2; ++d0) { s16x4 lo[4], hi[4];
#pragma unroll
        for (int ks = 0; ks < 4; ++ks) {
            asm volatile("ds_read_b64_tr_b16 %0,%1 offset:%c2" : "=&v"(lo[ks]) : "v"(vb), "i"(d0 * 4096 + ks * 1024) : "memory");
            asm volatile("ds_read_b64_tr_b16 %0,%1 offset:%c2" : "=&v"(hi[ks]) : "v"(vb), "i"(d0 * 4096 + ks * 1024 + 512) : "memory"); }
        asm volatile("s_waitcnt lgkmcnt(0)" ::: "memory"); __builtin_amdgcn_sched_barrier(0);
#define MLA_PK(k) (bf16x8){lo[k][0], lo[k][1], lo[k][2], lo[k][3], hi[k][0], hi[k][1], hi[k][2], hi[k][3]}
        o[d0] = __builtin_amdgcn_mfma_f32_32x32x16_bf16(pa0, MLA_PK(0), o[d0], 0, 0, 0);
        o[d0] = __builtin_amdgcn_mfma_f32_32x32x16_bf16(pa1, MLA_PK(1), o[d0], 0, 0, 0);
        o[d0] = __builtin_amdgcn_mfma_f32_32x32x16_bf16(pa2, MLA_PK(2), o[d0], 0, 0, 0);
        o[d0] = __builtin_amdgcn_mfma_f32_32x32x16_bf16(pa3, MLA_PK(3), o[d0], 0, 0, 0);
#undef MLA_PK
    }
}
__device__ __forceinline__ void attn_unit(int b, int h, int qb, const bf16* QB, const bf16* KN, const bf16* KPE, const bf16* VB, bf16* OB, LAS unsigned char* lds) {
    const int tid = threadIdx.x, lane = tid & 63, r32 = lane & 31, hi = lane >> 5; const int wid = __builtin_amdgcn_readfirstlane(tid >> 6);
    const size_t rowbase = (size_t)b * T; const int q0 = qb * 256;
    const int NT = 4 * (qb + 1), my_last = 4 * qb + (wid >> 1);
    LAS float* wsf = (LAS float*)(lds + L_WS) + wid * 64;
#define MLA_DMA(t, slot) do { const size_t krow_ = rowbase + (size_t)(t) * 64 + lane; \
        __builtin_amdgcn_global_load_lds((const unsigned*)(KN + krow_ * 512 + h * 64 + wid * 8), (LAS unsigned*)(lds + L_K + (slot) * KSLOT + wid * 1024), 16, 0, 0); \
        if (wid < 4) __builtin_amdgcn_global_load_lds((const unsigned*)(KPE + krow_ * 32 + wid * 8), (LAS unsigned*)(lds + L_K + (slot) * KSLOT + (8 + wid) * 1024), 16, 0, 0); \
        const size_t vrow_ = rowbase + (size_t)(t) * 64 + 16 * (wid & 3) + (lane >> 2); \
        __builtin_amdgcn_global_load_lds((const unsigned*)(VB + vrow_ * 512 + h * 64 + (wid >> 2) * 32 + (lane & 3) * 8), (LAS unsigned*)(lds + L_V + (slot) * VSLOT + wid * 1024), 16, 0, 0); } while (0)
    bf16x8 qr[6];
    { const bf16* Qw = QB + (rowbase + q0 + wid * 32 + r32) * 768 + h * 96 + hi * 8;
#pragma unroll
      for (int d0 = 0; d0 < 6; ++d0) qr[d0] = *(const bf16x8*)(Qw + d0 * 16); }
    MLA_DMA(0, 0); MLA_DMA(1, 1);
    int slot = 0, slot2 = 2;
    float m = 0.f, l = 0.f; f32x16 o[2], negm;
#pragma unroll
    for (int r = 0; r < 16; ++r) { o[0][r] = 0.f; o[1][r] = 0.f; negm[r] = 0.f; }
    const int kofs = hi * 1024 + r32 * 16;
    const int vb0 = (int)(unsigned)(uintptr_t)(lds + L_V) + ((lane >> 4) & 1) * 32 + (lane & 3) * 8 + (4 * hi + ((lane & 15) >> 2)) * 64;
    for (int t = 0; t < NT; ++t) {
        if (t + 1 < NT) { if (wid < 4) asm volatile("s_waitcnt vmcnt(3) lgkmcnt(0)\n\ts_barrier" ::: "memory"); else asm volatile("s_waitcnt vmcnt(2) lgkmcnt(0)\n\ts_barrier" ::: "memory"); }
        else asm volatile("s_waitcnt vmcnt(0) lgkmcnt(0)\n\ts_barrier" ::: "memory");
        if (t + 2 < NT) MLA_DMA(t + 2, slot2);
        const int cslot = slot; slot = (slot == 2) ? 0 : slot + 1; slot2 = (slot2 == 2) ? 0 : slot2 + 1;
        if (t <= my_last) {
            const int slot = cslot;
            const LAS unsigned char* kb = lds + L_K + slot * KSLOT + kofs;
            f32x16 p0, p1;
#pragma unroll
            for (int d0 = 0; d0 < 6; ++d0) {
                const bf16x8 b0 = *(const LAS bf16x8*)(kb + d0 * 2048), b1 = *(const LAS bf16x8*)(kb + d0 * 2048 + 512);
                if (d0 == 0) { p0 = __builtin_amdgcn_mfma_f32_32x32x16_bf16(b0, qr[0], negm, 0, 0, 0); p1 = __builtin_amdgcn_mfma_f32_32x32x16_bf16(b1, qr[0], negm, 0, 0, 0); }
                else { p0 = __builtin_amdgcn_mfma_f32_32x32x16_bf16(b0, qr[d0], p0, 0, 0, 0); p1 = __builtin_amdgcn_mfma_f32_32x32x16_bf16(b1, qr[d0], p1, 0, 0, 0); } }
#define MLA_MX3(a, b, c) __builtin_fmaxf(__builtin_fmaxf((a), (b)), (c))
            float ra = MLA_MX3(p0[0], p0[1], p1[0]), rb = MLA_MX3(p0[2], p0[3], p1[1]); ra = MLA_MX3(ra, p1[2], p1[3]);
#pragma unroll
            for (int r = 4; r < 16; r += 4) { ra = MLA_MX3(ra, p0[r], p0[r + 1]); rb = MLA_MX3(rb, p0[r + 2], p0[r + 3]); ra = MLA_MX3(ra, p1[r], p1[r + 1]); rb = MLA_MX3(rb, p1[r + 2], p1[r + 3]); }
#undef MLA_MX3
            float rm = __builtin_fmaxf(ra, rb);
            rm = __builtin_fmaxf(rm, xhalf(rm));
            if (t == 0 || __any(rm > 0.f)) {
                const float dl = (t == 0) ? rm : __builtin_fmaxf(rm, 0.f), f = __builtin_amdgcn_exp2f(-dl);
                m += dl; l *= f;
#pragma unroll
                for (int r = 0; r < 16; ++r) { p0[r] -= dl; p1[r] -= dl; negm[r] = -m; }
                if (t != 0) {
                    if (hi == 0) wsf[r32] = f;
                    asm volatile("s_waitcnt lgkmcnt(0)" ::: "memory");
#pragma unroll
                    for (int r = 0; r < 16; ++r) { const float fr_ = wsf[crow(r, hi)]; o[0][r] *= fr_; o[1][r] *= fr_; }
                }
            }
            float sacc = 0.f;
#pragma unroll
            for (int r = 0; r < 16; ++r) { p0[r] = __builtin_amdgcn_exp2f(p0[r]); p1[r] = __builtin_amdgcn_exp2f(p1[r]); sacc += p0[r] + p1[r]; }
            l += sacc;
            u32x4 pw0, pw1, pw2, pw3;
            pw0 = (u32x4){pg8::cvt_pk_bf16(p0[0], p0[1]), pg8::cvt_pk_bf16(p0[2], p0[3]), pg8::cvt_pk_bf16(p0[4], p0[5]), pg8::cvt_pk_bf16(p0[6], p0[7])};
            pw1 = (u32x4){pg8::cvt_pk_bf16(p0[8], p0[9]), pg8::cvt_pk_bf16(p0[10], p0[11]), pg8::cvt_pk_bf16(p0[12], p0[13]), pg8::cvt_pk_bf16(p0[14], p0[15])};
            pw2 = (u32x4){pg8::cvt_pk_bf16(p1[0], p1[1]), pg8::cvt_pk_bf16(p1[2], p1[3]), pg8::cvt_pk_bf16(p1[4], p1[5]), pg8::cvt_pk_bf16(p1[6], p1[7])};
            pw3 = (u32x4){pg8::cvt_pk_bf16(p1[8], p1[9]), pg8::cvt_pk_bf16(p1[10], p1[11]), pg8::cvt_pk_bf16(p1[12], p1[13]), pg8::cvt_pk_bf16(p1[14], p1[15])};
            pv(o, vb0 + slot * VSLOT, __builtin_bit_cast(bf16x8, pw0), __builtin_bit_cast(bf16x8, pw1), __builtin_bit_cast(bf16x8, pw2), __builtin_bit_cast(bf16x8, pw3));
        }
    }
#undef MLA_DMA
    l += xhalf(l);
    if (hi == 0) wsf[32 + r32] = l;
    asm volatile("s_waitcnt lgkmcnt(0)" ::: "memory");
    LAS bf16* stg = (LAS bf16*)(lds + L_OST) + wid * 2048;
#pragma unroll
    for (int r = 0; r < 16; ++r) { const int orow = crow(r, hi); const float rl = __builtin_amdgcn_rcpf(wsf[32 + orow]);
        stg[orow * 64 + r32] = (bf16)(pg8::cvt_pk_bf16(o[0][r] * rl, 0.f) & 0xffffu); stg[orow * 64 + 32 + r32] = (bf16)(pg8::cvt_pk_bf16(o[1][r] * rl, 0.f) & 0xffffu); }
    asm volatile("s_waitcnt lgkmcnt(0)" ::: "memory");
    bf16* Ow = OB + (rowbase + q0 + wid * 32) * 512 + h * 64;
#pragma unroll
    for (int i = 0; i < 4; ++i) { const int row = i * 8 + (lane >> 3), ch = lane & 7; const u32x4 v = *(const LAS u32x4*)(stg + row * 64 + ch * 8); *(u32x4*)(Ow + (size_t)row * 512 + ch * 8) = v; }
    asm volatile("s_waitcnt lgkmcnt(0)\n\ts_barrier" ::: "memory");
}
__device__ __forceinline__ void phase(int vcu, int G, const bf16* QB, const bf16* KN, const bf16* KPE, const bf16* VB, bf16* OB, LAS unsigned char* lds) {
    for (int u = vcu; u < 1024; u += G) { const int i = u >> 8, v = u & 255, bh = v >> 3, s = v & 7;
        const int qb = (i == 0) ? s : (i == 1) ? 15 - s : (i == 2) ? 16 + s : 31 - s;
        attn_unit(bh >> 3, bh & 7, qb, QB, KN, KPE, VB, OB, lds); }
}
}

namespace dsa {
typedef short bf16x8 __attribute__((ext_vector_type(8)));
typedef short v4i16 __attribute__((ext_vector_type(4)));
typedef unsigned u32x4m __attribute__((ext_vector_type(4)));
typedef unsigned u32x2m __attribute__((ext_vector_type(2)));
constexpr float LOG2E = 1.4426950408889634f;
__device__ __forceinline__ int t5_bucket(int rel) {
    const int n = rel < 0 ? -rel : rel; const int r = rel > 0 ? 16 : 0;
    if (n < 8) return r + n;
    int lg = 7; if (n < 128) lg = (31 - __clz(n * n)) - 6;
    return r + 8 + lg;
}
__device__ __forceinline__ void query(int q, const bf16* QA, const bf16* KA, const bf16* VA, const int* positions, bf16* OA, LAS unsigned char* vbuf, LAS unsigned short* selL, LAS unsigned char* bktL, const LAS float* bt, int lane) {
    const int l15 = lane & 15, kq = lane >> 4;
    const int trofs = ((l15 >> 2) + 4 * kq) * 128 + (l15 & 3) * 8;
    const int b = q >> 13, t = q & (T - 1); const size_t rowbase = (size_t)b * T;
    const int limit = 64 * (t / 64 + 1), nvalid = limit < 256 ? limit : 256; const int posq = positions[q];
#pragma unroll
    for (int j = 0; j < 4; ++j) { const int k = lane + 64 * j; const int sv = selL[k];
        bktL[k] = (unsigned char)((k < nvalid) ? t5_bucket(positions[rowbase + sv] - posq) : 32); }
#define DSA_VDMA(cch, buf) do { _Pragma("unroll") for (int i_ = 0; i_ < 4; ++i_) { const int row_ = selL[32 * (cch) + 8 * i_ + (lane >> 3)]; \
        __builtin_amdgcn_global_load_lds((const unsigned*)(VA + (rowbase + row_) * 64 + (lane & 7) * 8), (LAS unsigned*)(vbuf + (buf) * 4096 + i_ * 1024), 16, 0, 0); } } while (0)
    DSA_VDMA(0, 0); DSA_VDMA(1, 1); DSA_VDMA(2, 2); DSA_VDMA(3, 3);
    bf16x8 Qf[2];
#pragma unroll
    for (int s = 0; s < 2; ++s) { Qf[s] = (bf16x8){0, 0, 0, 0, 0, 0, 0, 0}; if (l15 < 8) Qf[s] = *(const bf16x8*)(QA + (size_t)q * 512 + l15 * 64 + 32 * s + 8 * kq); }
    f32x4 St[16];
#pragma unroll
    for (int half = 0; half < 2; ++half) {
        bf16x8 Ka[8][2];
#pragma unroll
        for (int i = 0; i < 8; ++i) { const int row = selL[16 * (8 * half + i) + l15]; const bf16* kp = KA + (rowbase + row) * 64 + 8 * kq;
            Ka[i][0] = *(const bf16x8*)kp; Ka[i][1] = *(const bf16x8*)(kp + 32); }
#pragma unroll
        for (int i = 0; i < 8; ++i) { f32x4 a = {0.f, 0.f, 0.f, 0.f};
            a = __builtin_amdgcn_mfma_f32_16x16x32_bf16(Ka[i][0], Qf[0], a, 0, 0, 0); a = __builtin_amdgcn_mfma_f32_16x16x32_bf16(Ka[i][1], Qf[1], a, 0, 0, 0); St[8 * half + i] = a; }
    }
    asm volatile("s_waitcnt lgkmcnt(0)" ::: "memory");
    float mx = -INFINITY;
#pragma unroll
    for (int kt = 0; kt < 16; ++kt) { const unsigned bk4 = *(const LAS unsigned*)(bktL + 16 * kt + 4 * kq);
#pragma unroll
        for (int i = 0; i < 4; ++i) { const float s = St[kt][i] * (0.125f * LOG2E) + bt[((bk4 >> (8 * i)) & 255u) * 8 + (l15 & 7)]; St[kt][i] = s; mx = fmaxf(mx, s); } }
    mx = fmaxf(mx, __shfl_xor(mx, 16)); mx = fmaxf(mx, __shfl_xor(mx, 32));
    float lsum = 0.f;
#pragma unroll
    for (int kt = 0; kt < 16; ++kt)
#pragma unroll
        for (int i = 0; i < 4; ++i) { const float p = __builtin_amdgcn_exp2f(St[kt][i] - mx); St[kt][i] = p; lsum += p; }
    lsum += __shfl_xor(lsum, 16); lsum += __shfl_xor(lsum, 32);
    f32x4 O[4];
#pragma unroll
    for (int dt = 0; dt < 4; ++dt) O[dt] = (f32x4){0.f, 0.f, 0.f, 0.f};
#pragma unroll
    for (int kk = 0; kk < 8; ++kk) {
        if (kk < 5) asm volatile("s_waitcnt vmcnt(12)" ::: "memory"); else if (kk == 5) asm volatile("s_waitcnt vmcnt(8)" ::: "memory"); else if (kk == 6) asm volatile("s_waitcnt vmcnt(4)" ::: "memory"); else asm volatile("s_waitcnt vmcnt(0)" ::: "memory");
        const LAS unsigned char* vb = vbuf + (kk & 3) * 4096 + trofs;
        const f32x4 pa = St[2 * kk], pb = St[2 * kk + 1];
        u32x4m pw; pw.x = pg8::cvt_pk_bf16(pa[0], pa[1]); pw.y = pg8::cvt_pk_bf16(pa[2], pa[3]); pw.z = pg8::cvt_pk_bf16(pb[0], pb[1]); pw.w = pg8::cvt_pk_bf16(pb[2], pb[3]);
        const bf16x8 Pf = __builtin_bit_cast(bf16x8, pw);
#pragma unroll
        for (int dt = 0; dt < 4; ++dt) {
            const v4i16 v0 = __builtin_amdgcn_ds_read_tr16_b64_v4i16((LAS v4i16*)(vb + dt * 32));
            const v4i16 v1 = __builtin_amdgcn_ds_read_tr16_b64_v4i16((LAS v4i16*)(vb + 2048 + dt * 32));
            const bf16x8 Vf = (bf16x8){v0[0], v0[1], v0[2], v0[3], v1[0], v1[1], v1[2], v1[3]};
            O[dt] = __builtin_amdgcn_mfma_f32_16x16x32_bf16(Vf, Pf, O[dt], 0, 0, 0); }
        if (kk < 4) { asm volatile("s_waitcnt lgkmcnt(0)" ::: "memory"); DSA_VDMA(kk + 4, kk); }
    }
#undef DSA_VDMA
    if (l15 < 8) { const float rl = __builtin_amdgcn_rcpf(lsum);
#pragma unroll
        for (int dt = 0; dt < 4; ++dt) { u32x2m w; w.x = pg8::cvt_pk_bf16(O[dt][0] * rl, O[dt][1] * rl); w.y = pg8::cvt_pk_bf16(O[dt][2] * rl, O[dt][3] * rl);
            *(u32x2m*)(OA + (size_t)q * 512 + l15 * 64 + 16 * dt + 4 * kq) = w; } }
    asm volatile("s_waitcnt vmcnt(0) lgkmcnt(0)" ::: "memory");
}
}

namespace idx {
typedef short bf16x8 __attribute__((ext_vector_type(8)));
typedef float f32x16 __attribute__((ext_vector_type(16)));
typedef unsigned u32x2 __attribute__((ext_vector_type(2)));
constexpr int CAP = 576, TRIG = CAP - 64, NE = (CAP + 63) / 64;
constexpr int L_CAND = 0, L_TRASH = 32 * CAP * 8, L_BIAS = L_TRASH + 8 * 512, L_END = L_BIAS + 33 * 8 * 4;
static_assert(4 * CAP * 8 >= 4 * 512 + 16384, "a wave's four candidate buffers hold its four selection tables + the attention's V buffers afterwards");
constexpr int KEEP_MAX = 272, SCHED_MIN = 304;
static_assert(L_END <= RING_BYTES, "indexer LDS");
__device__ __forceinline__ unsigned okey(float f) { const unsigned u = __float_as_uint(f); return (u & 0x80000000u) ? ~u : (u | 0x80000000u); }
__device__ __forceinline__ float ikey(unsigned k) { return __uint_as_float((k & 0x80000000u) ? (k ^ 0x80000000u) : ~k); }
__device__ __forceinline__ int prefix64(unsigned long long m) { return (int)__builtin_amdgcn_mbcnt_hi((unsigned)(m >> 32), __builtin_amdgcn_mbcnt_lo((unsigned)m, 0u)); }
__device__ __forceinline__ unsigned wave_umax(unsigned v) {
    v = max(v, (unsigned)__builtin_amdgcn_update_dpp(0, (int)v, 0xB1, 0xf, 0xf, false)); v = max(v, (unsigned)__builtin_amdgcn_update_dpp(0, (int)v, 0x4E, 0xf, 0xf, false));
    v = max(v, (unsigned)__builtin_amdgcn_update_dpp(0, (int)v, 0x141, 0xf, 0xf, false)); v = max(v, (unsigned)__builtin_amdgcn_update_dpp(0, (int)v, 0x140, 0xf, 0xf, false));
    return max(max((unsigned)__builtin_amdgcn_readlane((int)v, 0), (unsigned)__builtin_amdgcn_readlane((int)v, 16)), max((unsigned)__builtin_amdgcn_readlane((int)v, 32), (unsigned)__builtin_amdgcn_readlane((int)v, 48)));
}
__device__ __forceinline__ unsigned wave_umin(unsigned v) { return ~wave_umax(~v); }
__device__ __forceinline__ unsigned wave_usum(unsigned v) {
    v += (unsigned)__builtin_amdgcn_update_dpp(0, (int)v, 0xB1, 0xf, 0xf, false); v += (unsigned)__builtin_amdgcn_update_dpp(0, (int)v, 0x4E, 0xf, 0xf, false);
    v += (unsigned)__builtin_amdgcn_update_dpp(0, (int)v, 0x141, 0xf, 0xf, false); v += (unsigned)__builtin_amdgcn_update_dpp(0, (int)v, 0x140, 0xf, 0xf, false);
    return ((unsigned)__builtin_amdgcn_readlane((int)v, 0) + (unsigned)__builtin_amdgcn_readlane((int)v, 16)) + ((unsigned)__builtin_amdgcn_readlane((int)v, 32) + (unsigned)__builtin_amdgcn_readlane((int)v, 48));
}
__device__ __forceinline__ int count_ge_v(const unsigned (&k)[8], unsigned thr) { unsigned c = 0;
#pragma unroll
    for (int j = 0; j < 8; ++j) c += (k[j] >= thr) ? 1u : 0u;
    return (int)wave_usum(c); }
template <bool FINAL> __device__ __forceinline__ void select4(LAS u32x2* cb, int (&n)[4], unsigned (&tk)[4], int lane, LAS unsigned short* sel_out, LAS u32x2* trash) {
    unsigned k[4][NE], ix[4][FINAL ? NE : 1];
#pragma unroll
    for (int q = 0; q < 4; ++q)
#pragma unroll
        for (int j = 0; j < NE; ++j) { const int e = lane + 64 * j; const bool v = e < n[q]; const u32x2 en = cb[(size_t)q * CAP + (v ? e : 0)]; if (FINAL) ix[q][j] = en.y; k[q][j] = v ? okey(__uint_as_float(en.x)) : 0u; }
    unsigned lo[4], hx[4]; int clo[4];
#pragma unroll
    for (int q = 0; q < 4; ++q) { unsigned mn = 0xffffffffu, mxv = 0u;
#pragma unroll
        for (int j = 0; j < NE; ++j) { mxv = max(mxv, k[q][j]); mn = min(mn, k[q][j] ? k[q][j] : 0xffffffffu); }
        lo[q] = wave_umin(mn); hx[q] = wave_umax(mxv) + 1u; clo[q] = n[q]; }
    const int accept = FINAL ? 256 : KEEP_MAX;
    for (int it = 0; it < 40; ++it) {
        unsigned mid[4]; int c[4]; bool any = false;
#pragma unroll
        for (int q = 0; q < 4; ++q) mid[q] = lo[q] + ((hx[q] - lo[q]) >> 1);
        {
            unsigned v = 0;
#pragma unroll
            for (int q = 0; q < 4; ++q) { unsigned cl = 0;
#pragma unroll
                for (int j = 0; j < NE; ++j) cl += (k[q][j] >= mid[q]) ? 1u : 0u;
                v |= cl << (8 * q); }
            v += (unsigned)__builtin_amdgcn_update_dpp(0, (int)v, 0xB1, 0xf, 0xf, false); v += (unsigned)__builtin_amdgcn_update_dpp(0, (int)v, 0x4E, 0xf, 0xf, false);
            v += (unsigned)__builtin_amdgcn_update_dpp(0, (int)v, 0x141, 0xf, 0xf, false); v += (unsigned)__builtin_amdgcn_update_dpp(0, (int)v, 0x140, 0xf, 0xf, false);
            unsigned ev = 0, od = 0;
#pragma unroll
            for (int r = 0; r < 4; ++r) { const unsigned x = (unsigned)__builtin_amdgcn_readlane((int)v, 16 * r); ev += x & 0x00ff00ffu; od += (x >> 8) & 0x00ff00ffu; }
            c[0] = (int)(ev & 0xffffu); c[2] = (int)(ev >> 16); c[1] = (int)(od & 0xffffu); c[3] = (int)(od >> 16);
        }
#pragma unroll
        for (int q = 0; q < 4; ++q) { const bool upd = (clo[q] > accept) && (hx[q] - lo[q] > 1u), ge = c[q] >= 256;
            lo[q] = (upd && ge) ? mid[q] : lo[q]; clo[q] = (upd && ge) ? c[q] : clo[q]; hx[q] = (upd && !ge) ? mid[q] : hx[q]; any = any || upd; }
        if (!any) break;
    }
#pragma unroll
    for (int q = 0; q < 4; ++q) {
        const unsigned Tk = lo[q];
        const bool ties = FINAL ? (clo[q] != 256) : (clo[q] > accept);
        int running = 0;
        if (!ties) {
#pragma unroll
            for (int j = 0; j < NE; ++j) {
                const bool take = k[q][j] >= Tk;
                const unsigned long long mt = __ballot(take);
                const int pos = running + prefix64(mt);
                if (FINAL) { LAS unsigned short* dst = take ? sel_out + q * 256 + pos : (LAS unsigned short*)trash + lane; *dst = (unsigned short)ix[q][j]; }
                else { const unsigned ixr = cb[(size_t)q * CAP + (lane + 64 * j < CAP ? lane + 64 * j : 0)].y; LAS u32x2* dst = take ? cb + (size_t)q * CAP + pos : trash + lane; *dst = (u32x2){__float_as_uint(ikey(k[q][j])), ixr}; }
                running += __popcll(mt);
            }
        } else {
            unsigned cg = 0, ixq[NE];
#pragma unroll
            for (int j = 0; j < NE; ++j) { cg += (k[q][j] > Tk) ? 1u : 0u; ixq[j] = FINAL ? ix[q][FINAL ? j : 0] : cb[(size_t)q * CAP + (lane + 64 * j < CAP ? lane + 64 * j : 0)].y; }
            const int r_eq = 256 - (int)wave_usum(cg); int eqrun = 0;
#pragma unroll
            for (int j = 0; j < NE; ++j) {
                const bool gt = k[q][j] > Tk, eq = (k[q][j] == Tk);
                const unsigned long long meq = __ballot(eq);
                const bool take = gt || (eq && (eqrun + prefix64(meq)) < r_eq);
                const unsigned long long mt = __ballot(take);
                const int pos = running + prefix64(mt);
                if (FINAL) { LAS unsigned short* dst = (take && pos < 256) ? sel_out + q * 256 + pos : (LAS unsigned short*)trash + lane; *dst = (unsigned short)ixq[j]; }
                else { LAS u32x2* dst = take ? cb + (size_t)q * CAP + pos : trash + lane; *dst = (u32x2){__float_as_uint(ikey(k[q][j])), ixq[j]}; }
                running += __popcll(mt); eqrun += __popcll(meq);
            }
        }
        tk[q] = Tk; n[q] = running;
    }
}
struct AttnArgs { const bf16* QA; const bf16* KA; const bf16* VA; const int* positions; bf16* OA; };
__device__ __forceinline__ void unit(int b, int g, const bf16* QI, const bf16* KI, const float* WI, const AttnArgs& AA, LAS unsigned char* lds, int variant) {
    const int q0 = g * 32, L = 64 * (q0 / 64 + 1);
    const int tid = threadIdx.x, lane = tid & 63, c = lane & 31, hi = lane >> 5; const int wid = __builtin_amdgcn_readfirstlane(tid >> 6);
    const size_t rowbase = (size_t)b * T; const int ntile = L / 64;
    LAS unsigned char* wreg = lds + L_CAND + (size_t)wid * (4 * CAP * 8);
    LAS unsigned short* selT = (LAS unsigned short*)wreg;
    if (L > 256) {
    bf16x8 Af[4];
    { const int r = c, jq = ((r >> 2) & 1) + 2 * (r >> 4), hd = (r & 3) + 4 * ((r >> 3) & 1);
      const bf16* qp = QI + (rowbase + q0 + 4 * wid + jq) * 512 + hd * 64 + 8 * hi;
#pragma unroll
      for (int s = 0; s < 4; ++s) Af[s] = *(const bf16x8*)(qp + 16 * s); }
    float wv[2][8];
#pragma unroll
    for (int u = 0; u < 2; ++u) { const float* wp = WI + (rowbase + q0 + 4 * wid + hi + 2 * u) * 8; const f32x4 a = *(const f32x4*)wp, bq = *(const f32x4*)(wp + 4);
#pragma unroll
        for (int i = 0; i < 4; ++i) { wv[u][i] = a[i] * (0.125f * 0.35355339059327373f); wv[u][4 + i] = bq[i] * (0.125f * 0.35355339059327373f); } }
    float tau[2] = {-INFINITY, -INFINITY}; int cnt[2] = {0, 0};
    LAS u32x2* cbase = (LAS u32x2*)(lds + L_CAND) + (size_t)(wid * 4) * CAP;
    LAS u32x2* trash = (LAS u32x2*)(lds + L_TRASH) + wid * 64;
    const bf16* kp = KI + (rowbase >> 5) * 2048 + (size_t)lane * 8;
    bf16x8 Ba[8], Bb[8];
#define IDX_LOAD(dst, tt) do { _Pragma("unroll") for (int i_ = 0; i_ < 8; ++i_) dst[i_] = *(const bf16x8*)(kp + (size_t)((2 * (tt) + (i_ >> 2)) * 4 + (i_ & 3)) * 512); } while (0)
#define IDX_TILE(Bf, tt) do { \
        f32x16 acc0, acc1; \
        _Pragma("unroll") for (int r_ = 0; r_ < 16; ++r_) { acc0[r_] = 0.f; acc1[r_] = 0.f; } \
        _Pragma("unroll") for (int s4 = 0; s4 < 4; ++s4) { acc0 = __builtin_amdgcn_mfma_f32_32x32x16_bf16(Af[s4], Bf[s4], acc0, 0, 0, 0); acc1 = __builtin_amdgcn_mfma_f32_32x32x16_bf16(Af[s4], Bf[4 + s4], acc1, 0, 0, 0); } \
        float sv[2][2]; \
        _Pragma("unroll") for (int u = 0; u < 2; ++u) { float a_ = 0.f, b_ = 0.f; \
            _Pragma("unroll") for (int i = 0; i < 8; ++i) { a_ = fmaf(__builtin_amdgcn_fmed3f(acc0[8 * u + i], 0.f, 3.0e38f), wv[u][i], a_); b_ = fmaf(__builtin_amdgcn_fmed3f(acc1[8 * u + i], 0.f, 3.0e38f), wv[u][i], b_); } \
            sv[u][0] = a_; sv[u][1] = b_; } \
        bool ps[2][2]; unsigned long long mk[2][2]; \
        _Pragma("unroll") for (int u = 0; u < 2; ++u) _Pragma("unroll") for (int kh = 0; kh < 2; ++kh) { ps[u][kh] = (sv[u][kh] > tau[u]) && !(variant & 2); mk[u][kh] = __ballot(ps[u][kh]); } \
        if ((mk[0][0] | mk[0][1] | mk[1][0] | mk[1][1]) != 0ull) { \
            _Pragma("unroll") for (int u = 0; u < 2; ++u) _Pragma("unroll") for (int kh = 0; kh < 2; ++kh) { \
                const unsigned mlo = (unsigned)mk[u][kh], mhi = (unsigned)(mk[u][kh] >> 32); \
                const int pre = (int)__builtin_amdgcn_mbcnt_hi(mhi, __builtin_amdgcn_mbcnt_lo(mlo, 0u)) - (hi ? __popc(mlo) : 0);     \
                LAS u32x2* dst = ps[u][kh] ? cbase + (size_t)(hi + 2 * u) * CAP + cnt[u] + pre : trash + lane; \
                *dst = (u32x2){__float_as_uint(sv[u][kh]), (unsigned)((tt) * 64 + kh * 32 + c)}; \
                cnt[u] += hi ? __popc(mhi) : __popc(mlo); } } \
    } while (0)
    IDX_LOAD(Ba, 0); IDX_LOAD(Bb, 1);
    for (int t = 0; t < ntile; t += 2) {
#define IDX_CHECK() do { const int n0 = __builtin_amdgcn_readlane(cnt[0], 0), n1 = __builtin_amdgcn_readlane(cnt[0], 32), n2 = __builtin_amdgcn_readlane(cnt[1], 0), n3 = __builtin_amdgcn_readlane(cnt[1], 32); \
          if (max(max(n0, n1), max(n2, n3)) > TRIG && !(variant & 1)) { int n4[4] = {n0, n1, n2, n3}; unsigned tk4[4]; \
            PROF_T0(1); select4<false>(cbase, n4, tk4, lane, (LAS unsigned short*)nullptr, trash); PROF_T1(1, lds, wid, lane); \
            cnt[0] = hi ? n4[1] : n4[0]; cnt[1] = hi ? n4[3] : n4[2]; tau[0] = ikey(hi ? tk4[1] : tk4[0]); tau[1] = ikey(hi ? tk4[3] : tk4[2]); } } while (0)
        IDX_CHECK();
        IDX_TILE(Ba, t);
        if (t + 2 < ntile) IDX_LOAD(Ba, t + 2);
        if (t + 1 < ntile) { IDX_CHECK(); IDX_TILE(Bb, t + 1); if (t + 3 < ntile) IDX_LOAD(Bb, t + 3); }
    }
#undef IDX_LOAD
#undef IDX_TILE
#undef IDX_CHECK
    asm volatile("s_waitcnt lgkmcnt(0)" ::: "memory");
    if (!(variant & 9)) { int n4[4] = {__builtin_amdgcn_readlane(cnt[0], 0), __builtin_amdgcn_readlane(cnt[0], 32), __builtin_amdgcn_readlane(cnt[1], 0), __builtin_amdgcn_readlane(cnt[1], 32)}; unsigned tk4[4];
      PROF_T0(2); select4<true>(cbase, n4, tk4, lane, selT, trash); PROF_T1(2, lds, wid, lane); }
    } else {
#pragma unroll
        for (int jq = 0; jq < 4; ++jq)
#pragma unroll
            for (int j = 0; j < 4; ++j) { const int k = lane + 64 * j; selT[jq * 256 + k] = (unsigned short)(k < L ? k : L - 1); }
    }
    asm volatile("s_waitcnt lgkmcnt(0)" ::: "memory");
    PROF_T0(8);
    for (int jq = 0; jq < 4; ++jq)
        dsa::query((int)(rowbase + q0 + 4 * wid + jq), AA.QA, AA.KA, AA.VA, AA.positions, AA.OA, wreg + 2048, selT + jq * 256, (LAS unsigned char*)((LAS u32x2*)(lds + L_TRASH) + wid * 64), (const LAS float*)(lds + L_BIAS), lane);
    PROF_T1(8, lds, wid, lane);
}
__device__ __forceinline__ void phase(int vcu, int G, const bf16* QI, const bf16* KI, const float* WI, const AttnArgs& AA, const float* rel_bias, LAS unsigned char* lds, int variant) {
    { LAS float* bt = (LAS float*)(lds + L_BIAS); for (int i = threadIdx.x; i < 33 * 8; i += NWAVES * 64) bt[i] = (i < 256) ? rel_bias[i] * dsa::LOG2E : -INFINITY; }
    __syncthreads();
    PROF_T0(7);
    const int wrot = 0, nun = (1024 - vcu + G - 1) / G;
    for (int ii = 0; ii < nun; ++ii) { const int u = vcu + ((ii + wrot) % nun) * G; const int i = u >> 8, v = u & 255, b = v >> 6, s = v & 63;
        const int g = (i == 0) ? s : (i == 1) ? 127 - s : (i == 2) ? 128 + s : 255 - s;
        unit(b, g, QI, KI, WI, AA, lds, variant); }
    PROF_T1(7, lds, (int)__builtin_amdgcn_readfirstlane(threadIdx.x >> 6), (int)(threadIdx.x & 63));
    __syncthreads();
}
}


struct PhaseTimer { unsigned long long t0; int k; LAS unsigned char* l; int w, ln; bool once;
    __device__ __forceinline__ PhaseTimer(int k_, LAS unsigned char* l_, int w_, int ln_) : t0(0), k(k_), l(l_), w(w_), ln(ln_), once(true) { if (PROF_SEL == 20 + k) t0 = __builtin_amdgcn_s_memrealtime(); }
    __device__ __forceinline__ void stop() { once = false; if (PROF_SEL == 20 + k) { const unsigned d = (unsigned)(__builtin_amdgcn_s_memrealtime() - t0); if (ln == 0) *PROF_WORD(l, w) += d; } } };
constexpr int NPHASE = 16;
__global__ void __launch_bounds__(NWAVES * 64, 2) mk_fwd(Args args) {
    extern __shared__ __attribute__((aligned(16))) unsigned char lds[];
    Frame F;
    F.lds = (LAS unsigned char*)lds;
    F.MISC = (volatile LAS unsigned*)(F.lds + MISC_OFF);
    F.tid = threadIdx.x; F.lane = F.tid & 63; F.wave = __builtin_amdgcn_readfirstlane(F.tid >> 6);
    F.G = gridDim.x; { const int bx = blockIdx.x; F.vcu = (F.G % 8 == 0) ? (bx % 8) * (F.G / 8) + bx / 8 : bx; }
    unsigned char* ws = args.ws;
    F.ctl = (gu32*)(ws + WS_CTL);
    for (int u = F.tid; u < (LDS_BYTES - LDSCTL_OFF) / 4; u += NWAVES * 64) ((LAS unsigned*)(F.lds + LDSCTL_OFF))[u] = 0u;
    __syncthreads();
    XcdBarrier bar; bar.bar = (unsigned*)(F.ctl + CW_BAR); bar.x = 0; bar.st = nullptr;
    if (MK_FUSED) bar = xcd_barrier_post((unsigned*)(F.ctl + CW_BAR), F.MISC + 8);
#define GRID_BAR() do { if (MK_FUSED) { PROF_T0(50); xcd_barrier(bar); PROF_T1(50, F.lds + RING_OFF, F.wave, F.lane); } } while (0)
    const int lo = args.ph_lo, hi = args.ph_hi;
#ifdef ONLY_PH
#define IN(k) ((k) == ONLY_PH && lo <= (k) && (k) < hi)
#else
#define IN(k) (lo <= (k) && (k) < hi)
#endif
#define BOTH(k) (IN(k) && IN((k) + 1))
#ifndef DUP_PH
#define DUP_PH -1
#endif
#ifndef P7_VARIANT
#define P7_VARIANT 0
#endif
#define PHASE_TIMED(k) for (PhaseTimer pt_((k), F.lds + RING_OFF, F.wave, F.lane); pt_.once; pt_.stop())
#define REP(k) for (int rep_ = 0; rep_ < ((k) == DUP_PH ? 2 : 1); ++rep_)
    const float* x = (const float*)args.in[0];
    const float* mod = (const float*)(ws + WS_MOD);
    bf16* XN = (bf16*)(ws + WS_XN); bf16* ACT = (bf16*)(ws + WS_ACT);
    float* X1 = args.out;
    const float* rcos = (const float*)(ws + WS_RCOS); const float* rsin = (const float*)(ws + WS_RSIN);
    float* ssq_q = (float*)(ws + WS_SSQQ); float* ssq_kv = (float*)(ws + WS_SSQKV);

    if (IN(0)) REP(0) PHASE_TIMED(0) { p0_prologue(F, args); if (BOTH(0)) GRID_BAR(); }
    if (IN(1)) REP(1) PHASE_TIMED(1) { norm_mod_phase(F, x, (const float*)args.in[5], mod, 0 * D, 1 * D, XN); if (BOTH(1)) GRID_BAR(); }
    if (IN(2)) REP(2) PHASE_TIMED(2) {
        pg8::Gemm g{XN, (const bf16*)(ws + WS_W1A), M, 2 * DFF, D}; pg8::StaticOrder S; S.init(M, 2 * DFF, F.G, (int)blockIdx.x);
        pg8::EpiSwiglu E{ACT, DFF};
        pg8::gemm_phase<pg8::EpiSwiglu, pg8::StaticOrder, true, true>(F.lds + RING_OFF, g, S, E);
        if (BOTH(2)) GRID_BAR(); }
    if (IN(3)) REP(3) PHASE_TIMED(3) {
        pg8::Gemm g{ACT, (const bf16*)(ws + WS_W1D), M, D, DFF}; pg8::StaticOrder S; S.init(M, D, F.G, (int)blockIdx.x);
        pg8::EpiResid E{x, X1, mod, 2 * D, 0.5f};
        pg8::gemm_phase<pg8::EpiResid, pg8::StaticOrder, true, true>(F.lds + RING_OFF, g, S, E);
        if (BOTH(3)) GRID_BAR(); }
    if (IN(4)) REP(4) PHASE_TIMED(4) { norm_mod_phase(F, X1, (const float*)args.in[8], mod, 3 * D, 4 * D, XN); if (BOTH(4)) GRID_BAR(); }
    if (IN(5)) REP(5) PHASE_TIMED(5) {
        pg8::Gemm g{XN, (const bf16*)(ws + WS_WIN), M, NPROJ, D}; pg8::StaticOrder S; S.init(M, NPROJ, F.G, (int)blockIdx.x);
        pg8::EpiProj E{(bf16*)(ws + WS_QA), (bf16*)(ws + WS_QI), (bf16*)(ws + WS_CQ), (bf16*)(ws + WS_CKV), (bf16*)(ws + WS_KA), (bf16*)(ws + WS_VA), (bf16*)(ws + WS_KI), (bf16*)(ws + WS_KPE), (bf16*)(ws + WS_G),
                       (float*)(ws + WS_WI), ssq_q, ssq_kv, rcos, rsin};
        pg8::gemm_phase<pg8::EpiProj, pg8::StaticOrder, true, true>(F.lds + RING_OFF, g, S, E);
        if (BOTH(5)) GRID_BAR(); }
    if (IN(6)) REP(6) PHASE_TIMED(6) {
        { pg8::Gemm g{(const bf16*)(ws + WS_CQ), (const bf16*)(ws + WS_WUQ), M, 768, 384}; pg8::StaticOrder S; S.init(M, 768, F.G, (int)blockIdx.x);
          pg8::EpiUpQ E{(bf16*)(ws + WS_QB), ssq_q, rcos, rsin};
          pg8::gemm_phase<pg8::EpiUpQ, pg8::StaticOrder, true, true>(F.lds + RING_OFF, g, S, E); }
        __syncthreads();
        { pg8::Gemm g{(const bf16*)(ws + WS_CKV), (const bf16*)(ws + WS_WUKV), M, 1024, 256}; pg8::StaticOrder S; S.init(M, 1024, F.G, (int)blockIdx.x);
          pg8::EpiUpKV E{(bf16*)(ws + WS_KN), (bf16*)(ws + WS_VB), ssq_kv};
          pg8::gemm_phase<pg8::EpiUpKV, pg8::StaticOrder, true, true>(F.lds + RING_OFF, g, S, E); }
        __syncthreads(); }
    if (IN(7)) REP(7) PHASE_TIMED(7) { const idx::AttnArgs AA{(const bf16*)(ws + WS_QA), (const bf16*)(ws + WS_KA), (const bf16*)(ws + WS_VA), (const int*)args.in[2], (bf16*)(ws + WS_OA)};
        idx::phase(F.vcu, F.G, (const bf16*)(ws + WS_QI), (const bf16*)(ws + WS_KI), (const float*)(ws + WS_WI), AA, (const float*)args.in[15], F.lds + RING_OFF, args.pad); if (BOTH(7)) GRID_BAR(); }
    if (IN(9)) REP(9) PHASE_TIMED(9) { mla::phase(F.vcu, F.G, (const bf16*)(ws + WS_QB), (const bf16*)(ws + WS_KN), (const bf16*)(ws + WS_KPE), (const bf16*)(ws + WS_VB), (bf16*)(ws + WS_OB), F.lds + RING_OFF); if (BOTH(9)) GRID_BAR(); }
    if (IN(10)) REP(10) PHASE_TIMED(10) {
        { pg8::Gemm g{(const bf16*)(ws + WS_OA), (const bf16*)(ws + WS_WOA), M, D, 512}; pg8::StaticOrder S; S.init(M, D, F.G, (int)blockIdx.x);
          pg8::EpiGate<false> E{(const bf16*)(ws + WS_G), 0, nullptr, (bf16*)(ws + WS_Y1)};
          pg8::gemm_phase<pg8::EpiGate<false>, pg8::StaticOrder, true, true>(F.lds + RING_OFF, g, S, E); }
        VM_WAIT(); __syncthreads();
        { pg8::Gemm g{(const bf16*)(ws + WS_OB), (const bf16*)(ws + WS_WOB), M, D, 512}; pg8::StaticOrder S; S.init(M, D, F.G, (int)blockIdx.x);
          pg8::EpiGate<true> E{(const bf16*)(ws + WS_G), 1024, (const bf16*)(ws + WS_Y1), (bf16*)(ws + WS_Y)};
          pg8::gemm_phase<pg8::EpiGate<true>, pg8::StaticOrder, true, true>(F.lds + RING_OFF, g, S, E); }
        if (BOTH(10)) GRID_BAR(); }
    if (IN(11)) PHASE_TIMED(11) {
        pg8::Gemm g{(const bf16*)(ws + WS_Y), (const bf16*)(ws + WS_WOUT), M, D, D}; pg8::StaticOrder S; S.init(M, D, F.G, (int)blockIdx.x);
        pg8::EpiResid E{X1, X1, mod, 5 * D, 1.0f};
        pg8::gemm_phase<pg8::EpiResid, pg8::StaticOrder, true, true>(F.lds + RING_OFF, g, S, E);
        if (BOTH(11)) GRID_BAR(); }
    if (IN(12)) REP(12) PHASE_TIMED(12) { norm_mod_phase(F, X1, (const float*)args.in[19], mod, 6 * D, 7 * D, XN); if (BOTH(12)) GRID_BAR(); }
    if (IN(13)) REP(13) PHASE_TIMED(13) {
        pg8::Gemm g{XN, (const bf16*)(ws + WS_W2A), M, 2 * DFF, D}; pg8::StaticOrder S; S.init(M, 2 * DFF, F.G, (int)blockIdx.x);
        pg8::EpiSwiglu E{ACT, DFF};
        pg8::gemm_phase<pg8::EpiSwiglu, pg8::StaticOrder, true, true>(F.lds + RING_OFF, g, S, E);
        if (BOTH(13)) GRID_BAR(); }
    if (IN(14)) PHASE_TIMED(14) {
        pg8::Gemm g{ACT, (const bf16*)(ws + WS_W2D), M, D, DFF}; pg8::StaticOrder S; S.init(M, D, F.G, (int)blockIdx.x);
        pg8::EpiResid E{X1, X1, mod, 8 * D, 0.5f};
        pg8::gemm_phase<pg8::EpiResid, pg8::StaticOrder, true, true>(F.lds + RING_OFF, g, S, E);
        if (BOTH(14)) GRID_BAR(); }
    if (IN(15)) PHASE_TIMED(15) { final_norm_phase(F, X1, (const float*)args.in[22], args.out); }
    if (PROF_SEL != 0) { asm volatile("s_waitcnt lgkmcnt(0)" ::: "memory"); const unsigned a_ = *PROF_WORD(F.lds + RING_OFF, F.wave); const unsigned long long t0_ = __builtin_amdgcn_s_memrealtime();
        while (__builtin_amdgcn_s_memrealtime() - t0_ < (unsigned long long)a_ * PROF_MULT) __builtin_amdgcn_s_sleep(32); }
#undef IN
#undef BOTH
}

extern "C" void kernel_launch(void* const* d_in, const int* in_sizes, int n_in, void* d_out, int out_size, void* d_ws, size_t ws_size, hipStream_t stream) {
    static int grid = 0;
    if (grid == 0) {
        if (n_in != 23 || out_size != M * D || ws_size < WS_END + 4096) { fprintf(stderr, "kernel_launch: unexpected problem shape (n_in %d, out %d, ws %zu)\n", n_in, out_size, ws_size); grid = -1; return; }
        int dev = 0, cus = 0, per_cu = 0;
        if (hipGetDevice(&dev) != hipSuccess || hipDeviceGetAttribute(&cus, hipDeviceAttributeMultiprocessorCount, dev) != hipSuccess) { grid = -1; return; }
        if (hipFuncSetAttribute((const void*)mk_fwd, hipFuncAttributeMaxDynamicSharedMemorySize, LDS_BYTES) != hipSuccess) { fprintf(stderr, "kernel_launch: hipFuncSetAttribute failed\n"); grid = -1; return; }
        if (hipOccupancyMaxActiveBlocksPerMultiprocessor(&per_cu, (const void*)mk_fwd, NWAVES * 64, LDS_BYTES) != hipSuccess || per_cu < 1) fprintf(stderr, "kernel_launch: occupancy query reports %d\n", per_cu);
        (void)hipGetLastError();
        grid = cus;
    }
    if (grid < 0) return;
    (void)in_sizes;
    if (hipMemsetAsync((char*)d_ws + WS_CTL, 0, CTL_ZERO_BYTES, stream) != hipSuccess) return;
    Args a{};
    for (int i = 0; i < 23; ++i) a.in[i] = d_in[i];
    a.out = (float*)d_out; a.ws = (unsigned char*)d_ws;
    auto launch = [&](int lo, int hi) { a.ph_lo = lo; a.ph_hi = hi; a.li = 0; hipLaunchKernelGGL(mk_fwd, dim3(grid), dim3(NWAVES * 64), LDS_BYTES, stream, a); };
#if MK_FUSED
    launch(0, NPHASE);
#else
    for (int p = 0; p < NPHASE; ++p) launch(p, p + 1);
#endif
}
```

```cpp
#include <hip/hip_runtime.h>
#include <cstdio>
#include <cstdint>
namespace pg8 {
#define PG8_LAS __attribute__((address_space(3)))
typedef unsigned short bf16_t;
typedef short bf16x8 __attribute__((ext_vector_type(8)));
typedef float f32x4 __attribute__((ext_vector_type(4)));
typedef unsigned u32x4 __attribute__((ext_vector_type(4)));
constexpr int BM = 256, BK = 64, HALF = 128, HTB = HALF * BK * 2  , STAGE_BYTES = 8 * HTB, NXCD = 8, WGM = 8;

__host__ __device__ __forceinline__ int lds_byte(int r, int c) { const int st = (r >> 4) * 2 + (c >> 5), rr = r & 15, cc = c & 31, ob = rr * 64 + cc * 2; return st * 1024 + (ob ^ (((ob >> 9) & 1) << 5)); }
__host__ __device__ __forceinline__ void stage_rc(int b, int& R, int& C) { const int st = b / 1024, sb = b % 1024, swz = sb ^ (((sb >> 9) & 1) << 5); R = (st >> 1) * 16 + swz / 64; C = (st & 1) * 32 + (swz % 64) / 2; }
__host__ __device__ __forceinline__ int perm32(int rho) { const int n = rho >> 4, i = rho & 15; return 8 * (i >> 2) + 4 * n + (i & 3); }

struct Unit { int pm, pn; };
struct Gemm { const bf16_t* A; const bf16_t* Bt; int M, N, K; };

struct StaticOrder {
    int nM, nN, nwg, G, c;
    __host__ __device__ void init(int M, int N, int G_, int c_) { nM = M / BM; nN = N / BM; nwg = nM * nN; G = G_; c = c_; }
    __host__ __device__ bool next(int i, Unit& u) const {
        const long L = (long)i * G + c; if (L >= nwg) return false;
        int wgid = (int)L; { const int q = nwg / NXCD, r = nwg % NXCD, xcd = wgid % NXCD, off = wgid / NXCD; wgid = (xcd < r ? xcd * (q + 1) : r * (q + 1) + (xcd - r) * q) + off; }
        const int nig = WGM * nN, gid = wgid / nig, fm = gid * WGM, gsz = (nM - fm) < WGM ? (nM - fm) : WGM;
        u.pm = fm + ((wgid % nig) % gsz); u.pn = (wgid % nig) / gsz; return true;
    }
    __device__ __forceinline__ void a_ready(const Unit&) const {}
    __device__ __forceinline__ void done(const Unit&) const {}
};

typedef float f32x2 __attribute__((ext_vector_type(2)));
typedef __bf16 bf16x2_cv __attribute__((ext_vector_type(2)));
__device__ __forceinline__ unsigned cvt_pk_bf16(float lo, float hi) { const f32x2 v = {lo, hi}; const bf16x2_cv b = __builtin_convertvector(v, bf16x2_cv); return __builtin_bit_cast(unsigned, b); }

__device__ __forceinline__ u32x4 pack8(const f32x4 a, const f32x4 b) { u32x4 w; w.x = cvt_pk_bf16(a[0], a[1]); w.y = cvt_pk_bf16(a[2], a[3]); w.z = cvt_pk_bf16(b[0], b[1]); w.w = cvt_pk_bf16(b[2], b[3]); return w; }
__device__ __forceinline__ float sigm(float v) { return __builtin_amdgcn_rcpf(1.f + __builtin_amdgcn_exp2f(-1.4426950408889634f * v)); }
__device__ __forceinline__ f32x4 sigm4(const f32x4 v) { return (f32x4){sigm(v[0]), sigm(v[1]), sigm(v[2]), sigm(v[3])}; }
__device__ __forceinline__ void unpack8(const u32x4 w, f32x4& a, f32x4& b) {
    a = (f32x4){__uint_as_float(w.x << 16), __uint_as_float(w.x & 0xffff0000u), __uint_as_float(w.y << 16), __uint_as_float(w.y & 0xffff0000u)};
    b = (f32x4){__uint_as_float(w.z << 16), __uint_as_float(w.z & 0xffff0000u), __uint_as_float(w.w << 16), __uint_as_float(w.w & 0xffff0000u)}; }
constexpr float EPS_RMS = 1e-6f;
constexpr float QSCALE = 0.10206207261596575f * 1.4426950408889634f;

struct EpiSwiglu {
    static constexpr bool PERM = true, AFTER_DRAIN = false;
    bf16_t* O; int ldc;
    __device__ __forceinline__ void operator()(const f32x4 (&acc)[2][2][4][2], const Unit& u, int wr, int wc, int fr, int fq) const {
        const int row0 = u.pm * BM + wr * 64 + fr, col0 = u.pn * HALF + wc * 32 + 8 * fq;
#pragma unroll
        for (int ai = 0; ai < 2; ++ai)
#pragma unroll
            for (int m = 0; m < 4; ++m) {
                const f32x4 g0 = acc[ai][0][m][0], g1 = acc[ai][0][m][1], u0 = acc[ai][1][m][0], u1 = acc[ai][1][m][1];
                const f32x4 v0 = g0 * sigm4(g0) * u0, v1 = g1 * sigm4(g1) * u1;
                *(u32x4*)(O + (size_t)(row0 + ai * HALF + m * 16) * ldc + col0) = pack8(v0, v1); }
    }
};
struct EpiResid {
    static constexpr bool PERM = false, AFTER_DRAIN = false;
    const float* base; float* out; const float* mod; int goff; float scale;
    __device__ __forceinline__ void operator()(const f32x4 (&acc)[2][2][4][2], const Unit& u, int wr, int wc, int fr, int fq) const {
        const float* gate = mod + (u.pm >> 5) * 9216 + goff;
        const int col0 = u.pn * BM + wc * 32 + 4 * fq;
        f32x4 gv[2][2];
#pragma unroll
        for (int bj = 0; bj < 2; ++bj)
#pragma unroll
            for (int n = 0; n < 2; ++n) gv[bj][n] = *(const f32x4*)(gate + col0 + bj * HALF + n * 16) * scale;
#pragma unroll
        for (int ai = 0; ai < 2; ++ai)
#pragma unroll
            for (int m = 0; m < 4; ++m) { const size_t off = (size_t)(u.pm * BM + ai * HALF + wr * 64 + m * 16 + fr) * 1024 + col0;
#pragma unroll
                for (int bj = 0; bj < 2; ++bj)
#pragma unroll
                    for (int n = 0; n < 2; ++n) { const f32x4 bs = *(const f32x4*)(base + off + bj * HALF + n * 16); *(f32x4*)(out + off + bj * HALF + n * 16) = bs + gv[bj][n] * acc[ai][bj][m][n]; } }
    }
};
struct EpiProj {
    static constexpr bool PERM = true, AFTER_DRAIN = false;
    bf16_t *QA, *QI, *CQ, *CKV, *KA, *VA, *KI, *KPE, *G; float *WI, *ssq_q, *ssq_kv; const float *rcos, *rsin;
    __device__ __forceinline__ void operator()(const f32x4 (&acc)[2][2][4][2], const Unit& u, int wr, int wc, int fr, int fq) const {
        const int row0 = u.pm * BM + wr * 64 + fr, pn = u.pn, c32 = wc * 32 + 8 * fq;
#pragma unroll
        for (int ai = 0; ai < 2; ++ai)
#pragma unroll
            for (int m = 0; m < 4; ++m) {
                const size_t r = (size_t)(row0 + ai * HALF + m * 16);
                const f32x4 a0 = acc[ai][0][m][0], a1 = acc[ai][0][m][1], b0 = acc[ai][1][m][0], b1 = acc[ai][1][m][1];
                const float sa = (a0[0] * a0[0] + a0[1] * a0[1]) + (a0[2] * a0[2] + a0[3] * a0[3]) + (a1[0] * a1[0] + a1[1] * a1[1]) + (a1[2] * a1[2] + a1[3] * a1[3]);
                const float sb = (b0[0] * b0[0] + b0[1] * b0[1]) + (b0[2] * b0[2] + b0[3] * b0[3]) + (b1[0] * b1[0] + b1[1] * b1[1]) + (b1[2] * b1[2] + b1[3] * b1[3]);
                if (pn < 2) { bf16_t* p = QA + r * 512 + pn * 256 + c32; *(u32x4*)p = pack8(a0, a1); *(u32x4*)(p + HALF) = pack8(b0, b1); }
                else if (pn < 4) { bf16_t* p = QI + r * 512 + (pn - 2) * 256 + c32; *(u32x4*)p = pack8(a0, a1); *(u32x4*)(p + HALF) = pack8(b0, b1); }
                else if (pn == 4) { bf16_t* p = CQ + r * 384 + c32; *(u32x4*)p = pack8(a0, a1); *(u32x4*)(p + HALF) = pack8(b0, b1);
                    float s = sa + sb; s += __shfl_xor(s, 16); s += __shfl_xor(s, 32); if (fq == 0) ssq_q[r * 8 + wc] = s; }
                else if (pn == 5) { *(u32x4*)(CQ + r * 384 + 256 + c32) = pack8(a0, a1); *(u32x4*)(CKV + r * 256 + c32) = pack8(b0, b1);
                    float s = sa; s += __shfl_xor(s, 16); s += __shfl_xor(s, 32); float t = sb; t += __shfl_xor(t, 16); t += __shfl_xor(t, 32);
                    if (fq == 0) { ssq_q[r * 8 + 4 + wc] = s; ssq_kv[r * 8 + wc] = t; } }
                else if (pn == 6) { *(u32x4*)(CKV + r * 256 + 128 + c32) = pack8(a0, a1);
                    float s = sa; s += __shfl_xor(s, 16); s += __shfl_xor(s, 32); if (fq == 0) ssq_kv[r * 8 + 4 + wc] = s;
                    if (wc < 2) *(u32x4*)(KA + r * 64 + c32) = pack8(b0, b1); else *(u32x4*)(VA + r * 64 + (c32 - 64)) = pack8(b0, b1); }
                else if (pn == 7) {
                    if (wc < 2) { const int ch = 4 * wc + fq;
                        *(u32x4*)(KI + ((r >> 5) * 4 + (ch >> 1)) * 512 + (ch & 1) * 256 + (r & 31) * 8) = pack8(a0, a1); }
                    else if (wc == 2) {
                        const f32x4 c4 = *(const f32x4*)(rcos + r * 16 + 4 * fq), s4 = *(const f32x4*)(rsin + r * 16 + 4 * fq);
                        const f32x4 o0 = (f32x4){a0[0] * c4[0] - a0[1] * s4[0], a0[1] * c4[0] + a0[0] * s4[0], a0[2] * c4[1] - a0[3] * s4[1], a0[3] * c4[1] + a0[2] * s4[1]};
                        const f32x4 o1 = (f32x4){a1[0] * c4[2] - a1[1] * s4[2], a1[1] * c4[2] + a1[0] * s4[2], a1[2] * c4[3] - a1[3] * s4[3], a1[3] * c4[3] + a1[2] * s4[3]};
                        *(u32x4*)(KPE + r * 32 + 8 * fq) = pack8(o0, o1); }
                    else if (fq == 0) { *(f32x4*)(WI + r * 8) = a0; *(f32x4*)(WI + r * 8 + 4) = a1; }
                }
                else { bf16_t* p = G + r * 2048 + (pn - 8) * 256 + c32; *(u32x4*)p = pack8(sigm4(a0), sigm4(a1)); *(u32x4*)(p + HALF) = pack8(sigm4(b0), sigm4(b1)); }
            }
    }
};
struct EpiUpQ {
    static constexpr bool PERM = true, AFTER_DRAIN = false;
    bf16_t* QB; const float* ssq; const float *rcos, *rsin;
    __device__ __forceinline__ void operator()(const f32x4 (&acc)[2][2][4][2], const Unit& u, int wr, int wc, int fr, int fq) const {
        const int row0 = u.pm * BM + wr * 64 + fr;
#pragma unroll
        for (int ai = 0; ai < 2; ++ai)
#pragma unroll
            for (int m = 0; m < 4; ++m) {
                const size_t r = (size_t)(row0 + ai * HALF + m * 16);
                const f32x4 pa = *(const f32x4*)(ssq + r * 8), pb = *(const f32x4*)(ssq + r * 8 + 4);
                const float rs = __builtin_amdgcn_rsqf((((pa[0] + pa[1]) + (pa[2] + pa[3])) + ((pb[0] + pb[1]) + (pb[2] + pb[3]))) * (1.f / 384.f) + EPS_RMS) * QSCALE;
#pragma unroll
                for (int bj = 0; bj < 2; ++bj) {
                    const int c = u.pn * BM + bj * HALF + wc * 32 + 8 * fq;
                    const bool pe = ((u.pn * 8 + bj * 4 + wc) % 3) == 2;
                    f32x4 v0 = acc[ai][bj][m][0] * rs, v1 = acc[ai][bj][m][1] * rs;
                    if (pe) { const int i0 = 4 * fq;
                        const f32x4 c4 = *(const f32x4*)(rcos + r * 16 + i0), s4 = *(const f32x4*)(rsin + r * 16 + i0);
                        const f32x4 o0 = (f32x4){v0[0] * c4[0] - v0[1] * s4[0], v0[1] * c4[0] + v0[0] * s4[0], v0[2] * c4[1] - v0[3] * s4[1], v0[3] * c4[1] + v0[2] * s4[1]};
                        const f32x4 o1 = (f32x4){v1[0] * c4[2] - v1[1] * s4[2], v1[1] * c4[2] + v1[0] * s4[2], v1[2] * c4[3] - v1[3] * s4[3], v1[3] * c4[3] + v1[2] * s4[3]};
                        v0 = o0; v1 = o1; }
                    *(u32x4*)(QB + r * 768 + c) = pack8(v0, v1); }
                asm volatile("" ::: "memory"); }
    }
};
struct EpiUpKV {
    static constexpr bool PERM = true, AFTER_DRAIN = false;
    bf16_t *KN, *VB; const float* ssq;
    __device__ __forceinline__ void operator()(const f32x4 (&acc)[2][2][4][2], const Unit& u, int wr, int wc, int fr, int fq) const {
        const int row0 = u.pm * BM + wr * 64 + fr; bf16_t* dst = (u.pn < 2) ? KN : VB; const int c0 = (u.pn & 1) * BM + wc * 32 + 8 * fq;
#pragma unroll
        for (int ai = 0; ai < 2; ++ai)
#pragma unroll
            for (int m = 0; m < 4; ++m) {
                const size_t r = (size_t)(row0 + ai * HALF + m * 16);
                const f32x4 pa = *(const f32x4*)(ssq + r * 8), pb = *(const f32x4*)(ssq + r * 8 + 4);
                const float rs = __builtin_amdgcn_rsqf((((pa[0] + pa[1]) + (pa[2] + pa[3])) + ((pb[0] + pb[1]) + (pb[2] + pb[3]))) * (1.f / 256.f) + EPS_RMS);
#pragma unroll
                for (int bj = 0; bj < 2; ++bj) *(u32x4*)(dst + r * 512 + c0 + bj * HALF) = pack8(acc[ai][bj][m][0] * rs, acc[ai][bj][m][1] * rs);
                asm volatile("" ::: "memory"); }
    }
};
template <bool ADD> struct EpiGate {
    static constexpr bool PERM = true, AFTER_DRAIN = false;
    const bf16_t* G; int goff; const bf16_t* Yin; bf16_t* Y;
    __device__ __forceinline__ void operator()(const f32x4 (&acc)[2][2][4][2], const Unit& u, int wr, int wc, int fr, int fq) const {
        const int row0 = u.pm * BM + wr * 64 + fr, c0 = u.pn * BM + wc * 32 + 8 * fq;
#pragma unroll
        for (int ai = 0; ai < 2; ++ai)
#pragma unroll
            for (int m = 0; m < 4; ++m) {
                const size_t r = (size_t)(row0 + ai * HALF + m * 16);
#pragma unroll
                for (int bj = 0; bj < 2; ++bj) { const int c = c0 + bj * HALF;
                    f32x4 g0, g1; unpack8(*(const u32x4*)(G + r * 2048 + goff + c), g0, g1);
                    f32x4 v0 = g0 * acc[ai][bj][m][0], v1 = g1 * acc[ai][bj][m][1];
                    if (ADD) { f32x4 y0, y1; unpack8(*(const u32x4*)(Yin + r * 1024 + c), y0, y1); v0 += y0; v1 += y1; }
                    *(u32x4*)(Y + r * 1024 + c) = pack8(v0, v1); } }
    }
};

template <class Epi, class Sched, bool ALIGN_EPI = false, bool SP2 = false>
__device__ __forceinline__ void gemm_phase(PG8_LAS unsigned char* lds, const Gemm g, const Sched& S, const Epi& E) {
    const int tid = threadIdx.x, wid = __builtin_amdgcn_readfirstlane(tid >> 6), lane = tid & 63, wr = wid >> 2, wc = wid & 3, fr = lane & 15, fq = lane >> 4;
    const int K = g.K, nt = K / BK;
    unsigned voffA[2], voffB[2];
#pragma unroll
    for (int i = 0; i < 2; ++i) { int R, C; stage_rc(tid * 16 + i * 8192, R, C); const int Rb = Epi::PERM ? ((R & ~31) + perm32(R & 31)) : R;
        voffA[i] = (unsigned)(R * K + C) * 2u; voffB[i] = (unsigned)(Rb * K + C) * 2u; }
    const size_t kstep = (size_t)(BK * 2);
    const size_t hstep = (size_t)HALF * K * 2;
    const size_t tstep = 2 * hstep;
    const unsigned ldsw = (unsigned)wid * 1024u;
    const int aoff = lds_byte(wr * 64 + fr, fq * 8), boff = lds_byte(wc * 32 + fr, fq * 8);
#define PG8_SA(b, h) (((b) * 2 + (h)) * HTB)
#define PG8_SB(b, h) ((4 + (b) * 2 + (h)) * HTB)
#define PG8_STAGE(bufoff, gbase, voff) do { _Pragma("unroll") for (int _i = 0; _i < 2; ++_i) \
        __builtin_amdgcn_global_load_lds((const unsigned*)((const char*)(gbase) + (voff)[_i]), (PG8_LAS unsigned*)(lds + (bufoff) + ldsw + _i * 8192), 16, 0, 0); } while (0)
#define PG8_LDA(dst, b, h) do { _Pragma("unroll") for (int m = 0; m < 4; ++m) _Pragma("unroll") for (int k = 0; k < 2; ++k) dst[m][k] = *(const PG8_LAS bf16x8*)(lds + PG8_SA(b, h) + aoff + m * 2048 + k * 1024); } while (0)
#define PG8_LDB(dst, b, h) do { _Pragma("unroll") for (int n = 0; n < 2; ++n) _Pragma("unroll") for (int k = 0; k < 2; ++k) dst[n][k] = *(const PG8_LAS bf16x8*)(lds + PG8_SB(b, h) + boff + n * 2048 + k * 1024); } while (0)
#define PG8_MMA(ai, bj, At, Bt) do { __builtin_amdgcn_s_setprio(1); _Pragma("unroll") for (int m = 0; m < 4; ++m) _Pragma("unroll") for (int n = 0; n < 2; ++n) _Pragma("unroll") for (int k = 0; k < 2; ++k) \
        acc[ai][bj][m][n] = __builtin_amdgcn_mfma_f32_16x16x32_bf16(Bt[n][k], At[m][k], acc[ai][bj][m][n], 0, 0, 0); __builtin_amdgcn_s_setprio(0); } while (0)
#define PG8_WAIT_V(n) asm volatile("s_waitcnt vmcnt(" #n ")" ::: "memory")
#define PG8_WAIT_L(n) asm volatile("s_waitcnt lgkmcnt(" #n ")" ::: "memory")
#define PG8_BAR __builtin_amdgcn_s_barrier()
#define PG8_SCHED __builtin_amdgcn_sched_barrier(0)
    Unit cur, nxt; int ui = 0;
    if (!S.next(0, cur)) return;
    f32x4 acc[2][2][4][2];
#pragma unroll
    for (int a = 0; a < 2; ++a)
#pragma unroll
        for (int b = 0; b < 2; ++b)
#pragma unroll
            for (int m = 0; m < 4; ++m)
#pragma unroll
                for (int n = 0; n < 2; ++n) acc[a][b][m][n] = (f32x4){0.f, 0.f, 0.f, 0.f};
    bf16x8 At[4][2], B0[2][2], B1[2][2];
    const char* cA = (const char*)g.A + (size_t)cur.pm * tstep; const char* cB = (const char*)g.Bt + (size_t)cur.pn * tstep;
    S.a_ready(cur);
    if constexpr (SP2) {
        PG8_STAGE(PG8_SB(0, 0), cB, voffB); PG8_STAGE(PG8_SB(0, 1), cB + hstep, voffB); PG8_STAGE(PG8_SA(0, 0), cA, voffA); PG8_STAGE(PG8_SA(0, 1), cA + hstep, voffA);
        if (wr == 1) PG8_BAR;
        PG8_WAIT_V(2); PG8_BAR;
        PG8_STAGE(PG8_SB(1, 0), cB + kstep, voffB); PG8_STAGE(PG8_SA(1, 0), cA + kstep, voffA); PG8_STAGE(PG8_SB(1, 1), cB + hstep + kstep, voffB);
        PG8_WAIT_V(6); PG8_BAR;
    } else {
        PG8_STAGE(PG8_SB(0, 0), cB, voffB); PG8_STAGE(PG8_SA(0, 0), cA, voffA); PG8_STAGE(PG8_SB(0, 1), cB + hstep, voffB); PG8_STAGE(PG8_SA(0, 1), cA + hstep, voffA);
        if (wr == 1) PG8_BAR;
        PG8_WAIT_V(4); PG8_BAR;
        PG8_STAGE(PG8_SB(1, 0), cB + kstep, voffB); PG8_STAGE(PG8_SA(1, 0), cA + kstep, voffA); PG8_STAGE(PG8_SB(1, 1), cB + hstep + kstep, voffB);
        PG8_WAIT_V(6); PG8_BAR;
    }
    for (;;) {
        const bool has_next = S.next(ui + 1, nxt);
        const char* nA = has_next ? (const char*)g.A + (size_t)nxt.pm * tstep : cA; const char* nB = has_next ? (const char*)g.Bt + (size_t)nxt.pn * tstep : cB;
#pragma nounroll
        for (int t = 0; t < nt; t += 2) {
            const bool last = (t == nt - 2);
            const char* a1 = cA + (size_t)(t + 1) * kstep;
            const char* a2 = last ? nA : cA + (size_t)(t + 2) * kstep; const char* b2 = last ? nB : cB + (size_t)(t + 2) * kstep;
            const char* a3 = a2 + kstep; const char* b3 = b2 + kstep;
            if (last && has_next) S.a_ready(nxt);
            if constexpr (SP2) {
            PG8_LDB(B0, 0, 0); PG8_LDB(B1, 0, 1); PG8_SCHED; PG8_LDA(At, 0, 0); PG8_STAGE(PG8_SA(1, 1), a1 + hstep, voffA);
            PG8_WAIT_V(8); PG8_WAIT_L(0); PG8_BAR; PG8_MMA(0, 0, At, B0); PG8_MMA(0, 1, At, B1); PG8_BAR; PG8_SCHED;
            PG8_LDA(At, 0, 1); PG8_STAGE(PG8_SB(0, 0), b2, voffB); PG8_STAGE(PG8_SB(0, 1), b2 + hstep, voffB); PG8_STAGE(PG8_SA(0, 0), a2, voffA);
            PG8_WAIT_V(8); PG8_WAIT_L(0); PG8_BAR; PG8_MMA(1, 0, At, B0); PG8_MMA(1, 1, At, B1); PG8_BAR; PG8_SCHED;
            PG8_LDB(B0, 1, 0); PG8_LDB(B1, 1, 1); PG8_SCHED; PG8_LDA(At, 1, 0); PG8_STAGE(PG8_SA(0, 1), a2 + hstep, voffA);
            PG8_WAIT_V(8); PG8_WAIT_L(0); PG8_BAR; PG8_MMA(0, 0, At, B0); PG8_MMA(0, 1, At, B1); PG8_BAR; PG8_SCHED;
            PG8_LDA(At, 1, 1); PG8_STAGE(PG8_SB(1, 0), b3, voffB); PG8_STAGE(PG8_SB(1, 1), b3 + hstep, voffB); PG8_STAGE(PG8_SA(1, 0), a3, voffA);
            PG8_WAIT_V(8); PG8_WAIT_L(0); PG8_BAR; PG8_MMA(1, 0, At, B0); PG8_MMA(1, 1, At, B1); PG8_BAR; PG8_SCHED;
            } else {
            PG8_LDB(B0, 0, 0); PG8_SCHED; PG8_LDA(At, 0, 0); PG8_STAGE(PG8_SA(1, 1), a1 + hstep, voffA);
            PG8_WAIT_L(8); PG8_BAR; PG8_WAIT_L(0); PG8_MMA(0, 0, At, B0); PG8_BAR; PG8_SCHED;
            PG8_LDB(B1, 0, 1); PG8_STAGE(PG8_SB(0, 0), b2, voffB);
            PG8_BAR; PG8_WAIT_L(0); PG8_MMA(0, 1, At, B1); PG8_BAR;
            PG8_LDA(At, 0, 1); PG8_STAGE(PG8_SA(0, 0), a2, voffA);
            PG8_BAR; PG8_WAIT_L(0); PG8_MMA(1, 0, At, B0); PG8_BAR; PG8_SCHED;
            PG8_STAGE(PG8_SB(0, 1), b2 + hstep, voffB);
            PG8_WAIT_V(6); PG8_BAR; PG8_MMA(1, 1, At, B1); PG8_BAR;
            PG8_LDB(B0, 1, 0); PG8_SCHED; PG8_LDA(At, 1, 0); PG8_STAGE(PG8_SA(0, 1), a2 + hstep, voffA);
            PG8_WAIT_L(8); PG8_BAR; PG8_WAIT_L(0); PG8_MMA(0, 0, At, B0); PG8_BAR; PG8_SCHED;
            PG8_LDB(B1, 1, 1); PG8_STAGE(PG8_SB(1, 0), b3, voffB);
            PG8_BAR; PG8_WAIT_L(0); PG8_MMA(0, 1, At, B1); PG8_BAR;
            PG8_LDA(At, 1, 1); PG8_STAGE(PG8_SA(1, 0), a3, voffA);
            PG8_BAR; PG8_WAIT_L(0); PG8_MMA(1, 0, At, B0); PG8_BAR; PG8_SCHED;
            PG8_STAGE(PG8_SB(1, 1), b3 + hstep, voffB);
            PG8_WAIT_V(6); PG8_BAR; PG8_MMA(1, 1, At, B1); PG8_BAR;
            }
        }
        if constexpr (ALIGN_EPI) { if (wr == 0) PG8_BAR; }
        if constexpr (!Epi::AFTER_DRAIN) { E(acc, cur, wr, wc, fr, fq); S.done(cur); }
        if (!has_next) break;
#pragma unroll
        for (int a = 0; a < 2; ++a)
#pragma unroll
            for (int b = 0; b < 2; ++b)
#pragma unroll
                for (int m = 0; m < 4; ++m)
#pragma unroll
                    for (int n = 0; n < 2; ++n) acc[a][b][m][n] = (f32x4){0.f, 0.f, 0.f, 0.f};
        cur = nxt; cA = nA; cB = nB; ++ui;
        if constexpr (ALIGN_EPI) { if (wr == 1) PG8_BAR; }
    }
    PG8_WAIT_V(0);
    if constexpr (!ALIGN_EPI) { if (wr == 0) PG8_BAR; }
    PG8_BAR;
    if constexpr (Epi::AFTER_DRAIN) { E.fused(acc, cur, wr, wc, fr, fq, lds, wid, lane); S.done(cur); }
#undef PG8_SA
#undef PG8_SB
#undef PG8_STAGE
#undef PG8_LDA
#undef PG8_LDB
#undef PG8_MMA
#undef PG8_WAIT_V
#undef PG8_WAIT_L
#undef PG8_BAR
#undef PG8_SCHED
}
}

constexpr int NWAVES = 8;
constexpr int BATCH = 4, T = 8192, D = 1024, DFF = 2816, M = BATCH * T;
constexpr int INC = 3944, NPROJ = 4096;
constexpr int O_QA = 0, O_KA = 512, O_VA = 576, O_QI = 640, O_KI = 1152, O_WI = 1216, O_CQ = 1224, O_CKV = 1608, O_KR = 1864, O_GATE = 1896;
constexpr float EPS = 1e-6f;
#ifndef MK_FUSED
#define MK_FUSED 1
#endif

constexpr size_t MiB = 1u << 20;
constexpr size_t WS_CTL = 0, CTL_ZERO_BYTES = 2 * MiB;
constexpr size_t WS_MOD = 256 * 1024;
constexpr size_t WS_SSQQ = 49 * MiB, WS_SSQKV = 50 * MiB;
constexpr size_t WS_W1A = 2 * MiB, SZ_WA = (size_t)2 * DFF * D * 2, SZ_WD = (size_t)D * DFF * 2;
constexpr size_t WS_W1D = WS_W1A + SZ_WA, WS_WIN = WS_W1D + SZ_WD, WS_WUQ = WS_WIN + (size_t)NPROJ * D * 2, WS_WUKV = WS_WUQ + (size_t)768 * 384 * 2;
constexpr size_t WS_WOA = WS_WUKV + (size_t)1024 * 256 * 2, WS_WOB = WS_WOA + (size_t)D * 512 * 2, WS_WOUT = WS_WOB + (size_t)D * 512 * 2;
constexpr size_t WS_W2A = WS_WOUT + (size_t)D * D * 2, WS_W2D = WS_W2A + SZ_WA, WS_WEND = WS_W2D + SZ_WD;
static_assert(WS_WEND <= 49 * MiB, "weights");
constexpr size_t WS_RCOS = 51 * MiB, WS_RSIN = 53 * MiB;
constexpr size_t WS_XN = 55 * MiB;
constexpr size_t WS_ACT = 119 * MiB;
constexpr size_t WS_QA = WS_ACT, WS_QI = WS_QA + 32 * MiB, WS_CQ = WS_QI + 32 * MiB, WS_CKV = WS_CQ + 24 * MiB, WS_KA = WS_CKV + 16 * MiB, WS_VA = WS_KA + 4 * MiB;
constexpr size_t WS_KI = WS_VA + 4 * MiB, WS_KPE = WS_KI + 4 * MiB, WS_WI = WS_KPE + 2 * MiB, WS_QB = WS_WI + 1 * MiB, WS_MIXEND = WS_QB + 48 * MiB;
static_assert(WS_MIXEND <= WS_ACT + 176 * MiB, "mixer overlay");
constexpr size_t WS_G = 295 * MiB;
constexpr size_t WS_KN = 423 * MiB, WS_VB = 455 * MiB;
constexpr size_t WS_SEL = 487 * MiB;
constexpr size_t WS_END = 503 * MiB;
static_assert(WS_XN + 64 * MiB <= WS_ACT && WS_ACT + 176 * MiB <= WS_G && WS_G + 128 * MiB <= WS_KN && WS_VB + 32 * MiB <= WS_SEL, "d_ws map");
constexpr size_t WS_OA = WS_QA, WS_OB = WS_QI, WS_Y1 = WS_KN, WS_Y = WS_XN;
constexpr int CW_TMO = 0, CW_CODE = 1, CW_BAR = 4096;

constexpr int RING_OFF = 0, RING_BYTES = 152704;
constexpr int LDSCTL_OFF = RING_BYTES, MISC_OFF = LDSCTL_OFF + 320;
constexpr int LDS_BYTES = RING_BYTES + 1024;
#ifndef PROF_SEL
#define PROF_SEL 0
#endif
#ifndef PROF_MULT
#define PROF_MULT 4
#endif
#define PROF_WORD(ldsring, wid_) ((LAS unsigned*)((ldsring) + (MISC_OFF - RING_OFF) + 64) + (wid_))
#define PROF_T0(id) unsigned long long pt_##id = 0ull; if (PROF_SEL == (id)) pt_##id = __builtin_amdgcn_s_memrealtime()
#define PROF_T1(id, ldsring, wid_, lane_) do { if (PROF_SEL == (id)) { const unsigned d_ = (unsigned)(__builtin_amdgcn_s_memrealtime() - pt_##id); if ((lane_) == 0) *PROF_WORD(ldsring, wid_) += d_; } } while (0)
#define GAS __attribute__((address_space(1)))
#define LAS __attribute__((address_space(3)))
typedef unsigned short bf16;
typedef unsigned v4u __attribute__((ext_vector_type(4)));
typedef float f32x4 __attribute__((ext_vector_type(4)));
typedef short bf16x8 __attribute__((ext_vector_type(8)));
typedef GAS unsigned gu32;
typedef GAS unsigned long long gu64;
#define RLX_AGENT __ATOMIC_RELAXED, __HIP_MEMORY_SCOPE_AGENT
#define LDS_WAIT() asm volatile("s_waitcnt lgkmcnt(0)" ::: "memory")
#define VM_WAIT() asm volatile("s_waitcnt vmcnt(0)" ::: "memory")
__device__ __forceinline__ unsigned long long rt() { return __builtin_amdgcn_s_memrealtime(); }
__device__ __forceinline__ unsigned f2bf(float f) { unsigned u = __builtin_bit_cast(unsigned, f); return (u + 0x7fffu + ((u >> 16) & 1u)) >> 16; }
__device__ __forceinline__ unsigned pk2(float lo, float hi) { return f2bf(lo) | (f2bf(hi) << 16); }

#define XB_TMO      128
#define XB_XCNT(j)  (256  + 64 * (j))
#define XB_XSUB(j)  (1280 + 64 * (j))
#define XB_XGEN(j)  (2304 + 64 * (j))
#define XB_TOP      3328
#define XB_TOPGEN   3392
#define XCD_BAR_WORDS 3456
#define XB_SPIN_CAP (1u << 18)

__device__ __forceinline__ unsigned xb_ld(unsigned* p)              { return __hip_atomic_load(p, __ATOMIC_RELAXED, __HIP_MEMORY_SCOPE_AGENT); }
__device__ __forceinline__ unsigned xb_add(unsigned* p, unsigned v) { return __hip_atomic_fetch_add(p, v, __ATOMIC_RELAXED, __HIP_MEMORY_SCOPE_AGENT); }
__device__ __forceinline__ unsigned xb_xcc_id() { return (unsigned)__builtin_amdgcn_s_getreg((3 << 11) | 20) & 0xFu; }
#define XB_SPIN(cond, bar) do { unsigned _sp = 0; while (cond) { __builtin_amdgcn_s_sleep(1); \
    if ((++_sp & 255u) == 0u) { if (xb_ld(&(bar)[XB_TMO])) break; if (_sp > XB_SPIN_CAP) { atomicAdd(&(bar)[XB_TMO], 1u); break; } } } } while (0)

struct XcdBarrier {
    unsigned* bar; unsigned x;
    volatile LAS unsigned* st;
};

__device__ __forceinline__ XcdBarrier xcd_barrier_post(unsigned* bar, volatile LAS unsigned* st) {
    XcdBarrier b; b.bar = bar; b.x = xb_xcc_id(); b.st = st;
    if (threadIdx.x == 0) (void)xb_add(&bar[XB_XCNT(b.x)], 1u);
    return b;
}
__device__ __forceinline__ void xcd_barrier_complete(unsigned* bar, unsigned x, unsigned& nloc, unsigned& nx) {
    const unsigned G = gridDim.x * gridDim.y * gridDim.z;
    unsigned sum, cnt, mine, sp = 0u;
    for (;;) {
        sum = 0u; cnt = 0u; mine = 0u;
#pragma unroll
        for (unsigned j = 0; j < 16; ++j) { const unsigned c = xb_ld(&bar[XB_XCNT(j)]); sum += c; cnt += (c > 0u) ? 1u : 0u; mine = (j == x) ? c : mine; }
        if (sum == G) break;
        __builtin_amdgcn_s_sleep(1);
        if ((++sp & 255u) == 0u) { if (xb_ld(&bar[XB_TMO])) break; if (sp > XB_SPIN_CAP) { atomicAdd(&bar[XB_TMO], 1u); break; } }
    }
    nloc = mine > 0u ? mine : 1u; nx = cnt > 0u ? cnt : 1u;
}

__device__ __forceinline__ void xcd_barrier(const XcdBarrier& b) {
    asm volatile("s_waitcnt vmcnt(0)" ::: "memory");
    __syncthreads();
    if (threadIdx.x == 0) {
        unsigned* bar = b.bar;
        __builtin_amdgcn_s_waitcnt(0);
        unsigned nloc = b.st[0], nx = b.st[1];
        if (nloc == 0u) { xcd_barrier_complete(bar, b.x, nloc, nx); b.st[0] = nloc; b.st[1] = nx; }
        const unsigned old = xb_add(&bar[XB_XSUB(b.x)], 1u);
        const unsigned gen = old / nloc;
        if (old + 1u == (gen + 1u) * nloc) {
            __builtin_amdgcn_fence(__ATOMIC_RELEASE, "agent");
            asm volatile("s_waitcnt vmcnt(0)" ::: "memory");
            const unsigned og = xb_add(&bar[XB_TOP], 1u);
            const unsigned tg = og / nx;
            if (og + 1u == (tg + 1u) * nx) xb_add(&bar[XB_TOPGEN], 1u);
            else XB_SPIN(xb_ld(&bar[XB_TOPGEN]) == tg, bar);
            __builtin_amdgcn_fence(__ATOMIC_ACQUIRE, "agent");
            xb_add(&bar[XB_XGEN(b.x)], 1u);
            asm volatile("s_waitcnt vmcnt(0)" ::: "memory");
        } else {
            XB_SPIN(xb_ld(&bar[XB_XGEN(b.x)]) == gen, bar);
            __builtin_amdgcn_fence(__ATOMIC_ACQUIRE, "agent");
            asm volatile("s_waitcnt vmcnt(0)" ::: "memory");
        }
    }
    __syncthreads();
}

struct Frame {
    LAS unsigned char* lds;
    volatile LAS unsigned* MISC;
    gu32* ctl;
    int tid, lane, wave;
    int vcu, G;
};
__device__ __forceinline__ float wave_sum(float v) {
#pragma unroll
    for (int o = 1; o < 64; o <<= 1) v += __shfl_xor(v, o);
    return v;
}
struct MapIdent { int off; __device__ __forceinline__ int src(int n) const { return n + off; } };
struct MapFfnIn { __device__ __forceinline__ int src(int n) const { const int pn = n >> 8, j = n & 255; return (j >> 7) * DFF + pn * 128 + (j & 127); } };
struct MapProj { __device__ __forceinline__ int src(int n) const { const int pn = n >> 8, j = n & 255;
    if (pn < 2) return O_QA + n; if (pn < 4) return O_QI + (n - 512); if (pn == 4) return O_CQ + j;
    if (pn == 5) return j < 128 ? O_CQ + 256 + j : O_CKV + (j - 128);
    if (pn == 6) return j < 128 ? O_CKV + 128 + j : (j < 192 ? O_KA + (j - 128) : O_VA + (j - 192));
    if (pn == 7) { if (j < 64) return O_KI + j; if (j < 96) { const int jj = j - 64; return O_KR + (jj >> 1) + 16 * (jj & 1); } if (j < 104) return O_WI + (j - 96); return -1; }
    return O_GATE + (n - 2048); } };
struct MapUq { __device__ __forceinline__ int src(int n) const { const int h = n / 96, w = n % 96; if (w < 64) return n; const int jj = w - 64; return h * 96 + 64 + (jj >> 1) + 16 * (jj & 1); } };
template <class Map> __device__ __forceinline__ void p0_transpose_item(const float* W, int K, int Nsrc, int nblk, const float* kscale, bf16* WT, const Map mp, LAS float* scr, int item, int lane) {
    const int kb = item / nblk, nb = item % nblk, k0 = 64 * kb, n0 = 32 * nb;
    const int sc = mp.src(n0 + (lane & 31));
    float vv[32];
#pragma unroll
    for (int i = 0; i < 32; ++i) { const int kk = 2 * i + (lane >> 5); vv[i] = sc >= 0 ? W[(size_t)(k0 + kk) * Nsrc + sc] : 0.f; }
#pragma unroll
    for (int i = 0; i < 32; ++i) { const int kk = 2 * i + (lane >> 5); float v = vv[i]; if (kscale) v *= kscale[k0 + kk]; scr[kk * 33 + (lane & 31)] = v; }
    LDS_WAIT(); asm volatile("" ::: "memory");
    const int c = lane & 7;
#pragma unroll
    for (int j = 0; j < 4; ++j) { const int n = (lane >> 3) + 8 * j; const LAS float* s = scr + (8 * c) * 33 + n;
        v4u o; o.x = pk2(s[0 * 33], s[1 * 33]); o.y = pk2(s[2 * 33], s[3 * 33]); o.z = pk2(s[4 * 33], s[5 * 33]); o.w = pk2(s[6 * 33], s[7 * 33]);
        *(GAS v4u*)(WT + (size_t)(n0 + n) * K + k0 + 8 * c) = o; }
    LDS_WAIT(); asm volatile("" ::: "memory");
}
struct Args { const void* in[23]; float* out; unsigned char* ws; int ph_lo, ph_hi, li, pad; };

__device__ __forceinline__ void p0_prologue(Frame& F, const Args& A) {
    LAS float* scr = (LAS float*)(F.lds + RING_OFF + F.wave * 16384);
    const int gw = F.vcu * NWAVES + F.wave, NGW = F.G * NWAVES;
    unsigned char* ws = A.ws;
    {
        const float* c = (const float*)A.in[1]; const float* w = (const float*)A.in[3]; const float* bias = (const float*)A.in[4]; float* mod = (float*)(ws + WS_MOD);
        for (int cg = F.vcu; cg < 256; cg += F.G) {
            const bool act = F.lane < 36; const int n = cg * 36 + (act ? F.lane : 0), k0 = F.wave * 128;
#pragma unroll
            for (int b = 0; b < 4; ++b)
#pragma unroll
                for (int h = 0; h < 2; ++h) { const float v = c[b * D + k0 + h * 64 + F.lane]; scr[b * 128 + h * 64 + F.lane] = v / (1.f + __expf(-v)); }
            LDS_WAIT(); asm volatile("" ::: "memory");
            float a0 = 0.f, a1 = 0.f, a2 = 0.f, a3 = 0.f;
#pragma unroll 8
            for (int k = 0; k < 128; ++k) { const float wv = act ? w[(size_t)(k0 + k) * 9216 + n] : 0.f; a0 += scr[k] * wv; a1 += scr[128 + k] * wv; a2 += scr[256 + k] * wv; a3 += scr[384 + k] * wv; }
            scr[1024 + F.lane] = a0; scr[1088 + F.lane] = a1; scr[1152 + F.lane] = a2; scr[1216 + F.lane] = a3;
            __syncthreads();
            if (F.wave < 4 && act) { float t = bias[n];
#pragma unroll
                for (int ww = 0; ww < 8; ++ww) t += ((LAS float*)(F.lds + RING_OFF + ww * 16384))[1024 + F.wave * 64 + F.lane];
                mod[F.wave * 9216 + n] = t; }
            __syncthreads();
        }
    }
    {
        const float* w1a = (const float*)A.in[6]; const float* w1d = (const float*)A.in[7]; const float* win = (const float*)A.in[9]; const float* gcq = (const float*)A.in[10];
        const float* wuq = (const float*)A.in[11]; const float* gckv = (const float*)A.in[12]; const float* wuk = (const float*)A.in[13]; const float* wuv = (const float*)A.in[14];
        const float* woa = (const float*)A.in[16]; const float* wob = (const float*)A.in[17]; const float* wout = (const float*)A.in[18]; const float* w2a = (const float*)A.in[20]; const float* w2d = (const float*)A.in[21];
        constexpr int I_A = 16 * 176, I_D = 44 * 32, I_IN = 16 * 128, I_UQ = 6 * 24, I_UK = 4 * 16, I_O = 8 * 32, I_OUT = 16 * 32;
        constexpr int NITEMS = 2 * I_A + 2 * I_D + I_IN + I_UQ + 2 * I_UK + 2 * I_O + I_OUT;
        for (int it = gw; it < NITEMS; it += NGW) {
            int r = it;
            if (r < I_A) { p0_transpose_item(w1a, D, 2 * DFF, 176, nullptr, (bf16*)(ws + WS_W1A), MapFfnIn{}, scr, r, F.lane); continue; } r -= I_A;
            if (r < I_A) { p0_transpose_item(w2a, D, 2 * DFF, 176, nullptr, (bf16*)(ws + WS_W2A), MapFfnIn{}, scr, r, F.lane); continue; } r -= I_A;
            if (r < I_D) { p0_transpose_item(w1d, DFF, D, 32, nullptr, (bf16*)(ws + WS_W1D), MapIdent{0}, scr, r, F.lane); continue; } r -= I_D;
            if (r < I_D) { p0_transpose_item(w2d, DFF, D, 32, nullptr, (bf16*)(ws + WS_W2D), MapIdent{0}, scr, r, F.lane); continue; } r -= I_D;
            if (r < I_IN) { p0_transpose_item(win, D, INC, 128, nullptr, (bf16*)(ws + WS_WIN), MapProj{}, scr, r, F.lane); continue; } r -= I_IN;
            if (r < I_UQ) { p0_transpose_item(wuq, 384, 768, 24, gcq, (bf16*)(ws + WS_WUQ), MapUq{}, scr, r, F.lane); continue; } r -= I_UQ;
            if (r < I_UK) { p0_transpose_item(wuk, 256, 512, 16, gckv, (bf16*)(ws + WS_WUKV), MapIdent{0}, scr, r, F.lane); continue; } r -= I_UK;
            if (r < I_UK) { p0_transpose_item(wuv, 256, 512, 16, gckv, (bf16*)(ws + WS_WUKV) + (size_t)512 * 256, MapIdent{0}, scr, r, F.lane); continue; } r -= I_UK;
            if (r < I_O) { p0_transpose_item(woa, 512, D, 32, nullptr, (bf16*)(ws + WS_WOA), MapIdent{0}, scr, r, F.lane); continue; } r -= I_O;
            if (r < I_O) { p0_transpose_item(wob, 512, D, 32, nullptr, (bf16*)(ws + WS_WOB), MapIdent{0}, scr, r, F.lane); continue; } r -= I_O;
            p0_transpose_item(wout, D, D, 32, nullptr, (bf16*)(ws + WS_WOUT), MapIdent{0}, scr, r, F.lane);
        }
    }
    {
        const int* pos = (const int*)A.in[2]; float* rc = (float*)(ws + WS_RCOS); float* rs = (float*)(ws + WS_RSIN);
        for (int idx = gw * 64 + F.lane; idx < M * 16; idx += NGW * 64) { const int t = idx >> 4, i = idx & 15;
            const float freq = powf(10000.0f, -2.0f * (float)i / 32.0f); const float ang = (float)pos[t] * freq;
            rc[idx] = cosf(ang); rs[idx] = sinf(ang); }
    }
}
__device__ __forceinline__ void norm_mod_phase(Frame& F, const float* xin, const float* g, const float* mod, int shoff, int scoff, bf16* out) {
    const int gw = F.vcu * NWAVES + F.wave, NGW = F.G * NWAVES;
    for (int m = gw; m < M; m += NGW) {
        const int b = m >> 13;
        const GAS f32x4* xr = (const GAS f32x4*)(xin + (size_t)m * D) + F.lane;
        const GAS f32x4* g4 = (const GAS f32x4*)g + F.lane; const GAS f32x4* sc4 = (const GAS f32x4*)(mod + b * 9216 + scoff) + F.lane; const GAS f32x4* sh4 = (const GAS f32x4*)(mod + b * 9216 + shoff) + F.lane;
        f32x4 v[4]; float s = 0.f;
#pragma unroll
        for (int j = 0; j < 4; ++j) { v[j] = xr[64 * j]; s += (v[j].x * v[j].x + v[j].y * v[j].y) + (v[j].z * v[j].z + v[j].w * v[j].w); }
        const float rs = __builtin_amdgcn_rsqf(wave_sum(s) * (1.f / D) + EPS);
        GAS unsigned long long* o8 = (GAS unsigned long long*)(out + (size_t)m * D) + F.lane;
#pragma unroll
        for (int j = 0; j < 4; ++j) { const f32x4 o = v[j] * rs * g4[64 * j] * (sc4[64 * j] + 1.f) + sh4[64 * j];
            o8[64 * j] = (unsigned long long)pk2(o.x, o.y) | ((unsigned long long)pk2(o.z, o.w) << 32); }
    }
}
__device__ __forceinline__ void final_norm_phase(Frame& F, const float* xin, const float* g, float* out) {
    const int gw = F.vcu * NWAVES + F.wave, NGW = F.G * NWAVES;
    for (int m = gw; m < M; m += NGW) {
        const GAS f32x4* xr = (const GAS f32x4*)(xin + (size_t)m * D) + F.lane; const GAS f32x4* g4 = (const GAS f32x4*)g + F.lane;
        f32x4 v[4]; float s = 0.f;
#pragma unroll
        for (int j = 0; j < 4; ++j) { v[j] = xr[64 * j]; s += (v[j].x * v[j].x + v[j].y * v[j].y) + (v[j].z * v[j].z + v[j].w * v[j].w); }
        const float rs = __builtin_amdgcn_rsqf(wave_sum(s) * (1.f / D) + EPS);
        GAS f32x4* o4 = (GAS f32x4*)(out + (size_t)m * D) + F.lane;
#pragma unroll
        for (int j = 0; j < 4; ++j) o4[64 * j] = v[j] * rs * g4[64 * j];
    }
}

namespace mla {
typedef unsigned u32x4 __attribute__((ext_vector_type(4)));
typedef short bf16x8 __attribute__((ext_vector_type(8)));
typedef short s16x4 __attribute__((ext_vector_type(4)));
typedef float f32x16 __attribute__((ext_vector_type(16)));
constexpr int KSLOT = 12288, VSLOT = 8192;
constexpr int L_K = 0, L_V = 3 * KSLOT, L_WS = L_V + 3 * VSLOT, L_OST = L_WS + 2048, L_END = L_OST + 8 * 4096;
static_assert(L_END <= RING_BYTES, "attention LDS");
__device__ __forceinline__ int crow(int r, int hi) { return (r & 3) + 8 * (r >> 2) + 4 * hi; }
__device__ __forceinline__ float xhalf(float v) { return __shfl_xor(v, 32); }
__device__ __forceinline__ void pv(f32x16* o, int vb, bf16x8 pa0, bf16x8 pa1, bf16x8 pa2, bf16x8 pa3) {
#pragma unroll
    for (int d0 = 0; d0 < 2; ++d0) { s16x4 lo[4], hi[4];
#pragma unroll
        for (int ks = 0; ks < 4; ++ks) {
            asm volatile("ds_read_b64_tr_b16 %0,%1 offset:%c2" : "=&v"(lo[ks]) : "v"(vb), "i"(d0 * 4096 + ks * 1024) : "memory");
            asm volatile("ds_read_b64_tr_b16 %0,%1 offset:%c2" : "=&v"(hi[ks]) : "v"(vb), "i"(d0 * 4096 + ks * 1024 + 512) : "memory"); }
        asm volatile("s_waitcnt lgkmcnt(0)" ::: "memory"); __builtin_amdgcn_sched_barrier(0);
#define MLA_PK(k) (bf16x8){lo[k][0], lo[k][1], lo[k][2], lo[k][3], hi[k][0], hi[k][1], hi[k][2], hi[k][3]}
        o[d0] = __builtin_amdgcn_mfma_f32_32x32x16_bf16(pa0, MLA_PK(0), o[d0], 0, 0, 0);
        o[d0] = __builtin_amdgcn_mfma_f32_32x32x16_bf16(pa1, MLA_PK(1), o[d0], 0, 0, 0);
        o[d0] = __builtin_amdgcn_mfma_f32_32x32x16_bf16(pa2, MLA_PK(2), o[d0], 0, 0, 0);
        o[d0] = __builtin_amdgcn_mfma_f32_32x32x16_bf16(pa3, MLA_PK(3), o[d0], 0, 0, 0);
#undef MLA_PK
    }
}
__device__ __forceinline__ void attn_unit(int b, int h, int qb, const bf16* QB, const bf16* KN, const bf16* KPE, const bf16* VB, bf16* OB, LAS unsigned char* lds) {
    const int tid = threadIdx.x, lane = tid & 63, r32 = lane & 31, hi = lane >> 5; const int wid = __builtin_amdgcn_readfirstlane(tid >> 6);
    const size_t rowbase = (size_t)b * T; const int q0 = qb * 256;
    const int NT = 4 * (qb + 1), my_last = 4 * qb + (wid >> 1);
    LAS float* wsf = (LAS float*)(lds + L_WS) + wid * 64;
#define MLA_DMA(t, slot) do { const size_t krow_ = rowbase + (size_t)(t) * 64 + lane; \
        __builtin_amdgcn_global_load_lds((const unsigned*)(KN + krow_ * 512 + h * 64 + wid * 8), (LAS unsigned*)(lds + L_K + (slot) * KSLOT + wid * 1024), 16, 0, 0); \
        if (wid < 4) __builtin_amdgcn_global_load_lds((const unsigned*)(KPE + krow_ * 32 + wid * 8), (LAS unsigned*)(lds + L_K + (slot) * KSLOT + (8 + wid) * 1024), 16, 0, 0); \
        const size_t vrow_ = rowbase + (size_t)(t) * 64 + 16 * (wid & 3) + (lane >> 2); \
        __builtin_amdgcn_global_load_lds((const unsigned*)(VB + vrow_ * 512 + h * 64 + (wid >> 2) * 32 + (lane & 3) * 8), (LAS unsigned*)(lds + L_V + (slot) * VSLOT + wid * 1024), 16, 0, 0); } while (0)
    bf16x8 qr[6];
    { const bf16* Qw = QB + (rowbase + q0 + wid * 32 + r32) * 768 + h * 96 + hi * 8;
#pragma unroll
      for (int d0 = 0; d0 < 6; ++d0) qr[d0] = *(const bf16x8*)(Qw + d0 * 16); }
    MLA_DMA(0, 0); MLA_DMA(1, 1);
    int slot = 0, slot2 = 2;
    float m = 0.f, l = 0.f; f32x16 o[2], negm;
#pragma unroll
    for (int r = 0; r < 16; ++r) { o[0][r] = 0.f; o[1][r] = 0.f; negm[r] = 0.f; }
    const int kofs = hi * 1024 + r32 * 16;
    const int vb0 = (int)(unsigned)(uintptr_t)(lds + L_V) + ((lane >> 4) & 1) * 32 + (lane & 3) * 8 + (4 * hi + ((lane & 15) >> 2)) * 64;
    for (int t = 0; t < NT; ++t) {
        if (t + 1 < NT) { if (wid < 4) asm volatile("s_waitcnt vmcnt(3) lgkmcnt(0)\n\ts_barrier" ::: "memory"); else asm volatile("s_waitcnt vmcnt(2) lgkmcnt(0)\n\ts_barrier" ::: "memory"); }
        else asm volatile("s_waitcnt vmcnt(0) lgkmcnt(0)\n\ts_barrier" ::: "memory");
        if (t + 2 < NT) MLA_DMA(t + 2, slot2);
        const int cslot = slot; slot = (slot == 2) ? 0 : slot + 1; slot2 = (slot2 == 2) ? 0 : slot2 + 1;
        if (t <= my_last) {
            const int slot = cslot;
            const LAS unsigned char* kb = lds + L_K + slot * KSLOT + kofs;
            f32x16 p0, p1;
#pragma unroll
            for (int d0 = 0; d0 < 6; ++d0) {
                const bf16x8 b0 = *(const LAS bf16x8*)(kb + d0 * 2048), b1 = *(const LAS bf16x8*)(kb + d0 * 2048 + 512);
                if (d0 == 0) { p0 = __builtin_amdgcn_mfma_f32_32x32x16_bf16(b0, qr[0], negm, 0, 0, 0); p1 = __builtin_amdgcn_mfma_f32_32x32x16_bf16(b1, qr[0], negm, 0, 0, 0); }
                else { p0 = __builtin_amdgcn_mfma_f32_32x32x16_bf16(b0, qr[d0], p0, 0, 0, 0); p1 = __builtin_amdgcn_mfma_f32_32x32x16_bf16(b1, qr[d0], p1, 0, 0, 0); } }
#define MLA_MX3(a, b, c) __builtin_fmaxf(__builtin_fmaxf((a), (b)), (c))
            float ra = MLA_MX3(p0[0], p0[1], p1[0]), rb = MLA_MX3(p0[2], p0[3], p1[1]); ra = MLA_MX3(ra, p1[2], p1[3]);
#pragma unroll
            for (int r = 4; r < 16; r += 4) { ra = MLA_MX3(ra, p0[r], p0[r + 1]); rb = MLA_MX3(rb, p0[r + 2], p0[r + 3]); ra = MLA_MX3(ra, p1[r], p1[r + 1]); rb = MLA_MX3(rb, p1[r + 2], p1[r + 3]); }
#undef MLA_MX3
            float rm = __builtin_fmaxf(ra, rb);
            rm = __builtin_fmaxf(rm, xhalf(rm));
            if (t == 0 || __any(rm > 0.f)) {
                const float dl = (t == 0) ? rm : __builtin_fmaxf(rm, 0.f), f = __builtin_amdgcn_exp2f(-dl);
                m += dl; l *= f;
#pragma unroll
                for (int r = 0; r < 16; ++r) { p0[r] -= dl; p1[r] -= dl; negm[r] = -m; }
                if (t != 0) {
                    if (hi == 0) wsf[r32] = f;
                    asm volatile("s_waitcnt lgkmcnt(0)" ::: "memory");
#pragma unroll
                    for (int r = 0; r < 16; ++r) { const float fr_ = wsf[crow(r, hi)]; o[0][r] *= fr_; o[1][r] *= fr_; }
                }
            }
            float sacc = 0.f;
#pragma unroll
            for (int r = 0; r < 16; ++r) { p0[r] = __builtin_amdgcn_exp2f(p0[r]); p1[r] = __builtin_amdgcn_exp2f(p1[r]); sacc += p0[r] + p1[r]; }
            l += sacc;
            u32x4 pw0, pw1, pw2, pw3;
            pw0 = (u32x4){pg8::cvt_pk_bf16(p0[0], p0[1]), pg8::cvt_pk_bf16(p0[2], p0[3]), pg8::cvt_pk_bf16(p0[4], p0[5]), pg8::cvt_pk_bf16(p0[6], p0[7])};
            pw1 = (u32x4){pg8::cvt_pk_bf16(p0[8], p0[9]), pg8::cvt_pk_bf16(p0[10], p0[11]), pg8::cvt_pk_bf16(p0[12], p0[13]), pg8::cvt_pk_bf16(p0[14], p0[15])};
            pw2 = (u32x4){pg8::cvt_pk_bf16(p1[0], p1[1]), pg8::cvt_pk_bf16(p1[2], p1[3]), pg8::cvt_pk_bf16(p1[4], p1[5]), pg8::cvt_pk_bf16(p1[6], p1[7])};
            pw3 = (u32x4){pg8::cvt_pk_bf16(p1[8], p1[9]), pg8::cvt_pk_bf16(p1[10], p1[11]), pg8::cvt_pk_bf16(p1[12], p1[13]), pg8::cvt_pk_bf16(p1[14], p1[15])};
            pv(o, vb0 + slot * VSLOT, __builtin_bit_cast(bf16x8, pw0), __builtin_bit_cast(bf16x8, pw1), __builtin_bit_cast(bf16x8, pw2), __builtin_bit_cast(bf16x8, pw3));
        }
    }
#undef MLA_DMA
    l += xhalf(l);
    if (hi == 0) wsf[32 + r32] = l;
    asm volatile("s_waitcnt lgkmcnt(0)" ::: "memory");
    LAS bf16* stg = (LAS bf16*)(lds + L_OST) + wid * 2048;
#pragma unroll
    for (int r = 0; r < 16; ++r) { const int orow = crow(r, hi); const float rl = __builtin_amdgcn_rcpf(wsf[32 + orow]);
        stg[orow * 64 + r32] = (bf16)(pg8::cvt_pk_bf16(o[0][r] * rl, 0.f) & 0xffffu); stg[orow * 64 + 32 + r32] = (bf16)(pg8::cvt_pk_bf16(o[1][r] * rl, 0.f) & 0xffffu); }
    asm volatile("s_waitcnt lgkmcnt(0)" ::: "memory");
    bf16* Ow = OB + (rowbase + q0 + wid * 32) * 512 + h * 64;
#pragma unroll
    for (int i = 0; i < 4; ++i) { const int row = i * 8 + (lane >> 3), ch = lane & 7; const u32x4 v = *(const LAS u32x4*)(stg + row * 64 + ch * 8); *(u32x4*)(Ow + (size_t)row * 512 + ch * 8) = v; }
    asm volatile("s_waitcnt lgkmcnt(0)\n\ts_barrier" ::: "memory");
}
__device__ __forceinline__ void phase(int vcu, int G, const bf16* QB, const bf16* KN, const bf16* KPE, const bf16* VB, bf16* OB, LAS unsigned char* lds) {
    const bool young = __builtin_amdgcn_readfirstlane((int)threadIdx.x) >= 256;
    if (young) __builtin_amdgcn_s_setprio(1);
    for (int u = vcu; u < 1024; u += G) { const int i = u >> 8, v = u & 255, bh = v >> 3, s = v & 7;
        const int qb = (i == 0) ? s : (i == 1) ? 15 - s : (i == 2) ? 16 + s : 31 - s;
        attn_unit(bh >> 3, bh & 7, qb, QB, KN, KPE, VB, OB, lds); }
    if (young) __builtin_amdgcn_s_setprio(0);
}
}

namespace dsa {
typedef short bf16x8 __attribute__((ext_vector_type(8)));
typedef short v4i16 __attribute__((ext_vector_type(4)));
typedef unsigned u32x4m __attribute__((ext_vector_type(4)));
typedef unsigned u32x2m __attribute__((ext_vector_type(2)));
constexpr float LOG2E = 1.4426950408889634f;
__device__ __forceinline__ int t5_bucket(int rel) {
    const int n = rel < 0 ? -rel : rel; const int r = rel > 0 ? 16 : 0;
    if (n < 8) return r + n;
    int lg = 7; if (n < 128) lg = (31 - __clz(n * n)) - 6;
    return r + 8 + lg;
}
__device__ __forceinline__ void query(int q, const bf16* QA, const bf16* KA, const bf16* VA, const int* positions, bf16* OA, LAS unsigned char* vbuf, LAS unsigned short* selL, LAS unsigned char* bktL, const LAS float* bt, int lane) {
    const int l15 = lane & 15, kq = lane >> 4;
    const int trofs = ((l15 >> 2) + 4 * kq) * 128 + (l15 & 3) * 8;
    const int b = q >> 13, t = q & (T - 1); const size_t rowbase = (size_t)b * T;
    const int limit = 64 * (t / 64 + 1), nvalid = limit < 256 ? limit : 256; const int posq = positions[q];
#pragma unroll
    for (int j = 0; j < 4; ++j) { const int k = lane + 64 * j; const int sv = selL[k];
        bktL[k] = (unsigned char)((k < nvalid) ? t5_bucket(positions[rowbase + sv] - posq) : 32); }
#define DSA_VDMA(cch, buf) do { _Pragma("unroll") for (int i_ = 0; i_ < 4; ++i_) { const int row_ = selL[32 * (cch) + 8 * i_ + (lane >> 3)]; \
        __builtin_amdgcn_global_load_lds((const unsigned*)(VA + (rowbase + row_) * 64 + (lane & 7) * 8), (LAS unsigned*)(vbuf + (buf) * 4096 + i_ * 1024), 16, 0, 0); } } while (0)
    DSA_VDMA(0, 0); DSA_VDMA(1, 1); DSA_VDMA(2, 2); DSA_VDMA(3, 3);
    bf16x8 Qf[2];
#pragma unroll
    for (int s = 0; s < 2; ++s) { Qf[s] = (bf16x8){0, 0, 0, 0, 0, 0, 0, 0}; if (l15 < 8) Qf[s] = *(const bf16x8*)(QA + (size_t)q * 512 + l15 * 64 + 32 * s + 8 * kq); }
    f32x4 St[16];
#pragma unroll
    for (int half = 0; half < 2; ++half) {
        bf16x8 Ka[8][2];
#pragma unroll
        for (int i = 0; i < 8; ++i) { const int row = selL[16 * (8 * half + i) + l15]; const bf16* kp = KA + (rowbase + row) * 64 + 8 * kq;
            Ka[i][0] = *(const bf16x8*)kp; Ka[i][1] = *(const bf16x8*)(kp + 32); }
#pragma unroll
        for (int i = 0; i < 8; ++i) { f32x4 a = {0.f, 0.f, 0.f, 0.f};
            a = __builtin_amdgcn_mfma_f32_16x16x32_bf16(Ka[i][0], Qf[0], a, 0, 0, 0); a = __builtin_amdgcn_mfma_f32_16x16x32_bf16(Ka[i][1], Qf[1], a, 0, 0, 0); St[8 * half + i] = a; }
    }
    asm volatile("s_waitcnt lgkmcnt(0)" ::: "memory");
    float mx = -INFINITY;
#pragma unroll
    for (int kt = 0; kt < 16; ++kt) { const unsigned bk4 = *(const LAS unsigned*)(bktL + 16 * kt + 4 * kq);
#pragma unroll
        for (int i = 0; i < 4; ++i) { const float s = St[kt][i] * (0.125f * LOG2E) + bt[((bk4 >> (8 * i)) & 255u) * 8 + (l15 & 7)]; St[kt][i] = s; mx = fmaxf(mx, s); } }
    mx = fmaxf(mx, __shfl_xor(mx, 16)); mx = fmaxf(mx, __shfl_xor(mx, 32));
    float lsum = 0.f;
#pragma unroll
    for (int kt = 0; kt < 16; ++kt)
#pragma unroll
        for (int i = 0; i < 4; ++i) { const float p = __builtin_amdgcn_exp2f(St[kt][i] - mx); St[kt][i] = p; lsum += p; }
    lsum += __shfl_xor(lsum, 16); lsum += __shfl_xor(lsum, 32);
    f32x4 O[4];
#pragma unroll
    for (int dt = 0; dt < 4; ++dt) O[dt] = (f32x4){0.f, 0.f, 0.f, 0.f};
#pragma unroll
    for (int kk = 0; kk < 8; ++kk) {
        if (kk < 5) asm volatile("s_waitcnt vmcnt(12)" ::: "memory"); else if (kk == 5) asm volatile("s_waitcnt vmcnt(8)" ::: "memory"); else if (kk == 6) asm volatile("s_waitcnt vmcnt(4)" ::: "memory"); else asm volatile("s_waitcnt vmcnt(0)" ::: "memory");
        const LAS unsigned char* vb = vbuf + (kk & 3) * 4096 + trofs;
        const f32x4 pa = St[2 * kk], pb = St[2 * kk + 1];
        u32x4m pw; pw.x = pg8::cvt_pk_bf16(pa[0], pa[1]); pw.y = pg8::cvt_pk_bf16(pa[2], pa[3]); pw.z = pg8::cvt_pk_bf16(pb[0], pb[1]); pw.w = pg8::cvt_pk_bf16(pb[2], pb[3]);
        const bf16x8 Pf = __builtin_bit_cast(bf16x8, pw);
#pragma unroll
        for (int dt = 0; dt < 4; ++dt) {
            const v4i16 v0 = __builtin_amdgcn_ds_read_tr16_b64_v4i16((LAS v4i16*)(vb + dt * 32));
            const v4i16 v1 = __builtin_amdgcn_ds_read_tr16_b64_v4i16((LAS v4i16*)(vb + 2048 + dt * 32));
            const bf16x8 Vf = (bf16x8){v0[0], v0[1], v0[2], v0[3], v1[0], v1[1], v1[2], v1[3]};
            O[dt] = __builtin_amdgcn_mfma_f32_16x16x32_bf16(Vf, Pf, O[dt], 0, 0, 0); }
        if (kk < 4) { asm volatile("s_waitcnt lgkmcnt(0)" ::: "memory"); DSA_VDMA(kk + 4, kk); }
    }
#undef DSA_VDMA
    if (l15 < 8) { const float rl = __builtin_amdgcn_rcpf(lsum);
#pragma unroll
        for (int dt = 0; dt < 4; ++dt) { u32x2m w; w.x = pg8::cvt_pk_bf16(O[dt][0] * rl, O[dt][1] * rl); w.y = pg8::cvt_pk_bf16(O[dt][2] * rl, O[dt][3] * rl);
            *(u32x2m*)(OA + (size_t)q * 512 + l15 * 64 + 16 * dt + 4 * kq) = w; } }
    asm volatile("s_waitcnt vmcnt(0) lgkmcnt(0)" ::: "memory");
}
}

namespace idx {
typedef short bf16x8 __attribute__((ext_vector_type(8)));
typedef float f32x16 __attribute__((ext_vector_type(16)));
typedef unsigned u32x2 __attribute__((ext_vector_type(2)));
constexpr int CAP = 576, TRIG = CAP - 64, NE = (CAP + 63) / 64;
constexpr int L_CAND = 0, L_TRASH = 32 * CAP * 8, L_BIAS = L_TRASH + 8 * 512, L_END = L_BIAS + 33 * 8 * 4;
static_assert(4 * CAP * 8 >= 4 * 512 + 16384, "a wave's four candidate buffers hold its four selection tables + the attention's V buffers afterwards");
constexpr int KEEP_MAX = 272, SCHED_MIN = 304;
static_assert(L_END <= RING_BYTES, "indexer LDS");
__device__ __forceinline__ unsigned okey(float f) { const unsigned u = __float_as_uint(f); return (u & 0x80000000u) ? ~u : (u | 0x80000000u); }
__device__ __forceinline__ float ikey(unsigned k) { return __uint_as_float((k & 0x80000000u) ? (k ^ 0x80000000u) : ~k); }
__device__ __forceinline__ int prefix64(unsigned long long m) { return (int)__builtin_amdgcn_mbcnt_hi((unsigned)(m >> 32), __builtin_amdgcn_mbcnt_lo((unsigned)m, 0u)); }
__device__ __forceinline__ unsigned wave_umax(unsigned v) {
    v = max(v, (unsigned)__builtin_amdgcn_update_dpp(0, (int)v, 0xB1, 0xf, 0xf, false)); v = max(v, (unsigned)__builtin_amdgcn_update_dpp(0, (int)v, 0x4E, 0xf, 0xf, false));
    v = max(v, (unsigned)__builtin_amdgcn_update_dpp(0, (int)v, 0x141, 0xf, 0xf, false)); v = max(v, (unsigned)__builtin_amdgcn_update_dpp(0, (int)v, 0x140, 0xf, 0xf, false));
    return max(max((unsigned)__builtin_amdgcn_readlane((int)v, 0), (unsigned)__builtin_amdgcn_readlane((int)v, 16)), max((unsigned)__builtin_amdgcn_readlane((int)v, 32), (unsigned)__builtin_amdgcn_readlane((int)v, 48)));
}
__device__ __forceinline__ unsigned wave_umin(unsigned v) { return ~wave_umax(~v); }
__device__ __forceinline__ unsigned wave_usum(unsigned v) {
    v += (unsigned)__builtin_amdgcn_update_dpp(0, (int)v, 0xB1, 0xf, 0xf, false); v += (unsigned)__builtin_amdgcn_update_dpp(0, (int)v, 0x4E, 0xf, 0xf, false);
    v += (unsigned)__builtin_amdgcn_update_dpp(0, (int)v, 0x141, 0xf, 0xf, false); v += (unsigned)__builtin_amdgcn_update_dpp(0, (int)v, 0x140, 0xf, 0xf, false);
    return ((unsigned)__builtin_amdgcn_readlane((int)v, 0) + (unsigned)__builtin_amdgcn_readlane((int)v, 16)) + ((unsigned)__builtin_amdgcn_readlane((int)v, 32) + (unsigned)__builtin_amdgcn_readlane((int)v, 48));
}
__device__ __forceinline__ int count_ge_v(const unsigned (&k)[8], unsigned thr) { unsigned c = 0;
#pragma unroll
    for (int j = 0; j < 8; ++j) c += (k[j] >= thr) ? 1u : 0u;
    return (int)wave_usum(c); }
template <bool FINAL> __device__ __forceinline__ void select4(LAS u32x2* cb, int (&n)[4], unsigned (&tk)[4], int lane, LAS unsigned short* sel_out, LAS u32x2* trash) {
    unsigned k[4][NE], ix[4][FINAL ? NE : 1];
#pragma unroll
    for (int q = 0; q < 4; ++q)
#pragma unroll
        for (int j = 0; j < NE; ++j) { const int e = lane + 64 * j; const bool v = e < n[q]; const u32x2 en = cb[(size_t)q * CAP + (v ? e : 0)]; if (FINAL) ix[q][j] = en.y; k[q][j] = v ? okey(__uint_as_float(en.x)) : 0u; }
    unsigned lo[4], hx[4]; int clo[4];
#pragma unroll
    for (int q = 0; q < 4; ++q) { unsigned mn = 0xffffffffu, mxv = 0u;
#pragma unroll
        for (int j = 0; j < NE; ++j) { mxv = max(mxv, k[q][j]); mn = min(mn, k[q][j] ? k[q][j] : 0xffffffffu); }
        lo[q] = wave_umin(mn); hx[q] = wave_umax(mxv) + 1u; clo[q] = n[q]; }
    const int accept = FINAL ? 256 : KEEP_MAX;
    for (int it = 0; it < 40; ++it) {
        unsigned mid[4]; int c[4]; bool any = false;
#pragma unroll
        for (int q = 0; q < 4; ++q) mid[q] = lo[q] + ((hx[q] - lo[q]) >> 1);
        {
            unsigned v = 0;
#pragma unroll
            for (int q = 0; q < 4; ++q) { unsigned cl = 0;
#pragma unroll
                for (int j = 0; j < NE; ++j) cl += (k[q][j] >= mid[q]) ? 1u : 0u;
                v |= cl << (8 * q); }
            v += (unsigned)__builtin_amdgcn_update_dpp(0, (int)v, 0xB1, 0xf, 0xf, false); v += (unsigned)__builtin_amdgcn_update_dpp(0, (int)v, 0x4E, 0xf, 0xf, false);
            v += (unsigned)__builtin_amdgcn_update_dpp(0, (int)v, 0x141, 0xf, 0xf, false); v += (unsigned)__builtin_amdgcn_update_dpp(0, (int)v, 0x140, 0xf, 0xf, false);
            unsigned ev = 0, od = 0;
#pragma unroll
            for (int r = 0; r < 4; ++r) { const unsigned x = (unsigned)__builtin_amdgcn_readlane((int)v, 16 * r); ev += x & 0x00ff00ffu; od += (x >> 8) & 0x00ff00ffu; }
            c[0] = (int)(ev & 0xffffu); c[2] = (int)(ev >> 16); c[1] = (int)(od & 0xffffu); c[3] = (int)(od >> 16);
        }
#pragma unroll
        for (int q = 0; q < 4; ++q) { const bool upd = (clo[q] > accept) && (hx[q] - lo[q] > 1u), ge = c[q] >= 256;
            lo[q] = (upd && ge) ? mid[q] : lo[q]; clo[q] = (upd && ge) ? c[q] : clo[q]; hx[q] = (upd && !ge) ? mid[q] : hx[q]; any = any || upd; }
        if (!any) break;
    }
#pragma unroll
    for (int q = 0; q < 4; ++q) {
        const unsigned Tk = lo[q];
        const bool ties = FINAL ? (clo[q] != 256) : (clo[q] > accept);
        int running = 0;
        if (!ties) {
#pragma unroll
            for (int j = 0; j < NE; ++j) {
                const bool take = k[q][j] >= Tk;
                const unsigned long long mt = __ballot(take);
                const int pos = running + prefix64(mt);
                if (FINAL) { LAS unsigned short* dst = take ? sel_out + q * 256 + pos : (LAS unsigned short*)trash + lane; *dst = (unsigned short)ix[q][j]; }
                else { const unsigned ixr = cb[(size_t)q * CAP + (lane + 64 * j < CAP ? lane + 64 * j : 0)].y; LAS u32x2* dst = take ? cb + (size_t)q * CAP + pos : trash + lane; *dst = (u32x2){__float_as_uint(ikey(k[q][j])), ixr}; }
                running += __popcll(mt);
            }
        } else {
            unsigned cg = 0, ixq[NE];
#pragma unroll
            for (int j = 0; j < NE; ++j) { cg += (k[q][j] > Tk) ? 1u : 0u; ixq[j] = FINAL ? ix[q][FINAL ? j : 0] : cb[(size_t)q * CAP + (lane + 64 * j < CAP ? lane + 64 * j : 0)].y; }
            const int r_eq = 256 - (int)wave_usum(cg); int eqrun = 0;
#pragma unroll
            for (int j = 0; j < NE; ++j) {
                const bool gt = k[q][j] > Tk, eq = (k[q][j] == Tk);
                const unsigned long long meq = __ballot(eq);
                const bool take = gt || (eq && (eqrun + prefix64(meq)) < r_eq);
                const unsigned long long mt = __ballot(take);
                const int pos = running + prefix64(mt);
                if (FINAL) { LAS unsigned short* dst = (take && pos < 256) ? sel_out + q * 256 + pos : (LAS unsigned short*)trash + lane; *dst = (unsigned short)ixq[j]; }
                else { LAS u32x2* dst = take ? cb + (size_t)q * CAP + pos : trash + lane; *dst = (u32x2){__float_as_uint(ikey(k[q][j])), ixq[j]}; }
                running += __popcll(mt); eqrun += __popcll(meq);
            }
        }
        tk[q] = Tk; n[q] = running;
    }
}
struct AttnArgs { const bf16* QA; const bf16* KA; const bf16* VA; const int* positions; bf16* OA; };
__device__ __forceinline__ void unit(int b, int g, const bf16* QI, const bf16* KI, const float* WI, const AttnArgs& AA, LAS unsigned char* lds, int variant) {
    const int q0 = g * 32, L = 64 * (q0 / 64 + 1);
    const int tid = threadIdx.x, lane = tid & 63, c = lane & 31, hi = lane >> 5; const int wid = __builtin_amdgcn_readfirstlane(tid >> 6);
    const size_t rowbase = (size_t)b * T; const int ntile = L / 64;
    LAS unsigned char* wreg = lds + L_CAND + (size_t)wid * (4 * CAP * 8);
    LAS unsigned short* selT = (LAS unsigned short*)wreg;
    if (L > 256) {
    bf16x8 Af[4];
    { const int r = c, jq = ((r >> 2) & 1) + 2 * (r >> 4), hd = (r & 3) + 4 * ((r >> 3) & 1);
      const bf16* qp = QI + (rowbase + q0 + 4 * wid + jq) * 512 + hd * 64 + 8 * hi;
#pragma unroll
      for (int s = 0; s < 4; ++s) Af[s] = *(const bf16x8*)(qp + 16 * s); }
    float wv[2][8];
#pragma unroll
    for (int u = 0; u < 2; ++u) { const float* wp = WI + (rowbase + q0 + 4 * wid + hi + 2 * u) * 8; const f32x4 a = *(const f32x4*)wp, bq = *(const f32x4*)(wp + 4);
#pragma unroll
        for (int i = 0; i < 4; ++i) { wv[u][i] = a[i] * (0.125f * 0.35355339059327373f); wv[u][4 + i] = bq[i] * (0.125f * 0.35355339059327373f); } }
    float tau[2] = {-INFINITY, -INFINITY}; int cnt[2] = {0, 0};
    LAS u32x2* cbase = (LAS u32x2*)(lds + L_CAND) + (size_t)(wid * 4) * CAP;
    LAS u32x2* trash = (LAS u32x2*)(lds + L_TRASH) + wid * 64;
    const bf16* kp = KI + (rowbase >> 5) * 2048 + (size_t)lane * 8;
    bf16x8 Ba[8], Bb[8];
#define IDX_LOAD(dst, tt) do { _Pragma("unroll") for (int i_ = 0; i_ < 8; ++i_) dst[i_] = *(const bf16x8*)(kp + (size_t)((2 * (tt) + (i_ >> 2)) * 4 + (i_ & 3)) * 512); } while (0)
#define IDX_TILE(Bf, tt) do { \
        f32x16 acc0, acc1; \
        _Pragma("unroll") for (int r_ = 0; r_ < 16; ++r_) { acc0[r_] = 0.f; acc1[r_] = 0.f; } \
        _Pragma("unroll") for (int s4 = 0; s4 < 4; ++s4) { acc0 = __builtin_amdgcn_mfma_f32_32x32x16_bf16(Af[s4], Bf[s4], acc0, 0, 0, 0); acc1 = __builtin_amdgcn_mfma_f32_32x32x16_bf16(Af[s4], Bf[4 + s4], acc1, 0, 0, 0); } \
        float sv[2][2]; \
        _Pragma("unroll") for (int u = 0; u < 2; ++u) { float a_ = 0.f, b_ = 0.f; \
            _Pragma("unroll") for (int i = 0; i < 8; ++i) { a_ = fmaf(__builtin_amdgcn_fmed3f(acc0[8 * u + i], 0.f, 3.0e38f), wv[u][i], a_); b_ = fmaf(__builtin_amdgcn_fmed3f(acc1[8 * u + i], 0.f, 3.0e38f), wv[u][i], b_); } \
            sv[u][0] = a_; sv[u][1] = b_; } \
        bool ps[2][2]; unsigned long long mk[2][2]; \
        _Pragma("unroll") for (int u = 0; u < 2; ++u) _Pragma("unroll") for (int kh = 0; kh < 2; ++kh) { ps[u][kh] = (sv[u][kh] > tau[u]) && !(variant & 2); mk[u][kh] = __ballot(ps[u][kh]); } \
        if ((mk[0][0] | mk[0][1] | mk[1][0] | mk[1][1]) != 0ull) { \
            _Pragma("unroll") for (int u = 0; u < 2; ++u) _Pragma("unroll") for (int kh = 0; kh < 2; ++kh) { \
                const unsigned mlo = (unsigned)mk[u][kh], mhi = (unsigned)(mk[u][kh] >> 32); \
                const int pre = (int)__builtin_amdgcn_mbcnt_hi(mhi, __builtin_amdgcn_mbcnt_lo(mlo, 0u)) - (hi ? __popc(mlo) : 0);     \
                LAS u32x2* dst = ps[u][kh] ? cbase + (size_t)(hi + 2 * u) * CAP + cnt[u] + pre : trash + lane; \
                *dst = (u32x2){__float_as_uint(sv[u][kh]), (unsigned)((tt) * 64 + kh * 32 + c)}; \
                cnt[u] += hi ? __popc(mhi) : __popc(mlo); } } \
    } while (0)
    IDX_LOAD(Ba, 0); IDX_LOAD(Bb, 1);
    for (int t = 0; t < ntile; t += 2) {
#define IDX_CHECK() do { const int n0 = __builtin_amdgcn_readlane(cnt[0], 0), n1 = __builtin_amdgcn_readlane(cnt[0], 32), n2 = __builtin_amdgcn_readlane(cnt[1], 0), n3 = __builtin_amdgcn_readlane(cnt[1], 32); \
          if (max(max(n0, n1), max(n2, n3)) > TRIG && !(variant & 1)) { int n4[4] = {n0, n1, n2, n3}; unsigned tk4[4]; \
            PROF_T0(1); select4<false>(cbase, n4, tk4, lane, (LAS unsigned short*)nullptr, trash); PROF_T1(1, lds, wid, lane); \
            cnt[0] = hi ? n4[1] : n4[0]; cnt[1] = hi ? n4[3] : n4[2]; tau[0] = ikey(hi ? tk4[1] : tk4[0]); tau[1] = ikey(hi ? tk4[3] : tk4[2]); } } while (0)
        IDX_CHECK();
        IDX_TILE(Ba, t);
        if (t + 2 < ntile) IDX_LOAD(Ba, t + 2);
        if (t + 1 < ntile) { IDX_CHECK(); IDX_TILE(Bb, t + 1); if (t + 3 < ntile) IDX_LOAD(Bb, t + 3); }
    }
#undef IDX_LOAD
#undef IDX_TILE
#undef IDX_CHECK
    asm volatile("s_waitcnt lgkmcnt(0)" ::: "memory");
    if (!(variant & 9)) { int n4[4] = {__builtin_amdgcn_readlane(cnt[0], 0), __builtin_amdgcn_readlane(cnt[0], 32), __builtin_amdgcn_readlane(cnt[1], 0), __builtin_amdgcn_readlane(cnt[1], 32)}; unsigned tk4[4];
      PROF_T0(2); select4<true>(cbase, n4, tk4, lane, selT, trash); PROF_T1(2, lds, wid, lane); }
    } else {
#pragma unroll
        for (int jq = 0; jq < 4; ++jq)
#pragma unroll
            for (int j = 0; j < 4; ++j) { const int k = lane + 64 * j; selT[jq * 256 + k] = (unsigned short)(k < L ? k : L - 1); }
    }
    asm volatile("s_waitcnt lgkmcnt(0)" ::: "memory");
    PROF_T0(8);
    for (int jq = 0; jq < 4; ++jq)
        dsa::query((int)(rowbase + q0 + 4 * wid + jq), AA.QA, AA.KA, AA.VA, AA.positions, AA.OA, wreg + 2048, selT + jq * 256, (LAS unsigned char*)((LAS u32x2*)(lds + L_TRASH) + wid * 64), (const LAS float*)(lds + L_BIAS), lane);
    PROF_T1(8, lds, wid, lane);
}
__device__ __forceinline__ void phase(int vcu, int G, const bf16* QI, const bf16* KI, const float* WI, const AttnArgs& AA, const float* rel_bias, LAS unsigned char* lds, int variant) {
    { LAS float* bt = (LAS float*)(lds + L_BIAS); for (int i = threadIdx.x; i < 33 * 8; i += NWAVES * 64) bt[i] = (i < 256) ? rel_bias[i] * dsa::LOG2E : -INFINITY; }
    __syncthreads();
    PROF_T0(7);
    const int wrot = 0, nun = (1024 - vcu + G - 1) / G;
    for (int ii = 0; ii < nun; ++ii) { const int u = vcu + ((ii + wrot) % nun) * G; const int i = u >> 8, v = u & 255, b = v >> 6, s = v & 63;
        const int g = (i == 0) ? s : (i == 1) ? 127 - s : (i == 2) ? 128 + s : 255 - s;
        unit(b, g, QI, KI, WI, AA, lds, variant); }
    PROF_T1(7, lds, (int)__builtin_amdgcn_readfirstlane(threadIdx.x >> 6), (int)(threadIdx.x & 63));
    __syncthreads();
}
}


struct PhaseTimer { unsigned long long t0; int k; LAS unsigned char* l; int w, ln; bool once;
    __device__ __forceinline__ PhaseTimer(int k_, LAS unsigned char* l_, int w_, int ln_) : t0(0), k(k_), l(l_), w(w_), ln(ln_), once(true) { if (PROF_SEL == 20 + k) t0 = __builtin_amdgcn_s_memrealtime(); }
    __device__ __forceinline__ void stop() { once = false; if (PROF_SEL == 20 + k) { const unsigned d = (unsigned)(__builtin_amdgcn_s_memrealtime() - t0); if (ln == 0) *PROF_WORD(l, w) += d; } } };
constexpr int NPHASE = 16;
__global__ void __launch_bounds__(NWAVES * 64, 2) mk_fwd(Args args) {
    extern __shared__ __attribute__((aligned(16))) unsigned char lds[];
    Frame F;
    F.lds = (LAS unsigned char*)lds;
    F.MISC = (volatile LAS unsigned*)(F.lds + MISC_OFF);
    F.tid = threadIdx.x; F.lane = F.tid & 63; F.wave = __builtin_amdgcn_readfirstlane(F.tid >> 6);
    F.G = gridDim.x; { const int bx = blockIdx.x; F.vcu = (F.G % 8 == 0) ? (bx % 8) * (F.G / 8) + bx / 8 : bx; }
    unsigned char* ws = args.ws;
    F.ctl = (gu32*)(ws + WS_CTL);
    for (int u = F.tid; u < (LDS_BYTES - LDSCTL_OFF) / 4; u += NWAVES * 64) ((LAS unsigned*)(F.lds + LDSCTL_OFF))[u] = 0u;
    __syncthreads();
    XcdBarrier bar; bar.bar = (unsigned*)(F.ctl + CW_BAR); bar.x = 0; bar.st = nullptr;
    if (MK_FUSED) bar = xcd_barrier_post((unsigned*)(F.ctl + CW_BAR), F.MISC + 8);
#define GRID_BAR() do { if (MK_FUSED) { PROF_T0(50); xcd_barrier(bar); PROF_T1(50, F.lds + RING_OFF, F.wave, F.lane); } } while (0)
    const int lo = args.ph_lo, hi = args.ph_hi;
#ifdef ONLY_PH
#define IN(k) ((k) == ONLY_PH && lo <= (k) && (k) < hi)
#else
#define IN(k) (lo <= (k) && (k) < hi)
#endif
#define BOTH(k) (IN(k) && IN((k) + 1))
#ifndef DUP_PH
#define DUP_PH -1
#endif
#ifndef P7_VARIANT
#define P7_VARIANT 0
#endif
#define PHASE_TIMED(k) for (PhaseTimer pt_((k), F.lds + RING_OFF, F.wave, F.lane); pt_.once; pt_.stop())
#define REP(k) for (int rep_ = 0; rep_ < ((k) == DUP_PH ? 2 : 1); ++rep_)
    const float* x = (const float*)args.in[0];
    const float* mod = (const float*)(ws + WS_MOD);
    bf16* XN = (bf16*)(ws + WS_XN); bf16* ACT = (bf16*)(ws + WS_ACT);
    float* X1 = args.out;
    const float* rcos = (const float*)(ws + WS_RCOS); const float* rsin = (const float*)(ws + WS_RSIN);
    float* ssq_q = (float*)(ws + WS_SSQQ); float* ssq_kv = (float*)(ws + WS_SSQKV);

    if (IN(0)) REP(0) PHASE_TIMED(0) { p0_prologue(F, args); if (BOTH(0)) GRID_BAR(); }
    if (IN(1)) REP(1) PHASE_TIMED(1) { norm_mod_phase(F, x, (const float*)args.in[5], mod, 0 * D, 1 * D, XN); if (BOTH(1)) GRID_BAR(); }
    if (IN(2)) REP(2) PHASE_TIMED(2) {
        pg8::Gemm g{XN, (const bf16*)(ws + WS_W1A), M, 2 * DFF, D}; pg8::StaticOrder S; S.init(M, 2 * DFF, F.G, (int)blockIdx.x);
        pg8::EpiSwiglu E{ACT, DFF};
        pg8::gemm_phase<pg8::EpiSwiglu, pg8::StaticOrder, true, true>(F.lds + RING_OFF, g, S, E);
        if (BOTH(2)) GRID_BAR(); }
    if (IN(3)) REP(3) PHASE_TIMED(3) {
        pg8::Gemm g{ACT, (const bf16*)(ws + WS_W1D), M, D, DFF}; pg8::StaticOrder S; S.init(M, D, F.G, (int)blockIdx.x);
        pg8::EpiResid E{x, X1, mod, 2 * D, 0.5f};
        pg8::gemm_phase<pg8::EpiResid, pg8::StaticOrder, true, true>(F.lds + RING_OFF, g, S, E);
        if (BOTH(3)) GRID_BAR(); }
    if (IN(4)) REP(4) PHASE_TIMED(4) { norm_mod_phase(F, X1, (const float*)args.in[8], mod, 3 * D, 4 * D, XN); if (BOTH(4)) GRID_BAR(); }
    if (IN(5)) REP(5) PHASE_TIMED(5) {
        pg8::Gemm g{XN, (const bf16*)(ws + WS_WIN), M, NPROJ, D}; pg8::StaticOrder S; S.init(M, NPROJ, F.G, (int)blockIdx.x);
        pg8::EpiProj E{(bf16*)(ws + WS_QA), (bf16*)(ws + WS_QI), (bf16*)(ws + WS_CQ), (bf16*)(ws + WS_CKV), (bf16*)(ws + WS_KA), (bf16*)(ws + WS_VA), (bf16*)(ws + WS_KI), (bf16*)(ws + WS_KPE), (bf16*)(ws + WS_G),
                       (float*)(ws + WS_WI), ssq_q, ssq_kv, rcos, rsin};
        pg8::gemm_phase<pg8::EpiProj, pg8::StaticOrder, true, true>(F.lds + RING_OFF, g, S, E);
        if (BOTH(5)) GRID_BAR(); }
    if (IN(6)) REP(6) PHASE_TIMED(6) {
        { pg8::Gemm g{(const bf16*)(ws + WS_CQ), (const bf16*)(ws + WS_WUQ), M, 768, 384}; pg8::StaticOrder S; S.init(M, 768, F.G, (int)blockIdx.x);
          pg8::EpiUpQ E{(bf16*)(ws + WS_QB), ssq_q, rcos, rsin};
          pg8::gemm_phase<pg8::EpiUpQ, pg8::StaticOrder, true, true>(F.lds + RING_OFF, g, S, E); }
        __syncthreads();
        { pg8::Gemm g{(const bf16*)(ws + WS_CKV), (const bf16*)(ws + WS_WUKV), M, 1024, 256}; pg8::StaticOrder S; S.init(M, 1024, F.G, (int)blockIdx.x);
          pg8::EpiUpKV E{(bf16*)(ws + WS_KN), (bf16*)(ws + WS_VB), ssq_kv};
          pg8::gemm_phase<pg8::EpiUpKV, pg8::StaticOrder, true, true>(F.lds + RING_OFF, g, S, E); }
        __syncthreads(); }
    if (IN(7)) REP(7) PHASE_TIMED(7) { const idx::AttnArgs AA{(const bf16*)(ws + WS_QA), (const bf16*)(ws + WS_KA), (const bf16*)(ws + WS_VA), (const int*)args.in[2], (bf16*)(ws + WS_OA)};
        idx::phase(F.vcu, F.G, (const bf16*)(ws + WS_QI), (const bf16*)(ws + WS_KI), (const float*)(ws + WS_WI), AA, (const float*)args.in[15], F.lds + RING_OFF, args.pad); if (BOTH(7)) GRID_BAR(); }
    if (IN(9)) REP(9) PHASE_TIMED(9) { mla::phase(F.vcu, F.G, (const bf16*)(ws + WS_QB), (const bf16*)(ws + WS_KN), (const bf16*)(ws + WS_KPE), (const bf16*)(ws + WS_VB), (bf16*)(ws + WS_OB), F.lds + RING_OFF); if (BOTH(9)) GRID_BAR(); }
    if (IN(10)) REP(10) PHASE_TIMED(10) {
        { pg8::Gemm g{(const bf16*)(ws + WS_OA), (const bf16*)(ws + WS_WOA), M, D, 512}; pg8::StaticOrder S; S.init(M, D, F.G, (int)blockIdx.x);
          pg8::EpiGate<false> E{(const bf16*)(ws + WS_G), 0, nullptr, (bf16*)(ws + WS_Y1)};
          pg8::gemm_phase<pg8::EpiGate<false>, pg8::StaticOrder, true, true>(F.lds + RING_OFF, g, S, E); }
        VM_WAIT(); __syncthreads();
        { pg8::Gemm g{(const bf16*)(ws + WS_OB), (const bf16*)(ws + WS_WOB), M, D, 512}; pg8::StaticOrder S; S.init(M, D, F.G, (int)blockIdx.x);
          pg8::EpiGate<true> E{(const bf16*)(ws + WS_G), 1024, (const bf16*)(ws + WS_Y1), (bf16*)(ws + WS_Y)};
          pg8::gemm_phase<pg8::EpiGate<true>, pg8::StaticOrder, true, true>(F.lds + RING_OFF, g, S, E); }
        if (BOTH(10)) GRID_BAR(); }
    if (IN(11)) PHASE_TIMED(11) {
        pg8::Gemm g{(const bf16*)(ws + WS_Y), (const bf16*)(ws + WS_WOUT), M, D, D}; pg8::StaticOrder S; S.init(M, D, F.G, (int)blockIdx.x);
        pg8::EpiResid E{X1, X1, mod, 5 * D, 1.0f};
        pg8::gemm_phase<pg8::EpiResid, pg8::StaticOrder, true, true>(F.lds + RING_OFF, g, S, E);
        if (BOTH(11)) GRID_BAR(); }
    if (IN(12)) REP(12) PHASE_TIMED(12) { norm_mod_phase(F, X1, (const float*)args.in[19], mod, 6 * D, 7 * D, XN); if (BOTH(12)) GRID_BAR(); }
    if (IN(13)) REP(13) PHASE_TIMED(13) {
        pg8::Gemm g{XN, (const bf16*)(ws + WS_W2A), M, 2 * DFF, D}; pg8::StaticOrder S; S.init(M, 2 * DFF, F.G, (int)blockIdx.x);
        pg8::EpiSwiglu E{ACT, DFF};
        pg8::gemm_phase<pg8::EpiSwiglu, pg8::StaticOrder, true, true>(F.lds + RING_OFF, g, S, E);
        if (BOTH(13)) GRID_BAR(); }
    if (IN(14)) PHASE_TIMED(14) {
        pg8::Gemm g{ACT, (const bf16*)(ws + WS_W2D), M, D, DFF}; pg8::StaticOrder S; S.init(M, D, F.G, (int)blockIdx.x);
        pg8::EpiResid E{X1, X1, mod, 8 * D, 0.5f};
        pg8::gemm_phase<pg8::EpiResid, pg8::StaticOrder, true, true>(F.lds + RING_OFF, g, S, E);
        if (BOTH(14)) GRID_BAR(); }
    if (IN(15)) PHASE_TIMED(15) { final_norm_phase(F, X1, (const float*)args.in[22], args.out); }
    if (PROF_SEL != 0) { asm volatile("s_waitcnt lgkmcnt(0)" ::: "memory"); const unsigned a_ = *PROF_WORD(F.lds + RING_OFF, F.wave); const unsigned long long t0_ = __builtin_amdgcn_s_memrealtime();
        while (__builtin_amdgcn_s_memrealtime() - t0_ < (unsigned long long)a_ * PROF_MULT) __builtin_amdgcn_s_sleep(32); }
#undef IN
#undef BOTH
}

extern "C" void kernel_launch(void* const* d_in, const int* in_sizes, int n_in, void* d_out, int out_size, void* d_ws, size_t ws_size, hipStream_t stream) {
    static int grid = 0;
    if (grid == 0) {
        if (n_in != 23 || out_size != M * D || ws_size < WS_END + 4096) { fprintf(stderr, "kernel_launch: unexpected problem shape (n_in %d, out %d, ws %zu)\n", n_in, out_size, ws_size); grid = -1; return; }
        int dev = 0, cus = 0, per_cu = 0;
        if (hipGetDevice(&dev) != hipSuccess || hipDeviceGetAttribute(&cus, hipDeviceAttributeMultiprocessorCount, dev) != hipSuccess) { grid = -1; return; }
        if (hipFuncSetAttribute((const void*)mk_fwd, hipFuncAttributeMaxDynamicSharedMemorySize, LDS_BYTES) != hipSuccess) { fprintf(stderr, "kernel_launch: hipFuncSetAttribute failed\n"); grid = -1; return; }
        if (hipOccupancyMaxActiveBlocksPerMultiprocessor(&per_cu, (const void*)mk_fwd, NWAVES * 64, LDS_BYTES) != hipSuccess || per_cu < 1) fprintf(stderr, "kernel_launch: occupancy query reports %d\n", per_cu);
        (void)hipGetLastError();
        grid = cus;
    }
    if (grid < 0) return;
    (void)in_sizes;
    if (hipMemsetAsync((char*)d_ws + WS_CTL, 0, CTL_ZERO_BYTES, stream) != hipSuccess) return;
    Args a{};
    for (int i = 0; i < 23; ++i) a.in[i] = d_in[i];
    a.out = (float*)d_out; a.ws = (unsigned char*)d_ws;
    auto launch = [&](int lo, int hi) { a.ph_lo = lo; a.ph_hi = hi; a.li = 0; hipLaunchKernelGGL(mk_fwd, dim3(grid), dim3(NWAVES * 64), LDS_BYTES, stream, a); };
#if MK_FUSED
    launch(0, NPHASE);
#else
    for (int p = 0; p < NPHASE; ++p) launch(p, p + 1);
#endif
}
```

```cpp
#include <hip/hip_runtime.h>
#include <cstdio>
#include <cstdint>
namespace pg8 {
#define PG8_LAS __attribute__((address_space(3)))
typedef unsigned short bf16_t;
typedef short bf16x8 __attribute__((ext_vector_type(8)));
typedef float f32x4 __attribute__((ext_vector_type(4)));
typedef unsigned u32x4 __attribute__((ext_vector_type(4)));
constexpr int BM = 256, BK = 64, HALF = 128, HTB = HALF * BK * 2  , STAGE_BYTES = 8 * HTB, NXCD = 8, WGM = 8;

__host__ __device__ __forceinline__ int lds_byte(int r, int c) { const int st = (r >> 4) * 2 + (c >> 5), rr = r & 15, cc = c & 31, ob = rr * 64 + cc * 2; return st * 1024 + (ob ^ (((ob >> 9) & 1) << 5)); }
__host__ __device__ __forceinline__ void stage_rc(int b, int& R, int& C) { const int st = b / 1024, sb = b % 1024, swz = sb ^ (((sb >> 9) & 1) << 5); R = (st >> 1) * 16 + swz / 64; C = (st & 1) * 32 + (swz % 64) / 2; }
__host__ __device__ __forceinline__ int perm32(int rho) { const int n = rho >> 4, i = rho & 15; return 8 * (i >> 2) + 4 * n + (i & 3); }

struct Unit { int pm, pn; };
struct Gemm { const bf16_t* A; const bf16_t* Bt; int M, N, K; };

struct StaticOrder {
    int nM, nN, nwg, G, c;
    __host__ __device__ void init(int M, int N, int G_, int c_) { nM = M / BM; nN = N / BM; nwg = nM * nN; G = G_; c = c_; }
    __host__ __device__ bool next(int i, Unit& u) const {
        const long L = (long)i * G + c; if (L >= nwg) return false;
        int wgid = (int)L; { const int q = nwg / NXCD, r = nwg % NXCD, xcd = wgid % NXCD, off = wgid / NXCD; wgid = (xcd < r ? xcd * (q + 1) : r * (q + 1) + (xcd - r) * q) + off; }
        const int nig = WGM * nN, gid = wgid / nig, fm = gid * WGM, gsz = (nM - fm) < WGM ? (nM - fm) : WGM;
        u.pm = fm + ((wgid % nig) % gsz); u.pn = (wgid % nig) / gsz; return true;
    }
    __device__ __forceinline__ void a_ready(const Unit&) const {}
    __device__ __forceinline__ void done(const Unit&) const {}
};

typedef float f32x2 __attribute__((ext_vector_type(2)));
typedef __bf16 bf16x2_cv __attribute__((ext_vector_type(2)));
__device__ __forceinline__ unsigned cvt_pk_bf16(float lo, float hi) { const f32x2 v = {lo, hi}; const bf16x2_cv b = __builtin_convertvector(v, bf16x2_cv); return __builtin_bit_cast(unsigned, b); }

__device__ __forceinline__ u32x4 pack8(const f32x4 a, const f32x4 b) { u32x4 w; w.x = cvt_pk_bf16(a[0], a[1]); w.y = cvt_pk_bf16(a[2], a[3]); w.z = cvt_pk_bf16(b[0], b[1]); w.w = cvt_pk_bf16(b[2], b[3]); return w; }
__device__ __forceinline__ float sigm(float v) { return __builtin_amdgcn_rcpf(1.f + __builtin_amdgcn_exp2f(-1.4426950408889634f * v)); }
__device__ __forceinline__ f32x4 sigm4(const f32x4 v) { return (f32x4){sigm(v[0]), sigm(v[1]), sigm(v[2]), sigm(v[3])}; }
__device__ __forceinline__ void unpack8(const u32x4 w, f32x4& a, f32x4& b) {
    a = (f32x4){__uint_as_float(w.x << 16), __uint_as_float(w.x & 0xffff0000u), __uint_as_float(w.y << 16), __uint_as_float(w.y & 0xffff0000u)};
    b = (f32x4){__uint_as_float(w.z << 16), __uint_as_float(w.z & 0xffff0000u), __uint_as_float(w.w << 16), __uint_as_float(w.w & 0xffff0000u)}; }
constexpr float EPS_RMS = 1e-6f;
constexpr float QSCALE = 0.10206207261596575f * 1.4426950408889634f;

struct EpiSwiglu {
    static constexpr bool PERM = true, AFTER_DRAIN = false; static constexpr int MID_T = 0;
    bf16_t* O; int ldc;
    __device__ __forceinline__ void operator()(const f32x4 (&acc)[2][2][4][2], const Unit& u, int wr, int wc, int fr, int fq) const {
        const int row0 = u.pm * BM + wr * 64 + fr, col0 = u.pn * HALF + wc * 32 + 8 * fq;
#pragma unroll
        for (int ai = 0; ai < 2; ++ai)
#pragma unroll
            for (int m = 0; m < 4; ++m) {
                const f32x4 g0 = acc[ai][0][m][0], g1 = acc[ai][0][m][1], u0 = acc[ai][1][m][0], u1 = acc[ai][1][m][1];
                const f32x4 v0 = g0 * sigm4(g0) * u0, v1 = g1 * sigm4(g1) * u1;
                *(u32x4*)(O + (size_t)(row0 + ai * HALF + m * 16) * ldc + col0) = pack8(v0, v1); }
    }
};
struct EpiResid {
    static constexpr bool PERM = false, AFTER_DRAIN = false; static constexpr int MID_T = 0;
    const float* base; float* out; const float* mod; int goff; float scale;
    __device__ __forceinline__ void operator()(const f32x4 (&acc)[2][2][4][2], const Unit& u, int wr, int wc, int fr, int fq) const {
        const float* gate = mod + (u.pm >> 5) * 9216 + goff;
        const int col0 = u.pn * BM + wc * 32 + 4 * fq;
        f32x4 gv[2][2];
#pragma unroll
        for (int bj = 0; bj < 2; ++bj)
#pragma unroll
            for (int n = 0; n < 2; ++n) gv[bj][n] = *(const f32x4*)(gate + col0 + bj * HALF + n * 16) * scale;
#pragma unroll
        for (int ai = 0; ai < 2; ++ai)
#pragma unroll
            for (int m = 0; m < 4; ++m) { const size_t off = (size_t)(u.pm * BM + ai * HALF + wr * 64 + m * 16 + fr) * 1024 + col0;
#pragma unroll
                for (int bj = 0; bj < 2; ++bj)
#pragma unroll
                    for (int n = 0; n < 2; ++n) { const f32x4 bs = *(const f32x4*)(base + off + bj * HALF + n * 16); *(f32x4*)(out + off + bj * HALF + n * 16) = bs + gv[bj][n] * acc[ai][bj][m][n]; } }
    }
};
template <bool BASE_BF16> struct EpiResidB {
    static constexpr bool PERM = true, AFTER_DRAIN = false; static constexpr int MID_T = 0;
    const void* base; bf16_t* out; const float* mod; int goff; float scale;
    __device__ __forceinline__ void operator()(const f32x4 (&acc)[2][2][4][2], const Unit& u, int wr, int wc, int fr, int fq) const {
        const float* gate = mod + (u.pm >> 5) * 9216 + goff;
        const int col0 = u.pn * BM + wc * 32 + 8 * fq;
        f32x4 gv[2][2];
#pragma unroll
        for (int bj = 0; bj < 2; ++bj)
#pragma unroll
            for (int n = 0; n < 2; ++n) gv[bj][n] = *(const f32x4*)(gate + col0 + bj * HALF + n * 4) * scale;
#pragma unroll
        for (int ai = 0; ai < 2; ++ai)
#pragma unroll
            for (int m = 0; m < 4; ++m) { const size_t off = (size_t)(u.pm * BM + ai * HALF + wr * 64 + m * 16 + fr) * 1024 + col0;
#pragma unroll
                for (int bj = 0; bj < 2; ++bj) { f32x4 b0, b1;
                    if (BASE_BF16) { const u32x4 w = *(const u32x4*)((const bf16_t*)base + off + bj * HALF); unpack8(w, b0, b1); }
                    else { b0 = *(const f32x4*)((const float*)base + off + bj * HALF); b1 = *(const f32x4*)((const float*)base + off + bj * HALF + 4); }
                    *(u32x4*)(out + off + bj * HALF) = pack8(b0 + gv[bj][0] * acc[ai][bj][m][0], b1 + gv[bj][1] * acc[ai][bj][m][1]); } }
    }
};
struct EpiProj {
    static constexpr bool PERM = true, AFTER_DRAIN = false; static constexpr int MID_T = 0;
    bf16_t *QA, *QI, *CQ, *CKV, *KA, *VA, *KI, *KPE, *G; float *WI, *ssq_q, *ssq_kv; const float *rcos, *rsin;
    __device__ __forceinline__ void operator()(const f32x4 (&acc)[2][2][4][2], const Unit& u, int wr, int wc, int fr, int fq) const {
        const int row0 = u.pm * BM + wr * 64 + fr, pn = u.pn, c32 = wc * 32 + 8 * fq;
#pragma unroll
        for (int ai = 0; ai < 2; ++ai)
#pragma unroll
            for (int m = 0; m < 4; ++m) {
                const size_t r = (size_t)(row0 + ai * HALF + m * 16);
                const f32x4 a0 = acc[ai][0][m][0], a1 = acc[ai][0][m][1], b0 = acc[ai][1][m][0], b1 = acc[ai][1][m][1];
                const float sa = (a0[0] * a0[0] + a0[1] * a0[1]) + (a0[2] * a0[2] + a0[3] * a0[3]) + (a1[0] * a1[0] + a1[1] * a1[1]) + (a1[2] * a1[2] + a1[3] * a1[3]);
                const float sb = (b0[0] * b0[0] + b0[1] * b0[1]) + (b0[2] * b0[2] + b0[3] * b0[3]) + (b1[0] * b1[0] + b1[1] * b1[1]) + (b1[2] * b1[2] + b1[3] * b1[3]);
                if (pn < 2) { bf16_t* p = QA + r * 512 + pn * 256 + c32; *(u32x4*)p = pack8(a0, a1); *(u32x4*)(p + HALF) = pack8(b0, b1); }
                else if (pn < 4) { bf16_t* p = QI + r * 512 + (pn - 2) * 256 + c32; *(u32x4*)p = pack8(a0, a1); *(u32x4*)(p + HALF) = pack8(b0, b1); }
                else if (pn == 4) { bf16_t* p = CQ + r * 384 + c32; *(u32x4*)p = pack8(a0, a1); *(u32x4*)(p + HALF) = pack8(b0, b1);
                    float s = sa + sb; s += __shfl_xor(s, 16); s += __shfl_xor(s, 32); if (fq == 0) ssq_q[r * 8 + wc] = s; }
                else if (pn == 5) { *(u32x4*)(CQ + r * 384 + 256 + c32) = pack8(a0, a1); *(u32x4*)(CKV + r * 256 + c32) = pack8(b0, b1);
                    float s = sa; s += __shfl_xor(s, 16); s += __shfl_xor(s, 32); float t = sb; t += __shfl_xor(t, 16); t += __shfl_xor(t, 32);
                    if (fq == 0) { ssq_q[r * 8 + 4 + wc] = s; ssq_kv[r * 8 + wc] = t; } }
                else if (pn == 6) { *(u32x4*)(CKV + r * 256 + 128 + c32) = pack8(a0, a1);
                    float s = sa; s += __shfl_xor(s, 16); s += __shfl_xor(s, 32); if (fq == 0) ssq_kv[r * 8 + 4 + wc] = s;
                    if (wc < 2) *(u32x4*)(KA + r * 64 + c32) = pack8(b0, b1); else *(u32x4*)(VA + r * 64 + (c32 - 64)) = pack8(b0, b1); }
                else if (pn == 7) {
                    if (wc < 2) { const int ch = 4 * wc + fq;
                        *(u32x4*)(KI + ((r >> 5) * 4 + (ch >> 1)) * 512 + (ch & 1) * 256 + (r & 31) * 8) = pack8(a0, a1); }
                    else if (wc == 2) {
                        const f32x4 c4 = *(const f32x4*)(rcos + r * 16 + 4 * fq), s4 = *(const f32x4*)(rsin + r * 16 + 4 * fq);
                        const f32x4 o0 = (f32x4){a0[0] * c4[0] - a0[1] * s4[0], a0[1] * c4[0] + a0[0] * s4[0], a0[2] * c4[1] - a0[3] * s4[1], a0[3] * c4[1] + a0[2] * s4[1]};
                        const f32x4 o1 = (f32x4){a1[0] * c4[2] - a1[1] * s4[2], a1[1] * c4[2] + a1[0] * s4[2], a1[2] * c4[3] - a1[3] * s4[3], a1[3] * c4[3] + a1[2] * s4[3]};
                        *(u32x4*)(KPE + r * 32 + 8 * fq) = pack8(o0, o1); }
                    else if (fq == 0) { *(f32x4*)(WI + r * 8) = a0; *(f32x4*)(WI + r * 8 + 4) = a1; }
                }
                else {
                    f32x4 ra[2], gb[2];
#pragma unroll
                    for (int h = 0; h < 2; ++h) { const f32x4 av = h ? a1 : a0, bv = h ? b1 : b0;
#pragma unroll
                        for (int e = 0; e < 4; ++e) { const float ea = __builtin_amdgcn_exp2f(-1.4426950408889634f * av[e]), eb = __builtin_fminf(__builtin_amdgcn_exp2f(-1.4426950408889634f * bv[e]), 1.1529215e18f);
                            gb[h][e] = __builtin_amdgcn_rcpf(1.f + eb); ra[h][e] = (1.f + eb) * __builtin_amdgcn_rcpf(1.f + ea); } }
                    bf16_t* p = G + r * 2048 + (pn - 8) * 128 + c32; *(u32x4*)p = pack8(ra[0], ra[1]); *(u32x4*)(p + 1024) = pack8(gb[0], gb[1]); }
            }
    }
};
struct EpiUpQ {
    static constexpr bool PERM = true, AFTER_DRAIN = false; static constexpr int MID_T = 0;
    bf16_t* QB; const float* ssq; const float *rcos, *rsin;
    __device__ __forceinline__ void operator()(const f32x4 (&acc)[2][2][4][2], const Unit& u, int wr, int wc, int fr, int fq) const {
        const int row0 = u.pm * BM + wr * 64 + fr;
#pragma unroll
        for (int ai = 0; ai < 2; ++ai)
#pragma unroll
            for (int m = 0; m < 4; ++m) {
                const size_t r = (size_t)(row0 + ai * HALF + m * 16);
                const f32x4 pa = *(const f32x4*)(ssq + r * 8), pb = *(const f32x4*)(ssq + r * 8 + 4);
                const float rs = __builtin_amdgcn_rsqf((((pa[0] + pa[1]) + (pa[2] + pa[3])) + ((pb[0] + pb[1]) + (pb[2] + pb[3]))) * (1.f / 384.f) + EPS_RMS) * QSCALE;
#pragma unroll
                for (int bj = 0; bj < 2; ++bj) {
                    const int c = u.pn * BM + bj * HALF + wc * 32 + 8 * fq;
                    const bool pe = ((u.pn * 8 + bj * 4 + wc) % 3) == 2;
                    f32x4 v0 = acc[ai][bj][m][0] * rs, v1 = acc[ai][bj][m][1] * rs;
                    if (pe) { const int i0 = 4 * fq;
                        const f32x4 c4 = *(const f32x4*)(rcos + r * 16 + i0), s4 = *(const f32x4*)(rsin + r * 16 + i0);
                        const f32x4 o0 = (f32x4){v0[0] * c4[0] - v0[1] * s4[0], v0[1] * c4[0] + v0[0] * s4[0], v0[2] * c4[1] - v0[3] * s4[1], v0[3] * c4[1] + v0[2] * s4[1]};
                        const f32x4 o1 = (f32x4){v1[0] * c4[2] - v1[1] * s4[2], v1[1] * c4[2] + v1[0] * s4[2], v1[2] * c4[3] - v1[3] * s4[3], v1[3] * c4[3] + v1[2] * s4[3]};
                        v0 = o0; v1 = o1; }
                    *(u32x4*)(QB + r * 768 + c) = pack8(v0, v1); }
                asm volatile("" ::: "memory"); }
    }
};
struct EpiUpKV {
    static constexpr bool PERM = true, AFTER_DRAIN = false; static constexpr int MID_T = 0;
    bf16_t *KN, *VB; const float* ssq;
    __device__ __forceinline__ void operator()(const f32x4 (&acc)[2][2][4][2], const Unit& u, int wr, int wc, int fr, int fq) const {
        const int row0 = u.pm * BM + wr * 64 + fr; bf16_t* dst = (u.pn < 2) ? KN : VB; const int c0 = (u.pn & 1) * BM + wc * 32 + 8 * fq;
#pragma unroll
        for (int ai = 0; ai < 2; ++ai)
#pragma unroll
            for (int m = 0; m < 4; ++m) {
                const size_t r = (size_t)(row0 + ai * HALF + m * 16);
                const f32x4 pa = *(const f32x4*)(ssq + r * 8), pb = *(const f32x4*)(ssq + r * 8 + 4);
                const float rs = __builtin_amdgcn_rsqf((((pa[0] + pa[1]) + (pa[2] + pa[3])) + ((pb[0] + pb[1]) + (pb[2] + pb[3]))) * (1.f / 256.f) + EPS_RMS);
#pragma unroll
                for (int bj = 0; bj < 2; ++bj) *(u32x4*)(dst + r * 512 + c0 + bj * HALF) = pack8(acc[ai][bj][m][0] * rs, acc[ai][bj][m][1] * rs);
                asm volatile("" ::: "memory"); }
    }
};
template <bool ADD> struct EpiGate {
    static constexpr bool PERM = true, AFTER_DRAIN = false; static constexpr int MID_T = 0;
    const bf16_t* G; int goff; const bf16_t* Yin; bf16_t* Y;
    __device__ __forceinline__ void operator()(const f32x4 (&acc)[2][2][4][2], const Unit& u, int wr, int wc, int fr, int fq) const {
        const int row0 = u.pm * BM + wr * 64 + fr, c0 = u.pn * BM + wc * 32 + 8 * fq;
#pragma unroll
        for (int ai = 0; ai < 2; ++ai)
#pragma unroll
            for (int m = 0; m < 4; ++m) {
                const size_t r = (size_t)(row0 + ai * HALF + m * 16);
#pragma unroll
                for (int bj = 0; bj < 2; ++bj) { const int c = c0 + bj * HALF;
                    f32x4 g0, g1; unpack8(*(const u32x4*)(G + r * 2048 + goff + c), g0, g1);
                    f32x4 v0 = g0 * acc[ai][bj][m][0], v1 = g1 * acc[ai][bj][m][1];
                    if (ADD) { f32x4 y0, y1; unpack8(*(const u32x4*)(Yin + r * 1024 + c), y0, y1); v0 += y0; v1 += y1; }
                    *(u32x4*)(Y + r * 1024 + c) = pack8(v0, v1); } }
    }
};
struct EpiGateR {
    static constexpr bool PERM = true, AFTER_DRAIN = false; static constexpr int MID_T = 8;
    const bf16_t* G; bf16_t* Y;
    __device__ __forceinline__ void mid(f32x4 (&acc)[2][2][4][2], const Unit& u, int wr, int wc, int fr, int fq) const {
        int opq = 0; asm volatile("" : "+v"(opq));
        const int row0 = u.pm * BM + wr * 64 + fr + opq, c0 = u.pn * BM + wc * 32 + 8 * fq;
#pragma unroll
        for (int ai = 0; ai < 2; ++ai) {
            u32x4 w[4][2];
#pragma unroll
            for (int m = 0; m < 4; ++m)
#pragma unroll
                for (int bj = 0; bj < 2; ++bj) w[m][bj] = *(const u32x4*)(G + (size_t)(row0 + ai * HALF + m * 16) * 2048 + c0 + bj * HALF);
#pragma unroll
            for (int m = 0; m < 4; ++m)
#pragma unroll
                for (int bj = 0; bj < 2; ++bj) { f32x4 r0, r1; unpack8(w[m][bj], r0, r1); acc[ai][bj][m][0] *= r0; acc[ai][bj][m][1] *= r1; }
            __builtin_amdgcn_sched_barrier(0);
        }
    }
    __device__ __forceinline__ void operator()(const f32x4 (&acc)[2][2][4][2], const Unit& u, int wr, int wc, int fr, int fq) const {
        const int row0 = u.pm * BM + wr * 64 + fr, c0 = u.pn * BM + wc * 32 + 8 * fq;
#pragma unroll
        for (int ai = 0; ai < 2; ++ai)
#pragma unroll
            for (int m = 0; m < 4; ++m) { const size_t r = (size_t)(row0 + ai * HALF + m * 16);
#pragma unroll
                for (int bj = 0; bj < 2; ++bj) { const int c = c0 + bj * HALF; f32x4 g0, g1; unpack8(*(const u32x4*)(G + r * 2048 + 1024 + c), g0, g1);
                    *(u32x4*)(Y + r * 1024 + c) = pack8(g0 * acc[ai][bj][m][0], g1 * acc[ai][bj][m][1]); } }
    }
};

template <class Epi, class Sched, bool ALIGN_EPI = false, bool SP2 = false>
__device__ __forceinline__ void gemm_phase(PG8_LAS unsigned char* lds, const Gemm g, const Sched& S, const Epi& E) {
    const int tid = threadIdx.x, wid = __builtin_amdgcn_readfirstlane(tid >> 6), lane = tid & 63, wr = wid >> 2, wc = wid & 3, fr = lane & 15, fq = lane >> 4;
    const int K = g.K, nt = K / BK;
    unsigned voffA[2], voffB[2];
#pragma unroll
    for (int i = 0; i < 2; ++i) { int R, C; stage_rc(tid * 16 + i * 8192, R, C); const int Rb = Epi::PERM ? ((R & ~31) + perm32(R & 31)) : R;
        voffA[i] = (unsigned)(R * K + C) * 2u; voffB[i] = (unsigned)(Rb * K + C) * 2u; }
    const size_t kstep = (size_t)(BK * 2);
    const size_t hstep = (size_t)HALF * K * 2;
    const size_t tstep = 2 * hstep;
    const unsigned ldsw = (unsigned)wid * 1024u;
    const int aoff = lds_byte(wr * 64 + fr, fq * 8), boff = lds_byte(wc * 32 + fr, fq * 8);
#define PG8_SA(b, h) (((b) * 2 + (h)) * HTB)
#define PG8_SB(b, h) ((4 + (b) * 2 + (h)) * HTB)
#define PG8_STAGE(bufoff, gbase, voff) do { _Pragma("unroll") for (int _i = 0; _i < 2; ++_i) \
        __builtin_amdgcn_global_load_lds((const unsigned*)((const char*)(gbase) + (voff)[_i]), (PG8_LAS unsigned*)(lds + (bufoff) + ldsw + _i * 8192), 16, 0, 0); } while (0)
#define PG8_LDA(dst, b, h) do { _Pragma("unroll") for (int m = 0; m < 4; ++m) _Pragma("unroll") for (int k = 0; k < 2; ++k) dst[m][k] = *(const PG8_LAS bf16x8*)(lds + PG8_SA(b, h) + aoff + m * 2048 + k * 1024); } while (0)
#define PG8_LDB(dst, b, h) do { _Pragma("unroll") for (int n = 0; n < 2; ++n) _Pragma("unroll") for (int k = 0; k < 2; ++k) dst[n][k] = *(const PG8_LAS bf16x8*)(lds + PG8_SB(b, h) + boff + n * 2048 + k * 1024); } while (0)
#define PG8_MMA(ai, bj, At, Bt) do { __builtin_amdgcn_s_setprio(1); _Pragma("unroll") for (int m = 0; m < 4; ++m) _Pragma("unroll") for (int n = 0; n < 2; ++n) _Pragma("unroll") for (int k = 0; k < 2; ++k) \
        acc[ai][bj][m][n] = __builtin_amdgcn_mfma_f32_16x16x32_bf16(Bt[n][k], At[m][k], acc[ai][bj][m][n], 0, 0, 0); __builtin_amdgcn_s_setprio(0); } while (0)
#define PG8_WAIT_V(n) asm volatile("s_waitcnt vmcnt(" #n ")" ::: "memory")
#define PG8_WAIT_L(n) asm volatile("s_waitcnt lgkmcnt(" #n ")" ::: "memory")
#define PG8_BAR __builtin_amdgcn_s_barrier()
#define PG8_SCHED __builtin_amdgcn_sched_barrier(0)
    Unit cur, nxt; int ui = 0;
    if (!S.next(0, cur)) return;
    f32x4 acc[2][2][4][2];
#pragma unroll
    for (int a = 0; a < 2; ++a)
#pragma unroll
        for (int b = 0; b < 2; ++b)
#pragma unroll
            for (int m = 0; m < 4; ++m)
#pragma unroll
                for (int n = 0; n < 2; ++n) acc[a][b][m][n] = (f32x4){0.f, 0.f, 0.f, 0.f};
    bf16x8 At[4][2], B0[2][2], B1[2][2];
    const char* cA = (const char*)g.A + (size_t)cur.pm * tstep; const char* cB = (const char*)g.Bt + (size_t)cur.pn * tstep;
    S.a_ready(cur);
    if constexpr (SP2) {
        PG8_STAGE(PG8_SB(0, 0), cB, voffB); PG8_STAGE(PG8_SB(0, 1), cB + hstep, voffB); PG8_STAGE(PG8_SA(0, 0), cA, voffA); PG8_STAGE(PG8_SA(0, 1), cA + hstep, voffA);
        if (wr == 1) PG8_BAR;
        PG8_WAIT_V(2); PG8_BAR;
        PG8_STAGE(PG8_SB(1, 0), cB + kstep, voffB); PG8_STAGE(PG8_SA(1, 0), cA + kstep, voffA); PG8_STAGE(PG8_SB(1, 1), cB + hstep + kstep, voffB);
        PG8_WAIT_V(6); PG8_BAR;
    } else {
        PG8_STAGE(PG8_SB(0, 0), cB, voffB); PG8_STAGE(PG8_SA(0, 0), cA, voffA); PG8_STAGE(PG8_SB(0, 1), cB + hstep, voffB); PG8_STAGE(PG8_SA(0, 1), cA + hstep, voffA);
        if (wr == 1) PG8_BAR;
        PG8_WAIT_V(4); PG8_BAR;
        PG8_STAGE(PG8_SB(1, 0), cB + kstep, voffB); PG8_STAGE(PG8_SA(1, 0), cA + kstep, voffA); PG8_STAGE(PG8_SB(1, 1), cB + hstep + kstep, voffB);
        PG8_WAIT_V(6); PG8_BAR;
    }
    for (;;) {
        const bool has_next = S.next(ui + 1, nxt);
        const char* nA = has_next ? (const char*)g.A + (size_t)nxt.pm * tstep : cA; const char* nB = has_next ? (const char*)g.Bt + (size_t)nxt.pn * tstep : cB;
#pragma nounroll
        for (int t = 0; t < nt; t += 2) {
            if constexpr (Epi::MID_T > 0) { if (t == Epi::MID_T) E.mid(acc, cur, wr, wc, fr, fq); }
            const bool last = (t == nt - 2);
            const char* a1 = cA + (size_t)(t + 1) * kstep;
            const char* a2 = last ? nA : cA + (size_t)(t + 2) * kstep; const char* b2 = last ? nB : cB + (size_t)(t + 2) * kstep;
            const char* a3 = a2 + kstep; const char* b3 = b2 + kstep;
            if (last && has_next) S.a_ready(nxt);
            if constexpr (SP2) {
            PG8_LDB(B0, 0, 0); PG8_LDB(B1, 0, 1); PG8_SCHED; PG8_LDA(At, 0, 0); PG8_STAGE(PG8_SA(1, 1), a1 + hstep, voffA);
            PG8_WAIT_V(8); PG8_WAIT_L(0); PG8_BAR; PG8_MMA(0, 0, At, B0); PG8_MMA(0, 1, At, B1); PG8_BAR; PG8_SCHED;
            PG8_LDA(At, 0, 1); PG8_STAGE(PG8_SB(0, 0), b2, voffB); PG8_STAGE(PG8_SB(0, 1), b2 + hstep, voffB); PG8_STAGE(PG8_SA(0, 0), a2, voffA);
            PG8_WAIT_V(8); PG8_WAIT_L(0); PG8_BAR; PG8_MMA(1, 0, At, B0); PG8_MMA(1, 1, At, B1); PG8_BAR; PG8_SCHED;
            PG8_LDB(B0, 1, 0); PG8_LDB(B1, 1, 1); PG8_SCHED; PG8_LDA(At, 1, 0); PG8_STAGE(PG8_SA(0, 1), a2 + hstep, voffA);
            PG8_WAIT_V(8); PG8_WAIT_L(0); PG8_BAR; PG8_MMA(0, 0, At, B0); PG8_MMA(0, 1, At, B1); PG8_BAR; PG8_SCHED;
            PG8_LDA(At, 1, 1); PG8_STAGE(PG8_SB(1, 0), b3, voffB); PG8_STAGE(PG8_SB(1, 1), b3 + hstep, voffB); PG8_STAGE(PG8_SA(1, 0), a3, voffA);
            PG8_WAIT_V(8); PG8_WAIT_L(0); PG8_BAR; PG8_MMA(1, 0, At, B0); PG8_MMA(1, 1, At, B1); PG8_BAR; PG8_SCHED;
            } else {
            PG8_LDB(B0, 0, 0); PG8_SCHED; PG8_LDA(At, 0, 0); PG8_STAGE(PG8_SA(1, 1), a1 + hstep, voffA);
            PG8_WAIT_L(8); PG8_BAR; PG8_WAIT_L(0); PG8_MMA(0, 0, At, B0); PG8_BAR; PG8_SCHED;
            PG8_LDB(B1, 0, 1); PG8_STAGE(PG8_SB(0, 0), b2, voffB);
            PG8_BAR; PG8_WAIT_L(0); PG8_MMA(0, 1, At, B1); PG8_BAR;
            PG8_LDA(At, 0, 1); PG8_STAGE(PG8_SA(0, 0), a2, voffA);
            PG8_BAR; PG8_WAIT_L(0); PG8_MMA(1, 0, At, B0); PG8_BAR; PG8_SCHED;
            PG8_STAGE(PG8_SB(0, 1), b2 + hstep, voffB);
            PG8_WAIT_V(6); PG8_BAR; PG8_MMA(1, 1, At, B1); PG8_BAR;
            PG8_LDB(B0, 1, 0); PG8_SCHED; PG8_LDA(At, 1, 0); PG8_STAGE(PG8_SA(0, 1), a2 + hstep, voffA);
            PG8_WAIT_L(8); PG8_BAR; PG8_WAIT_L(0); PG8_MMA(0, 0, At, B0); PG8_BAR; PG8_SCHED;
            PG8_LDB(B1, 1, 1); PG8_STAGE(PG8_SB(1, 0), b3, voffB);
            PG8_BAR; PG8_WAIT_L(0); PG8_MMA(0, 1, At, B1); PG8_BAR;
            PG8_LDA(At, 1, 1); PG8_STAGE(PG8_SA(1, 0), a3, voffA);
            PG8_BAR; PG8_WAIT_L(0); PG8_MMA(1, 0, At, B0); PG8_BAR; PG8_SCHED;
            PG8_STAGE(PG8_SB(1, 1), b3 + hstep, voffB);
            PG8_WAIT_V(6); PG8_BAR; PG8_MMA(1, 1, At, B1); PG8_BAR;
            }
        }
        if constexpr (ALIGN_EPI) { if (wr == 0) PG8_BAR; }
        if constexpr (!Epi::AFTER_DRAIN) { E(acc, cur, wr, wc, fr, fq); S.done(cur); }
        if (!has_next) break;
#pragma unroll
        for (int a = 0; a < 2; ++a)
#pragma unroll
            for (int b = 0; b < 2; ++b)
#pragma unroll
                for (int m = 0; m < 4; ++m)
#pragma unroll
                    for (int n = 0; n < 2; ++n) acc[a][b][m][n] = (f32x4){0.f, 0.f, 0.f, 0.f};
        cur = nxt; cA = nA; cB = nB; ++ui;
        if constexpr (ALIGN_EPI) { if (wr == 1) PG8_BAR; }
    }
    PG8_WAIT_V(0);
    if constexpr (!ALIGN_EPI) { if (wr == 0) PG8_BAR; }
    PG8_BAR;
    if constexpr (Epi::AFTER_DRAIN) { E.fused(acc, cur, wr, wc, fr, fq, lds, wid, lane); S.done(cur); }
#undef PG8_SA
#undef PG8_SB
#undef PG8_STAGE
#undef PG8_LDA
#undef PG8_LDB
#undef PG8_MMA
#undef PG8_WAIT_V
#undef PG8_WAIT_L
#undef PG8_BAR
#undef PG8_SCHED
}
}

constexpr int NWAVES = 8;
constexpr int BATCH = 4, T = 8192, D = 1024, DFF = 2816, M = BATCH * T;
constexpr int INC = 3944, NPROJ = 4096;
constexpr int O_QA = 0, O_KA = 512, O_VA = 576, O_QI = 640, O_KI = 1152, O_WI = 1216, O_CQ = 1224, O_CKV = 1608, O_KR = 1864, O_GATE = 1896;
constexpr float EPS = 1e-6f;
#ifndef MK_FUSED
#define MK_FUSED 1
#endif

constexpr size_t MiB = 1u << 20;
constexpr size_t WS_CTL = 0, CTL_ZERO_BYTES = 64 * 1024;
constexpr size_t WS_MOD = 256 * 1024;
constexpr size_t WS_SSQQ = 49 * MiB, WS_SSQKV = 50 * MiB;
constexpr size_t WS_W1A = 2 * MiB, SZ_WA = (size_t)2 * DFF * D * 2, SZ_WD = (size_t)D * DFF * 2;
constexpr size_t WS_W1D = WS_W1A + SZ_WA, WS_WIN = WS_W1D + SZ_WD, WS_WUQ = WS_WIN + (size_t)NPROJ * D * 2, WS_WUKV = WS_WUQ + (size_t)768 * 384 * 2;
constexpr size_t WS_WOA = WS_WUKV + (size_t)1024 * 256 * 2, WS_WOB = WS_WOA + (size_t)D * 512 * 2, WS_WOUT = WS_WOB + (size_t)D * 512 * 2;
constexpr size_t WS_W2A = WS_WOUT + (size_t)D * D * 2, WS_W2D = WS_W2A + SZ_WA, WS_WEND = WS_W2D + SZ_WD;
static_assert(WS_WEND <= 49 * MiB, "weights");
constexpr size_t WS_RCOS = 51 * MiB, WS_RSIN = 53 * MiB;
constexpr size_t WS_XN = 55 * MiB;
constexpr size_t WS_ACT = 119 * MiB;
constexpr size_t WS_QA = WS_ACT, WS_QI = WS_QA + 32 * MiB, WS_CQ = WS_QI + 32 * MiB, WS_CKV = WS_CQ + 24 * MiB, WS_KA = WS_CKV + 16 * MiB, WS_VA = WS_KA + 4 * MiB;
constexpr size_t WS_KI = WS_VA + 4 * MiB, WS_KPE = WS_KI + 4 * MiB, WS_WI = WS_KPE + 2 * MiB, WS_QB = WS_WI + 1 * MiB, WS_MIXEND = WS_QB + 48 * MiB;
static_assert(WS_MIXEND <= WS_ACT + 176 * MiB, "mixer overlay");
constexpr size_t WS_G = 295 * MiB;
constexpr size_t WS_KN = 423 * MiB, WS_VB = 455 * MiB;
constexpr size_t WS_SEL = 487 * MiB;
constexpr size_t WS_END = 503 * MiB;
static_assert(WS_XN + 64 * MiB <= WS_ACT && WS_ACT + 176 * MiB <= WS_G && WS_G + 128 * MiB <= WS_KN && WS_VB + 32 * MiB <= WS_SEL, "d_ws map");
constexpr size_t WS_OA = WS_XN, WS_OB = WS_XN + 1024, WS_Y1 = WS_KN, WS_Y = WS_KN;
constexpr int CW_TMO = 0, CW_CODE = 1, CW_BAR = 4096;

constexpr int RING_OFF = 0, RING_BYTES = 152704;
constexpr int LDSCTL_OFF = RING_BYTES, MISC_OFF = LDSCTL_OFF + 320;
constexpr int LDS_BYTES = RING_BYTES + 1024;
#ifndef PROF_SEL
#define PROF_SEL 0
#endif
#ifndef PROF_MULT
#define PROF_MULT 4
#endif
#define PROF_WORD(ldsring, wid_) ((LAS unsigned*)((ldsring) + (MISC_OFF - RING_OFF) + 64) + (wid_))
#define PROF_T0(id) unsigned long long pt_##id = 0ull; if (PROF_SEL == (id)) pt_##id = __builtin_amdgcn_s_memrealtime()
#define PROF_T1(id, ldsring, wid_, lane_) do { if (PROF_SEL == (id)) { const unsigned d_ = (unsigned)(__builtin_amdgcn_s_memrealtime() - pt_##id); if ((lane_) == 0) *PROF_WORD(ldsring, wid_) += d_; } } while (0)
#define GAS __attribute__((address_space(1)))
#define LAS __attribute__((address_space(3)))
typedef unsigned short bf16;
typedef unsigned v4u __attribute__((ext_vector_type(4)));
typedef float f32x4 __attribute__((ext_vector_type(4)));
typedef short bf16x8 __attribute__((ext_vector_type(8)));
typedef GAS unsigned gu32;
typedef GAS unsigned long long gu64;
#define RLX_AGENT __ATOMIC_RELAXED, __HIP_MEMORY_SCOPE_AGENT
#define LDS_WAIT() asm volatile("s_waitcnt lgkmcnt(0)" ::: "memory")
#define VM_WAIT() asm volatile("s_waitcnt vmcnt(0)" ::: "memory")
__device__ __forceinline__ unsigned long long rt() { return __builtin_amdgcn_s_memrealtime(); }
__device__ __forceinline__ unsigned f2bf(float f) { unsigned u = __builtin_bit_cast(unsigned, f); return (u + 0x7fffu + ((u >> 16) & 1u)) >> 16; }
__device__ __forceinline__ unsigned pk2(float lo, float hi) { return pg8::cvt_pk_bf16(lo, hi); }

#define XB_TMO      128
#define XB_XCNT(j)  (256  + 64 * (j))
#define XB_XSUB(j)  (1280 + 64 * (j))
#define XB_XGEN(j)  (2304 + 64 * (j))
#define XB_TOP      3328
#define XB_TOPGEN   3392
#define XCD_BAR_WORDS 3456
#define XB_SPIN_CAP (1u << 18)

__device__ __forceinline__ unsigned xb_ld(unsigned* p)              { return __hip_atomic_load(p, __ATOMIC_RELAXED, __HIP_MEMORY_SCOPE_AGENT); }
__device__ __forceinline__ unsigned xb_add(unsigned* p, unsigned v) { return __hip_atomic_fetch_add(p, v, __ATOMIC_RELAXED, __HIP_MEMORY_SCOPE_AGENT); }
__device__ __forceinline__ unsigned xb_xcc_id() { return (unsigned)__builtin_amdgcn_s_getreg((3 << 11) | 20) & 0xFu; }
#define XB_SPIN(cond, bar) do { unsigned _sp = 0; while (cond) { __builtin_amdgcn_s_sleep(1); \
    if ((++_sp & 255u) == 0u) { if (xb_ld(&(bar)[XB_TMO])) break; if (_sp > XB_SPIN_CAP) { atomicAdd(&(bar)[XB_TMO], 1u); break; } } } } while (0)

struct XcdBarrier {
    unsigned* bar; unsigned x;
    volatile LAS unsigned* st;
};

__device__ __forceinline__ XcdBarrier xcd_barrier_post(unsigned* bar, volatile LAS unsigned* st) {
    XcdBarrier b; b.bar = bar; b.x = xb_xcc_id(); b.st = st;
    if (threadIdx.x == 0) (void)xb_add(&bar[XB_XCNT(b.x)], 1u);
    return b;
}
__device__ __forceinline__ void xcd_barrier_complete(unsigned* bar, unsigned x, unsigned& nloc, unsigned& nx) {
    const unsigned G = gridDim.x * gridDim.y * gridDim.z;
    unsigned sum, cnt, mine, sp = 0u;
    for (;;) {
        sum = 0u; cnt = 0u; mine = 0u;
#pragma unroll
        for (unsigned j = 0; j < 16; ++j) { const unsigned c = xb_ld(&bar[XB_XCNT(j)]); sum += c; cnt += (c > 0u) ? 1u : 0u; mine = (j == x) ? c : mine; }
        if (sum == G) break;
        __builtin_amdgcn_s_sleep(1);
        if ((++sp & 255u) == 0u) { if (xb_ld(&bar[XB_TMO])) break; if (sp > XB_SPIN_CAP) { atomicAdd(&bar[XB_TMO], 1u); break; } }
    }
    nloc = mine > 0u ? mine : 1u; nx = cnt > 0u ? cnt : 1u;
}

__device__ __forceinline__ void xcd_barrier(const XcdBarrier& b) {
    asm volatile("s_waitcnt vmcnt(0)" ::: "memory");
    __syncthreads();
    if (threadIdx.x == 0) {
        unsigned* bar = b.bar;
        __builtin_amdgcn_s_waitcnt(0);
        unsigned nloc = b.st[0], nx = b.st[1];
        if (nloc == 0u) { xcd_barrier_complete(bar, b.x, nloc, nx); b.st[0] = nloc; b.st[1] = nx; }
        const unsigned old = xb_add(&bar[XB_XSUB(b.x)], 1u);
        const unsigned gen = old / nloc;
        if (old + 1u == (gen + 1u) * nloc) {
            __builtin_amdgcn_fence(__ATOMIC_RELEASE, "agent");
            asm volatile("s_waitcnt vmcnt(0)" ::: "memory");
            const unsigned og = xb_add(&bar[XB_TOP], 1u);
            const unsigned tg = og / nx;
            if (og + 1u == (tg + 1u) * nx) xb_add(&bar[XB_TOPGEN], 1u);
            else XB_SPIN(xb_ld(&bar[XB_TOPGEN]) == tg, bar);
            __builtin_amdgcn_fence(__ATOMIC_ACQUIRE, "agent");
            xb_add(&bar[XB_XGEN(b.x)], 1u);
            asm volatile("s_waitcnt vmcnt(0)" ::: "memory");
        } else {
            XB_SPIN(xb_ld(&bar[XB_XGEN(b.x)]) == gen, bar);
            __builtin_amdgcn_fence(__ATOMIC_ACQUIRE, "agent");
            asm volatile("s_waitcnt vmcnt(0)" ::: "memory");
        }
    }
    __syncthreads();
}

struct Frame {
    LAS unsigned char* lds;
    volatile LAS unsigned* MISC;
    gu32* ctl;
    int tid, lane, wave;
    int vcu, G;
};
__device__ __forceinline__ float wave_sum(float v) {
#pragma unroll
    for (int o = 1; o < 64; o <<= 1) v += __shfl_xor(v, o);
    return v;
}
struct MapIdent { int off; __device__ __forceinline__ int src(int n) const { return n + off; } };
struct MapFfnIn { __device__ __forceinline__ int src(int n) const { const int pn = n >> 8, j = n & 255; return (j >> 7) * DFF + pn * 128 + (j & 127); } };
struct MapProj { __device__ __forceinline__ int src(int n) const { const int pn = n >> 8, j = n & 255;
    if (pn < 2) return O_QA + n; if (pn < 4) return O_QI + (n - 512); if (pn == 4) return O_CQ + j;
    if (pn == 5) return j < 128 ? O_CQ + 256 + j : O_CKV + (j - 128);
    if (pn == 6) return j < 128 ? O_CKV + 128 + j : (j < 192 ? O_KA + (j - 128) : O_VA + (j - 192));
    if (pn == 7) { if (j < 64) return O_KI + j; if (j < 96) { const int jj = j - 64; return O_KR + (jj >> 1) + 16 * (jj & 1); } if (j < 104) return O_WI + (j - 96); return -1; }
    { const int g = n - 2048, jj = g >> 8, rr = g & 255; return O_GATE + (rr >> 7) * 1024 + jj * 128 + (rr & 127); } } };
struct MapUq { __device__ __forceinline__ int src(int n) const { const int h = n / 96, w = n % 96; if (w < 64) return n; const int jj = w - 64; return h * 96 + 64 + (jj >> 1) + 16 * (jj & 1); } };
template <class Map> __device__ __forceinline__ void p0_transpose_item(const float* W, int K, int Nsrc, int nblk, const float* kscale, bf16* WT, const Map mp, LAS float* scr, int item, int lane, int ldw = 0) {
    const int kb = item / nblk, nb = item % nblk, k0 = 64 * kb, n0 = 32 * nb;
    const int sc = mp.src(n0 + (lane & 31));
    float vv[32];
#pragma unroll
    for (int i = 0; i < 32; ++i) { const int kk = 2 * i + (lane >> 5); vv[i] = sc >= 0 ? W[(size_t)(k0 + kk) * Nsrc + sc] : 0.f; }
#pragma unroll
    for (int i = 0; i < 32; ++i) { const int kk = 2 * i + (lane >> 5); float v = vv[i]; if (kscale) v *= kscale[k0 + kk]; scr[kk * 33 + (lane & 31)] = v; }
    LDS_WAIT(); asm volatile("" ::: "memory");
    const int c = lane & 7;
#pragma unroll
    for (int j = 0; j < 4; ++j) { const int n = (lane >> 3) + 8 * j; const LAS float* s = scr + (8 * c) * 33 + n;
        v4u o; o.x = pk2(s[0 * 33], s[1 * 33]); o.y = pk2(s[2 * 33], s[3 * 33]); o.z = pk2(s[4 * 33], s[5 * 33]); o.w = pk2(s[6 * 33], s[7 * 33]);
        *(GAS v4u*)(WT + (size_t)(n0 + n) * (ldw ? ldw : K) + k0 + 8 * c) = o; }
    LDS_WAIT(); asm volatile("" ::: "memory");
}
struct Args { const void* in[23]; float* out; unsigned char* ws; int ph_lo, ph_hi, li, pad; };

__device__ __forceinline__ void p0_prologue(Frame& F, const Args& A) {
    LAS float* scr = (LAS float*)(F.lds + RING_OFF + F.wave * 16384);
    const int gw = F.vcu * NWAVES + F.wave, NGW = F.G * NWAVES;
    unsigned char* ws = A.ws;
    {
        const float* c = (const float*)A.in[1]; const float* w = (const float*)A.in[3]; const float* bias = (const float*)A.in[4]; float* mod = (float*)(ws + WS_MOD);
        for (int cg = F.vcu; cg < 256; cg += F.G) {
            const bool act = F.lane < 36; const int n = cg * 36 + (act ? F.lane : 0), k0 = F.wave * 128;
#pragma unroll
            for (int b = 0; b < 4; ++b)
#pragma unroll
                for (int h = 0; h < 2; ++h) { const float v = c[b * D + k0 + h * 64 + F.lane]; scr[b * 128 + h * 64 + F.lane] = v / (1.f + __expf(-v)); }
            LDS_WAIT(); asm volatile("" ::: "memory");
            float a0 = 0.f, a1 = 0.f, a2 = 0.f, a3 = 0.f;
#pragma unroll 8
            for (int k = 0; k < 128; ++k) { const float wv = act ? w[(size_t)(k0 + k) * 9216 + n] : 0.f; a0 += scr[k] * wv; a1 += scr[128 + k] * wv; a2 += scr[256 + k] * wv; a3 += scr[384 + k] * wv; }
            scr[1024 + F.lane] = a0; scr[1088 + F.lane] = a1; scr[1152 + F.lane] = a2; scr[1216 + F.lane] = a3;
            __syncthreads();
            if (F.wave < 4 && act) { float t = bias[n];
#pragma unroll
                for (int ww = 0; ww < 8; ++ww) t += ((LAS float*)(F.lds + RING_OFF + ww * 16384))[1024 + F.wave * 64 + F.lane];
                mod[F.wave * 9216 + n] = t; }
            __syncthreads();
        }
    }
    {
        const float* w1a = (const float*)A.in[6]; const float* w1d = (const float*)A.in[7]; const float* win = (const float*)A.in[9]; const float* gcq = (const float*)A.in[10];
        const float* wuq = (const float*)A.in[11]; const float* gckv = (const float*)A.in[12]; const float* wuk = (const float*)A.in[13]; const float* wuv = (const float*)A.in[14];
        const float* woa = (const float*)A.in[16]; const float* wob = (const float*)A.in[17]; const float* wout = (const float*)A.in[18]; const float* w2a = (const float*)A.in[20]; const float* w2d = (const float*)A.in[21];
        constexpr int I_A = 16 * 176, I_D = 44 * 32, I_IN = 16 * 128, I_UQ = 6 * 24, I_UK = 4 * 16, I_O = 8 * 32, I_OUT = 16 * 32;
        constexpr int NITEMS = 2 * I_A + 2 * I_D + I_IN + I_UQ + 2 * I_UK + 2 * I_O + I_OUT;
        for (int it = gw; it < NITEMS; it += NGW) {
            int r = it;
            if (r < I_A) { p0_transpose_item(w1a, D, 2 * DFF, 176, nullptr, (bf16*)(ws + WS_W1A), MapFfnIn{}, scr, r, F.lane); continue; } r -= I_A;
            if (r < I_A) { p0_transpose_item(w2a, D, 2 * DFF, 176, nullptr, (bf16*)(ws + WS_W2A), MapFfnIn{}, scr, r, F.lane); continue; } r -= I_A;
            if (r < I_D) { p0_transpose_item(w1d, DFF, D, 32, nullptr, (bf16*)(ws + WS_W1D), MapIdent{0}, scr, r, F.lane); continue; } r -= I_D;
            if (r < I_D) { p0_transpose_item(w2d, DFF, D, 32, nullptr, (bf16*)(ws + WS_W2D), MapIdent{0}, scr, r, F.lane); continue; } r -= I_D;
            if (r < I_IN) { p0_transpose_item(win, D, INC, 128, nullptr, (bf16*)(ws + WS_WIN), MapProj{}, scr, r, F.lane); continue; } r -= I_IN;
            if (r < I_UQ) { p0_transpose_item(wuq, 384, 768, 24, gcq, (bf16*)(ws + WS_WUQ), MapUq{}, scr, r, F.lane); continue; } r -= I_UQ;
            if (r < I_UK) { p0_transpose_item(wuk, 256, 512, 16, gckv, (bf16*)(ws + WS_WUKV), MapIdent{0}, scr, r, F.lane); continue; } r -= I_UK;
            if (r < I_UK) { p0_transpose_item(wuv, 256, 512, 16, gckv, (bf16*)(ws + WS_WUKV) + (size_t)512 * 256, MapIdent{0}, scr, r, F.lane); continue; } r -= I_UK;
            if (r < I_O) { p0_transpose_item(woa, 512, D, 32, nullptr, (bf16*)(ws + WS_WOA), MapIdent{0}, scr, r, F.lane, 1024); continue; } r -= I_O;
            if (r < I_O) { p0_transpose_item(wob, 512, D, 32, nullptr, (bf16*)(ws + WS_WOA) + 512, MapIdent{0}, scr, r, F.lane, 1024); continue; } r -= I_O;
            p0_transpose_item(wout, D, D, 32, nullptr, (bf16*)(ws + WS_WOUT), MapIdent{0}, scr, r, F.lane);
        }
    }
    {
        const int* pos = (const int*)A.in[2]; float* rc = (float*)(ws + WS_RCOS); float* rs = (float*)(ws + WS_RSIN);
        for (int idx = gw * 64 + F.lane; idx < M * 16; idx += NGW * 64) { const int t = idx >> 4, i = idx & 15;
            const float freq = powf(10000.0f, -2.0f * (float)i / 32.0f); const float ang = (float)pos[t] * freq;
            rc[idx] = cosf(ang); rs[idx] = sinf(ang); }
    }
}
__device__ __forceinline__ void norm_mod_phase(Frame& F, const float* xin, const float* g, const float* mod, int shoff, int scoff, bf16* out) {
    const int gw = F.vcu * NWAVES + F.wave, NGW = F.G * NWAVES;
    for (int m = gw; m < M; m += NGW) {
        const int b = m >> 13;
        const GAS f32x4* xr = (const GAS f32x4*)(xin + (size_t)m * D) + F.lane;
        const GAS f32x4* g4 = (const GAS f32x4*)g + F.lane; const GAS f32x4* sc4 = (const GAS f32x4*)(mod + b * 9216 + scoff) + F.lane; const GAS f32x4* sh4 = (const GAS f32x4*)(mod + b * 9216 + shoff) + F.lane;
        f32x4 v[4]; float s = 0.f;
#pragma unroll
        for (int j = 0; j < 4; ++j) { v[j] = xr[64 * j]; s += (v[j].x * v[j].x + v[j].y * v[j].y) + (v[j].z * v[j].z + v[j].w * v[j].w); }
        const float rs = __builtin_amdgcn_rsqf(wave_sum(s) * (1.f / D) + EPS);
        GAS unsigned long long* o8 = (GAS unsigned long long*)(out + (size_t)m * D) + F.lane;
#pragma unroll
        for (int j = 0; j < 4; ++j) { const f32x4 o = v[j] * rs * g4[64 * j] * (sc4[64 * j] + 1.f) + sh4[64 * j];
            o8[64 * j] = (unsigned long long)pk2(o.x, o.y) | ((unsigned long long)pk2(o.z, o.w) << 32); }
    }
}
__device__ __forceinline__ void norm_mod_phase_b(Frame& F, const bf16* xin, const float* g, const float* mod, int shoff, int scoff, bf16* out) {
    const int gw = F.vcu * NWAVES + F.wave, NGW = F.G * NWAVES;
    for (int m = gw; m < M; m += NGW) {
        const int b = m >> 13;
        const GAS v4u* xr = (const GAS v4u*)(xin + (size_t)m * D) + F.lane;
        const GAS f32x4* g4 = (const GAS f32x4*)g + 2 * F.lane; const GAS f32x4* sc4 = (const GAS f32x4*)(mod + b * 9216 + scoff) + 2 * F.lane; const GAS f32x4* sh4 = (const GAS f32x4*)(mod + b * 9216 + shoff) + 2 * F.lane;
        f32x4 v[4]; float s = 0.f;
#pragma unroll
        for (int j = 0; j < 2; ++j) { const v4u w = xr[64 * j];
            v[2 * j] = (f32x4){__uint_as_float(w.x << 16), __uint_as_float(w.x & 0xffff0000u), __uint_as_float(w.y << 16), __uint_as_float(w.y & 0xffff0000u)};
            v[2 * j + 1] = (f32x4){__uint_as_float(w.z << 16), __uint_as_float(w.z & 0xffff0000u), __uint_as_float(w.w << 16), __uint_as_float(w.w & 0xffff0000u)}; }
#pragma unroll
        for (int j = 0; j < 4; ++j) s += (v[j].x * v[j].x + v[j].y * v[j].y) + (v[j].z * v[j].z + v[j].w * v[j].w);
        const float rs = __builtin_amdgcn_rsqf(wave_sum(s) * (1.f / D) + EPS);
        GAS v4u* o16 = (GAS v4u*)(out + (size_t)m * D) + F.lane;
#pragma unroll
        for (int j = 0; j < 2; ++j) {
            const f32x4 o0 = v[2 * j] * rs * g4[128 * j] * (sc4[128 * j] + 1.f) + sh4[128 * j], o1 = v[2 * j + 1] * rs * g4[128 * j + 1] * (sc4[128 * j + 1] + 1.f) + sh4[128 * j + 1];
            v4u o; o.x = pk2(o0.x, o0.y); o.y = pk2(o0.z, o0.w); o.z = pk2(o1.x, o1.y); o.w = pk2(o1.z, o1.w); o16[64 * j] = o; }
    }
}
__device__ __forceinline__ void final_norm_phase_b(Frame& F, const bf16* xin, const float* g, float* out) {
    const int gw = F.vcu * NWAVES + F.wave, NGW = F.G * NWAVES;
    for (int m = gw; m < M; m += NGW) {
        const GAS v4u* xr = (const GAS v4u*)(xin + (size_t)m * D) + F.lane; const GAS f32x4* g4 = (const GAS f32x4*)g + 2 * F.lane;
        f32x4 v[4]; float s = 0.f;
#pragma unroll
        for (int j = 0; j < 2; ++j) { const v4u w = xr[64 * j];
            v[2 * j] = (f32x4){__uint_as_float(w.x << 16), __uint_as_float(w.x & 0xffff0000u), __uint_as_float(w.y << 16), __uint_as_float(w.y & 0xffff0000u)};
            v[2 * j + 1] = (f32x4){__uint_as_float(w.z << 16), __uint_as_float(w.z & 0xffff0000u), __uint_as_float(w.w << 16), __uint_as_float(w.w & 0xffff0000u)}; }
#pragma unroll
        for (int j = 0; j < 4; ++j) s += (v[j].x * v[j].x + v[j].y * v[j].y) + (v[j].z * v[j].z + v[j].w * v[j].w);
        const float rs = __builtin_amdgcn_rsqf(wave_sum(s) * (1.f / D) + EPS);
        GAS f32x4* o4 = (GAS f32x4*)(out + (size_t)m * D) + 2 * F.lane;
#pragma unroll
        for (int j = 0; j < 2; ++j) { o4[128 * j] = v[2 * j] * rs * g4[128 * j]; o4[128 * j + 1] = v[2 * j + 1] * rs * g4[128 * j + 1]; }
    }
}
__device__ __forceinline__ void final_norm_phase(Frame& F, const float* xin, const float* g, float* out) {
    const int gw = F.vcu * NWAVES + F.wave, NGW = F.G * NWAVES;
    for (int m = gw; m < M; m += NGW) {
        const GAS f32x4* xr = (const GAS f32x4*)(xin + (size_t)m * D) + F.lane; const GAS f32x4* g4 = (const GAS f32x4*)g + F.lane;
        f32x4 v[4]; float s = 0.f;
#pragma unroll
        for (int j = 0; j < 4; ++j) { v[j] = xr[64 * j]; s += (v[j].x * v[j].x + v[j].y * v[j].y) + (v[j].z * v[j].z + v[j].w * v[j].w); }
        const float rs = __builtin_amdgcn_rsqf(wave_sum(s) * (1.f / D) + EPS);
        GAS f32x4* o4 = (GAS f32x4*)(out + (size_t)m * D) + F.lane;
#pragma unroll
        for (int j = 0; j < 4; ++j) o4[64 * j] = v[j] * rs * g4[64 * j];
    }
}

namespace mla {
typedef unsigned u32x4 __attribute__((ext_vector_type(4)));
typedef short bf16x8 __attribute__((ext_vector_type(8)));
typedef short s16x4 __attribute__((ext_vector_type(4)));
typedef float f32x16 __attribute__((ext_vector_type(16)));
constexpr int KSLOT = 12288, VSLOT = 8192;
constexpr int NS = 5;
constexpr int L_K = 0, L_V = NS * KSLOT, L_WS = L_V + NS * VSLOT, L_OST = L_WS + 2048, L_END = L_OST + 8 * 4096;
static_assert(L_END <= RING_BYTES, "attention LDS");
__device__ __forceinline__ int crow(int r, int hi) { return (r & 3) + 8 * (r >> 2) + 4 * hi; }
__device__ __forceinline__ float xhalf(float v) { return __shfl_xor(v, 32); }
struct VFrag { s16x4 lo[2][4], hi[2][4]; };
__device__ __forceinline__ void pv_request(VFrag& f, int vb) {
#pragma unroll
    for (int d0 = 0; d0 < 2; ++d0)
#pragma unroll
        for (int ks = 0; ks < 4; ++ks) {
            asm volatile("ds_read_b64_tr_b16 %0,%1 offset:%c2" : "=&v"(f.lo[d0][ks]) : "v"(vb), "i"(d0 * 4096 + ks * 1024) : "memory");
            asm volatile("ds_read_b64_tr_b16 %0,%1 offset:%c2" : "=&v"(f.hi[d0][ks]) : "v"(vb), "i"(d0 * 4096 + ks * 1024 + 512) : "memory"); }
}
__device__ __forceinline__ void pv_mma(f32x16* o, const VFrag& f, bf16x8 pa0, bf16x8 pa1, bf16x8 pa2, bf16x8 pa3) {
    asm volatile("s_waitcnt lgkmcnt(0)" ::: "memory"); __builtin_amdgcn_sched_barrier(0);
#define MLA_PK(d, k) (bf16x8){f.lo[d][k][0], f.lo[d][k][1], f.lo[d][k][2], f.lo[d][k][3], f.hi[d][k][0], f.hi[d][k][1], f.hi[d][k][2], f.hi[d][k][3]}
#pragma unroll
    for (int d0 = 0; d0 < 2; ++d0) {
        o[d0] = __builtin_amdgcn_mfma_f32_32x32x16_bf16(pa0, MLA_PK(d0, 0), o[d0], 0, 0, 0);
        o[d0] = __builtin_amdgcn_mfma_f32_32x32x16_bf16(pa1, MLA_PK(d0, 1), o[d0], 0, 0, 0);
        o[d0] = __builtin_amdgcn_mfma_f32_32x32x16_bf16(pa2, MLA_PK(d0, 2), o[d0], 0, 0, 0);
        o[d0] = __builtin_amdgcn_mfma_f32_32x32x16_bf16(pa3, MLA_PK(d0, 3), o[d0], 0, 0, 0);
    }
#undef MLA_PK
}
__device__ __forceinline__ void attn_unit(int b, int h, int qb, const bf16* QB, const bf16* KN, const bf16* KPE, const bf16* VB, bf16* OB, LAS unsigned char* lds) {
    const int tid = threadIdx.x, lane = tid & 63, r32 = lane & 31, hi = lane >> 5; const int wid = __builtin_amdgcn_readfirstlane(tid >> 6);
    const size_t rowbase = (size_t)b * T; const int q0 = qb * 256;
    const int NT = 4 * (qb + 1), my_last = 4 * qb + (wid >> 1);
    LAS float* wsf = (LAS float*)(lds + L_WS) + wid * 64;
#define MLA_DMA(t, slot) do { const size_t krow_ = rowbase + (size_t)(t) * 64 + lane; \
        __builtin_amdgcn_global_load_lds((const unsigned*)(KN + krow_ * 512 + h * 64 + wid * 8), (LAS unsigned*)(lds + L_K + (slot) * KSLOT + wid * 1024), 16, 0, 0); \
        if (wid < 4) __builtin_amdgcn_global_load_lds((const unsigned*)(KPE + krow_ * 32 + wid * 8), (LAS unsigned*)(lds + L_K + (slot) * KSLOT + (8 + wid) * 1024), 16, 0, 0); \
        const size_t vrow_ = rowbase + (size_t)(t) * 64 + 16 * (wid & 3) + (lane >> 2); \
        __builtin_amdgcn_global_load_lds((const unsigned*)(VB + vrow_ * 512 + h * 64 + (wid >> 2) * 32 + (lane & 3) * 8), (LAS unsigned*)(lds + L_V + (slot) * VSLOT + wid * 1024), 16, 0, 0); } while (0)
    bf16x8 qr[6];
    { const bf16* Qw = QB + (rowbase + q0 + wid * 32 + r32) * 768 + h * 96 + hi * 8;
#pragma unroll
      for (int d0 = 0; d0 < 6; ++d0) qr[d0] = *(const bf16x8*)(Qw + d0 * 16); }
    MLA_DMA(0, 0); MLA_DMA(1, 1); MLA_DMA(2, 2);
    float m = 0.f, l = 0.f; f32x16 o[2], negm;
#pragma unroll
    for (int r = 0; r < 16; ++r) { o[0][r] = 0.f; o[1][r] = 0.f; negm[r] = 0.f; }
    const int kofs = hi * 1024 + r32 * 16;
    const int vb0 = (int)(unsigned)(uintptr_t)(lds + L_V) + ((lane >> 4) & 1) * 32 + (lane & 3) * 8 + (4 * hi + ((lane & 15) >> 2)) * 64;
    const bool lag = wid >= 4;
#define MLA_BARL(k) do { if ((k) + 2 < NT) asm volatile("s_waitcnt vmcnt(6) lgkmcnt(0)\n\ts_barrier" ::: "memory"); else if ((k) + 1 < NT) asm volatile("s_waitcnt vmcnt(3) lgkmcnt(0)\n\ts_barrier" ::: "memory"); \
        else asm volatile("s_waitcnt vmcnt(0) lgkmcnt(0)\n\ts_barrier" ::: "memory"); } while (0)
#define MLA_BARG(k) do { if ((k) + 2 < NT) asm volatile("s_waitcnt vmcnt(4) lgkmcnt(0)\n\ts_barrier" ::: "memory"); else if ((k) + 1 < NT) asm volatile("s_waitcnt vmcnt(2) lgkmcnt(0)\n\ts_barrier" ::: "memory"); \
        else asm volatile("s_waitcnt vmcnt(0) lgkmcnt(0)\n\ts_barrier" ::: "memory"); } while (0)
    if (lag) { MLA_BARG(0); MLA_DMA(3, 3); }
    int slotc = 0;
    for (int t = 0; t < NT; ++t) {
        if (!lag) MLA_BARL(t);
        const int slot = slotc, slot3 = (slot + 3 >= NS) ? slot + 3 - NS : slot + 3, slot4 = (slot + 4 >= NS) ? slot + 4 - NS : slot + 4; slotc = (slotc == NS - 1) ? 0 : slotc + 1;
        const bool act = t <= my_last;
        const LAS unsigned char* kb = lds + L_K + slot * KSLOT + kofs;
        bf16x8 kf[12]; f32x16 p0, p1; VFrag vf;
        if (act) {
#pragma unroll
            for (int i = 0; i < 12; ++i) kf[i] = *(const LAS bf16x8*)(kb + (i >> 1) * 2048 + (i & 1) * 512);
            __builtin_amdgcn_sched_barrier(0);
            p0 = __builtin_amdgcn_mfma_f32_32x32x16_bf16(kf[0], qr[0], negm, 0, 0, 0); p1 = __builtin_amdgcn_mfma_f32_32x32x16_bf16(kf[1], qr[0], negm, 0, 0, 0);
#pragma unroll
            for (int d0 = 1; d0 < 6; ++d0) { p0 = __builtin_amdgcn_mfma_f32_32x32x16_bf16(kf[2 * d0], qr[d0], p0, 0, 0, 0); p1 = __builtin_amdgcn_mfma_f32_32x32x16_bf16(kf[2 * d0 + 1], qr[d0], p1, 0, 0, 0); }
            pv_request(vf, vb0 + slot * VSLOT);
        }
        if (!lag) { if (t + 3 < NT) MLA_DMA(t + 3, slot3); }
        else if (t + 1 < NT) { MLA_BARG(t + 1); if (t + 4 < NT) MLA_DMA(t + 4, slot4); }
        if (act) {
            __builtin_amdgcn_sched_barrier(0);
#ifndef MLA_LOGBIG
#define MLA_LOGBIG 40
#endif
            bool careful = (t == 0);
            float sacc = 0.f;
            u32x4 pw0, pw1, pw2, pw3;
#define MLA_PACK() do { \
            pw0 = (u32x4){pg8::cvt_pk_bf16(p0[0], p0[1]), pg8::cvt_pk_bf16(p0[2], p0[3]), pg8::cvt_pk_bf16(p0[4], p0[5]), pg8::cvt_pk_bf16(p0[6], p0[7])}; \
            pw1 = (u32x4){pg8::cvt_pk_bf16(p0[8], p0[9]), pg8::cvt_pk_bf16(p0[10], p0[11]), pg8::cvt_pk_bf16(p0[12], p0[13]), pg8::cvt_pk_bf16(p0[14], p0[15])}; \
            pw2 = (u32x4){pg8::cvt_pk_bf16(p1[0], p1[1]), pg8::cvt_pk_bf16(p1[2], p1[3]), pg8::cvt_pk_bf16(p1[4], p1[5]), pg8::cvt_pk_bf16(p1[6], p1[7])}; \
            pw3 = (u32x4){pg8::cvt_pk_bf16(p1[8], p1[9]), pg8::cvt_pk_bf16(p1[10], p1[11]), pg8::cvt_pk_bf16(p1[12], p1[13]), pg8::cvt_pk_bf16(p1[14], p1[15])}; } while (0)
            if (!careful) {
#pragma unroll
                for (int r = 0; r < 16; ++r) { p0[r] = __builtin_amdgcn_exp2f(p0[r]); p1[r] = __builtin_amdgcn_exp2f(p1[r]); sacc += p0[r] + p1[r]; }
                MLA_PACK();
#pragma unroll
                for (int i = 0; i < 32; ++i) { __builtin_amdgcn_sched_group_barrier(0x400, 1, 0); __builtin_amdgcn_sched_group_barrier(0x002, 1, 0); }
                careful = __any(!(sacc <= __builtin_ldexpf(1.f, MLA_LOGBIG)));
                if (careful) {
#pragma unroll
                    for (int i = 0; i < 12; ++i) kf[i] = *(const LAS bf16x8*)(kb + (i >> 1) * 2048 + (i & 1) * 512);
                    p0 = __builtin_amdgcn_mfma_f32_32x32x16_bf16(kf[0], qr[0], negm, 0, 0, 0); p1 = __builtin_amdgcn_mfma_f32_32x32x16_bf16(kf[1], qr[0], negm, 0, 0, 0);
#pragma unroll
                    for (int d0 = 1; d0 < 6; ++d0) { p0 = __builtin_amdgcn_mfma_f32_32x32x16_bf16(kf[2 * d0], qr[d0], p0, 0, 0, 0); p1 = __builtin_amdgcn_mfma_f32_32x32x16_bf16(kf[2 * d0 + 1], qr[d0], p1, 0, 0, 0); }
                }
            }
            if (careful) {
#define MLA_MX3(a, b, c) __builtin_fmaxf(__builtin_fmaxf((a), (b)), (c))
                float ra = MLA_MX3(p0[0], p0[1], p1[0]), rb = MLA_MX3(p0[2], p0[3], p1[1]); ra = MLA_MX3(ra, p1[2], p1[3]);
#pragma unroll
                for (int r = 4; r < 16; r += 4) { ra = MLA_MX3(ra, p0[r], p0[r + 1]); rb = MLA_MX3(rb, p0[r + 2], p0[r + 3]); ra = MLA_MX3(ra, p1[r], p1[r + 1]); rb = MLA_MX3(rb, p1[r + 2], p1[r + 3]); }
#undef MLA_MX3
                float rm = __builtin_fmaxf(ra, rb);
                rm = __builtin_fmaxf(rm, xhalf(rm));
                if (t == 0 || __any(rm > 0.f)) {
                    const float dl = (t == 0) ? rm : __builtin_fmaxf(rm, 0.f), f = __builtin_amdgcn_exp2f(-dl);
                    m += dl; l *= f;
#pragma unroll
                    for (int r = 0; r < 16; ++r) { p0[r] -= dl; p1[r] -= dl; negm[r] = -m; }
                    if (t != 0) {
                        if (hi == 0) wsf[r32] = f;
                        asm volatile("s_waitcnt lgkmcnt(0)" ::: "memory");
#pragma unroll
                        for (int r = 0; r < 16; ++r) { const float fr_ = wsf[crow(r, hi)]; o[0][r] *= fr_; o[1][r] *= fr_; }
                    }
                }
                sacc = 0.f;
#pragma unroll
                for (int r = 0; r < 16; ++r) { p0[r] = __builtin_amdgcn_exp2f(p0[r]); p1[r] = __builtin_amdgcn_exp2f(p1[r]); sacc += p0[r] + p1[r]; }
                MLA_PACK();
            }
#undef MLA_PACK
            l += sacc;
            pv_mma(o, vf, __builtin_bit_cast(bf16x8, pw0), __builtin_bit_cast(bf16x8, pw1), __builtin_bit_cast(bf16x8, pw2), __builtin_bit_cast(bf16x8, pw3));
        }
    }
#undef MLA_BARL
#undef MLA_BARG
#undef MLA_DMA
    l += xhalf(l);
    if (hi == 0) wsf[32 + r32] = l;
    asm volatile("s_waitcnt lgkmcnt(0)" ::: "memory");
    LAS bf16* stg = (LAS bf16*)(lds + L_OST) + wid * 2048;
#pragma unroll
    for (int r = 0; r < 16; ++r) { const int orow = crow(r, hi); const float rl = __builtin_amdgcn_rcpf(wsf[32 + orow]);
        stg[orow * 64 + r32] = (bf16)(pg8::cvt_pk_bf16(o[0][r] * rl, 0.f) & 0xffffu); stg[orow * 64 + 32 + r32] = (bf16)(pg8::cvt_pk_bf16(o[1][r] * rl, 0.f) & 0xffffu); }
    asm volatile("s_waitcnt lgkmcnt(0)" ::: "memory");
    bf16* Ow = OB + (rowbase + q0 + wid * 32) * 1024 + h * 64;
#pragma unroll
    for (int i = 0; i < 4; ++i) { const int row = i * 8 + (lane >> 3), ch = lane & 7; const u32x4 v = *(const LAS u32x4*)(stg + row * 64 + ch * 8); *(u32x4*)(Ow + (size_t)row * 1024 + ch * 8) = v; }
    asm volatile("s_waitcnt lgkmcnt(0)\n\ts_barrier" ::: "memory");
}
__device__ __forceinline__ void phase(int vcu, int G, const bf16* QB, const bf16* KN, const bf16* KPE, const bf16* VB, bf16* OB, LAS unsigned char* lds) {
    const bool young = __builtin_amdgcn_readfirstlane((int)threadIdx.x) >= 256;
    if (young) __builtin_amdgcn_s_setprio(1);
    for (int u = vcu; u < 1024; u += G) { const int i = u >> 8, v = u & 255, bh = v >> 3, s = v & 7;
        const int qb = (i == 0) ? s : (i == 1) ? 15 - s : (i == 2) ? 16 + s : 31 - s;
        attn_unit(bh >> 3, bh & 7, qb, QB, KN, KPE, VB, OB, lds); }
    if (young) __builtin_amdgcn_s_setprio(0);
}
}

namespace dsa {
typedef short bf16x8 __attribute__((ext_vector_type(8)));
typedef short v4i16 __attribute__((ext_vector_type(4)));
typedef unsigned u32x4m __attribute__((ext_vector_type(4)));
typedef unsigned u32x2m __attribute__((ext_vector_type(2)));
constexpr float LOG2E = 1.4426950408889634f;
__device__ __forceinline__ int t5_bucket(int rel) {
    const int n = rel < 0 ? -rel : rel; const int r = rel > 0 ? 16 : 0;
    if (n < 8) return r + n;
    int lg = 7; if (n < 128) lg = (31 - __clz(n * n)) - 6;
    return r + 8 + lg;
}
__device__ __forceinline__ void query(int q, const bf16* QA, const bf16* KA, const bf16* VA, const int* positions, bf16* OA, LAS unsigned char* vbuf, LAS unsigned short* selL, LAS unsigned char* bktL, const LAS float* bt, int lane) {
    const int l15 = lane & 15, kq = lane >> 4;
    const int trofs = ((l15 >> 2) + 4 * kq) * 128 + (l15 & 3) * 8;
    const int b = q >> 13, t = q & (T - 1); const size_t rowbase = (size_t)b * T;
    const int limit = 64 * (t / 64 + 1), nvalid = limit < 256 ? limit : 256; const int posq = positions[q];
    bf16x8 Qf[2];
#pragma unroll
    for (int s = 0; s < 2; ++s) { Qf[s] = (bf16x8){0, 0, 0, 0, 0, 0, 0, 0}; if (l15 < 8) Qf[s] = *(const bf16x8*)(QA + (size_t)q * 512 + l15 * 64 + 32 * s + 8 * kq); }
    __builtin_amdgcn_sched_barrier(0);
#pragma unroll
    for (int j = 0; j < 4; ++j) { const int k = lane + 64 * j; const int sv = selL[k];
        bktL[k] = (unsigned char)((k < nvalid) ? t5_bucket(positions[rowbase + sv] - posq) : 32); }
#define DSA_VDMA(cch, buf) do { _Pragma("unroll") for (int i_ = 0; i_ < 4; ++i_) { const int row_ = selL[32 * (cch) + 8 * i_ + (lane >> 3)]; \
        __builtin_amdgcn_global_load_lds((const unsigned*)(VA + (rowbase + row_) * 64 + (lane & 7) * 8), (LAS unsigned*)(vbuf + (buf) * 4096 + i_ * 1024), 16, 0, 0); } } while (0)
    DSA_VDMA(0, 0); DSA_VDMA(1, 1); DSA_VDMA(2, 2); DSA_VDMA(3, 3);
#ifndef DSA_CAREFUL
#define DSA_CAREFUL 0
#endif
    f32x4 St[16]; float lsum = 0.f;
#pragma nounroll
    for (int pass = 0; pass < 2; ++pass) {
#pragma unroll
    for (int half = 0; half < 2; ++half) {
        bf16x8 Ka[8][2];
#pragma unroll
        for (int i = 0; i < 8; ++i) { const int row = selL[16 * (8 * half + i) + l15]; const bf16* kp = KA + (rowbase + row) * 64 + 8 * kq;
            Ka[i][0] = *(const bf16x8*)kp; Ka[i][1] = *(const bf16x8*)(kp + 32); }
#pragma unroll
        for (int i = 0; i < 8; ++i) { f32x4 a = {0.f, 0.f, 0.f, 0.f};
            a = __builtin_amdgcn_mfma_f32_16x16x32_bf16(Ka[i][0], Qf[0], a, 0, 0, 0); a = __builtin_amdgcn_mfma_f32_16x16x32_bf16(Ka[i][1], Qf[1], a, 0, 0, 0); St[8 * half + i] = a; }
    }
    asm volatile("s_waitcnt lgkmcnt(0)" ::: "memory");
    if (pass == 0 && DSA_CAREFUL != 1) {
        lsum = 0.f;
#pragma unroll
        for (int kt = 0; kt < 16; ++kt) { const unsigned bk4 = *(const LAS unsigned*)(bktL + 16 * kt + 4 * kq);
#pragma unroll
            for (int i = 0; i < 4; ++i) { const float p = __builtin_amdgcn_exp2f(St[kt][i] * (0.125f * LOG2E) + bt[((bk4 >> (8 * i)) & 255u) * 8 + (l15 & 7)]); St[kt][i] = p; lsum += p; } }
        lsum += __shfl_xor(lsum, 16); lsum += __shfl_xor(lsum, 32);
        if (DSA_CAREFUL != 2 && __all((lsum >= 8.6736174e-19f && lsum <= 1.1529215e18f) || l15 >= 8)) break;
    } else {
        float mx = -INFINITY;
#pragma unroll
        for (int kt = 0; kt < 16; ++kt) { const unsigned bk4 = *(const LAS unsigned*)(bktL + 16 * kt + 4 * kq);
#pragma unroll
            for (int i = 0; i < 4; ++i) { const float s = St[kt][i] * (0.125f * LOG2E) + bt[((bk4 >> (8 * i)) & 255u) * 8 + (l15 & 7)]; St[kt][i] = s; mx = fmaxf(mx, s); } }
        mx = fmaxf(mx, __shfl_xor(mx, 16)); mx = fmaxf(mx, __shfl_xor(mx, 32));
        lsum = 0.f;
#pragma unroll
        for (int kt = 0; kt < 16; ++kt)
#pragma unroll
            for (int i = 0; i < 4; ++i) { const float p = __builtin_amdgcn_exp2f(St[kt][i] - mx); St[kt][i] = p; lsum += p; }
        lsum += __shfl_xor(lsum, 16); lsum += __shfl_xor(lsum, 32);
        break;
    }
    }
    f32x4 O[4];
#pragma unroll
    for (int dt = 0; dt < 4; ++dt) O[dt] = (f32x4){0.f, 0.f, 0.f, 0.f};
#pragma unroll
    for (int kk = 0; kk < 8; ++kk) {
        if (kk < 5) asm volatile("s_waitcnt vmcnt(12)" ::: "memory"); else if (kk == 5) asm volatile("s_waitcnt vmcnt(8)" ::: "memory"); else if (kk == 6) asm volatile("s_waitcnt vmcnt(4)" ::: "memory"); else asm volatile("s_waitcnt vmcnt(0)" ::: "memory");
        const LAS unsigned char* vb = vbuf + (kk & 3) * 4096 + trofs;
        const f32x4 pa = St[2 * kk], pb = St[2 * kk + 1];
        u32x4m pw; pw.x = pg8::cvt_pk_bf16(pa[0], pa[1]); pw.y = pg8::cvt_pk_bf16(pa[2], pa[3]); pw.z = pg8::cvt_pk_bf16(pb[0], pb[1]); pw.w = pg8::cvt_pk_bf16(pb[2], pb[3]);
        const bf16x8 Pf = __builtin_bit_cast(bf16x8, pw);
#pragma unroll
        for (int dt = 0; dt < 4; ++dt) {
            const v4i16 v0 = __builtin_amdgcn_ds_read_tr16_b64_v4i16((LAS v4i16*)(vb + dt * 32));
            const v4i16 v1 = __builtin_amdgcn_ds_read_tr16_b64_v4i16((LAS v4i16*)(vb + 2048 + dt * 32));
            const bf16x8 Vf = (bf16x8){v0[0], v0[1], v0[2], v0[3], v1[0], v1[1], v1[2], v1[3]};
            O[dt] = __builtin_amdgcn_mfma_f32_16x16x32_bf16(Vf, Pf, O[dt], 0, 0, 0); }
        if (kk < 4) { asm volatile("s_waitcnt lgkmcnt(0)" ::: "memory"); DSA_VDMA(kk + 4, kk); }
    }
#undef DSA_VDMA
    if (l15 < 8) { const float rl = __builtin_amdgcn_rcpf(lsum);
#pragma unroll
        for (int dt = 0; dt < 4; ++dt) { u32x2m w; w.x = pg8::cvt_pk_bf16(O[dt][0] * rl, O[dt][1] * rl); w.y = pg8::cvt_pk_bf16(O[dt][2] * rl, O[dt][3] * rl);
            *(u32x2m*)(OA + (size_t)q * 1024 + l15 * 64 + 16 * dt + 4 * kq) = w; } }
    asm volatile("s_waitcnt vmcnt(0) lgkmcnt(0)" ::: "memory");
}
}

namespace idx {
typedef short bf16x8 __attribute__((ext_vector_type(8)));
typedef float f32x16 __attribute__((ext_vector_type(16)));
typedef unsigned u32x2 __attribute__((ext_vector_type(2)));
constexpr int CAP = 1152, CAPU = 1024, TRIG = CAPU - 128, NE = CAPU / 64;
constexpr int L_CAND = 0, L_TRASH = 32 * CAP * 4, L_BIAS = L_TRASH + 8 * 512, L_END = L_BIAS + 33 * 8 * 4;
static_assert(4 * CAP * 4 >= 4 * 512 + 16384, "a wave's four candidate buffers hold its four selection tables + the attention's V buffers afterwards");
constexpr int KEEP_MAX = 272, SCHED_MIN = 304;
static_assert(L_END <= RING_BYTES, "indexer LDS");
__device__ __forceinline__ unsigned okey(float f) { const unsigned u = __float_as_uint(f); return (u & 0x80000000u) ? ~u : (u | 0x80000000u); }
__device__ __forceinline__ float ikey(unsigned k) { return __uint_as_float((k & 0x80000000u) ? (k ^ 0x80000000u) : ~k); }
__device__ __forceinline__ int prefix64(unsigned long long m) { return (int)__builtin_amdgcn_mbcnt_hi((unsigned)(m >> 32), __builtin_amdgcn_mbcnt_lo((unsigned)m, 0u)); }
__device__ __forceinline__ unsigned wave_umax(unsigned v) {
    v = max(v, (unsigned)__builtin_amdgcn_update_dpp(0, (int)v, 0xB1, 0xf, 0xf, false)); v = max(v, (unsigned)__builtin_amdgcn_update_dpp(0, (int)v, 0x4E, 0xf, 0xf, false));
    v = max(v, (unsigned)__builtin_amdgcn_update_dpp(0, (int)v, 0x141, 0xf, 0xf, false)); v = max(v, (unsigned)__builtin_amdgcn_update_dpp(0, (int)v, 0x140, 0xf, 0xf, false));
    return max(max((unsigned)__builtin_amdgcn_readlane((int)v, 0), (unsigned)__builtin_amdgcn_readlane((int)v, 16)), max((unsigned)__builtin_amdgcn_readlane((int)v, 32), (unsigned)__builtin_amdgcn_readlane((int)v, 48)));
}
__device__ __forceinline__ unsigned wave_umin(unsigned v) { return ~wave_umax(~v); }
__device__ __forceinline__ unsigned wave_usum(unsigned v) {
    v += (unsigned)__builtin_amdgcn_update_dpp(0, (int)v, 0xB1, 0xf, 0xf, false); v += (unsigned)__builtin_amdgcn_update_dpp(0, (int)v, 0x4E, 0xf, 0xf, false);
    v += (unsigned)__builtin_amdgcn_update_dpp(0, (int)v, 0x141, 0xf, 0xf, false); v += (unsigned)__builtin_amdgcn_update_dpp(0, (int)v, 0x140, 0xf, 0xf, false);
    return ((unsigned)__builtin_amdgcn_readlane((int)v, 0) + (unsigned)__builtin_amdgcn_readlane((int)v, 16)) + ((unsigned)__builtin_amdgcn_readlane((int)v, 32) + (unsigned)__builtin_amdgcn_readlane((int)v, 48));
}
__device__ __forceinline__ int count_ge_v(const unsigned (&k)[8], unsigned thr) { unsigned c = 0;
#pragma unroll
    for (int j = 0; j < 8; ++j) c += (k[j] >= thr) ? 1u : 0u;
    return (int)wave_usum(c); }
template <bool FINAL> __device__ __forceinline__ void select2(LAS unsigned* cb, int* n, unsigned* tk, int lane, LAS unsigned short* sel_out, LAS unsigned* trash) {
    unsigned k[2][NE];
#pragma unroll
    for (int q = 0; q < 2; ++q)
#pragma unroll
        for (int j = 0; j < NE; ++j) { const int e = lane + 64 * j; const bool v = e < n[q]; const unsigned en = cb[(size_t)q * CAP + (v ? e : 0)]; k[q][j] = v ? en : 0u; }
    unsigned lo[2], hx[2]; int clo[2];
#pragma unroll
    for (int q = 0; q < 2; ++q) { unsigned mn = 0xffffffffu, mxv = 0u;
#pragma unroll
        for (int j = 0; j < NE; ++j) { mxv = max(mxv, k[q][j]); mn = min(mn, k[q][j] ? k[q][j] : 0xffffffffu); }
        lo[q] = wave_umin(mn); hx[q] = wave_umax(mxv) + 1u; clo[q] = n[q]; }
    const int accept = FINAL ? 256 : KEEP_MAX;
    for (int it = 0; it < 40; ++it) {
        unsigned mid[2]; int c[2]; bool any = false;
#pragma unroll
        for (int q = 0; q < 2; ++q) mid[q] = lo[q] + ((hx[q] - lo[q]) >> 1);
        {
            unsigned v = 0u;
#pragma unroll
            for (int q = 0; q < 2; ++q) { unsigned cl = 0;
#pragma unroll
                for (int j = 0; j < NE; ++j) cl += (k[q][j] >= mid[q]) ? 1u : 0u;
                v |= cl << (16 * q); }
            v += (unsigned)__builtin_amdgcn_update_dpp(0, (int)v, 0xB1, 0xf, 0xf, false); v += (unsigned)__builtin_amdgcn_update_dpp(0, (int)v, 0x4E, 0xf, 0xf, false);
            v += (unsigned)__builtin_amdgcn_update_dpp(0, (int)v, 0x141, 0xf, 0xf, false); v += (unsigned)__builtin_amdgcn_update_dpp(0, (int)v, 0x140, 0xf, 0xf, false);
            unsigned sm = 0;
#pragma unroll
            for (int r = 0; r < 4; ++r) sm += (unsigned)__builtin_amdgcn_readlane((int)v, 16 * r);
            c[0] = (int)(sm & 0xffffu); c[1] = (int)(sm >> 16);
        }
#pragma unroll
        for (int q = 0; q < 2; ++q) { const bool upd = (clo[q] > accept) && (hx[q] - lo[q] > 1u), ge = c[q] >= 256;
            lo[q] = (upd && ge) ? mid[q] : lo[q]; clo[q] = (upd && ge) ? c[q] : clo[q]; hx[q] = (upd && !ge) ? mid[q] : hx[q]; any = any || upd; }
        if (!any) break;
    }
#pragma unroll
    for (int q = 0; q < 2; ++q) {
        const unsigned Tk = lo[q];
        int running = 0;
#pragma unroll
        for (int j = 0; j < NE; ++j) {
            const bool take = k[q][j] >= Tk;
            const unsigned long long mt = __ballot(take);
            const int pos = running + prefix64(mt);
            if (FINAL) { LAS unsigned short* dst = (take && pos < 256) ? sel_out + q * 256 + pos : (LAS unsigned short*)trash + lane; *dst = (unsigned short)(8191u - (k[q][j] & 0x1fffu)); }
            else { LAS unsigned* dst = take ? cb + (size_t)q * CAP + pos : trash + lane; *dst = k[q][j]; }
            running += __popcll(mt);
        }
        tk[q] = Tk; n[q] = running;
    }
}
template <bool FINAL> __device__ __forceinline__ void select4(LAS unsigned* cb, int (&n)[4], unsigned (&tk)[4], int lane, LAS unsigned short* sel_out, LAS unsigned* trash) {
    select2<FINAL>(cb, &n[0], &tk[0], lane, sel_out, trash);
    select2<FINAL>(cb + 2 * CAP, &n[2], &tk[2], lane, sel_out + 512, trash);
}
struct AttnArgs { const bf16* QA; const bf16* KA; const bf16* VA; const int* positions; bf16* OA; };
__device__ __forceinline__ void unit(int b, int g, const bf16* QI, const bf16* KI, const float* WI, const AttnArgs& AA, LAS unsigned char* lds, int variant) {
    const int q0 = g * 32, L = 64 * (q0 / 64 + 1);
    const int tid = threadIdx.x, lane = tid & 63, c = lane & 31, hi = lane >> 5; const int wid = __builtin_amdgcn_readfirstlane(tid >> 6);
    const size_t rowbase = (size_t)b * T; const int ntile = L / 64;
    LAS unsigned char* wreg = lds + L_CAND + (size_t)wid * (4 * CAP * 4);
    LAS unsigned short* selT = (LAS unsigned short*)wreg;
    if (L > 256) {
    bf16x8 Af[4];
    { const int r = c, jq = ((r >> 2) & 1) + 2 * (r >> 4), hd = (r & 3) + 4 * ((r >> 3) & 1);
      const bf16* qp = QI + (rowbase + q0 + 4 * wid + jq) * 512 + hd * 64 + 8 * hi;
#pragma unroll
      for (int s = 0; s < 4; ++s) Af[s] = *(const bf16x8*)(qp + 16 * s); }
    bf16x8 Wa[2][2];
#pragma unroll
    for (int a = 0; a < 2; ++a)
#pragma unroll
        for (int s2 = 0; s2 < 2; ++s2) { const int qq = c - 4 * a; const bool on = (qq == hi + 2 * s2);
            const float* wp = WI + (rowbase + q0 + 4 * wid + (on ? qq : 0)) * 8; const f32x4 x = *(const f32x4*)wp, y = *(const f32x4*)(wp + 4);
            const float sc = on ? (0.125f * 0.35355339059327373f) : 0.f;
            const pg8::u32x4 w = {pg8::cvt_pk_bf16(x[0] * sc, x[1] * sc), pg8::cvt_pk_bf16(x[2] * sc, x[3] * sc), pg8::cvt_pk_bf16(y[0] * sc, y[1] * sc), pg8::cvt_pk_bf16(y[2] * sc, y[3] * sc)};
            Wa[a][s2] = __builtin_bit_cast(bf16x8, w); }
    float tau[4] = {-INFINITY, -INFINITY, -INFINITY, -INFINITY}; int cnt[4] = {0, 0, 0, 0};
    LAS unsigned* cbase = (LAS unsigned*)(lds + L_CAND) + (size_t)(wid * 4) * CAP;
    LAS unsigned* trash = (LAS unsigned*)((LAS u32x2*)(lds + L_TRASH) + wid * 64);
    const bf16* kp = KI + (rowbase >> 5) * 2048 + (size_t)lane * 8;
    bf16x8 Ba[8], Bb[8];
#define IDX_LOAD(dst, tt) do { _Pragma("unroll") for (int i_ = 0; i_ < 8; ++i_) dst[i_] = *(const bf16x8*)(kp + (size_t)((2 * (tt) + (i_ >> 2)) * 4 + (i_ & 3)) * 512); } while (0)
#define IDX_RELU8(X, s2) ({ typedef short s16x2_ __attribute__((ext_vector_type(2))); pg8::u32x4 w_; \
        _Pragma("unroll") for (int p_ = 0; p_ < 4; ++p_) { const unsigned u_ = pg8::cvt_pk_bf16(X[8 * (s2) + 2 * p_], X[8 * (s2) + 2 * p_ + 1]); \
            w_[p_] = __builtin_bit_cast(unsigned, __builtin_elementwise_max(__builtin_bit_cast(s16x2_, u_), (s16x2_){0, 0})); } \
        __builtin_bit_cast(bf16x8, w_); })
#define IDX_TILE(Bf, tt) do { \
        f32x16 acc0, acc1, d2; \
        _Pragma("unroll") for (int r_ = 0; r_ < 16; ++r_) { acc0[r_] = 0.f; acc1[r_] = 0.f; d2[r_] = 0.f; } \
        _Pragma("unroll") for (int s4 = 0; s4 < 4; ++s4) { acc0 = __builtin_amdgcn_mfma_f32_32x32x16_bf16(Af[s4], Bf[s4], acc0, 0, 0, 0); acc1 = __builtin_amdgcn_mfma_f32_32x32x16_bf16(Af[s4], Bf[4 + s4], acc1, 0, 0, 0); } \
        d2 = __builtin_amdgcn_mfma_f32_32x32x16_bf16(Wa[0][0], IDX_RELU8(acc0, 0), d2, 0, 0, 0); d2 = __builtin_amdgcn_mfma_f32_32x32x16_bf16(Wa[0][1], IDX_RELU8(acc0, 1), d2, 0, 0, 0); \
        d2 = __builtin_amdgcn_mfma_f32_32x32x16_bf16(Wa[1][0], IDX_RELU8(acc1, 0), d2, 0, 0, 0); d2 = __builtin_amdgcn_mfma_f32_32x32x16_bf16(Wa[1][1], IDX_RELU8(acc1, 1), d2, 0, 0, 0); \
        bool ps[4]; unsigned long long mk[4]; \
        _Pragma("unroll") for (int q_ = 0; q_ < 4; ++q_) { ps[q_] = d2[q_] > tau[q_]; mk[q_] = __ballot(ps[q_]); } \
        if ((mk[0] | mk[1] | mk[2] | mk[3]) != 0ull) { \
            _Pragma("unroll") for (int q_ = 0; q_ < 4; ++q_) { \
                const int pre = (int)__builtin_amdgcn_mbcnt_hi((unsigned)(mk[q_] >> 32), __builtin_amdgcn_mbcnt_lo((unsigned)mk[q_], 0u));     \
                LAS unsigned* dst = ps[q_] ? cbase + (size_t)q_ * CAP + cnt[q_] + pre : trash + lane; \
                *dst = (okey(d2[q_]) & 0xffffe000u) | (8191u - (unsigned)((tt) * 64 + lane)); \
                cnt[q_] += (int)__popcll(mk[q_]); } } \
    } while (0)
    IDX_LOAD(Ba, 0); IDX_LOAD(Bb, 1);
    for (int t = 0; t < ntile; t += 2) {
#define IDX_CHECK() do { if (max(max(cnt[0], cnt[1]), max(cnt[2], cnt[3])) > TRIG) { int n4[4] = {cnt[0], cnt[1], cnt[2], cnt[3]}; unsigned tk4[4]; \
            PROF_T0(1); select4<false>(cbase, n4, tk4, lane, (LAS unsigned short*)nullptr, trash); PROF_T1(1, lds, wid, lane); \
            _Pragma("unroll") for (int q_ = 0; q_ < 4; ++q_) { cnt[q_] = n4[q_]; tau[q_] = ikey(tk4[q_] | 0x1fffu); } } } while (0)
        IDX_CHECK();
        IDX_TILE(Ba, t);
        if (t + 2 < ntile) IDX_LOAD(Ba, t + 2);
        if (t + 1 < ntile) { IDX_TILE(Bb, t + 1); if (t + 3 < ntile) IDX_LOAD(Bb, t + 3); }
    }
#undef IDX_RELU8
#undef IDX_LOAD
#undef IDX_TILE
#undef IDX_CHECK
    asm volatile("s_waitcnt lgkmcnt(0)" ::: "memory");
    { int n4[4] = {cnt[0], cnt[1], cnt[2], cnt[3]}; unsigned tk4[4];
      PROF_T0(2); select4<true>(cbase, n4, tk4, lane, selT, trash); PROF_T1(2, lds, wid, lane); }
    } else {
#pragma unroll
        for (int jq = 0; jq < 4; ++jq)
#pragma unroll
            for (int j = 0; j < 4; ++j) { const int k = lane + 64 * j; selT[jq * 256 + k] = (unsigned short)(k < L ? k : L - 1); }
    }
    asm volatile("s_waitcnt lgkmcnt(0)" ::: "memory");
    PROF_T0(8);
    for (int jq = 0; jq < 4; ++jq)
        dsa::query((int)(rowbase + q0 + 4 * wid + jq), AA.QA, AA.KA, AA.VA, AA.positions, AA.OA, wreg + 2048, selT + jq * 256, (LAS unsigned char*)((LAS u32x2*)(lds + L_TRASH) + wid * 64), (const LAS float*)(lds + L_BIAS), lane);
    PROF_T1(8, lds, wid, lane);
}
__device__ __forceinline__ void phase(int vcu, int G, const bf16* QI, const bf16* KI, const float* WI, const AttnArgs& AA, const float* rel_bias, LAS unsigned char* lds, int variant) {
    { LAS float* bt = (LAS float*)(lds + L_BIAS); for (int i = threadIdx.x; i < 33 * 8; i += NWAVES * 64) bt[i] = (i < 256) ? rel_bias[i] * dsa::LOG2E : -INFINITY; }
    __syncthreads();
    PROF_T0(7);
    const int wrot = 0, nun = (1024 - vcu + G - 1) / G;
    for (int ii = 0; ii < nun; ++ii) { const int u = vcu + ((ii + wrot) % nun) * G; const int i = u >> 8, v = u & 255, b = v >> 6, s = v & 63;
        const int g = (i == 0) ? s : (i == 1) ? 127 - s : (i == 2) ? 128 + s : 255 - s;
        unit(b, g, QI, KI, WI, AA, lds, variant); }
    PROF_T1(7, lds, (int)__builtin_amdgcn_readfirstlane(threadIdx.x >> 6), (int)(threadIdx.x & 63));
    __syncthreads();
}
}


struct PhaseTimer { unsigned long long t0; int k; LAS unsigned char* l; int w, ln; bool once;
    __device__ __forceinline__ PhaseTimer(int k_, LAS unsigned char* l_, int w_, int ln_) : t0(0), k(k_), l(l_), w(w_), ln(ln_), once(true) { if (PROF_SEL == 20 + k) t0 = __builtin_amdgcn_s_memrealtime(); }
    __device__ __forceinline__ void stop() { once = false; if (PROF_SEL == 20 + k) { const unsigned d = (unsigned)(__builtin_amdgcn_s_memrealtime() - t0); if (ln == 0) *PROF_WORD(l, w) += d; } } };
constexpr int NPHASE = 16;
__global__ void __launch_bounds__(NWAVES * 64, 2) mk_fwd(Args args) {
    extern __shared__ __attribute__((aligned(16))) unsigned char lds[];
    Frame F;
    F.lds = (LAS unsigned char*)lds;
    F.MISC = (volatile LAS unsigned*)(F.lds + MISC_OFF);
    F.tid = threadIdx.x; F.lane = F.tid & 63; F.wave = __builtin_amdgcn_readfirstlane(F.tid >> 6);
    F.G = gridDim.x; { const int bx = blockIdx.x; F.vcu = (F.G % 8 == 0) ? (bx % 8) * (F.G / 8) + bx / 8 : bx; }
    unsigned char* ws = args.ws;
    F.ctl = (gu32*)(ws + WS_CTL);
    for (int u = F.tid; u < (LDS_BYTES - LDSCTL_OFF) / 4; u += NWAVES * 64) ((LAS unsigned*)(F.lds + LDSCTL_OFF))[u] = 0u;
    __syncthreads();
    XcdBarrier bar; bar.bar = (unsigned*)(F.ctl + CW_BAR); bar.x = 0; bar.st = nullptr;
    if (MK_FUSED) bar = xcd_barrier_post((unsigned*)(F.ctl + CW_BAR), F.MISC + 8);
#define GRID_BAR() do { if (MK_FUSED) { PROF_T0(50); xcd_barrier(bar); PROF_T1(50, F.lds + RING_OFF, F.wave, F.lane); } } while (0)
    const int lo = args.ph_lo, hi = args.ph_hi;
#ifdef ONLY_PH
#define IN(k) ((k) == ONLY_PH && lo <= (k) && (k) < hi)
#else
#define IN(k) (lo <= (k) && (k) < hi)
#endif
#define BOTH(k) (IN(k) && IN((k) + 1))
#ifndef DUP_PH
#define DUP_PH -1
#endif
#ifndef P7_VARIANT
#define P7_VARIANT 0
#endif
#define PHASE_TIMED(k) for (PhaseTimer pt_((k), F.lds + RING_OFF, F.wave, F.lane); pt_.once; pt_.stop())
#define REP(k) for (int rep_ = 0; rep_ < ((k) == DUP_PH ? 2 : 1); ++rep_)
    const float* x = (const float*)args.in[0];
    const float* mod = (const float*)(ws + WS_MOD);
    bf16* XN = (bf16*)(ws + WS_XN); bf16* ACT = (bf16*)(ws + WS_ACT);
    bf16* XS = (bf16*)args.out;
    bf16* X3 = (bf16*)(ws + WS_XN);
    const float* rcos = (const float*)(ws + WS_RCOS); const float* rsin = (const float*)(ws + WS_RSIN);
    float* ssq_q = (float*)(ws + WS_SSQQ); float* ssq_kv = (float*)(ws + WS_SSQKV);

    if (IN(0)) REP(0) PHASE_TIMED(0) { p0_prologue(F, args); if (BOTH(0)) GRID_BAR(); }
    if (IN(1)) REP(1) PHASE_TIMED(1) { norm_mod_phase(F, x, (const float*)args.in[5], mod, 0 * D, 1 * D, XN); if (BOTH(1)) GRID_BAR(); }
    if (IN(2)) REP(2) PHASE_TIMED(2) {
        pg8::Gemm g{XN, (const bf16*)(ws + WS_W1A), M, 2 * DFF, D}; pg8::StaticOrder S; S.init(M, 2 * DFF, F.G, (int)blockIdx.x);
        pg8::EpiSwiglu E{ACT, DFF};
        pg8::gemm_phase<pg8::EpiSwiglu, pg8::StaticOrder, true, true>(F.lds + RING_OFF, g, S, E);
        if (BOTH(2)) GRID_BAR(); }
    if (IN(3)) REP(3) PHASE_TIMED(3) {
        pg8::Gemm g{ACT, (const bf16*)(ws + WS_W1D), M, D, DFF}; pg8::StaticOrder S; S.init(M, D, F.G, (int)blockIdx.x);
        pg8::EpiResidB<false> E{x, XS, mod, 2 * D, 0.5f};
        pg8::gemm_phase<pg8::EpiResidB<false>, pg8::StaticOrder, true, true>(F.lds + RING_OFF, g, S, E);
        if (BOTH(3)) GRID_BAR(); }
    if (IN(4)) REP(4) PHASE_TIMED(4) { norm_mod_phase_b(F, XS, (const float*)args.in[8], mod, 3 * D, 4 * D, XN); if (BOTH(4)) GRID_BAR(); }
    if (IN(5)) REP(5) PHASE_TIMED(5) {
        pg8::Gemm g{XN, (const bf16*)(ws + WS_WIN), M, NPROJ, D}; pg8::StaticOrder S; S.init(M, NPROJ, F.G, (int)blockIdx.x);
        pg8::EpiProj E{(bf16*)(ws + WS_QA), (bf16*)(ws + WS_QI), (bf16*)(ws + WS_CQ), (bf16*)(ws + WS_CKV), (bf16*)(ws + WS_KA), (bf16*)(ws + WS_VA), (bf16*)(ws + WS_KI), (bf16*)(ws + WS_KPE), (bf16*)(ws + WS_G),
                       (float*)(ws + WS_WI), ssq_q, ssq_kv, rcos, rsin};
        pg8::gemm_phase<pg8::EpiProj, pg8::StaticOrder, true, true>(F.lds + RING_OFF, g, S, E);
        if (BOTH(5)) GRID_BAR(); }
    if (IN(6)) REP(6) PHASE_TIMED(6) {
        { pg8::Gemm g{(const bf16*)(ws + WS_CQ), (const bf16*)(ws + WS_WUQ), M, 768, 384}; pg8::StaticOrder S; S.init(M, 768, F.G, (int)blockIdx.x);
          pg8::EpiUpQ E{(bf16*)(ws + WS_QB), ssq_q, rcos, rsin};
          pg8::gemm_phase<pg8::EpiUpQ, pg8::StaticOrder, true, true>(F.lds + RING_OFF, g, S, E); }
        __syncthreads();
        { pg8::Gemm g{(const bf16*)(ws + WS_CKV), (const bf16*)(ws + WS_WUKV), M, 1024, 256}; pg8::StaticOrder S; S.init(M, 1024, F.G, (int)blockIdx.x);
          pg8::EpiUpKV E{(bf16*)(ws + WS_KN), (bf16*)(ws + WS_VB), ssq_kv};
          pg8::gemm_phase<pg8::EpiUpKV, pg8::StaticOrder, true, true>(F.lds + RING_OFF, g, S, E); }
        __syncthreads(); }
    if (IN(7)) REP(7) PHASE_TIMED(7) { const idx::AttnArgs AA{(const bf16*)(ws + WS_QA), (const bf16*)(ws + WS_KA), (const bf16*)(ws + WS_VA), (const int*)args.in[2], (bf16*)(ws + WS_OA)};
        idx::phase(F.vcu, F.G, (const bf16*)(ws + WS_QI), (const bf16*)(ws + WS_KI), (const float*)(ws + WS_WI), AA, (const float*)args.in[15], F.lds + RING_OFF, P7_VARIANT); if (BOTH(7)) GRID_BAR(); }
    if (IN(9)) REP(9) PHASE_TIMED(9) { mla::phase(F.vcu, F.G, (const bf16*)(ws + WS_QB), (const bf16*)(ws + WS_KN), (const bf16*)(ws + WS_KPE), (const bf16*)(ws + WS_VB), (bf16*)(ws + WS_OB), F.lds + RING_OFF); if (BOTH(9)) GRID_BAR(); }
    if (IN(10)) REP(10) PHASE_TIMED(10) {
        pg8::Gemm g{(const bf16*)(ws + WS_OA), (const bf16*)(ws + WS_WOA), M, D, D}; pg8::StaticOrder S; S.init(M, D, F.G, (int)blockIdx.x);
        pg8::EpiGateR E{(const bf16*)(ws + WS_G), (bf16*)(ws + WS_Y)};
        pg8::gemm_phase<pg8::EpiGateR, pg8::StaticOrder, true, true>(F.lds + RING_OFF, g, S, E);
        if (BOTH(10)) GRID_BAR(); }
    if (IN(11)) PHASE_TIMED(11) {
        pg8::Gemm g{(const bf16*)(ws + WS_Y), (const bf16*)(ws + WS_WOUT), M, D, D}; pg8::StaticOrder S; S.init(M, D, F.G, (int)blockIdx.x);
        pg8::EpiResidB<true> E{XS, XS, mod, 5 * D, 1.0f};
        pg8::gemm_phase<pg8::EpiResidB<true>, pg8::StaticOrder, true, true>(F.lds + RING_OFF, g, S, E);
        if (BOTH(11)) GRID_BAR(); }
    if (IN(12)) REP(12) PHASE_TIMED(12) { norm_mod_phase_b(F, XS, (const float*)args.in[19], mod, 6 * D, 7 * D, XN); if (BOTH(12)) GRID_BAR(); }
    if (IN(13)) REP(13) PHASE_TIMED(13) {
        pg8::Gemm g{XN, (const bf16*)(ws + WS_W2A), M, 2 * DFF, D}; pg8::StaticOrder S; S.init(M, 2 * DFF, F.G, (int)blockIdx.x);
        pg8::EpiSwiglu E{ACT, DFF};
        pg8::gemm_phase<pg8::EpiSwiglu, pg8::StaticOrder, true, true>(F.lds + RING_OFF, g, S, E);
        if (BOTH(13)) GRID_BAR(); }
    if (IN(14)) PHASE_TIMED(14) {
        pg8::Gemm g{ACT, (const bf16*)(ws + WS_W2D), M, D, DFF}; pg8::StaticOrder S; S.init(M, D, F.G, (int)blockIdx.x);
        pg8::EpiResidB<true> E{XS, X3, mod, 8 * D, 0.5f};
        pg8::gemm_phase<pg8::EpiResidB<true>, pg8::StaticOrder, true, true>(F.lds + RING_OFF, g, S, E);
        if (BOTH(14)) GRID_BAR(); }
    if (IN(15)) PHASE_TIMED(15) { final_norm_phase_b(F, X3, (const float*)args.in[22], args.out); }
    if (PROF_SEL != 0) { asm volatile("s_waitcnt lgkmcnt(0)" ::: "memory"); const unsigned a_ = *PROF_WORD(F.lds + RING_OFF, F.wave); const unsigned long long t0_ = __builtin_amdgcn_s_memrealtime();
        while (__builtin_amdgcn_s_memrealtime() - t0_ < (unsigned long long)a_ * PROF_MULT) __builtin_amdgcn_s_sleep(32); }
#undef IN
#undef BOTH
}

extern "C" void kernel_launch(void* const* d_in, const int* in_sizes, int n_in, void* d_out, int out_size, void* d_ws, size_t ws_size, hipStream_t stream) {
    static int grid = 0;
    if (grid == 0) {
        if (n_in != 23 || out_size != M * D || ws_size < WS_END + 4096) { fprintf(stderr, "kernel_launch: unexpected problem shape (n_in %d, out %d, ws %zu)\n", n_in, out_size, ws_size); grid = -1; return; }
        int dev = 0, cus = 0, per_cu = 0;
        if (hipGetDevice(&dev) != hipSuccess || hipDeviceGetAttribute(&cus, hipDeviceAttributeMultiprocessorCount, dev) != hipSuccess) { grid = -1; return; }
        if (hipFuncSetAttribute((const void*)mk_fwd, hipFuncAttributeMaxDynamicSharedMemorySize, LDS_BYTES) != hipSuccess) { fprintf(stderr, "kernel_launch: hipFuncSetAttribute failed\n"); grid = -1; return; }
        if (hipOccupancyMaxActiveBlocksPerMultiprocessor(&per_cu, (const void*)mk_fwd, NWAVES * 64, LDS_BYTES) != hipSuccess || per_cu < 1) fprintf(stderr, "kernel_launch: occupancy query reports %d\n", per_cu);
        (void)hipGetLastError();
        grid = cus;
    }
    if (grid < 0) return;
    (void)in_sizes;
    if (hipMemsetAsync((char*)d_ws + WS_CTL, 0, CTL_ZERO_BYTES, stream) != hipSuccess) return;
    Args a{};
    for (int i = 0; i < 23; ++i) a.in[i] = d_in[i];
    a.out = (float*)d_out; a.ws = (unsigned char*)d_ws;
    auto launch = [&](int lo, int hi) { a.ph_lo = lo; a.ph_hi = hi; a.li = 0; hipLaunchKernelGGL(mk_fwd, dim3(grid), dim3(NWAVES * 64), LDS_BYTES, stream, a); };
#if MK_FUSED
    launch(0, NPHASE);
#else
    for (int p = 0; p < NPHASE; ++p) launch(p, p + 1);
#endif
}
```
